# Optimizing an MI355X kernel written in HIP

```python
import jax, jax.numpy as jnp
from jax import lax
import numpy as np

D_MODEL = 1024
BATCH = 4
SEQ = 4096
DEPTH = 1
DEC_BATCH = 128
DEC_SEQ = 8
PAST_LEN = 8192
PAGE_SIZE = 128

HD = 64
N_ATT_HEADS = D_MODEL // 128
ATT_WIDTH = N_ATT_HEADS * HD
MLSTM_HEADS = 4
MLSTM_WIDTH = D_MODEL - ATT_WIDTH
MLSTM_HD = MLSTM_WIDTH // MLSTM_HEADS
ROT_DIM = HD // 4
ROPE_THETA = 500000.0
DILATED = ((128, 1), (512, 4), (2048, 16))
MAX_WINDOW = 2048
BLOCK = 128
CONV_W = 4
CHUNK = 128
D_FF = 4 * D_MODEL
EPS = 1e-6
IN_SIZES = (ATT_WIDTH, ATT_WIDTH, ATT_WIDTH, 2 * MLSTM_WIDTH, MLSTM_WIDTH, MLSTM_WIDTH, 2 * MLSTM_HEADS)
IN_COLS = sum(IN_SIZES)
IN_SPLITS = tuple(int(s) for s in np.cumsum(IN_SIZES)[:-1])

kernel_name = 'dilated_swa_mlstm_hybrid_step'


def rms_norm(x, g):
    xf = x.astype(jnp.float32)
    y = xf * lax.rsqrt(jnp.mean(xf * xf, axis=-1, keepdims=True) + EPS)
    return (y * g.astype(jnp.float32)).astype(x.dtype)


def rotary(x, pos):
    half = ROT_DIM // 2
    inv_freq = ROPE_THETA ** (-jnp.arange(half, dtype=jnp.float32) / half)
    ang = pos.astype(jnp.float32)[:, None] * inv_freq[None, :]
    cos = jnp.cos(ang)[None, :, None, :]
    sin = jnp.sin(ang)[None, :, None, :]
    x1 = x[..., :half].astype(jnp.float32)
    x2 = x[..., half:ROT_DIM].astype(jnp.float32)
    rot = jnp.concatenate([x1 * cos - x2 * sin, x2 * cos + x1 * sin], axis=-1).astype(x.dtype)
    return jnp.concatenate([rot, x[..., ROT_DIM:]], axis=-1)


def from_blocks(x, B, S, dil):
    L = S // dil
    rest = x.shape[3:]
    x = x.reshape((B, dil, -1) + rest)[:, :, :L]
    perm = (0, 2, 1) + tuple(range(3, x.ndim))
    return x.transpose(perm).reshape((B, S) + rest)


def banded_residue_attention(q, k, v, window, dil):
    B, S, H, Dh = q.shape
    L = S // dil
    nb = -(-L // BLOCK)
    Lp = nb * BLOCK
    sub_w = window // dil

    def to_blocks(x):
        x = x.reshape(B, L, dil, H, Dh).transpose(0, 2, 1, 3, 4).reshape(B * dil, L, H, Dh)
        x = jnp.pad(x, ((0, 0), (0, Lp - L), (0, 0), (0, 0)))
        return x.reshape(B * dil, nb, BLOCK, H, Dh)

    def with_prev(x):
        prev = jnp.pad(x[:, :-1], ((0, 0), (1, 0), (0, 0), (0, 0), (0, 0)))
        return jnp.concatenate([prev, x], axis=2)

    qb = to_blocks(q)
    kk = with_prev(to_blocks(k))
    vv = with_prev(to_blocks(v))
    s = jnp.einsum('bnqhd,bnkhd->bnhqk', qb, kk, preferred_element_type=jnp.float32)
    qi = jnp.arange(BLOCK)
    ki = jnp.arange(2 * BLOCK) - BLOCK
    rel = qi[:, None] - ki[None, :]
    start = jnp.arange(nb) * BLOCK
    valid = ((rel >= 0) & (rel <= sub_w))[None] & ((start[:, None, None] + ki[None, None, :]) >= 0)
    s = jnp.where(valid[None, :, None], s, -jnp.inf)
    mx = jnp.max(s, axis=-1, keepdims=True)
    p = jnp.exp(s - mx)
    den = jnp.sum(p, axis=-1)
    o = jnp.einsum('bnhqk,bnkhd->bnqhd', p.astype(v.dtype), vv, preferred_element_type=jnp.float32)
    o = o / jnp.swapaxes(den, 2, 3)[..., None]
    lse = jnp.swapaxes(mx[..., 0] + jnp.log(den), 2, 3)
    return from_blocks(o, B, S, dil), from_blocks(lse, B, S, dil)


def combine_by_denominator(outs, lses):
    w = jax.nn.softmax(jnp.stack(lses, 0), axis=0)
    return jnp.einsum('gbth,gbthd->bthd', w, jnp.stack(outs, 0))


def dilated_attention_prompt(q, k, v):
    outs, lses = [], []
    for window, dil in DILATED:
        o, lse = banded_residue_attention(q, k, v, window, dil)
        outs.append(o)
        lses.append(lse)
    return combine_by_denominator(outs, lses)


def dilated_attention_sample(q, kc, vc):
    B, T, H, Dh = q.shape
    W = kc.shape[1] - T
    ti = jnp.arange(T)
    outs, lses = [], []
    for window, dil in DILATED:
        j = jnp.arange(window // dil + 1)
        idx = W + ti[:, None] - dil * j[None, :]
        valid = idx >= 0
        idx = jnp.maximum(idx, 0)
        kg = kc[:, idx]
        vg = vc[:, idx]
        s = jnp.einsum('bthd,btjhd->bthj', q, kg, preferred_element_type=jnp.float32)
        s = jnp.where(valid[None, :, None, :], s, -jnp.inf)
        mx = jnp.max(s, axis=-1, keepdims=True)
        p = jnp.exp(s - mx)
        den = jnp.sum(p, axis=-1)
        o = jnp.einsum('bthj,btjhd->bthd', p.astype(vc.dtype), vg, preferred_element_type=jnp.float32)
        outs.append(o / den[..., None])
        lses.append(mx[..., 0] + jnp.log(den))
    return combine_by_denominator(outs, lses)


def mlstm_chunkwise(q, k, v, ig, lf, C0, n0, m0, chunk):
    B, T, H, D = q.shape
    nc = T // chunk
    to_c4 = lambda x: x.reshape(B, nc, chunk, H, D).transpose(1, 0, 3, 2, 4)
    to_c3 = lambda x: x.reshape(B, nc, chunk, H).transpose(1, 0, 3, 2)
    causal = jnp.tril(jnp.ones((chunk, chunk), dtype=bool))

    def step(carry, inp):
        C, n, m = carry
        qc, kc, vc, igc, lfc = inp
        b = jnp.cumsum(lfc, axis=-1)
        a = b + m[..., None]
        Dm = b[..., :, None] - b[..., None, :] + igc[..., None, :]
        Dm = jnp.where(causal, Dm, -jnp.inf)
        mt = jnp.maximum(a, jnp.max(Dm, axis=-1))
        w_inter = jnp.exp(a - mt)
        Wm = jnp.exp(Dm - mt[..., None])
        sc = jnp.einsum('bhtd,bhsd->bhts', qc, kc) * Wm
        num = w_inter[..., None] * jnp.einsum('bhtd,bhde->bhte', qc, C) + jnp.einsum('bhts,bhse->bhte', sc, vc)
        den = w_inter * jnp.einsum('bhtd,bhd->bht', qc, n) + jnp.sum(sc, axis=-1)
        h = num / jnp.maximum(jnp.abs(den), jnp.exp(-mt))[..., None]
        mT = mt[..., -1]
        wT_inter = jnp.exp(a[..., -1] - mT)
        wT = jnp.exp(b[..., -1:] - b + igc - mT[..., None])
        C_new = wT_inter[..., None, None] * C + jnp.einsum('bhs,bhsd,bhse->bhde', wT, kc, vc)
        n_new = wT_inter[..., None] * n + jnp.einsum('bhs,bhsd->bhd', wT, kc)
        return (C_new, n_new, mT), h

    (C1, n1, m1), hs = lax.scan(step, (C0, n0, m0), (to_c4(q), to_c4(k), to_c4(v), to_c3(ig), to_c3(lf)))
    h = hs.transpose(1, 0, 3, 2, 4).reshape(B, T, H, D)
    return h, C1, n1, m1


def mixer_block(h, pos, past, w_in, b_gate, w_conv, b_conv, mh_norm_g, w_out):
    B, T, _ = h.shape
    f32 = jnp.float32
    proj = jnp.einsum('btd,dc->btc', h, w_in)
    qa, ka, va, qk_raw, vb, ob, gates = jnp.split(proj, IN_SPLITS, axis=-1)
    qa = rotary(qa.reshape(B, T, N_ATT_HEADS, HD), pos) * (HD ** -0.5)
    ka = rotary(ka.reshape(B, T, N_ATT_HEADS, HD), pos)
    va = va.reshape(B, T, N_ATT_HEADS, HD)
    if past is None:
        att = dilated_attention_prompt(qa, ka, va)
        n_keep = min(MAX_WINDOW, T)
        new_k, new_v = ka[:, T - n_keep:], va[:, T - n_keep:]
        conv_buf = jnp.zeros((B, CONV_W - 1, 2 * MLSTM_WIDTH), h.dtype)
        C0 = jnp.zeros((B, MLSTM_HEADS, MLSTM_HD, MLSTM_HD), f32)
        n0 = jnp.zeros((B, MLSTM_HEADS, MLSTM_HD), f32)
        m0 = jnp.zeros((B, MLSTM_HEADS), f32)
        chunk = CHUNK if T % CHUNK == 0 else T
    else:
        win_k, win_v, conv_buf, C0, n0, m0 = past
        kc = jnp.concatenate([win_k.astype(ka.dtype), ka], axis=1)
        vc = jnp.concatenate([win_v.astype(va.dtype), va], axis=1)
        att = dilated_attention_sample(qa, kc, vc)
        n_keep = win_k.shape[1]
        new_k, new_v = kc[:, -n_keep:], vc[:, -n_keep:]
        C0, n0, m0 = C0.astype(f32), n0.astype(f32), m0.astype(f32)
        chunk = T
    xp = jnp.concatenate([conv_buf.astype(h.dtype), qk_raw], axis=1)
    conv = b_conv + sum(xp[:, w:w + T] * w_conv[w] for w in range(CONV_W))
    new_conv = xp[:, T:]
    qb, kb = jnp.split(jax.nn.silu(conv), 2, axis=-1)
    qb = qb.reshape(B, T, MLSTM_HEADS, MLSTM_HD).astype(f32)
    kb = kb.reshape(B, T, MLSTM_HEADS, MLSTM_HD).astype(f32) * (MLSTM_HD ** -0.5)
    vb = vb.reshape(B, T, MLSTM_HEADS, MLSTM_HD).astype(f32)
    ig, fg = jnp.split((gates + b_gate).astype(f32), 2, axis=-1)
    lf = jax.nn.log_sigmoid(fg)
    hb, C1, n1, m1 = mlstm_chunkwise(qb, kb, vb, ig, lf, C0, n0, m0, chunk)
    hb = hb * lax.rsqrt(jnp.mean(hb * hb, axis=-1, keepdims=True) + EPS)
    hb = hb * mh_norm_g.reshape(MLSTM_HEADS, MLSTM_HD).astype(f32)
    hb = hb * jax.nn.sigmoid(ob.reshape(B, T, MLSTM_HEADS, MLSTM_HD).astype(f32))
    mix = jnp.concatenate([att.reshape(B, T, ATT_WIDTH).astype(h.dtype), hb.reshape(B, T, MLSTM_WIDTH).astype(h.dtype)], axis=-1)
    out = jnp.einsum('btc,cd->btd', mix, w_out)
    dt = h.dtype
    return out, (new_k, new_v, new_conv, C1.astype(dt), n1.astype(dt), m1.astype(dt))


def sqrelu_mlp(h, w_up, w_down):
    u = jnp.einsum('btd,df->btf', h, w_up)
    return jnp.einsum('btf,fd->btd', jnp.square(jax.nn.relu(u)), w_down)


def setup_inputs(seed: int = 0) -> dict:
    key = jax.random.key(seed)
    ks = jax.random.split(key, 20)
    nrm = jax.random.normal
    wb = min(MAX_WINDOW, PAST_LEN)
    f_bias = jnp.linspace(3.0, 6.0, MLSTM_HEADS, dtype=jnp.float32)[None, :] + 0.1 * nrm(ks[9], (DEPTH, MLSTM_HEADS))
    i_bias = 0.1 * nrm(ks[10], (DEPTH, MLSTM_HEADS))
    return {
        'x_prompt': nrm(ks[0], (BATCH, SEQ, D_MODEL), jnp.float32),
        'x_sample': nrm(ks[1], (DEC_BATCH, DEC_SEQ, D_MODEL), jnp.float32),
        'cache_win_k': nrm(ks[2], (DEPTH, DEC_BATCH, wb, N_ATT_HEADS, HD), jnp.float32),
        'cache_win_v': nrm(ks[3], (DEPTH, DEC_BATCH, wb, N_ATT_HEADS, HD), jnp.float32),
        'state_conv': nrm(ks[4], (DEPTH, DEC_BATCH, CONV_W - 1, 2 * MLSTM_WIDTH), jnp.float32),
        'state_C': 0.2 * nrm(ks[5], (DEPTH, DEC_BATCH, MLSTM_HEADS, MLSTM_HD, MLSTM_HD), jnp.float32),
        'state_n': 0.2 * nrm(ks[6], (DEPTH, DEC_BATCH, MLSTM_HEADS, MLSTM_HD), jnp.float32),
        'state_m': jax.random.uniform(ks[7], (DEPTH, DEC_BATCH, MLSTM_HEADS), jnp.float32, 0.0, 4.0),
        'norm1_g': 1.0 + 0.01 * nrm(ks[8], (DEPTH, D_MODEL)),
        'w_in': nrm(ks[11], (DEPTH, D_MODEL, IN_COLS)) * D_MODEL ** -0.5,
        'b_gate': jnp.concatenate([i_bias, f_bias], axis=-1),
        'w_conv': nrm(ks[12], (DEPTH, CONV_W, 2 * MLSTM_WIDTH)) * CONV_W ** -0.5,
        'b_conv': 0.01 * nrm(ks[13], (DEPTH, 2 * MLSTM_WIDTH)),
        'mh_norm_g': 1.0 + 0.01 * nrm(ks[14], (DEPTH, MLSTM_WIDTH)),
        'w_out': nrm(ks[15], (DEPTH, D_MODEL, D_MODEL)) * D_MODEL ** -0.5,
        'norm2_g': 1.0 + 0.01 * nrm(ks[16], (DEPTH, D_MODEL)),
        'w_up': nrm(ks[17], (DEPTH, D_MODEL, D_FF)) * D_MODEL ** -0.5,
        'w_down': nrm(ks[18], (DEPTH, D_FF, D_MODEL)) * D_FF ** -0.5,
        'norm_f_g': 1.0 + 0.01 * nrm(ks[19], (D_MODEL,)),
    }


def reference(x_prompt, x_sample, cache_win_k, cache_win_v, state_conv, state_C, state_n, state_m,
              norm1_g, w_in, b_gate, w_conv, b_conv, mh_norm_g, w_out, norm2_g, w_up, w_down, norm_f_g):
    pos_p = jnp.arange(x_prompt.shape[1])
    pos_s = PAST_LEN + jnp.arange(x_sample.shape[1])
    hp, hs = x_prompt, x_sample
    st_p, st_s = [], []
    for l in range(DEPTH):
        params = (w_in[l], b_gate[l], w_conv[l], b_conv[l], mh_norm_g[l], w_out[l])
        a_p, sp = mixer_block(rms_norm(hp, norm1_g[l]), pos_p, None, *params)
        past = (cache_win_k[l], cache_win_v[l], state_conv[l], state_C[l], state_n[l], state_m[l])
        a_s, ss = mixer_block(rms_norm(hs, norm1_g[l]), pos_s, past, *params)
        hp = hp + a_p
        hs = hs + a_s
        hp = hp + sqrelu_mlp(rms_norm(hp, norm2_g[l]), w_up[l], w_down[l])
        hs = hs + sqrelu_mlp(rms_norm(hs, norm2_g[l]), w_up[l], w_down[l])
        st_p.append(sp)
        st_s.append(ss)
    y_prompt = rms_norm(hp, norm_f_g)
    y_sample = rms_norm(hs, norm_f_g)
    pk, pv, pconv, pC, pn, pm = (jnp.stack([s[i] for s in st_p], 0) for i in range(6))
    sk, sv, sconv, sC, sn, sm = (jnp.stack([s[i] for s in st_s], 0) for i in range(6))
    return (y_prompt, y_sample, pk, pv, pconv, pC, pn, pm, sk, sv, sconv, sC, sn, sm)
```

```cpp
#include <hip/hip_runtime.h>
#include <cstdio>
#include <cstdint>
namespace pg8 {
#define PG8_LAS __attribute__((address_space(3)))
typedef unsigned short bf16_t;
typedef short bf16x8 __attribute__((ext_vector_type(8)));
typedef float f32x4 __attribute__((ext_vector_type(4)));
typedef unsigned u32x4 __attribute__((ext_vector_type(4)));
constexpr int BM = 256, BK = 64, HALF = 128, HTB = HALF * BK * 2  , STAGE_BYTES = 8 * HTB, NXCD = 8, WGM = 8;

__host__ __device__ __forceinline__ int lds_byte(int r, int c) { const int st = (r >> 4) * 2 + (c >> 5), rr = r & 15, cc = c & 31, ob = rr * 64 + cc * 2; return st * 1024 + (ob ^ (((ob >> 9) & 1) << 5)); }
__host__ __device__ __forceinline__ void stage_rc(int b, int& R, int& C) { const int st = b / 1024, sb = b % 1024, swz = sb ^ (((sb >> 9) & 1) << 5); R = (st >> 1) * 16 + swz / 64; C = (st & 1) * 32 + (swz % 64) / 2; }
__host__ __device__ __forceinline__ int perm32(int rho) { const int n = rho >> 4, i = rho & 15; return 8 * (i >> 2) + 4 * n + (i & 3); }

struct Unit { int pm, pn; };
struct Gemm { const bf16_t* A; const bf16_t* Bt; int M, N, K; };

struct StaticOrder {
    int nM, nN, nwg, G, c;
    __host__ __device__ void init(int M, int N, int G_, int c_) { nM = M / BM; nN = N / BM; nwg = nM * nN; G = G_; c = c_; }
    __host__ __device__ bool next(int i, Unit& u) const {
        const long L = (long)i * G + c; if (L >= nwg) return false;
        int wgid = (int)L; { const int q = nwg / NXCD, r = nwg % NXCD, xcd = wgid % NXCD, off = wgid / NXCD; wgid = (xcd < r ? xcd * (q + 1) : r * (q + 1) + (xcd - r) * q) + off; }
        const int nig = WGM * nN, gid = wgid / nig, fm = gid * WGM, gsz = (nM - fm) < WGM ? (nM - fm) : WGM;
        u.pm = fm + ((wgid % nig) % gsz); u.pn = (wgid % nig) / gsz; return true;
    }
    __device__ __forceinline__ void a_ready(const Unit&) const {}
    __device__ __forceinline__ void done(const Unit&) const {}
};

__device__ __forceinline__ unsigned cvt_pk_bf16(float lo, float hi) { unsigned r; asm volatile("v_cvt_pk_bf16_f32 %0, %1, %2" : "=v"(r) : "v"(lo), "v"(hi)); return r; }
typedef float f32x2 __attribute__((ext_vector_type(2)));

template <class Epi, class Sched, bool ALIGN_EPI = false, bool SP2 = false>
__device__ __forceinline__ void gemm_phase(PG8_LAS unsigned char* lds, const Gemm g, const Sched& S, const Epi& E) {
    const int tid = threadIdx.x, wid = __builtin_amdgcn_readfirstlane(tid >> 6), lane = tid & 63, wr = wid >> 2, wc = wid & 3, fr = lane & 15, fq = lane >> 4;
    const int K = g.K, nt = K / BK;
    unsigned voffA[2], voffB[2];
#pragma unroll
    for (int i = 0; i < 2; ++i) { int R, C; stage_rc(tid * 16 + i * 8192, R, C); const int Rb = Epi::PERM ? ((R & ~31) + perm32(R & 31)) : R;
        voffA[i] = (unsigned)(R * K + C) * 2u; voffB[i] = (unsigned)(Rb * K + C) * 2u; }
    const size_t kstep = (size_t)(BK * 2);
    const size_t hstep = (size_t)HALF * K * 2;
    const size_t tstep = 2 * hstep;
    const unsigned ldsw = (unsigned)wid * 1024u;
    const int aoff = lds_byte(wr * 64 + fr, fq * 8), boff = lds_byte(wc * 32 + fr, fq * 8);
#define PG8_SA(b, h) (((b) * 2 + (h)) * HTB)
#define PG8_SB(b, h) ((4 + (b) * 2 + (h)) * HTB)
#define PG8_STAGE(bufoff, gbase, voff) do { _Pragma("unroll") for (int _i = 0; _i < 2; ++_i) \
        __builtin_amdgcn_global_load_lds((const unsigned*)((const char*)(gbase) + (voff)[_i]), (PG8_LAS unsigned*)(lds + (bufoff) + ldsw + _i * 8192), 16, 0, 0); } while (0)
#define PG8_LDA(dst, b, h) do { _Pragma("unroll") for (int m = 0; m < 4; ++m) _Pragma("unroll") for (int k = 0; k < 2; ++k) dst[m][k] = *(const PG8_LAS bf16x8*)(lds + PG8_SA(b, h) + aoff + m * 2048 + k * 1024); } while (0)
#define PG8_LDB(dst, b, h) do { _Pragma("unroll") for (int n = 0; n < 2; ++n) _Pragma("unroll") for (int k = 0; k < 2; ++k) dst[n][k] = *(const PG8_LAS bf16x8*)(lds + PG8_SB(b, h) + boff + n * 2048 + k * 1024); } while (0)
#define PG8_MMA(ai, bj, At, Bt) do { __builtin_amdgcn_s_setprio(1); _Pragma("unroll") for (int m = 0; m < 4; ++m) _Pragma("unroll") for (int n = 0; n < 2; ++n) _Pragma("unroll") for (int k = 0; k < 2; ++k) \
        acc[ai][bj][m][n] = __builtin_amdgcn_mfma_f32_16x16x32_bf16(Bt[n][k], At[m][k], acc[ai][bj][m][n], 0, 0, 0); __builtin_amdgcn_s_setprio(0); } while (0)
#define PG8_WAIT_V(n) asm volatile("s_waitcnt vmcnt(" #n ")" ::: "memory")
#define PG8_WAIT_L(n) asm volatile("s_waitcnt lgkmcnt(" #n ")" ::: "memory")
#define PG8_BAR __builtin_amdgcn_s_barrier()
#define PG8_SCHED __builtin_amdgcn_sched_barrier(0)
    Unit cur, nxt; int ui = 0;
    if (!S.next(0, cur)) return;
    f32x4 acc[2][2][4][2];
#pragma unroll
    for (int a = 0; a < 2; ++a)
#pragma unroll
        for (int b = 0; b < 2; ++b)
#pragma unroll
            for (int m = 0; m < 4; ++m)
#pragma unroll
                for (int n = 0; n < 2; ++n) acc[a][b][m][n] = (f32x4){0.f, 0.f, 0.f, 0.f};
    bf16x8 At[4][2], B0[2][2], B1[2][2];
    const char* cA = (const char*)g.A + (size_t)cur.pm * tstep; const char* cB = (const char*)g.Bt + (size_t)cur.pn * tstep;
    S.a_ready(cur);
    if constexpr (SP2) {
        PG8_STAGE(PG8_SB(0, 0), cB, voffB); PG8_STAGE(PG8_SB(0, 1), cB + hstep, voffB); PG8_STAGE(PG8_SA(0, 0), cA, voffA); PG8_STAGE(PG8_SA(0, 1), cA + hstep, voffA);
        if (wr == 1) PG8_BAR;
        PG8_WAIT_V(2); PG8_BAR;
        PG8_STAGE(PG8_SB(1, 0), cB + kstep, voffB); PG8_STAGE(PG8_SA(1, 0), cA + kstep, voffA); PG8_STAGE(PG8_SB(1, 1), cB + hstep + kstep, voffB);
        PG8_WAIT_V(6); PG8_BAR;
    } else {
        PG8_STAGE(PG8_SB(0, 0), cB, voffB); PG8_STAGE(PG8_SA(0, 0), cA, voffA); PG8_STAGE(PG8_SB(0, 1), cB + hstep, voffB); PG8_STAGE(PG8_SA(0, 1), cA + hstep, voffA);
        if (wr == 1) PG8_BAR;
        PG8_WAIT_V(4); PG8_BAR;
        PG8_STAGE(PG8_SB(1, 0), cB + kstep, voffB); PG8_STAGE(PG8_SA(1, 0), cA + kstep, voffA); PG8_STAGE(PG8_SB(1, 1), cB + hstep + kstep, voffB);
        PG8_WAIT_V(6); PG8_BAR;
    }
    for (;;) {
        const bool has_next = S.next(ui + 1, nxt);
        const char* nA = has_next ? (const char*)g.A + (size_t)nxt.pm * tstep : cA; const char* nB = has_next ? (const char*)g.Bt + (size_t)nxt.pn * tstep : cB;
        for (int t = 0; t < nt; t += 2) {
            const bool last = (t == nt - 2);
            const char* a1 = cA + (size_t)(t + 1) * kstep;
            const char* a2 = last ? nA : cA + (size_t)(t + 2) * kstep; const char* b2 = last ? nB : cB + (size_t)(t + 2) * kstep;
            const char* a3 = a2 + kstep; const char* b3 = b2 + kstep;
            if (last && has_next) S.a_ready(nxt);
            if constexpr (SP2) {
            PG8_LDB(B0, 0, 0); PG8_LDB(B1, 0, 1); PG8_SCHED; PG8_LDA(At, 0, 0); PG8_STAGE(PG8_SA(1, 1), a1 + hstep, voffA);
            PG8_WAIT_V(8); PG8_WAIT_L(0); PG8_BAR; PG8_MMA(0, 0, At, B0); PG8_MMA(0, 1, At, B1); PG8_BAR; PG8_SCHED;
            PG8_LDA(At, 0, 1); PG8_STAGE(PG8_SB(0, 0), b2, voffB); PG8_STAGE(PG8_SB(0, 1), b2 + hstep, voffB); PG8_STAGE(PG8_SA(0, 0), a2, voffA);
            PG8_WAIT_V(8); PG8_WAIT_L(0); PG8_BAR; PG8_MMA(1, 0, At, B0); PG8_MMA(1, 1, At, B1); PG8_BAR; PG8_SCHED;
            PG8_LDB(B0, 1, 0); PG8_LDB(B1, 1, 1); PG8_SCHED; PG8_LDA(At, 1, 0); PG8_STAGE(PG8_SA(0, 1), a2 + hstep, voffA);
            PG8_WAIT_V(8); PG8_WAIT_L(0); PG8_BAR; PG8_MMA(0, 0, At, B0); PG8_MMA(0, 1, At, B1); PG8_BAR; PG8_SCHED;
            PG8_LDA(At, 1, 1); PG8_STAGE(PG8_SB(1, 0), b3, voffB); PG8_STAGE(PG8_SB(1, 1), b3 + hstep, voffB); PG8_STAGE(PG8_SA(1, 0), a3, voffA);
            PG8_WAIT_V(8); PG8_WAIT_L(0); PG8_BAR; PG8_MMA(1, 0, At, B0); PG8_MMA(1, 1, At, B1); PG8_BAR; PG8_SCHED;
            } else {
            PG8_LDB(B0, 0, 0); PG8_SCHED; PG8_LDA(At, 0, 0); PG8_STAGE(PG8_SA(1, 1), a1 + hstep, voffA);
            PG8_WAIT_L(8); PG8_BAR; PG8_WAIT_L(0); PG8_MMA(0, 0, At, B0); PG8_BAR; PG8_SCHED;
            PG8_LDB(B1, 0, 1); PG8_STAGE(PG8_SB(0, 0), b2, voffB);
            PG8_BAR; PG8_WAIT_L(0); PG8_MMA(0, 1, At, B1); PG8_BAR;
            PG8_LDA(At, 0, 1); PG8_STAGE(PG8_SA(0, 0), a2, voffA);
            PG8_BAR; PG8_WAIT_L(0); PG8_MMA(1, 0, At, B0); PG8_BAR; PG8_SCHED;
            PG8_STAGE(PG8_SB(0, 1), b2 + hstep, voffB);
            PG8_WAIT_V(6); PG8_BAR; PG8_MMA(1, 1, At, B1); PG8_BAR;
            PG8_LDB(B0, 1, 0); PG8_SCHED; PG8_LDA(At, 1, 0); PG8_STAGE(PG8_SA(0, 1), a2 + hstep, voffA);
            PG8_WAIT_L(8); PG8_BAR; PG8_WAIT_L(0); PG8_MMA(0, 0, At, B0); PG8_BAR; PG8_SCHED;
            PG8_LDB(B1, 1, 1); PG8_STAGE(PG8_SB(1, 0), b3, voffB);
            PG8_BAR; PG8_WAIT_L(0); PG8_MMA(0, 1, At, B1); PG8_BAR;
            PG8_LDA(At, 1, 1); PG8_STAGE(PG8_SA(1, 0), a3, voffA);
            PG8_BAR; PG8_WAIT_L(0); PG8_MMA(1, 0, At, B0); PG8_BAR; PG8_SCHED;
            PG8_STAGE(PG8_SB(1, 1), b3 + hstep, voffB);
            PG8_WAIT_V(6); PG8_BAR; PG8_MMA(1, 1, At, B1); PG8_BAR;
            }
        }
        if constexpr (ALIGN_EPI) { if (wr == 0) PG8_BAR; }
        if constexpr (!Epi::AFTER_DRAIN) { E(acc, cur, wr, wc, fr, fq); S.done(cur); }
        if (!has_next) break;
#pragma unroll
        for (int a = 0; a < 2; ++a)
#pragma unroll
            for (int b = 0; b < 2; ++b)
#pragma unroll
                for (int m = 0; m < 4; ++m)
#pragma unroll
                    for (int n = 0; n < 2; ++n) acc[a][b][m][n] = (f32x4){0.f, 0.f, 0.f, 0.f};
        cur = nxt; cA = nA; cB = nB; ++ui;
        if constexpr (ALIGN_EPI) { if (wr == 1) PG8_BAR; }
    }
    PG8_WAIT_V(0);
    if constexpr (!ALIGN_EPI) { if (wr == 0) PG8_BAR; }
    PG8_BAR;
    if constexpr (Epi::AFTER_DRAIN) { E.fused(acc, cur, wr, wc, fr, fq, lds, wid, lane); S.done(cur); }
#undef PG8_SA
#undef PG8_SB
#undef PG8_STAGE
#undef PG8_LDA
#undef PG8_LDB
#undef PG8_MMA
#undef PG8_WAIT_V
#undef PG8_WAIT_L
#undef PG8_BAR
#undef PG8_SCHED
}
}

#ifndef PER_PHASE_LAUNCH
#define PER_PHASE_LAUNCH 0
#endif

constexpr int DM = 1024, NBP = 4, SEQ = 4096, DBS = 128, DTS = 8;
constexpr int MP = NBP * SEQ, MS = DBS * DTS, M = MP + MS;
constexpr int NPROJ = 3584, INCOLS = 3592, FF = 4096, WBUF = 2048;
constexpr int C_Q = 0, C_K = 512, C_V = 1024, C_RAW = 1536, C_VB = 2560, C_OB = 3072;
constexpr float EPS = 1e-6f;
constexpr int NPH = 10;
constexpr size_t O_YP = 0, O_YS = O_YP + (size_t)MP * DM, O_PK = O_YS + (size_t)MS * DM, O_PV = O_PK + (size_t)NBP * WBUF * 512,
    O_PCONV = O_PV + (size_t)NBP * WBUF * 512, O_PC = O_PCONV + (size_t)NBP * 3 * 1024, O_PN = O_PC + (size_t)NBP * 4 * 128 * 128, O_PM = O_PN + (size_t)NBP * 4 * 128,
    O_SK = O_PM + (size_t)NBP * 4, O_SV = O_SK + (size_t)DBS * WBUF * 512, O_SCONV = O_SV + (size_t)DBS * WBUF * 512, O_SC = O_SCONV + (size_t)DBS * 3 * 1024,
    O_SN = O_SC + (size_t)DBS * 4 * 128 * 128, O_SM = O_SN + (size_t)DBS * 4 * 128, O_END = O_SM + (size_t)DBS * 4;
static_assert(O_END == 303774224ull, "output size");
constexpr size_t MiB = 1u << 20;
constexpr size_t WS_CTL = 0, CTL_ZERO_BYTES = 1 * MiB;
constexpr int CW_BAR = 4096;
constexpr size_t WS_SS2 = 256 * 1024, WS_SSF = 512 * 1024;
constexpr size_t WS_WIN = 2 * MiB, WS_WOUT = 10 * MiB, WS_WUP = 12 * MiB, WS_WDN = 20 * MiB;
constexpr size_t WS_ROPE = 28 * MiB, WS_RSTD1 = 29 * MiB, WS_IG = 29 * MiB + 512 * 1024, WS_LF = 30 * MiB, WS_CHK = 31 * MiB;
constexpr size_t WS_XB = 32 * MiB, WS_PROJ = 68 * MiB, WS_MIX = 188 * MiB, WS_HPB = 222 * MiB, WS_ACT = 256 * MiB;
constexpr size_t WS_QF = 392 * MiB, WS_KF = 426 * MiB, WS_L = 460 * MiB, WS_CPRE = 492 * MiB, WS_NLOC = 524 * MiB, WS_NPRE = 525 * MiB, WS_END = 526 * MiB;
static_assert(WS_PROJ + (size_t)M * NPROJ * 2 <= WS_MIX && WS_ACT + (size_t)M * FF * 2 <= WS_QF && WS_XB + (size_t)M * DM * 2 <= WS_PROJ, "ws map");

constexpr int LDS_BYTES = 147456;
constexpr int MISC_OFF = 131072 + 8192;

#define GAS __attribute__((address_space(1)))
#define LAS __attribute__((address_space(3)))
typedef unsigned short bf16;
typedef unsigned v4u __attribute__((ext_vector_type(4)));
typedef unsigned v2u __attribute__((ext_vector_type(2)));
typedef float f32x4 __attribute__((ext_vector_type(4)));
typedef GAS unsigned gu32;
#define LDS_WAIT() asm volatile("s_waitcnt lgkmcnt(0)" ::: "memory")
__device__ __forceinline__ unsigned f2bf(float f) { unsigned u = __builtin_bit_cast(unsigned, f); return (u + 0x7fffu + ((u >> 16) & 1u)) >> 16; }
__device__ __forceinline__ unsigned pk2(float lo, float hi) { return f2bf(lo) | (f2bf(hi) << 16); }
__device__ __forceinline__ float bf2f(unsigned short u) { return __builtin_bit_cast(float, (unsigned)u << 16); }
__device__ __forceinline__ float bflo(unsigned u) { return __builtin_bit_cast(float, u << 16); }
__device__ __forceinline__ float bfhi(unsigned u) { return __builtin_bit_cast(float, u & 0xffff0000u); }
__device__ __forceinline__ float wave_sum(float v) {
#pragma unroll
    for (int o = 1; o < 64; o <<= 1) v += __shfl_xor(v, o);
    return v;
}
__device__ __forceinline__ float wave_max(float v) {
#pragma unroll
    for (int o = 1; o < 64; o <<= 1) v = fmaxf(v, __shfl_xor(v, o));
    return v;
}
__device__ __forceinline__ int opaque(int v) { asm volatile("" : "+v"(v)); return v; }
__device__ __forceinline__ float sigmoidf_(float x) { return 1.f / (1.f + __expf(-x)); }

#define XB_TMO      128
#define XB_XCNT(j)  (256  + 64 * (j))
#define XB_XSUB(j)  (1280 + 64 * (j))
#define XB_XGEN(j)  (2304 + 64 * (j))
#define XB_TOP      3328
#define XB_TOPGEN   3392
#define XCD_BAR_WORDS 3456
#define XB_SPIN_CAP (1u << 18)
__device__ __forceinline__ unsigned xb_ld(unsigned* p)              { return __hip_atomic_load(p, __ATOMIC_RELAXED, __HIP_MEMORY_SCOPE_AGENT); }
__device__ __forceinline__ unsigned xb_add(unsigned* p, unsigned v) { return __hip_atomic_fetch_add(p, v, __ATOMIC_RELAXED, __HIP_MEMORY_SCOPE_AGENT); }
__device__ __forceinline__ unsigned xb_xcc_id() { return (unsigned)__builtin_amdgcn_s_getreg((3 << 11) | 20) & 0xFu; }
#define XB_SPIN(cond, bar) do { unsigned _sp = 0; while (cond) { __builtin_amdgcn_s_sleep(1); \
    if ((++_sp & 255u) == 0u) { if (xb_ld(&(bar)[XB_TMO])) break; if (_sp > XB_SPIN_CAP) { atomicAdd(&(bar)[XB_TMO], 1u); break; } } } } while (0)
struct XcdBarrier { unsigned* bar; unsigned x; volatile LAS unsigned* st; };
__device__ __forceinline__ XcdBarrier xcd_barrier_post(unsigned* bar, volatile LAS unsigned* st) {
    XcdBarrier b; b.bar = bar; b.x = xb_xcc_id(); b.st = st;
    if (threadIdx.x == 0) (void)xb_add(&bar[XB_XCNT(b.x)], 1u);
    return b;
}
__device__ __forceinline__ void xcd_barrier_complete(unsigned* bar, unsigned x, unsigned& nloc, unsigned& nx) {
    const unsigned G = gridDim.x * gridDim.y * gridDim.z;
    unsigned sum, cnt, mine, sp = 0u;
    for (;;) {
        sum = 0u; cnt = 0u; mine = 0u;
#pragma unroll
        for (unsigned j = 0; j < 16; ++j) { const unsigned c = xb_ld(&bar[XB_XCNT(j)]); sum += c; cnt += (c > 0u) ? 1u : 0u; mine = (j == x) ? c : mine; }
        if (sum == G) break;
        __builtin_amdgcn_s_sleep(1);
        if ((++sp & 255u) == 0u) { if (xb_ld(&bar[XB_TMO])) break; if (sp > XB_SPIN_CAP) { atomicAdd(&bar[XB_TMO], 1u); break; } }
    }
    nloc = mine > 0u ? mine : 1u; nx = cnt > 0u ? cnt : 1u;
}
__device__ __forceinline__ void xcd_barrier(const XcdBarrier& b) {
    asm volatile("s_waitcnt vmcnt(0)" ::: "memory");
    __syncthreads();
    if (threadIdx.x == 0) {
        unsigned* bar = b.bar;
        __builtin_amdgcn_s_waitcnt(0);
        unsigned nloc = b.st[0], nx = b.st[1];
        if (nloc == 0u) { xcd_barrier_complete(bar, b.x, nloc, nx); b.st[0] = nloc; b.st[1] = nx; }
        const unsigned old = xb_add(&bar[XB_XSUB(b.x)], 1u);
        const unsigned gen = old / nloc;
        if (old + 1u == (gen + 1u) * nloc) {
            __builtin_amdgcn_fence(__ATOMIC_RELEASE, "agent");
            asm volatile("s_waitcnt vmcnt(0)" ::: "memory");
            const unsigned og = xb_add(&bar[XB_TOP], 1u);
            const unsigned tg = og / nx;
            if (og + 1u == (tg + 1u) * nx) xb_add(&bar[XB_TOPGEN], 1u);
            else XB_SPIN(xb_ld(&bar[XB_TOPGEN]) == tg, bar);
            __builtin_amdgcn_fence(__ATOMIC_ACQUIRE, "agent");
            xb_add(&bar[XB_XGEN(b.x)], 1u);
            asm volatile("s_waitcnt vmcnt(0)" ::: "memory");
        } else {
            XB_SPIN(xb_ld(&bar[XB_XGEN(b.x)]) == gen, bar);
            __builtin_amdgcn_fence(__ATOMIC_ACQUIRE, "agent");
            asm volatile("s_waitcnt vmcnt(0)" ::: "memory");
        }
    }
    __syncthreads();
}

struct Frame {
    LAS unsigned char* lds;
    int tid, lane, wave, vcu, G;
    const float *xp, *xs, *cache_k, *cache_v, *st_conv, *st_C, *st_n, *st_m, *g1, *w_in, *b_gate, *w_conv, *b_conv, *mhg, *w_out, *g2, *w_up, *w_down, *gf;
    float* out; unsigned char* ws;
    bf16 *Win_t, *Wout_t, *Wup_t, *Wdn_t, *XB, *PROJ, *MIX, *HPB, *ACT;
    float *rope, *rstd1, *ig, *lf, *chk, *ss2, *ssf, *QF, *KF, *L, *CPRE, *NLOC, *NPRE;
};

namespace pg8 {
struct EpiIn {
    static constexpr bool PERM = true, AFTER_DRAIN = false;
    bf16_t* proj; const float* rstd; const float* rope; float* out;
    __device__ __forceinline__ void operator()(const f32x4 (&acc)[2][2][4][2], const Unit& u, int wr, int wc, int fr, int fq) const {
        const int pn = u.pn;
        const bool rot = (pn < 4) && ((wc & 1) == 0);
#pragma unroll
        for (int ai = 0; ai < 2; ++ai)
#pragma unroll
            for (int m = 0; m < 4; ++m) {
                const int row = u.pm * BM + ai * HALF + wr * 64 + m * 16 + fr;
                const float rs = rstd[row];
                const bool smp = row >= MP;
                const int b = smp ? ((row - MP) >> 3) : (row >> 12), t = smp ? ((row - MP) & 7) : (row & 4095);
                const int pidx = smp ? (SEQ + t) : t;
#pragma unroll
                for (int bj = 0; bj < 2; ++bj) {
                    const int col0 = pn * BM + bj * HALF + wc * 32 + 8 * fq;
                    f32x4 v0 = acc[ai][bj][m][0] * rs, v1 = acc[ai][bj][m][1] * rs;
                    if (rot) {
                        f32x4 p0, p1;
                        p0.x = __shfl_xor(v0.x, 16); p0.y = __shfl_xor(v0.y, 16); p0.z = __shfl_xor(v0.z, 16); p0.w = __shfl_xor(v0.w, 16);
                        p1.x = __shfl_xor(v1.x, 16); p1.y = __shfl_xor(v1.y, 16); p1.z = __shfl_xor(v1.z, 16); p1.w = __shfl_xor(v1.w, 16);
                        if (fq < 2) {
                            const f32x4 c0 = *(const f32x4*)(rope + pidx * 16), c1 = *(const f32x4*)(rope + pidx * 16 + 4);
                            const f32x4 s0 = *(const f32x4*)(rope + pidx * 16 + 8), s1 = *(const f32x4*)(rope + pidx * 16 + 12);
                            if (fq == 0) { v0 = v0 * c0 - p0 * s0; v1 = v1 * c1 - p1 * s1; }
                            else         { v0 = v0 * c0 + p0 * s0; v1 = v1 * c1 + p1 * s1; }
                        }
                    }
                    if (pn < 2) { v0 = v0 * 0.125f; v1 = v1 * 0.125f; }
                    u32x4 w; w.x = cvt_pk_bf16(v0[0], v0[1]); w.y = cvt_pk_bf16(v0[2], v0[3]); w.z = cvt_pk_bf16(v1[0], v1[1]); w.w = cvt_pk_bf16(v1[2], v1[3]);
                    *(u32x4*)(proj + (size_t)row * NPROJ + col0) = w;
                    if (pn >= 2 && pn < 6) {
                        const bool isk = pn < 4; const int cc = col0 - (isk ? C_K : C_V);
                        float* dst = nullptr;
                        if (smp) dst = out + (isk ? O_SK : O_SV) + ((size_t)b * WBUF + (WBUF - DTS) + t) * 512 + cc;
                        else if (t >= SEQ - WBUF) dst = out + (isk ? O_PK : O_PV) + ((size_t)b * WBUF + (t - (SEQ - WBUF))) * 512 + cc;
                        if (dst) { *(f32x4*)dst = v0; *(f32x4*)(dst + 4) = v1; }
                    } else if (pn >= 6 && pn < 10) {
                        const int cc = col0 - C_RAW;
                        float* dst = nullptr;
                        if (smp) { if (t >= DTS - 3) dst = out + O_SCONV + ((size_t)b * 3 + (t - (DTS - 3))) * 1024 + cc; }
                        else if (t >= SEQ - 3) dst = out + O_PCONV + ((size_t)b * 3 + (t - (SEQ - 3))) * 1024 + cc;
                        if (dst) { *(f32x4*)dst = v0; *(f32x4*)(dst + 4) = v1; }
                    }
                }
            }
    }
};
struct EpiOut {
    static constexpr bool PERM = true, AFTER_DRAIN = false;
    const float* xp; const float* xs; float* hp; bf16_t* hpb; float* ss;
    __device__ __forceinline__ void operator()(const f32x4 (&acc)[2][2][4][2], const Unit& u, int wr, int wc, int fr, int fq) const {
#pragma unroll
        for (int ai = 0; ai < 2; ++ai)
#pragma unroll
            for (int m = 0; m < 4; ++m) {
                const int row = u.pm * BM + ai * HALF + wr * 64 + m * 16 + fr;
                const float* xr = (row < MP) ? xp + (size_t)row * DM : xs + (size_t)(row - MP) * DM;
                float s = 0.f;
#pragma unroll
                for (int bj = 0; bj < 2; ++bj) {
                    const int col0 = u.pn * BM + bj * HALF + wc * 32 + 8 * fq;
                    const f32x4 v0 = acc[ai][bj][m][0] + *(const f32x4*)(xr + col0), v1 = acc[ai][bj][m][1] + *(const f32x4*)(xr + col0 + 4);
                    *(f32x4*)(hp + (size_t)row * DM + col0) = v0; *(f32x4*)(hp + (size_t)row * DM + col0 + 4) = v1;
                    u32x4 w; w.x = cvt_pk_bf16(v0[0], v0[1]); w.y = cvt_pk_bf16(v0[2], v0[3]); w.z = cvt_pk_bf16(v1[0], v1[1]); w.w = cvt_pk_bf16(v1[2], v1[3]);
                    *(u32x4*)(hpb + (size_t)row * DM + col0) = w;
                    s += (v0[0] * v0[0] + v0[1] * v0[1]) + (v0[2] * v0[2] + v0[3] * v0[3]) + (v1[0] * v1[0] + v1[1] * v1[1]) + (v1[2] * v1[2] + v1[3] * v1[3]);
                }
                s += __shfl_xor(s, 16); s += __shfl_xor(s, 32);
                if (fq == 0) atomicAdd(ss + row, s);
            }
    }
};
struct EpiUp {
    static constexpr bool PERM = true, AFTER_DRAIN = false;
    bf16_t* act; const float* ss;
    __device__ __forceinline__ void operator()(const f32x4 (&acc)[2][2][4][2], const Unit& u, int wr, int wc, int fr, int fq) const {
#pragma unroll
        for (int ai = 0; ai < 2; ++ai)
#pragma unroll
            for (int m = 0; m < 4; ++m) {
                const int row = u.pm * BM + ai * HALF + wr * 64 + m * 16 + fr;
                const float rs = 1.f / sqrtf(ss[row] * (1.f / DM) + EPS);
#pragma unroll
                for (int bj = 0; bj < 2; ++bj) {
                    const int col0 = u.pn * BM + bj * HALF + wc * 32 + 8 * fq;
                    f32x4 v0 = acc[ai][bj][m][0] * rs, v1 = acc[ai][bj][m][1] * rs;
#pragma unroll
                    for (int e = 0; e < 4; ++e) { const float a = fmaxf(v0[e], 0.f), c = fmaxf(v1[e], 0.f); v0[e] = a * a; v1[e] = c * c; }
                    u32x4 w; w.x = cvt_pk_bf16(v0[0], v0[1]); w.y = cvt_pk_bf16(v0[2], v0[3]); w.z = cvt_pk_bf16(v1[0], v1[1]); w.w = cvt_pk_bf16(v1[2], v1[3]);
                    *(u32x4*)(act + (size_t)row * FF + col0) = w;
                }
            }
    }
};
struct EpiDown {
    static constexpr bool PERM = true, AFTER_DRAIN = false;
    float* hp; float* ss;
    __device__ __forceinline__ void operator()(const f32x4 (&acc)[2][2][4][2], const Unit& u, int wr, int wc, int fr, int fq) const {
#pragma unroll
        for (int ai = 0; ai < 2; ++ai)
#pragma unroll
            for (int m = 0; m < 4; ++m) {
                const int row = u.pm * BM + ai * HALF + wr * 64 + m * 16 + fr;
                float s = 0.f;
#pragma unroll
                for (int bj = 0; bj < 2; ++bj) {
                    const int col0 = u.pn * BM + bj * HALF + wc * 32 + 8 * fq;
                    float* p = hp + (size_t)row * DM + col0;
                    const f32x4 v0 = acc[ai][bj][m][0] + *(const f32x4*)p, v1 = acc[ai][bj][m][1] + *(const f32x4*)(p + 4);
                    *(f32x4*)p = v0; *(f32x4*)(p + 4) = v1;
                    s += (v0[0] * v0[0] + v0[1] * v0[1]) + (v0[2] * v0[2] + v0[3] * v0[3]) + (v1[0] * v1[0] + v1[1] * v1[1]) + (v1[2] * v1[2] + v1[3] * v1[3]);
                }
                s += __shfl_xor(s, 16); s += __shfl_xor(s, 32);
                if (fq == 0) atomicAdd(ss + row, s);
            }
    }
};
}

__device__ __forceinline__ void p0_transpose_item(const float* W, int K, int ldw, int nblk, const float* gain, bf16* WT, LAS float* scr, int item, int lane) {
    const int kb = item / nblk, nb = item % nblk, k0 = 64 * kb, n0 = 32 * nb;
#pragma unroll 8
    for (int i = 0; i < 32; ++i) { const int kk = 2 * i + (lane >> 5); const float gg = gain ? gain[k0 + kk] : 1.f; scr[kk * 33 + (lane & 31)] = gg * W[(size_t)(k0 + kk) * ldw + n0 + (lane & 31)]; }
    LDS_WAIT(); asm volatile("" ::: "memory");
    const int c = lane & 7;
#pragma unroll
    for (int j = 0; j < 4; ++j) { const int n = (lane >> 3) + 8 * j; const LAS float* s = scr + (8 * c) * 33 + n;
        v4u o; o.x = pk2(s[0 * 33], s[1 * 33]); o.y = pk2(s[2 * 33], s[3 * 33]); o.z = pk2(s[4 * 33], s[5 * 33]); o.w = pk2(s[6 * 33], s[7 * 33]);
        *(GAS v4u*)(WT + (size_t)(n0 + n) * K + k0 + 8 * c) = o; }
    LDS_WAIT(); asm volatile("" ::: "memory");
}
__device__ __forceinline__ void sincos_d(double a, double& s, double& c) {
    const double TWO_PI = 6.283185307179586476925286766559;
    const double k = __builtin_rint(a * (1.0 / TWO_PI));
    const double r = a - k * TWO_PI, r2 = r * r;
    double sc = 1.0, ss = r, tc = 1.0, ts = r;
#pragma unroll
    for (int n = 1; n <= 17; ++n) { tc *= -r2 / (double)((2 * n - 1) * (2 * n)); sc += tc; ts *= -r2 / (double)((2 * n) * (2 * n + 1)); ss += ts; }
    s = ss; c = sc;
}
__device__ __forceinline__ float log_sigmoidf_(float x) { return x < 0.f ? x - log1pf(expf(x)) : -log1pf(expf(-x)); }

__device__ __forceinline__ void p0_prologue(Frame& F) {
    const int gw = F.vcu * 8 + F.wave, NGW = F.G * 8;
    {
        LAS float* scr = (LAS float*)(F.lds + F.wave * 16384);
        constexpr int I_IN = 16 * 112, I_OUT = 16 * 32, I_UP = 16 * 128, I_DN = 64 * 32;
        for (int it = gw; it < I_IN + I_OUT + I_UP + I_DN; it += NGW) {
            int r = it;
            if (r < I_IN) { p0_transpose_item(F.w_in, DM, INCOLS, 112, F.g1, F.Win_t, scr, r, F.lane); continue; } r -= I_IN;
            if (r < I_OUT) { p0_transpose_item(F.w_out, DM, DM, 32, nullptr, F.Wout_t, scr, r, F.lane); continue; } r -= I_OUT;
            if (r < I_UP) { p0_transpose_item(F.w_up, DM, FF, 128, F.g2, F.Wup_t, scr, r, F.lane); continue; } r -= I_UP;
            p0_transpose_item(F.w_down, FF, DM, 32, nullptr, F.Wdn_t, scr, r, F.lane);
        }
    }
    __syncthreads();
    {
        LAS float* Wg = (LAS float*)F.lds;
        for (int i = F.tid; i < 8192; i += 512) { const int k = i >> 3, j = i & 7; Wg[j * 1024 + k] = F.g1[k] * F.w_in[(size_t)k * INCOLS + NPROJ + j]; }
        __syncthreads();
        for (int m = gw; m < M; m += NGW) {
            const float* xr = (m < MP) ? F.xp + (size_t)m * DM : F.xs + (size_t)(m - MP) * DM;
            f32x4 v[4]; float ss = 0.f;
#pragma unroll
            for (int j = 0; j < 4; ++j) { v[j] = *(const f32x4*)(xr + 256 * j + 4 * F.lane); ss += (v[j].x * v[j].x + v[j].y * v[j].y) + (v[j].z * v[j].z + v[j].w * v[j].w); }
            float ga[8];
#pragma unroll
            for (int g = 0; g < 8; ++g) { float a = 0.f;
#pragma unroll
                for (int j = 0; j < 4; ++j) { const f32x4 w = *(const LAS f32x4*)(Wg + g * 1024 + 256 * j + 4 * F.lane); a += (v[j].x * w.x + v[j].y * w.y) + (v[j].z * w.z + v[j].w * w.w); }
                ga[g] = wave_sum(a); }
            ss = wave_sum(ss);
            const float rstd = 1.f / sqrtf(ss * (1.f / DM) + EPS);
            float gv = 0.f;
#pragma unroll
            for (int g = 0; g < 8; ++g) gv = (F.lane == g) ? ga[g] : gv;
            if (F.lane == 0) F.rstd1[m] = rstd;
            if (F.lane < 8) { const float gg = gv * rstd + F.b_gate[F.lane];
                if (F.lane < 4) F.ig[m * 4 + F.lane] = gg; else F.lf[m * 4 + F.lane - 4] = log_sigmoidf_(gg); }
            v2u* o8 = (v2u*)(F.XB + (size_t)m * DM);
#pragma unroll
            for (int j = 0; j < 4; ++j) { v2u o; o.x = pk2(v[j].x, v[j].y); o.y = pk2(v[j].z, v[j].w); o8[64 * j + F.lane] = o; }
        }
    }
    {
        const double invf[8] = {1.0, 0.19392274474868576, 0.03760603093086393, 0.007292664737217109, 0.001414213562373095, 0.0002742481756762073, 5.318295896944988e-05, 1.031338537721246e-05};
        for (int i = F.vcu * 512 + F.tid; i < (SEQ + DTS) * 8; i += F.G * 512) {
            const int p = i >> 3, k = i & 7; const double pos = (p < SEQ) ? (double)p : (double)(8192 + p - SEQ);
            double fr = invf[0];
#pragma unroll
            for (int q = 1; q < 8; ++q) fr = (k == q) ? invf[q] : fr;
            double s, c; sincos_d(pos * fr, s, c);
            F.rope[p * 16 + k] = (float)c; F.rope[p * 16 + 8 + k] = (float)s;
        }
    }
    {
        constexpr int PER_B = (WBUF - DTS) * 128;
        const int total = DBS * PER_B;
        for (int i = F.vcu * 512 + F.tid; i < total; i += F.G * 512) {
            const int b = i / PER_B, r = i - b * PER_B;
            const size_t so = (size_t)b * (WBUF * 128) + DTS * 128 + r, dofs = (size_t)b * (WBUF * 128) + r;
            const f32x4 a = __builtin_nontemporal_load((const f32x4*)F.cache_k + so);
            const f32x4 c = __builtin_nontemporal_load((const f32x4*)F.cache_v + so);
            __builtin_nontemporal_store(a, (f32x4*)(F.out + O_SK) + dofs);
            __builtin_nontemporal_store(c, (f32x4*)(F.out + O_SV) + dofs);
        }
    }
}

__device__ __forceinline__ void load_q64(const bf16* qp, LAS float* sq, int lane) {
    sq[lane] = bf2f(qp[lane]);
    LDS_WAIT(); asm volatile("" ::: "memory");
}
__device__ __forceinline__ float dot_bf16row(const bf16* kp, const LAS float* sq) {
    float a = 0.f;
#pragma unroll 1
    for (int i = 0; i < 8; ++i) { const v4u w = *(const v4u*)(kp + 8 * i); const f32x4 q0 = *(const LAS f32x4*)(sq + 8 * i), q1 = *(const LAS f32x4*)(sq + 8 * i + 4);
        a += q0.x * bflo(w.x) + q0.y * bfhi(w.x) + q0.z * bflo(w.y) + q0.w * bfhi(w.y) + q1.x * bflo(w.z) + q1.y * bfhi(w.z) + q1.z * bflo(w.w) + q1.w * bfhi(w.w); }
    return a;
}
__device__ __forceinline__ float dot_f32row(const float* kp, const LAS float* sq) {
    float a = 0.f;
#pragma unroll 1
    for (int i = 0; i < 16; ++i) { const f32x4 w = *(const f32x4*)(kp + 4 * i); const f32x4 q0 = *(const LAS f32x4*)(sq + 4 * i);
        a += q0.x * w.x + q0.y * w.y + q0.z * w.z + q0.w * w.w; }
    return a;
}
__device__ __forceinline__ void p2_attn_v1(Frame& F) {
    const int gw = F.vcu * 8 + F.wave, NGW = F.G * 8, lane = F.lane;
    LAS float* q = (LAS float*)(F.lds + F.wave * 256);
    for (int it = gw; it < MP * 8; it += NGW) {
        const int row = it >> 3, h = it & 7, b = row >> 12, t = row & 4095;
        load_q64(F.PROJ + (size_t)row * NPROJ + C_Q + h * 64, q, lane);
        float sc[3][3];
#pragma unroll
        for (int g = 0; g < 3; ++g) { const int dil = (g == 0) ? 1 : (g == 1 ? 4 : 16);
#pragma unroll
            for (int i = 0; i < 3; ++i) { const int j = lane + 64 * i, tk = t - dil * j; const bool valid = (j <= 128) && (tk >= 0);
                const int tkc = valid ? tk : t;
                const float d = dot_bf16row(F.PROJ + (size_t)(b * SEQ + tkc) * NPROJ + C_K + h * 64, q);
                sc[g][i] = valid ? d : -INFINITY; asm volatile("" ::: "memory"); } }
        float mx = -INFINITY;
#pragma unroll
        for (int g = 0; g < 3; ++g)
#pragma unroll
            for (int i = 0; i < 3; ++i) mx = fmaxf(mx, sc[g][i]);
        mx = wave_max(mx);
        float sum = 0.f;
#pragma unroll
        for (int g = 0; g < 3; ++g)
#pragma unroll
            for (int i = 0; i < 3; ++i) { sc[g][i] = __expf(sc[g][i] - mx); sum += sc[g][i]; }
        sum = wave_sum(sum);
        float o = 0.f;
#pragma unroll
        for (int g = 0; g < 3; ++g) { const int dil = (g == 0) ? 1 : (g == 1 ? 4 : 16);
#pragma unroll
            for (int i = 0; i < 3; ++i) { const int cnt = (i == 2) ? 1 : 64;
#pragma unroll 1
                for (int jj = 0; jj < cnt; ++jj) { const int tk = t - dil * (jj + 64 * i); if (tk < 0) break;
                    const float p = __shfl(sc[g][i], jj);
                    o += p * bf2f(F.PROJ[(size_t)(b * SEQ + tk) * NPROJ + C_V + h * 64 + lane]); } } }
        F.MIX[(size_t)row * DM + h * 64 + lane] = (bf16)f2bf(o / sum);
    }
    for (int it = gw; it < MS * 8; it += NGW) {
        const int sr = it >> 3, h = it & 7, b = sr >> 3, t = sr & 7, row = MP + sr;
        load_q64(F.PROJ + (size_t)row * NPROJ + C_Q + h * 64, q, lane);
        float sc[3][3];
#pragma unroll
        for (int g = 0; g < 3; ++g) { const int dil = (g == 0) ? 1 : (g == 1 ? 4 : 16);
#pragma unroll
            for (int i = 0; i < 3; ++i) { const int j = lane + 64 * i; const bool valid = (j <= 128);
                const int idx = valid ? (WBUF + t - dil * j) : (WBUF + t);
                float d;
                if (idx < WBUF) d = dot_f32row(F.cache_k + (((size_t)b * WBUF + idx) * 8 + h) * 64, q);
                else d = dot_bf16row(F.PROJ + (size_t)(MP + b * DTS + idx - WBUF) * NPROJ + C_K + h * 64, q);
                sc[g][i] = valid ? d : -INFINITY; asm volatile("" ::: "memory"); } }
        float mx = -INFINITY;
#pragma unroll
        for (int g = 0; g < 3; ++g)
#pragma unroll
            for (int i = 0; i < 3; ++i) mx = fmaxf(mx, sc[g][i]);
        mx = wave_max(mx);
        float sum = 0.f;
#pragma unroll
        for (int g = 0; g < 3; ++g)
#pragma unroll
            for (int i = 0; i < 3; ++i) { sc[g][i] = __expf(sc[g][i] - mx); sum += sc[g][i]; }
        sum = wave_sum(sum);
        float o = 0.f;
#pragma unroll
        for (int g = 0; g < 3; ++g) { const int dil = (g == 0) ? 1 : (g == 1 ? 4 : 16);
#pragma unroll
            for (int i = 0; i < 3; ++i) { const int cnt = (i == 2) ? 1 : 64;
#pragma unroll 1
                for (int jj = 0; jj < cnt; ++jj) { const int idx = WBUF + t - dil * (jj + 64 * i);
                    const float p = __shfl(sc[g][i], jj);
                    const float vv = (idx < WBUF) ? F.cache_v[(((size_t)b * WBUF + idx) * 8 + h) * 64 + lane]
                                                  : bf2f(F.PROJ[(size_t)(MP + b * DTS + idx - WBUF) * NPROJ + C_V + h * 64 + lane]);
                    o += p * vv; } } }
        F.MIX[(size_t)row * DM + h * 64 + lane] = (bf16)f2bf(o / sum);
    }
    for (int i = F.vcu * 512 + F.tid; i < M * 1024; i += F.G * 512) {
        const int row = i >> 10, col = i & 1023; const bool smp = row >= MP;
        const int b = smp ? ((row - MP) >> 3) : (row >> 12), t = smp ? ((row - MP) & 7) : (row & 4095);
        float a = F.b_conv[col];
#pragma unroll
        for (int w = 0; w < 4; ++w) { const int tt = t + w - 3; float xv;
            if (tt >= 0) xv = bf2f(F.PROJ[(size_t)(row + w - 3) * NPROJ + C_RAW + col]);
            else xv = smp ? F.st_conv[((size_t)b * 3 + (3 + tt)) * 1024 + col] : 0.f;
            a += xv * F.w_conv[w * 1024 + col]; }
        const float s = a * sigmoidf_(a);
        if (col < 512) F.QF[(size_t)row * 512 + col] = s; else F.KF[(size_t)row * 512 + col - 512] = s * 0.08838834764831845f;
    }
}

__device__ __forceinline__ void p3_mlstm_local_v1(Frame& F) {
    const int tid = F.tid;
    LAS float* sB = (LAS float*)F.lds;
    LAS float* sW = sB + 128;
    LAS float* sK = (LAS float*)(F.lds + 4096);
    for (int u = F.vcu; u < 512; u += F.G) {
        const int bh = u >> 5, c = u & 31, b = bh >> 2, h = bh & 3, row0 = b * SEQ + c * 128;
        __syncthreads();
        if (tid < 128) { sB[tid] = F.lf[(row0 + tid) * 4 + h]; sW[tid] = F.ig[(row0 + tid) * 4 + h]; }
        for (int i = tid; i < 128 * 32; i += 512) { const int s = i >> 5, d4 = i & 31;
            *(LAS f32x4*)(sK + s * 128 + d4 * 4) = *(const f32x4*)(F.KF + (size_t)(row0 + s) * 512 + h * 128 + d4 * 4); }
        __syncthreads();
        if (tid == 0) { float acc = 0.f, um = -INFINITY;
            for (int s = 0; s < 128; ++s) { acc += sB[s]; const float uu = sW[s] - acc; sB[s] = acc; sW[s] = uu; um = fmaxf(um, uu); }
            for (int s = 0; s < 128; ++s) sW[s] = __expf(sW[s] - um);
            F.chk[u] = acc; F.chk[512 + u] = um; }
        __syncthreads();
        const int e = opaque(tid & 127), dg = opaque(tid >> 7);
        float acc[32];
#pragma unroll
        for (int i = 0; i < 32; ++i) acc[i] = 0.f;
#pragma unroll 1
        for (int s = 0; s < 128; ++s) {
            const float vv = sW[s] * bf2f(F.PROJ[(size_t)(row0 + s) * NPROJ + C_VB + h * 128 + e]);
#pragma unroll
            for (int d4 = 0; d4 < 8; ++d4) { const f32x4 kk = *(const LAS f32x4*)(sK + s * 128 + dg * 32 + d4 * 4);
                acc[4 * d4 + 0] += kk.x * vv; acc[4 * d4 + 1] += kk.y * vv; acc[4 * d4 + 2] += kk.z * vv; acc[4 * d4 + 3] += kk.w * vv; }
        }
#pragma unroll
        for (int i = 0; i < 32; ++i) F.L[(size_t)u * 16384 + (dg * 32 + i) * 128 + e] = acc[i];
        if (tid < 128) { float n = 0.f;
#pragma unroll 4
            for (int s = 0; s < 128; ++s) n += sW[s] * sK[s * 128 + tid];
            F.NLOC[u * 128 + tid] = n; }
    }
    LAS float* sQ = (LAS float*)(F.lds + 72 * 1024);
    LAS float* sKs = sQ + 1024;
    LAS float* sV = sKs + 1024;
    LAS float* sQC = sV + 1024;
    LAS float* sH = sQC + 4096;
    LAS float* sN0 = sH + 1024;
    LAS float* sS = sN0 + 128;
    for (int u = F.vcu; u < 512; u += F.G) {
        const int b = u >> 2, h = u & 3, r0 = MP + b * DTS;
        __syncthreads();
        for (int i = tid; i < 1024; i += 512) { const int t = i >> 7, d = i & 127;
            sQ[i] = F.QF[(size_t)(r0 + t) * 512 + h * 128 + d]; sKs[i] = F.KF[(size_t)(r0 + t) * 512 + h * 128 + d];
            sV[i] = bf2f(F.PROJ[(size_t)(r0 + t) * NPROJ + C_VB + h * 128 + d]); }
        if (tid < 128) sN0[tid] = F.st_n[(size_t)u * 128 + tid];
        if (tid == 0) {
            const float m0 = F.st_m[u]; float acc = 0.f, um = -INFINITY, cm = m0;
            for (int t = 0; t < 8; ++t) { acc += F.lf[(r0 + t) * 4 + h]; const float uu = F.ig[(r0 + t) * 4 + h] - acc; um = fmaxf(um, uu); cm = fmaxf(cm, uu);
                sS[t] = acc; sS[8 + t] = uu; sS[16 + t] = cm; sS[24 + t] = __expf(m0 - cm); }
            const float Mx = fmaxf(m0, um);
            for (int t = 0; t < 8; ++t) sS[32 + t] = __expf(sS[8 + t] - Mx);
            sS[40] = __expf(m0 - Mx);
            F.out[O_SM + u] = acc + Mx;
        }
        __syncthreads();
        if (tid < 64) { const int t = tid >> 3, s = tid & 7; float d = 0.f;
#pragma unroll 4
            for (int k = 0; k < 128; ++k) d += sQ[t * 128 + k] * sKs[s * 128 + k];
            sS[64 + tid] = (s <= t) ? d * __expf(sS[8 + s] - sS[16 + t]) : 0.f; }
        {
            const int e = opaque(tid & 127), dq = opaque(tid >> 7); const float alpha = sS[40];
            float vb[8], aq[8];
#pragma unroll
            for (int s = 0; s < 8; ++s) { vb[s] = sS[32 + s] * sV[s * 128 + e]; aq[s] = 0.f; }
            for (int dd = 0; dd < 32; ++dd) { const int d = dq * 32 + dd;
                const float c0 = F.st_C[((size_t)u * 128 + d) * 128 + e];
                float cn = alpha * c0;
#pragma unroll
                for (int s = 0; s < 8; ++s) { cn += sKs[s * 128 + d] * vb[s]; aq[s] += sQ[s * 128 + d] * c0; }
                F.out[O_SC + ((size_t)u * 128 + d) * 128 + e] = cn; }
#pragma unroll
            for (int s = 0; s < 8; ++s) sQC[(dq * 8 + s) * 128 + e] = aq[s];
        }
        if (tid < 128) { float n = sS[40] * sN0[tid];
#pragma unroll
            for (int s = 0; s < 8; ++s) n += sS[32 + s] * sKs[s * 128 + tid];
            F.out[O_SN + (size_t)u * 128 + tid] = n; }
        __syncthreads();
        if (tid < 8) { const int t = tid; float qn = 0.f;
#pragma unroll 4
            for (int k = 0; k < 128; ++k) qn += sQ[t * 128 + k] * sN0[k];
            float den = sS[24 + t] * qn; for (int s = 0; s < 8; ++s) den += sS[64 + t * 8 + s];
            sS[48 + t] = fmaxf(fabsf(den), __expf(-(sS[t] + sS[16 + t]))); }
        __syncthreads();
        { const int e = tid & 127, tq = tid >> 7;
#pragma unroll
            for (int k = 0; k < 2; ++k) { const int t = tq * 2 + k;
                float qc = sQC[(0 * 8 + t) * 128 + e] + sQC[(1 * 8 + t) * 128 + e] + sQC[(2 * 8 + t) * 128 + e] + sQC[(3 * 8 + t) * 128 + e];
                float num = sS[24 + t] * qc;
#pragma unroll
                for (int s = 0; s < 8; ++s) num += sS[64 + t * 8 + s] * sV[s * 128 + e];
                sH[t * 128 + e] = num / sS[48 + t]; } }
        __syncthreads();
        { const int t = F.wave; const float h0 = sH[t * 128 + F.lane], h1 = sH[t * 128 + 64 + F.lane];
            const float ssq = wave_sum(h0 * h0 + h1 * h1); const float rs = 1.f / sqrtf(ssq * (1.f / 128.f) + EPS);
            const int row = r0 + t;
#pragma unroll
            for (int k = 0; k < 2; ++k) { const int e = F.lane + 64 * k; const float hv = k ? h1 : h0;
                const float ob = bf2f(F.PROJ[(size_t)row * NPROJ + C_OB + h * 128 + e]);
                F.MIX[(size_t)row * DM + 512 + h * 128 + e] = (bf16)f2bf(hv * rs * F.mhg[h * 128 + e] * sigmoidf_(ob)); } }
    }
}

__device__ __forceinline__ void p4_prefix_v1(Frame& F) {
    const int tid = F.tid;
    for (int u = F.vcu; u < 256; u += F.G) {
        const int chain = u >> 4, sl = u & 15, idx = sl * 1024 + tid * 2;
        float m = 0.f, c0 = 0.f, c1 = 0.f, nn = 0.f;
        for (int c = 0; c < 32; ++c) { const int unit = chain * 32 + c;
            F.CPRE[(size_t)unit * 16384 + idx] = c0; F.CPRE[(size_t)unit * 16384 + idx + 1] = c1;
            if (sl == 0 && tid < 128) F.NPRE[unit * 128 + tid] = nn;
            if (sl == 0 && tid == 0) F.chk[1024 + unit] = m;
            const float Bc = F.chk[unit], um = F.chk[512 + unit], Mx = fmaxf(m, um), a = __expf(m - Mx), bb = __expf(um - Mx);
            c0 = a * c0 + bb * F.L[(size_t)unit * 16384 + idx]; c1 = a * c1 + bb * F.L[(size_t)unit * 16384 + idx + 1];
            if (sl == 0 && tid < 128) nn = a * nn + bb * F.NLOC[unit * 128 + tid];
            m = Bc + Mx; }
        F.out[O_PC + (size_t)chain * 16384 + idx] = c0; F.out[O_PC + (size_t)chain * 16384 + idx + 1] = c1;
        if (sl == 0 && tid < 128) F.out[O_PN + chain * 128 + tid] = nn;
        if (sl == 0 && tid == 0) F.out[O_PM + chain] = m;
    }
}

__device__ __forceinline__ void p5_mlstm_out_v1(Frame& F) {
    const int tid = F.tid;
    LAS float* sQT = (LAS float*)F.lds;
    LAS float* sKT = (LAS float*)(F.lds + 65536);
    LAS float* sB = (LAS float*)(F.lds + 131072);
    LAS float* sU = sB + 128, *sG = sU + 128, *sWi = sG + 128, *sDen = sWi + 128, *sN = sDen + 128;
    for (int u = F.vcu; u < 512; u += F.G) {
        const int bh = u >> 5, c = u & 31, b = bh >> 2, h = bh & 3, row0 = b * SEQ + c * 128;
        const float mc = F.chk[1024 + u];
        __syncthreads();
#pragma unroll 1
        for (int i = tid; i < 128 * 32; i += 512) { const int t = i >> 5, d4 = i & 31;
            const f32x4 qv = *(const f32x4*)(F.QF + (size_t)(row0 + t) * 512 + h * 128 + d4 * 4), kv = *(const f32x4*)(F.KF + (size_t)(row0 + t) * 512 + h * 128 + d4 * 4);
            sQT[(d4 * 4 + 0) * 128 + t] = qv.x; sQT[(d4 * 4 + 1) * 128 + t] = qv.y; sQT[(d4 * 4 + 2) * 128 + t] = qv.z; sQT[(d4 * 4 + 3) * 128 + t] = qv.w;
            sKT[(d4 * 4 + 0) * 128 + t] = kv.x; sKT[(d4 * 4 + 1) * 128 + t] = kv.y; sKT[(d4 * 4 + 2) * 128 + t] = kv.z; sKT[(d4 * 4 + 3) * 128 + t] = kv.w; }
        if (tid < 128) { sB[tid] = F.lf[(row0 + tid) * 4 + h]; sU[tid] = F.ig[(row0 + tid) * 4 + h]; sN[tid] = F.NPRE[u * 128 + tid]; }
        __syncthreads();
        if (tid == 0) { float acc = 0.f, cm = mc;
            for (int s = 0; s < 128; ++s) { acc += sB[s]; const float uu = sU[s] - acc; cm = fmaxf(cm, uu); sB[s] = acc; sU[s] = uu; sG[s] = cm; sWi[s] = __expf(mc - cm); } }
        __syncthreads();
        float S[4][8];
        const int tb = opaque(tid >> 4), sb = opaque(tid & 15);
#pragma unroll
        for (int i = 0; i < 4; ++i)
#pragma unroll
            for (int j = 0; j < 8; ++j) S[i][j] = 0.f;
#pragma unroll 1
        for (int d = 0; d < 128; ++d) {
            const f32x4 qv = *(const LAS f32x4*)(sQT + d * 128 + 4 * tb), k0 = *(const LAS f32x4*)(sKT + d * 128 + 8 * sb), k1 = *(const LAS f32x4*)(sKT + d * 128 + 8 * sb + 4);
#pragma unroll
            for (int i = 0; i < 4; ++i) { S[i][0] += qv[i] * k0.x; S[i][1] += qv[i] * k0.y; S[i][2] += qv[i] * k0.z; S[i][3] += qv[i] * k0.w;
                S[i][4] += qv[i] * k1.x; S[i][5] += qv[i] * k1.y; S[i][6] += qv[i] * k1.z; S[i][7] += qv[i] * k1.w; }
        }
        __syncthreads();
#pragma unroll
        for (int j = 0; j < 8; ++j) { const int s = 8 * sb + j; f32x4 pv;
#pragma unroll
            for (int i = 0; i < 4; ++i) { const int t = 4 * tb + i; pv[i] = (s <= t) ? S[i][j] * __expf(sU[s] - sG[t]) : 0.f; }
            *(LAS f32x4*)(sKT + s * 128 + 4 * tb) = pv; }
        __syncthreads();
        if (tid < 128) { const int t = tid; float qn = 0.f, ps = 0.f;
#pragma unroll 4
            for (int d = 0; d < 128; ++d) qn += sQT[d * 128 + t] * sN[d];
#pragma unroll 4
            for (int s = 0; s < 128; ++s) ps += sKT[s * 128 + t];
            const float den = sWi[t] * qn + ps;
            sDen[t] = fmaxf(fabsf(den), __expf(-(sB[t] + sG[t]))); }
        const int e = opaque(tid & 127), tg = opaque(tid >> 7);
        float aP[32], aC[32];
#pragma unroll
        for (int i = 0; i < 32; ++i) { aP[i] = 0.f; aC[i] = 0.f; }
#pragma unroll 1
        for (int s = 0; s < 128; ++s) {
            const float vv = bf2f(F.PROJ[(size_t)(row0 + s) * NPROJ + C_VB + h * 128 + e]);
            const float cc = F.CPRE[(size_t)u * 16384 + s * 128 + e];
#pragma unroll
            for (int t4 = 0; t4 < 8; ++t4) { const f32x4 pp = *(const LAS f32x4*)(sKT + s * 128 + tg * 32 + t4 * 4), qq = *(const LAS f32x4*)(sQT + s * 128 + tg * 32 + t4 * 4);
                aP[4 * t4 + 0] += pp.x * vv; aP[4 * t4 + 1] += pp.y * vv; aP[4 * t4 + 2] += pp.z * vv; aP[4 * t4 + 3] += pp.w * vv;
                aC[4 * t4 + 0] += qq.x * cc; aC[4 * t4 + 1] += qq.y * cc; aC[4 * t4 + 2] += qq.z * cc; aC[4 * t4 + 3] += qq.w * cc; }
        }
        __syncthreads();
#pragma unroll
        for (int i = 0; i < 32; ++i) { const int t = tg * 32 + i; sQT[t * 128 + e] = (sWi[t] * aC[i] + aP[i]) / sDen[t]; }
        __syncthreads();
#pragma unroll 1
        for (int r = 0; r < 16; ++r) { const int t = F.wave * 16 + r; const float h0 = sQT[t * 128 + F.lane], h1 = sQT[t * 128 + 64 + F.lane];
            const float ssq = wave_sum(h0 * h0 + h1 * h1); const float rs = 1.f / sqrtf(ssq * (1.f / 128.f) + EPS);
            const int row = row0 + t;
#pragma unroll
            for (int k = 0; k < 2; ++k) { const int ee = F.lane + 64 * k; const float hv = k ? h1 : h0;
                const float ob = bf2f(F.PROJ[(size_t)row * NPROJ + C_OB + h * 128 + ee]);
                F.MIX[(size_t)row * DM + 512 + h * 128 + ee] = (bf16)f2bf(hv * rs * F.mhg[h * 128 + ee] * sigmoidf_(ob)); } }
    }
}

__device__ __forceinline__ void p9_final_norm(Frame& F) {
    const int gw = F.vcu * 8 + F.wave, NGW = F.G * 8;
    for (int m = gw; m < M; m += NGW) {
        const float rs = 1.f / sqrtf(F.ssf[m] * (1.f / DM) + EPS);
        f32x4* p = (f32x4*)(F.out + (size_t)m * DM);
#pragma unroll
        for (int j = 0; j < 4; ++j) { const f32x4 g = *(const f32x4*)(F.gf + 256 * j + 4 * F.lane); f32x4 v = p[64 * j + F.lane]; v = v * rs * g; p[64 * j + F.lane] = v; }
    }
}

struct Args { const float* in[19]; float* out; unsigned char* ws; int ph_lo, ph_hi; };
__global__ void __launch_bounds__(512, 2) fwd(Args args) {
    extern __shared__ __attribute__((aligned(16))) unsigned char lds[];
    Frame F;
    F.lds = (LAS unsigned char*)lds;
    F.tid = threadIdx.x; F.lane = F.tid & 63; F.wave = __builtin_amdgcn_readfirstlane(F.tid >> 6);
    F.G = gridDim.x; { const int bx = blockIdx.x; F.vcu = (F.G % 8 == 0) ? (bx % 8) * (F.G / 8) + bx / 8 : bx; }
    F.xp = args.in[0]; F.xs = args.in[1]; F.cache_k = args.in[2]; F.cache_v = args.in[3]; F.st_conv = args.in[4]; F.st_C = args.in[5]; F.st_n = args.in[6]; F.st_m = args.in[7];
    F.g1 = args.in[8]; F.w_in = args.in[9]; F.b_gate = args.in[10]; F.w_conv = args.in[11]; F.b_conv = args.in[12]; F.mhg = args.in[13]; F.w_out = args.in[14]; F.g2 = args.in[15];
    F.w_up = args.in[16]; F.w_down = args.in[17]; F.gf = args.in[18];
    F.out = args.out; F.ws = args.ws;
    unsigned char* ws = args.ws;
    F.Win_t = (bf16*)(ws + WS_WIN); F.Wout_t = (bf16*)(ws + WS_WOUT); F.Wup_t = (bf16*)(ws + WS_WUP); F.Wdn_t = (bf16*)(ws + WS_WDN);
    F.XB = (bf16*)(ws + WS_XB); F.PROJ = (bf16*)(ws + WS_PROJ); F.MIX = (bf16*)(ws + WS_MIX); F.HPB = (bf16*)(ws + WS_HPB); F.ACT = (bf16*)(ws + WS_ACT);
    F.rope = (float*)(ws + WS_ROPE); F.rstd1 = (float*)(ws + WS_RSTD1); F.ig = (float*)(ws + WS_IG); F.lf = (float*)(ws + WS_LF); F.chk = (float*)(ws + WS_CHK);
    F.ss2 = (float*)(ws + WS_SS2); F.ssf = (float*)(ws + WS_SSF); F.QF = (float*)(ws + WS_QF); F.KF = (float*)(ws + WS_KF); F.L = (float*)(ws + WS_L);
    F.CPRE = (float*)(ws + WS_CPRE); F.NLOC = (float*)(ws + WS_NLOC); F.NPRE = (float*)(ws + WS_NPRE);
    volatile LAS unsigned* MISC = (volatile LAS unsigned*)(F.lds + MISC_OFF);
    if (F.tid < 32) MISC[F.tid] = 0u;
    __syncthreads();
    XcdBarrier bar; bar.bar = (unsigned*)(ws + WS_CTL) + CW_BAR; bar.x = 0; bar.st = nullptr;
    if (!PER_PHASE_LAUNCH) bar = xcd_barrier_post((unsigned*)(ws + WS_CTL) + CW_BAR, MISC + 8);
#define GRID_BAR() do { if (!PER_PHASE_LAUNCH) xcd_barrier(bar); } while (0)
    const int lo = args.ph_lo, hi = args.ph_hi;
#ifndef PHASE_MASK
#define PHASE_MASK 0x3ff
#endif
#define IN(k) (((PHASE_MASK >> (k)) & 1) && lo <= (k) && (k) < hi)
    if (IN(0)) { p0_prologue(F); GRID_BAR(); }
    if (IN(1)) {
        pg8::Gemm g{F.XB, F.Win_t, M, NPROJ, DM}; pg8::StaticOrder S; S.init(M, NPROJ, F.G, (int)blockIdx.x);
        pg8::EpiIn E{F.PROJ, F.rstd1, F.rope, F.out};
        pg8::gemm_phase<pg8::EpiIn, pg8::StaticOrder, true, true>(F.lds, g, S, E);
        GRID_BAR();
    }
    if (IN(2)) { p2_attn_v1(F); GRID_BAR(); }
    if (IN(3)) { p3_mlstm_local_v1(F); GRID_BAR(); }
    if (IN(4)) { p4_prefix_v1(F); GRID_BAR(); }
    if (IN(5)) { p5_mlstm_out_v1(F); GRID_BAR(); }
    if (IN(6)) {
        pg8::Gemm g{F.MIX, F.Wout_t, M, DM, DM}; pg8::StaticOrder S; S.init(M, DM, F.G, (int)blockIdx.x);
        pg8::EpiOut E{F.xp, F.xs, F.out, F.HPB, F.ss2};
        pg8::gemm_phase<pg8::EpiOut, pg8::StaticOrder, true, true>(F.lds, g, S, E);
        GRID_BAR();
    }
    if (IN(7)) {
        pg8::Gemm g{F.HPB, F.Wup_t, M, FF, DM}; pg8::StaticOrder S; S.init(M, FF, F.G, (int)blockIdx.x);
        pg8::EpiUp E{F.ACT, F.ss2};
        pg8::gemm_phase<pg8::EpiUp, pg8::StaticOrder, true, true>(F.lds, g, S, E);
        GRID_BAR();
    }
    if (IN(8)) {
        pg8::Gemm g{F.ACT, F.Wdn_t, M, DM, FF}; pg8::StaticOrder S; S.init(M, DM, F.G, (int)blockIdx.x);
        pg8::EpiDown E{F.out, F.ssf};
        pg8::gemm_phase<pg8::EpiDown, pg8::StaticOrder, true, true>(F.lds, g, S, E);
        GRID_BAR();
    }
    if (IN(9)) { p9_final_norm(F); }
#undef IN
}

extern "C" void kernel_launch(void* const* d_in, const int* in_sizes, int n_in, void* d_out, int out_size, void* d_ws, size_t ws_size, hipStream_t stream) {
    static int grid = 0;
    if (grid == 0) {
        if (n_in != 19 || (size_t)out_size != O_END || ws_size < WS_END) { fprintf(stderr, "kernel_launch: unexpected shapes (n_in %d out %d ws %zu)\n", n_in, out_size, ws_size); grid = -1; return; }
        int dev = 0, cus = 0, per_cu = 0;
        if (hipGetDevice(&dev) != hipSuccess || hipDeviceGetAttribute(&cus, hipDeviceAttributeMultiprocessorCount, dev) != hipSuccess) { grid = -1; return; }
        if (hipFuncSetAttribute((const void*)fwd, hipFuncAttributeMaxDynamicSharedMemorySize, LDS_BYTES) != hipSuccess) { fprintf(stderr, "kernel_launch: hipFuncSetAttribute failed\n"); grid = -1; return; }
        if (hipOccupancyMaxActiveBlocksPerMultiprocessor(&per_cu, (const void*)fwd, 512, LDS_BYTES) != hipSuccess || per_cu < 1) fprintf(stderr, "kernel_launch: occupancy query says %d\n", per_cu);
        (void)hipGetLastError();
        grid = cus;
    }
    if (grid < 0) return;
    if (hipMemsetAsync((char*)d_ws + WS_CTL, 0, CTL_ZERO_BYTES, stream) != hipSuccess) return;
    Args a{};
    for (int i = 0; i < 19; ++i) a.in[i] = (const float*)d_in[i];
    a.out = (float*)d_out; a.ws = (unsigned char*)d_ws;
#if PER_PHASE_LAUNCH
    for (int ph = 0; ph < NPH; ++ph) { a.ph_lo = ph; a.ph_hi = ph + 1; hipLaunchKernelGGL(fwd, dim3(grid), dim3(512), LDS_BYTES, stream, a); }
#else
    a.ph_lo = 0; a.ph_hi = NPH; hipLaunchKernelGGL(fwd, dim3(grid), dim3(512), LDS_BYTES, stream, a);
#endif
}
```

```cpp
#include <hip/hip_runtime.h>
#include <cstdio>
#include <cstdint>
namespace pg8 {
#define PG8_LAS __attribute__((address_space(3)))
typedef unsigned short bf16_t;
typedef short bf16x8 __attribute__((ext_vector_type(8)));
typedef float f32x4 __attribute__((ext_vector_type(4)));
typedef unsigned u32x4 __attribute__((ext_vector_type(4)));
constexpr int BM = 256, BK = 64, HALF = 128, HTB = HALF * BK * 2  , STAGE_BYTES = 8 * HTB, NXCD = 8, WGM = 8;

__host__ __device__ __forceinline__ int lds_byte(int r, int c) { const int st = (r >> 4) * 2 + (c >> 5), rr = r & 15, cc = c & 31, ob = rr * 64 + cc * 2; return st * 1024 + (ob ^ (((ob >> 9) & 1) << 5)); }
__host__ __device__ __forceinline__ void stage_rc(int b, int& R, int& C) { const int st = b / 1024, sb = b % 1024, swz = sb ^ (((sb >> 9) & 1) << 5); R = (st >> 1) * 16 + swz / 64; C = (st & 1) * 32 + (swz % 64) / 2; }
__host__ __device__ __forceinline__ int perm32(int rho) { const int n = rho >> 4, i = rho & 15; return 8 * (i >> 2) + 4 * n + (i & 3); }

struct Unit { int pm, pn; };
struct Gemm { const bf16_t* A; const bf16_t* Bt; int M, N, K; };

struct StaticOrder {
    int nM, nN, nwg, G, c;
    __host__ __device__ void init(int M, int N, int G_, int c_) { nM = M / BM; nN = N / BM; nwg = nM * nN; G = G_; c = c_; }
    __host__ __device__ bool next(int i, Unit& u) const {
        const long L = (long)i * G + c; if (L >= nwg) return false;
        int wgid = (int)L; { const int q = nwg / NXCD, r = nwg % NXCD, xcd = wgid % NXCD, off = wgid / NXCD; wgid = (xcd < r ? xcd * (q + 1) : r * (q + 1) + (xcd - r) * q) + off; }
        const int nig = WGM * nN, gid = wgid / nig, fm = gid * WGM, gsz = (nM - fm) < WGM ? (nM - fm) : WGM;
        u.pm = fm + ((wgid % nig) % gsz); u.pn = (wgid % nig) / gsz; return true;
    }
    __device__ __forceinline__ void a_ready(const Unit&) const {}
    __device__ __forceinline__ void done(const Unit&) const {}
};

__device__ __forceinline__ unsigned cvt_pk_bf16(float lo, float hi) { unsigned r; asm volatile("v_cvt_pk_bf16_f32 %0, %1, %2" : "=v"(r) : "v"(lo), "v"(hi)); return r; }
typedef float f32x2 __attribute__((ext_vector_type(2)));

template <class Epi, class Sched, bool ALIGN_EPI = false, bool SP2 = false>
__device__ __forceinline__ void gemm_phase(PG8_LAS unsigned char* lds, const Gemm g, const Sched& S, const Epi& E) {
    const int tid = threadIdx.x, wid = __builtin_amdgcn_readfirstlane(tid >> 6), lane = tid & 63, wr = wid >> 2, wc = wid & 3, fr = lane & 15, fq = lane >> 4;
    const int K = g.K, nt = K / BK;
    unsigned voffA[2], voffB[2];
#pragma unroll
    for (int i = 0; i < 2; ++i) { int R, C; stage_rc(tid * 16 + i * 8192, R, C); const int Rb = Epi::PERM ? ((R & ~31) + perm32(R & 31)) : R;
        voffA[i] = (unsigned)(R * K + C) * 2u; voffB[i] = (unsigned)(Rb * K + C) * 2u; }
    const size_t kstep = (size_t)(BK * 2);
    const size_t hstep = (size_t)HALF * K * 2;
    const size_t tstep = 2 * hstep;
    const unsigned ldsw = (unsigned)wid * 1024u;
    const int aoff = lds_byte(wr * 64 + fr, fq * 8), boff = lds_byte(wc * 32 + fr, fq * 8);
#define PG8_SA(b, h) (((b) * 2 + (h)) * HTB)
#define PG8_SB(b, h) ((4 + (b) * 2 + (h)) * HTB)
#define PG8_STAGE(bufoff, gbase, voff) do { _Pragma("unroll") for (int _i = 0; _i < 2; ++_i) \
        __builtin_amdgcn_global_load_lds((const unsigned*)((const char*)(gbase) + (voff)[_i]), (PG8_LAS unsigned*)(lds + (bufoff) + ldsw + _i * 8192), 16, 0, 0); } while (0)
#define PG8_LDA(dst, b, h) do { _Pragma("unroll") for (int m = 0; m < 4; ++m) _Pragma("unroll") for (int k = 0; k < 2; ++k) dst[m][k] = *(const PG8_LAS bf16x8*)(lds + PG8_SA(b, h) + aoff + m * 2048 + k * 1024); } while (0)
#define PG8_LDB(dst, b, h) do { _Pragma("unroll") for (int n = 0; n < 2; ++n) _Pragma("unroll") for (int k = 0; k < 2; ++k) dst[n][k] = *(const PG8_LAS bf16x8*)(lds + PG8_SB(b, h) + boff + n * 2048 + k * 1024); } while (0)
#define PG8_MMA(ai, bj, At, Bt) do { __builtin_amdgcn_s_setprio(1); _Pragma("unroll") for (int m = 0; m < 4; ++m) _Pragma("unroll") for (int n = 0; n < 2; ++n) _Pragma("unroll") for (int k = 0; k < 2; ++k) \
        acc[ai][bj][m][n] = __builtin_amdgcn_mfma_f32_16x16x32_bf16(Bt[n][k], At[m][k], acc[ai][bj][m][n], 0, 0, 0); __builtin_amdgcn_s_setprio(0); } while (0)
#define PG8_WAIT_V(n) asm volatile("s_waitcnt vmcnt(" #n ")" ::: "memory")
#define PG8_WAIT_L(n) asm volatile("s_waitcnt lgkmcnt(" #n ")" ::: "memory")
#define PG8_BAR __builtin_amdgcn_s_barrier()
#define PG8_SCHED __builtin_amdgcn_sched_barrier(0)
    Unit cur, nxt; int ui = 0;
    if (!S.next(0, cur)) return;
    f32x4 acc[2][2][4][2];
#pragma unroll
    for (int a = 0; a < 2; ++a)
#pragma unroll
        for (int b = 0; b < 2; ++b)
#pragma unroll
            for (int m = 0; m < 4; ++m)
#pragma unroll
                for (int n = 0; n < 2; ++n) acc[a][b][m][n] = (f32x4){0.f, 0.f, 0.f, 0.f};
    bf16x8 At[4][2], B0[2][2], B1[2][2];
    const char* cA = (const char*)g.A + (size_t)cur.pm * tstep; const char* cB = (const char*)g.Bt + (size_t)cur.pn * tstep;
    S.a_ready(cur);
    if constexpr (SP2) {
        PG8_STAGE(PG8_SB(0, 0), cB, voffB); PG8_STAGE(PG8_SB(0, 1), cB + hstep, voffB); PG8_STAGE(PG8_SA(0, 0), cA, voffA); PG8_STAGE(PG8_SA(0, 1), cA + hstep, voffA);
        if (wr == 1) PG8_BAR;
        PG8_WAIT_V(2); PG8_BAR;
        PG8_STAGE(PG8_SB(1, 0), cB + kstep, voffB); PG8_STAGE(PG8_SA(1, 0), cA + kstep, voffA); PG8_STAGE(PG8_SB(1, 1), cB + hstep + kstep, voffB);
        PG8_WAIT_V(6); PG8_BAR;
    } else {
        PG8_STAGE(PG8_SB(0, 0), cB, voffB); PG8_STAGE(PG8_SA(0, 0), cA, voffA); PG8_STAGE(PG8_SB(0, 1), cB + hstep, voffB); PG8_STAGE(PG8_SA(0, 1), cA + hstep, voffA);
        if (wr == 1) PG8_BAR;
        PG8_WAIT_V(4); PG8_BAR;
        PG8_STAGE(PG8_SB(1, 0), cB + kstep, voffB); PG8_STAGE(PG8_SA(1, 0), cA + kstep, voffA); PG8_STAGE(PG8_SB(1, 1), cB + hstep + kstep, voffB);
        PG8_WAIT_V(6); PG8_BAR;
    }
    for (;;) {
        const bool has_next = S.next(ui + 1, nxt);
        const char* nA = has_next ? (const char*)g.A + (size_t)nxt.pm * tstep : cA; const char* nB = has_next ? (const char*)g.Bt + (size_t)nxt.pn * tstep : cB;
        for (int t = 0; t < nt; t += 2) {
            const bool last = (t == nt - 2);
            const char* a1 = cA + (size_t)(t + 1) * kstep;
            const char* a2 = last ? nA : cA + (size_t)(t + 2) * kstep; const char* b2 = last ? nB : cB + (size_t)(t + 2) * kstep;
            const char* a3 = a2 + kstep; const char* b3 = b2 + kstep;
            if (last && has_next) S.a_ready(nxt);
            if constexpr (SP2) {
            PG8_LDB(B0, 0, 0); PG8_LDB(B1, 0, 1); PG8_SCHED; PG8_LDA(At, 0, 0); PG8_STAGE(PG8_SA(1, 1), a1 + hstep, voffA);
            PG8_WAIT_V(8); PG8_WAIT_L(0); PG8_BAR; PG8_MMA(0, 0, At, B0); PG8_MMA(0, 1, At, B1); PG8_BAR; PG8_SCHED;
            PG8_LDA(At, 0, 1); PG8_STAGE(PG8_SB(0, 0), b2, voffB); PG8_STAGE(PG8_SB(0, 1), b2 + hstep, voffB); PG8_STAGE(PG8_SA(0, 0), a2, voffA);
            PG8_WAIT_V(8); PG8_WAIT_L(0); PG8_BAR; PG8_MMA(1, 0, At, B0); PG8_MMA(1, 1, At, B1); PG8_BAR; PG8_SCHED;
            PG8_LDB(B0, 1, 0); PG8_LDB(B1, 1, 1); PG8_SCHED; PG8_LDA(At, 1, 0); PG8_STAGE(PG8_SA(0, 1), a2 + hstep, voffA);
            PG8_WAIT_V(8); PG8_WAIT_L(0); PG8_BAR; PG8_MMA(0, 0, At, B0); PG8_MMA(0, 1, At, B1); PG8_BAR; PG8_SCHED;
            PG8_LDA(At, 1, 1); PG8_STAGE(PG8_SB(1, 0), b3, voffB); PG8_STAGE(PG8_SB(1, 1), b3 + hstep, voffB); PG8_STAGE(PG8_SA(1, 0), a3, voffA);
            PG8_WAIT_V(8); PG8_WAIT_L(0); PG8_BAR; PG8_MMA(1, 0, At, B0); PG8_MMA(1, 1, At, B1); PG8_BAR; PG8_SCHED;
            } else {
            PG8_LDB(B0, 0, 0); PG8_SCHED; PG8_LDA(At, 0, 0); PG8_STAGE(PG8_SA(1, 1), a1 + hstep, voffA);
            PG8_WAIT_L(8); PG8_BAR; PG8_WAIT_L(0); PG8_MMA(0, 0, At, B0); PG8_BAR; PG8_SCHED;
            PG8_LDB(B1, 0, 1); PG8_STAGE(PG8_SB(0, 0), b2, voffB);
            PG8_BAR; PG8_WAIT_L(0); PG8_MMA(0, 1, At, B1); PG8_BAR;
            PG8_LDA(At, 0, 1); PG8_STAGE(PG8_SA(0, 0), a2, voffA);
            PG8_BAR; PG8_WAIT_L(0); PG8_MMA(1, 0, At, B0); PG8_BAR; PG8_SCHED;
            PG8_STAGE(PG8_SB(0, 1), b2 + hstep, voffB);
            PG8_WAIT_V(6); PG8_BAR; PG8_MMA(1, 1, At, B1); PG8_BAR;
            PG8_LDB(B0, 1, 0); PG8_SCHED; PG8_LDA(At, 1, 0); PG8_STAGE(PG8_SA(0, 1), a2 + hstep, voffA);
            PG8_WAIT_L(8); PG8_BAR; PG8_WAIT_L(0); PG8_MMA(0, 0, At, B0); PG8_BAR; PG8_SCHED;
            PG8_LDB(B1, 1, 1); PG8_STAGE(PG8_SB(1, 0), b3, voffB);
            PG8_BAR; PG8_WAIT_L(0); PG8_MMA(0, 1, At, B1); PG8_BAR;
            PG8_LDA(At, 1, 1); PG8_STAGE(PG8_SA(1, 0), a3, voffA);
            PG8_BAR; PG8_WAIT_L(0); PG8_MMA(1, 0, At, B0); PG8_BAR; PG8_SCHED;
            PG8_STAGE(PG8_SB(1, 1), b3 + hstep, voffB);
            PG8_WAIT_V(6); PG8_BAR; PG8_MMA(1, 1, At, B1); PG8_BAR;
            }
        }
        if constexpr (ALIGN_EPI) { if (wr == 0) PG8_BAR; }
        if constexpr (!Epi::AFTER_DRAIN) { E(acc, cur, wr, wc, fr, fq); S.done(cur); }
        if (!has_next) break;
#pragma unroll
        for (int a = 0; a < 2; ++a)
#pragma unroll
            for (int b = 0; b < 2; ++b)
#pragma unroll
                for (int m = 0; m < 4; ++m)
#pragma unroll
                    for (int n = 0; n < 2; ++n) acc[a][b][m][n] = (f32x4){0.f, 0.f, 0.f, 0.f};
        cur = nxt; cA = nA; cB = nB; ++ui;
        if constexpr (ALIGN_EPI) { if (wr == 1) PG8_BAR; }
    }
    PG8_WAIT_V(0);
    if constexpr (!ALIGN_EPI) { if (wr == 0) PG8_BAR; }
    PG8_BAR;
    if constexpr (Epi::AFTER_DRAIN) { E.fused(acc, cur, wr, wc, fr, fq, lds, wid, lane); S.done(cur); }
#undef PG8_SA
#undef PG8_SB
#undef PG8_STAGE
#undef PG8_LDA
#undef PG8_LDB
#undef PG8_MMA
#undef PG8_WAIT_V
#undef PG8_WAIT_L
#undef PG8_BAR
#undef PG8_SCHED
}
}

#ifndef PER_PHASE_LAUNCH
#define PER_PHASE_LAUNCH 0
#endif

constexpr int DM = 1024, NBP = 4, SEQ = 4096, DBS = 128, DTS = 8;
constexpr int MP = NBP * SEQ, MS = DBS * DTS, M = MP + MS;
constexpr int NPROJ = 3584, INCOLS = 3592, FF = 4096, WBUF = 2048;
constexpr int C_Q = 0, C_K = 512, C_V = 1024, C_RAW = 1536, C_VB = 2560, C_OB = 3072;
constexpr float EPS = 1e-6f;
constexpr int NPH = 10;
constexpr size_t O_YP = 0, O_YS = O_YP + (size_t)MP * DM, O_PK = O_YS + (size_t)MS * DM, O_PV = O_PK + (size_t)NBP * WBUF * 512,
    O_PCONV = O_PV + (size_t)NBP * WBUF * 512, O_PC = O_PCONV + (size_t)NBP * 3 * 1024, O_PN = O_PC + (size_t)NBP * 4 * 128 * 128, O_PM = O_PN + (size_t)NBP * 4 * 128,
    O_SK = O_PM + (size_t)NBP * 4, O_SV = O_SK + (size_t)DBS * WBUF * 512, O_SCONV = O_SV + (size_t)DBS * WBUF * 512, O_SC = O_SCONV + (size_t)DBS * 3 * 1024,
    O_SN = O_SC + (size_t)DBS * 4 * 128 * 128, O_SM = O_SN + (size_t)DBS * 4 * 128, O_END = O_SM + (size_t)DBS * 4;
static_assert(O_END == 303774224ull, "output size");
constexpr size_t MiB = 1u << 20;
constexpr size_t WS_CTL = 0, CTL_ZERO_BYTES = 1 * MiB;
constexpr int CW_BAR = 4096;
constexpr size_t WS_SS2 = 256 * 1024, WS_SSF = 512 * 1024;
constexpr size_t WS_WIN = 2 * MiB, WS_WOUT = 10 * MiB, WS_WUP = 12 * MiB, WS_WDN = 20 * MiB;
constexpr size_t WS_ROPE = 28 * MiB, WS_RSTD1 = 29 * MiB, WS_IG = 29 * MiB + 512 * 1024, WS_LF = 30 * MiB, WS_CHK = 31 * MiB;
constexpr size_t WS_XB = 32 * MiB, WS_PROJ = 68 * MiB, WS_MIX = 188 * MiB, WS_HPB = 222 * MiB, WS_ACT = 256 * MiB;
constexpr size_t WS_QF = 392 * MiB, WS_KF = 426 * MiB, WS_L = 460 * MiB, WS_CPRE = 492 * MiB, WS_NLOC = 524 * MiB, WS_NPRE = 525 * MiB, WS_END = 526 * MiB;
static_assert(WS_PROJ + (size_t)M * NPROJ * 2 <= WS_MIX && WS_ACT + (size_t)M * FF * 2 <= WS_QF && WS_XB + (size_t)M * DM * 2 <= WS_PROJ, "ws map");

constexpr int LDS_BYTES = 147456;
constexpr int MISC_OFF = 131072 + 8192;

#define GAS __attribute__((address_space(1)))
#define LAS __attribute__((address_space(3)))
typedef unsigned short bf16;
typedef unsigned v4u __attribute__((ext_vector_type(4)));
typedef unsigned v2u __attribute__((ext_vector_type(2)));
typedef float f32x4 __attribute__((ext_vector_type(4)));
typedef GAS unsigned gu32;
#define LDS_WAIT() asm volatile("s_waitcnt lgkmcnt(0)" ::: "memory")
__device__ __forceinline__ unsigned f2bf(float f) { unsigned u = __builtin_bit_cast(unsigned, f); return (u + 0x7fffu + ((u >> 16) & 1u)) >> 16; }
__device__ __forceinline__ unsigned pk2(float lo, float hi) { return f2bf(lo) | (f2bf(hi) << 16); }
__device__ __forceinline__ float bf2f(unsigned short u) { return __builtin_bit_cast(float, (unsigned)u << 16); }
__device__ __forceinline__ float bflo(unsigned u) { return __builtin_bit_cast(float, u << 16); }
__device__ __forceinline__ float bfhi(unsigned u) { return __builtin_bit_cast(float, u & 0xffff0000u); }
__device__ __forceinline__ float wave_sum(float v) {
#pragma unroll
    for (int o = 1; o < 64; o <<= 1) v += __shfl_xor(v, o);
    return v;
}
__device__ __forceinline__ float wave_max(float v) {
#pragma unroll
    for (int o = 1; o < 64; o <<= 1) v = fmaxf(v, __shfl_xor(v, o));
    return v;
}
__device__ __forceinline__ int opaque(int v) { asm volatile("" : "+v"(v)); return v; }
__device__ __forceinline__ float sigmoidf_(float x) { return 1.f / (1.f + __expf(-x)); }

#define XB_TMO      128
#define XB_XCNT(j)  (256  + 64 * (j))
#define XB_XSUB(j)  (1280 + 64 * (j))
#define XB_XGEN(j)  (2304 + 64 * (j))
#define XB_TOP      3328
#define XB_TOPGEN   3392
#define XCD_BAR_WORDS 3456
#define XB_SPIN_CAP (1u << 18)
__device__ __forceinline__ unsigned xb_ld(unsigned* p)              { return __hip_atomic_load(p, __ATOMIC_RELAXED, __HIP_MEMORY_SCOPE_AGENT); }
__device__ __forceinline__ unsigned xb_add(unsigned* p, unsigned v) { return __hip_atomic_fetch_add(p, v, __ATOMIC_RELAXED, __HIP_MEMORY_SCOPE_AGENT); }
__device__ __forceinline__ unsigned xb_xcc_id() { return (unsigned)__builtin_amdgcn_s_getreg((3 << 11) | 20) & 0xFu; }
#define XB_SPIN(cond, bar) do { unsigned _sp = 0; while (cond) { __builtin_amdgcn_s_sleep(1); \
    if ((++_sp & 255u) == 0u) { if (xb_ld(&(bar)[XB_TMO])) break; if (_sp > XB_SPIN_CAP) { atomicAdd(&(bar)[XB_TMO], 1u); break; } } } } while (0)
struct XcdBarrier { unsigned* bar; unsigned x; volatile LAS unsigned* st; };
__device__ __forceinline__ XcdBarrier xcd_barrier_post(unsigned* bar, volatile LAS unsigned* st) {
    XcdBarrier b; b.bar = bar; b.x = xb_xcc_id(); b.st = st;
    if (threadIdx.x == 0) (void)xb_add(&bar[XB_XCNT(b.x)], 1u);
    return b;
}
__device__ __forceinline__ void xcd_barrier_complete(unsigned* bar, unsigned x, unsigned& nloc, unsigned& nx) {
    const unsigned G = gridDim.x * gridDim.y * gridDim.z;
    unsigned sum, cnt, mine, sp = 0u;
    for (;;) {
        sum = 0u; cnt = 0u; mine = 0u;
#pragma unroll
        for (unsigned j = 0; j < 16; ++j) { const unsigned c = xb_ld(&bar[XB_XCNT(j)]); sum += c; cnt += (c > 0u) ? 1u : 0u; mine = (j == x) ? c : mine; }
        if (sum == G) break;
        __builtin_amdgcn_s_sleep(1);
        if ((++sp & 255u) == 0u) { if (xb_ld(&bar[XB_TMO])) break; if (sp > XB_SPIN_CAP) { atomicAdd(&bar[XB_TMO], 1u); break; } }
    }
    nloc = mine > 0u ? mine : 1u; nx = cnt > 0u ? cnt : 1u;
}
__device__ __forceinline__ void xcd_barrier(const XcdBarrier& b) {
    asm volatile("s_waitcnt vmcnt(0)" ::: "memory");
    __syncthreads();
    if (threadIdx.x == 0) {
        unsigned* bar = b.bar;
        __builtin_amdgcn_s_waitcnt(0);
        unsigned nloc = b.st[0], nx = b.st[1];
        if (nloc == 0u) { xcd_barrier_complete(bar, b.x, nloc, nx); b.st[0] = nloc; b.st[1] = nx; }
        const unsigned old = xb_add(&bar[XB_XSUB(b.x)], 1u);
        const unsigned gen = old / nloc;
        if (old + 1u == (gen + 1u) * nloc) {
            __builtin_amdgcn_fence(__ATOMIC_RELEASE, "agent");
            asm volatile("s_waitcnt vmcnt(0)" ::: "memory");
            const unsigned og = xb_add(&bar[XB_TOP], 1u);
            const unsigned tg = og / nx;
            if (og + 1u == (tg + 1u) * nx) xb_add(&bar[XB_TOPGEN], 1u);
            else XB_SPIN(xb_ld(&bar[XB_TOPGEN]) == tg, bar);
            __builtin_amdgcn_fence(__ATOMIC_ACQUIRE, "agent");
            xb_add(&bar[XB_XGEN(b.x)], 1u);
            asm volatile("s_waitcnt vmcnt(0)" ::: "memory");
        } else {
            XB_SPIN(xb_ld(&bar[XB_XGEN(b.x)]) == gen, bar);
            __builtin_amdgcn_fence(__ATOMIC_ACQUIRE, "agent");
            asm volatile("s_waitcnt vmcnt(0)" ::: "memory");
        }
    }
    __syncthreads();
}

struct Frame {
    LAS unsigned char* lds;
    int tid, lane, wave, vcu, G;
    const float *xp, *xs, *cache_k, *cache_v, *st_conv, *st_C, *st_n, *st_m, *g1, *w_in, *b_gate, *w_conv, *b_conv, *mhg, *w_out, *g2, *w_up, *w_down, *gf;
    float* out; unsigned char* ws;
    bf16 *Win_t, *Wout_t, *Wup_t, *Wdn_t, *XB, *PROJ, *MIX, *HPB, *ACT;
    float *rope, *rstd1, *ig, *lf, *chk, *ss2, *ssf, *QF, *KF, *L, *CPRE, *NLOC, *NPRE;
};

namespace pg8 {
struct EpiIn {
    static constexpr bool PERM = true, AFTER_DRAIN = false;
    bf16_t* proj; const float* rstd; const float* rope; float* out;
    __device__ __forceinline__ void operator()(const f32x4 (&acc)[2][2][4][2], const Unit& u, int wr, int wc, int fr, int fq) const {
        const int pn = u.pn;
        const bool rot = (pn < 4) && ((wc & 1) == 0);
#pragma unroll
        for (int ai = 0; ai < 2; ++ai)
#pragma unroll
            for (int m = 0; m < 4; ++m) {
                const int row = u.pm * BM + ai * HALF + wr * 64 + m * 16 + fr;
                const float rs = rstd[row];
                const bool smp = row >= MP;
                const int b = smp ? ((row - MP) >> 3) : (row >> 12), t = smp ? ((row - MP) & 7) : (row & 4095);
                const int pidx = smp ? (SEQ + t) : t;
#pragma unroll
                for (int bj = 0; bj < 2; ++bj) {
                    const int col0 = pn * BM + bj * HALF + wc * 32 + 8 * fq;
                    f32x4 v0 = acc[ai][bj][m][0] * rs, v1 = acc[ai][bj][m][1] * rs;
                    if (rot) {
                        f32x4 p0, p1;
                        p0.x = __shfl_xor(v0.x, 16); p0.y = __shfl_xor(v0.y, 16); p0.z = __shfl_xor(v0.z, 16); p0.w = __shfl_xor(v0.w, 16);
                        p1.x = __shfl_xor(v1.x, 16); p1.y = __shfl_xor(v1.y, 16); p1.z = __shfl_xor(v1.z, 16); p1.w = __shfl_xor(v1.w, 16);
                        if (fq < 2) {
                            const f32x4 c0 = *(const f32x4*)(rope + pidx * 16), c1 = *(const f32x4*)(rope + pidx * 16 + 4);
                            const f32x4 s0 = *(const f32x4*)(rope + pidx * 16 + 8), s1 = *(const f32x4*)(rope + pidx * 16 + 12);
                            if (fq == 0) { v0 = v0 * c0 - p0 * s0; v1 = v1 * c1 - p1 * s1; }
                            else         { v0 = v0 * c0 + p0 * s0; v1 = v1 * c1 + p1 * s1; }
                        }
                    }
                    if (pn < 2) { v0 = v0 * 0.125f; v1 = v1 * 0.125f; }
                    u32x4 w; w.x = cvt_pk_bf16(v0[0], v0[1]); w.y = cvt_pk_bf16(v0[2], v0[3]); w.z = cvt_pk_bf16(v1[0], v1[1]); w.w = cvt_pk_bf16(v1[2], v1[3]);
                    *(u32x4*)(proj + (size_t)row * NPROJ + col0) = w;
                    if (pn >= 2 && pn < 6) {
                        const bool isk = pn < 4; const int cc = col0 - (isk ? C_K : C_V);
                        float* dst = nullptr;
                        if (smp) dst = out + (isk ? O_SK : O_SV) + ((size_t)b * WBUF + (WBUF - DTS) + t) * 512 + cc;
                        else if (t >= SEQ - WBUF) dst = out + (isk ? O_PK : O_PV) + ((size_t)b * WBUF + (t - (SEQ - WBUF))) * 512 + cc;
                        if (dst) { *(f32x4*)dst = v0; *(f32x4*)(dst + 4) = v1; }
                    } else if (pn >= 6 && pn < 10) {
                        const int cc = col0 - C_RAW;
                        float* dst = nullptr;
                        if (smp) { if (t >= DTS - 3) dst = out + O_SCONV + ((size_t)b * 3 + (t - (DTS - 3))) * 1024 + cc; }
                        else if (t >= SEQ - 3) dst = out + O_PCONV + ((size_t)b * 3 + (t - (SEQ - 3))) * 1024 + cc;
                        if (dst) { *(f32x4*)dst = v0; *(f32x4*)(dst + 4) = v1; }
                    }
                }
            }
    }
};
struct EpiOut {
    static constexpr bool PERM = true, AFTER_DRAIN = false;
    const float* xp; const float* xs; float* hp; bf16_t* hpb; float* ss;
    __device__ __forceinline__ void operator()(const f32x4 (&acc)[2][2][4][2], const Unit& u, int wr, int wc, int fr, int fq) const {
#pragma unroll
        for (int ai = 0; ai < 2; ++ai)
#pragma unroll
            for (int m = 0; m < 4; ++m) {
                const int row = u.pm * BM + ai * HALF + wr * 64 + m * 16 + fr;
                const float* xr = (row < MP) ? xp + (size_t)row * DM : xs + (size_t)(row - MP) * DM;
                float s = 0.f;
#pragma unroll
                for (int bj = 0; bj < 2; ++bj) {
                    const int col0 = u.pn * BM + bj * HALF + wc * 32 + 8 * fq;
                    const f32x4 v0 = acc[ai][bj][m][0] + *(const f32x4*)(xr + col0), v1 = acc[ai][bj][m][1] + *(const f32x4*)(xr + col0 + 4);
                    *(f32x4*)(hp + (size_t)row * DM + col0) = v0; *(f32x4*)(hp + (size_t)row * DM + col0 + 4) = v1;
                    u32x4 w; w.x = cvt_pk_bf16(v0[0], v0[1]); w.y = cvt_pk_bf16(v0[2], v0[3]); w.z = cvt_pk_bf16(v1[0], v1[1]); w.w = cvt_pk_bf16(v1[2], v1[3]);
                    *(u32x4*)(hpb + (size_t)row * DM + col0) = w;
                    s += (v0[0] * v0[0] + v0[1] * v0[1]) + (v0[2] * v0[2] + v0[3] * v0[3]) + (v1[0] * v1[0] + v1[1] * v1[1]) + (v1[2] * v1[2] + v1[3] * v1[3]);
                }
                s += __shfl_xor(s, 16); s += __shfl_xor(s, 32);
                if (fq == 0) atomicAdd(ss + row, s);
            }
    }
};
struct EpiUp {
    static constexpr bool PERM = true, AFTER_DRAIN = false;
    bf16_t* act; const float* ss;
    __device__ __forceinline__ void operator()(const f32x4 (&acc)[2][2][4][2], const Unit& u, int wr, int wc, int fr, int fq) const {
#pragma unroll
        for (int ai = 0; ai < 2; ++ai)
#pragma unroll
            for (int m = 0; m < 4; ++m) {
                const int row = u.pm * BM + ai * HALF + wr * 64 + m * 16 + fr;
                const float rs = 1.f / sqrtf(ss[row] * (1.f / DM) + EPS);
#pragma unroll
                for (int bj = 0; bj < 2; ++bj) {
                    const int col0 = u.pn * BM + bj * HALF + wc * 32 + 8 * fq;
                    f32x4 v0 = acc[ai][bj][m][0] * rs, v1 = acc[ai][bj][m][1] * rs;
#pragma unroll
                    for (int e = 0; e < 4; ++e) { const float a = fmaxf(v0[e], 0.f), c = fmaxf(v1[e], 0.f); v0[e] = a * a; v1[e] = c * c; }
                    u32x4 w; w.x = cvt_pk_bf16(v0[0], v0[1]); w.y = cvt_pk_bf16(v0[2], v0[3]); w.z = cvt_pk_bf16(v1[0], v1[1]); w.w = cvt_pk_bf16(v1[2], v1[3]);
                    *(u32x4*)(act + (size_t)row * FF + col0) = w;
                }
            }
    }
};
struct EpiDown {
    static constexpr bool PERM = true, AFTER_DRAIN = false;
    float* hp; float* ss;
    __device__ __forceinline__ void operator()(const f32x4 (&acc)[2][2][4][2], const Unit& u, int wr, int wc, int fr, int fq) const {
#pragma unroll
        for (int ai = 0; ai < 2; ++ai)
#pragma unroll
            for (int m = 0; m < 4; ++m) {
                const int row = u.pm * BM + ai * HALF + wr * 64 + m * 16 + fr;
                float s = 0.f;
#pragma unroll
                for (int bj = 0; bj < 2; ++bj) {
                    const int col0 = u.pn * BM + bj * HALF + wc * 32 + 8 * fq;
                    float* p = hp + (size_t)row * DM + col0;
                    const f32x4 v0 = acc[ai][bj][m][0] + *(const f32x4*)p, v1 = acc[ai][bj][m][1] + *(const f32x4*)(p + 4);
                    *(f32x4*)p = v0; *(f32x4*)(p + 4) = v1;
                    s += (v0[0] * v0[0] + v0[1] * v0[1]) + (v0[2] * v0[2] + v0[3] * v0[3]) + (v1[0] * v1[0] + v1[1] * v1[1]) + (v1[2] * v1[2] + v1[3] * v1[3]);
                }
                s += __shfl_xor(s, 16); s += __shfl_xor(s, 32);
                if (fq == 0) atomicAdd(ss + row, s);
            }
    }
};
}

__device__ __forceinline__ void p0_transpose_item(const float* W, int K, int ldw, int nblk, const float* gain, bf16* WT, LAS float* scr, int item, int lane) {
    const int kb = item / nblk, nb = item % nblk, k0 = 64 * kb, n0 = 32 * nb;
#pragma unroll 8
    for (int i = 0; i < 32; ++i) { const int kk = 2 * i + (lane >> 5); const float gg = gain ? gain[k0 + kk] : 1.f; scr[kk * 33 + (lane & 31)] = gg * W[(size_t)(k0 + kk) * ldw + n0 + (lane & 31)]; }
    LDS_WAIT(); asm volatile("" ::: "memory");
    const int c = lane & 7;
#pragma unroll
    for (int j = 0; j < 4; ++j) { const int n = (lane >> 3) + 8 * j; const LAS float* s = scr + (8 * c) * 33 + n;
        v4u o; o.x = pk2(s[0 * 33], s[1 * 33]); o.y = pk2(s[2 * 33], s[3 * 33]); o.z = pk2(s[4 * 33], s[5 * 33]); o.w = pk2(s[6 * 33], s[7 * 33]);
        *(GAS v4u*)(WT + (size_t)(n0 + n) * K + k0 + 8 * c) = o; }
    LDS_WAIT(); asm volatile("" ::: "memory");
}
__device__ __forceinline__ void sincos_d(double a, double& s, double& c) {
    const double TWO_PI = 6.283185307179586476925286766559;
    const double k = __builtin_rint(a * (1.0 / TWO_PI));
    const double r = a - k * TWO_PI, r2 = r * r;
    double sc = 1.0, ss = r, tc = 1.0, ts = r;
#pragma unroll
    for (int n = 1; n <= 17; ++n) { tc *= -r2 / (double)((2 * n - 1) * (2 * n)); sc += tc; ts *= -r2 / (double)((2 * n) * (2 * n + 1)); ss += ts; }
    s = ss; c = sc;
}
__device__ __forceinline__ float log_sigmoidf_(float x) { return x < 0.f ? x - log1pf(expf(x)) : -log1pf(expf(-x)); }

__device__ __forceinline__ void p0_prologue(Frame& F) {
    const int gw = F.vcu * 8 + F.wave, NGW = F.G * 8;
    {
        LAS float* scr = (LAS float*)(F.lds + F.wave * 16384);
        constexpr int I_IN = 16 * 112, I_OUT = 16 * 32, I_UP = 16 * 128, I_DN = 64 * 32;
        for (int it = gw; it < I_IN + I_OUT + I_UP + I_DN; it += NGW) {
            int r = it;
            if (r < I_IN) { p0_transpose_item(F.w_in, DM, INCOLS, 112, F.g1, F.Win_t, scr, r, F.lane); continue; } r -= I_IN;
            if (r < I_OUT) { p0_transpose_item(F.w_out, DM, DM, 32, nullptr, F.Wout_t, scr, r, F.lane); continue; } r -= I_OUT;
            if (r < I_UP) { p0_transpose_item(F.w_up, DM, FF, 128, F.g2, F.Wup_t, scr, r, F.lane); continue; } r -= I_UP;
            p0_transpose_item(F.w_down, FF, DM, 32, nullptr, F.Wdn_t, scr, r, F.lane);
        }
    }
    __syncthreads();
    {
        LAS float* Wg = (LAS float*)F.lds;
        for (int i = F.tid; i < 8192; i += 512) { const int k = i >> 3, j = i & 7; Wg[j * 1024 + k] = F.g1[k] * F.w_in[(size_t)k * INCOLS + NPROJ + j]; }
        __syncthreads();
        for (int m = gw; m < M; m += NGW) {
            const float* xr = (m < MP) ? F.xp + (size_t)m * DM : F.xs + (size_t)(m - MP) * DM;
            f32x4 v[4]; float ss = 0.f;
#pragma unroll
            for (int j = 0; j < 4; ++j) { v[j] = *(const f32x4*)(xr + 256 * j + 4 * F.lane); ss += (v[j].x * v[j].x + v[j].y * v[j].y) + (v[j].z * v[j].z + v[j].w * v[j].w); }
            float ga[8];
#pragma unroll
            for (int g = 0; g < 8; ++g) { float a = 0.f;
#pragma unroll
                for (int j = 0; j < 4; ++j) { const f32x4 w = *(const LAS f32x4*)(Wg + g * 1024 + 256 * j + 4 * F.lane); a += (v[j].x * w.x + v[j].y * w.y) + (v[j].z * w.z + v[j].w * w.w); }
                ga[g] = wave_sum(a); }
            ss = wave_sum(ss);
            const float rstd = 1.f / sqrtf(ss * (1.f / DM) + EPS);
            float gv = 0.f;
#pragma unroll
            for (int g = 0; g < 8; ++g) gv = (F.lane == g) ? ga[g] : gv;
            if (F.lane == 0) F.rstd1[m] = rstd;
            if (F.lane < 8) { const float gg = gv * rstd + F.b_gate[F.lane];
                if (F.lane < 4) F.ig[m * 4 + F.lane] = gg; else F.lf[m * 4 + F.lane - 4] = log_sigmoidf_(gg); }
            v2u* o8 = (v2u*)(F.XB + (size_t)m * DM);
#pragma unroll
            for (int j = 0; j < 4; ++j) { v2u o; o.x = pk2(v[j].x, v[j].y); o.y = pk2(v[j].z, v[j].w); o8[64 * j + F.lane] = o; }
        }
    }
    {
        const double invf[8] = {1.0, 0.19392274474868576, 0.03760603093086393, 0.007292664737217109, 0.001414213562373095, 0.0002742481756762073, 5.318295896944988e-05, 1.031338537721246e-05};
        for (int i = F.vcu * 512 + F.tid; i < (SEQ + DTS) * 8; i += F.G * 512) {
            const int p = i >> 3, k = i & 7; const double pos = (p < SEQ) ? (double)p : (double)(8192 + p - SEQ);
            double fr = invf[0];
#pragma unroll
            for (int q = 1; q < 8; ++q) fr = (k == q) ? invf[q] : fr;
            double s, c; sincos_d(pos * fr, s, c);
            F.rope[p * 16 + k] = (float)c; F.rope[p * 16 + 8 + k] = (float)s;
        }
    }
    {
        constexpr int PER_B = (WBUF - DTS) * 128;
        const int total = DBS * PER_B;
        for (int i = F.vcu * 512 + F.tid; i < total; i += F.G * 512) {
            const int b = i / PER_B, r = i - b * PER_B;
            const size_t so = (size_t)b * (WBUF * 128) + DTS * 128 + r, dofs = (size_t)b * (WBUF * 128) + r;
            const f32x4 a = __builtin_nontemporal_load((const f32x4*)F.cache_k + so);
            const f32x4 c = __builtin_nontemporal_load((const f32x4*)F.cache_v + so);
            __builtin_nontemporal_store(a, (f32x4*)(F.out + O_SK) + dofs);
            __builtin_nontemporal_store(c, (f32x4*)(F.out + O_SV) + dofs);
        }
    }
}


typedef short bf16x8m __attribute__((ext_vector_type(8)));
typedef short v4i16m __attribute__((ext_vector_type(4)));
struct AttnTileP { int dil, rg, Q0, sp, ks, Lg; };
__device__ __forceinline__ AttnTileP attn_tile_params(int ti, int r16, int L0) {
    AttnTileP t;
    if (ti < 5)       { t.dil = 16; t.rg = r16;     t.Q0 = L0;                  t.sp = 1;  t.ks = t.Q0 - 128 + 32 * ti;        t.Lg = 256; }
    else if (ti < 11) { t.dil = 4;  t.rg = r16 & 3; t.Q0 = 4 * L0 + (r16 >> 2); t.sp = 4;  t.ks = t.Q0 - 128 + 32 * (ti - 5);  t.Lg = 1024; }
    else              { t.dil = 1;  t.rg = 0;       t.Q0 = 16 * L0 + r16;       t.sp = 16; t.ks = t.Q0 - 128 + 32 * (ti - 11); t.Lg = 4096; }
    return t;
}
__device__ __forceinline__ void attn_tile_load(const bf16* P, int b, int h, const AttnTileP& t, int lane, bf16x8m (&kf)[2][2], v4u (&vv)[4]) {
    const int fr = lane & 15, g4 = lane >> 4;
#pragma unroll
    for (int sub = 0; sub < 2; ++sub) { int kp = t.ks + 16 * sub + fr; kp = kp < 0 ? 0 : (kp >= t.Lg ? t.Lg - 1 : kp);
        const bf16* kr = P + (size_t)(b * SEQ + t.dil * kp + t.rg) * NPROJ + C_K + h * 64 + 8 * g4;
        kf[sub][0] = *(const bf16x8m*)kr; kf[sub][1] = *(const bf16x8m*)(kr + 32); }
#pragma unroll
    for (int k = 0; k < 4; ++k) { int kp = t.ks + (lane >> 3) + 8 * k; kp = kp < 0 ? 0 : (kp >= t.Lg ? t.Lg - 1 : kp);
        vv[k] = *(const v4u*)(P + (size_t)(b * SEQ + t.dil * kp + t.rg) * NPROJ + C_V + h * 64 + 8 * (lane & 7)); }
}
__device__ __forceinline__ void p2_attn_prompt_mfma(Frame& F) {
    const int lane = F.lane, fr = lane & 15, g4 = lane >> 4;
    LAS unsigned char* vbuf = F.lds + F.wave * 10240;
    const int gw = F.vcu * 8 + F.wave, NGW = F.G * 8;
    const int vwoff = (lane >> 3) * 160 + (lane & 7) * 16;
    const int troff = (4 * g4 + (fr >> 2)) * 160 + (fr & 3) * 8;
    for (int wt = gw; wt < 8192; wt += NGW) {
        const int r16 = wt & 15, L0 = ((wt >> 4) & 15) * 16, h = (wt >> 8) & 7, b = wt >> 11;
        const int rowq = b * SEQ + 16 * (L0 + fr) + r16;
        bf16x8m qf[2];
        { const bf16* qr = F.PROJ + (size_t)rowq * NPROJ + C_Q + h * 64 + 8 * g4; qf[0] = *(const bf16x8m*)qr; qf[1] = *(const bf16x8m*)(qr + 32); }
        f32x4 acc[4];
#pragma unroll
        for (int i = 0; i < 4; ++i) acc[i] = (f32x4){0.f, 0.f, 0.f, 0.f};
        float m = -1e30f, lsum = 0.f;
        bf16x8m kc[2][2]; v4u vr[4];
        { const AttnTileP t0 = attn_tile_params(0, r16, L0); attn_tile_load(F.PROJ, b, h, t0, lane, kc, vr); }
#pragma unroll
        for (int k = 0; k < 4; ++k) *(LAS v4u*)(vbuf + vwoff + k * 1280) = vr[k];
#pragma unroll 1
        for (int ti = 0; ti < 23; ++ti) {
            const AttnTileP t = attn_tile_params(ti, r16, L0);
            bf16x8m kn[2][2];
            if (ti + 1 < 23) { const AttnTileP tn = attn_tile_params(ti + 1, r16, L0); attn_tile_load(F.PROJ, b, h, tn, lane, kn, vr); }
            else {
#pragma unroll
                for (int a = 0; a < 2; ++a) { kn[a][0] = kc[a][0]; kn[a][1] = kc[a][1]; } }
            LAS unsigned char* vb = vbuf + (ti & 1) * 5120;
            f32x4 s0 = (f32x4){0.f, 0.f, 0.f, 0.f}, s1 = (f32x4){0.f, 0.f, 0.f, 0.f};
            s0 = __builtin_amdgcn_mfma_f32_16x16x32_bf16(kc[0][0], qf[0], s0, 0, 0, 0); s0 = __builtin_amdgcn_mfma_f32_16x16x32_bf16(kc[0][1], qf[1], s0, 0, 0, 0);
            s1 = __builtin_amdgcn_mfma_f32_16x16x32_bf16(kc[1][0], qf[0], s1, 0, 0, 0); s1 = __builtin_amdgcn_mfma_f32_16x16x32_bf16(kc[1][1], qf[1], s1, 0, 0, 0);
            const int qp = t.Q0 + t.sp * fr;
            float mx = -INFINITY;
#pragma unroll
            for (int i = 0; i < 4; ++i) { const int k0 = t.ks + 4 * g4 + i, k1 = k0 + 16;
                const bool v0 = (k0 >= 0) && (k0 <= qp) && (qp - k0 <= 128), v1 = (k1 >= 0) && (k1 <= qp) && (qp - k1 <= 128);
                s0[i] = v0 ? s0[i] : -INFINITY; s1[i] = v1 ? s1[i] : -INFINITY; mx = fmaxf(mx, fmaxf(s0[i], s1[i])); }
            mx = fmaxf(mx, __shfl_xor(mx, 16)); mx = fmaxf(mx, __shfl_xor(mx, 32));
            const float mn = fmaxf(m, mx), alpha = __expf(m - mn); m = mn;
            float ps = 0.f;
#pragma unroll
            for (int i = 0; i < 4; ++i) { s0[i] = __expf(s0[i] - mn); s1[i] = __expf(s1[i] - mn); ps += s0[i] + s1[i]; }
            lsum = lsum * alpha + ps;
#pragma unroll
            for (int i = 0; i < 4; ++i) acc[i] = acc[i] * alpha;
            bf16x8m pb;
            { v4u w; w.x = pk2(s0[0], s0[1]); w.y = pk2(s0[2], s0[3]); w.z = pk2(s1[0], s1[1]); w.w = pk2(s1[2], s1[3]); pb = __builtin_bit_cast(bf16x8m, w); }
#pragma unroll
            for (int db = 0; db < 4; ++db) {
                const v4i16m a0 = __builtin_amdgcn_ds_read_tr16_b64_v4i16((LAS v4i16m*)(vb + troff + db * 32));
                const v4i16m a1 = __builtin_amdgcn_ds_read_tr16_b64_v4i16((LAS v4i16m*)(vb + troff + db * 32 + 16 * 160));
                const bf16x8m vt = __builtin_shufflevector(a0, a1, 0, 1, 2, 3, 4, 5, 6, 7);
                acc[db] = __builtin_amdgcn_mfma_f32_16x16x32_bf16(vt, pb, acc[db], 0, 0, 0);
            }
            if (ti + 1 < 23) { LAS unsigned char* vn = vbuf + ((ti + 1) & 1) * 5120;
#pragma unroll
                for (int k = 0; k < 4; ++k) *(LAS v4u*)(vn + vwoff + k * 1280) = vr[k]; }
#pragma unroll
            for (int a = 0; a < 2; ++a) { kc[a][0] = kn[a][0]; kc[a][1] = kn[a][1]; }
        }
        lsum += __shfl_xor(lsum, 16); lsum += __shfl_xor(lsum, 32);
        const float inv = 1.f / lsum;
        bf16* orow = F.MIX + (size_t)rowq * DM + h * 64 + 4 * g4;
#pragma unroll
        for (int db = 0; db < 4; ++db) { v2u o; o.x = pk2(acc[db][0] * inv, acc[db][1] * inv); o.y = pk2(acc[db][2] * inv, acc[db][3] * inv); *(v2u*)(orow + 16 * db) = o; }
    }
}

__device__ __forceinline__ void load_q64(const bf16* qp, LAS float* sq, int lane) {
    sq[lane] = bf2f(qp[lane]);
    LDS_WAIT(); asm volatile("" ::: "memory");
}
__device__ __forceinline__ float dot_bf16row(const bf16* kp, const LAS float* sq) {
    float a = 0.f;
#pragma unroll 1
    for (int i = 0; i < 8; ++i) { const v4u w = *(const v4u*)(kp + 8 * i); const f32x4 q0 = *(const LAS f32x4*)(sq + 8 * i), q1 = *(const LAS f32x4*)(sq + 8 * i + 4);
        a += q0.x * bflo(w.x) + q0.y * bfhi(w.x) + q0.z * bflo(w.y) + q0.w * bfhi(w.y) + q1.x * bflo(w.z) + q1.y * bfhi(w.z) + q1.z * bflo(w.w) + q1.w * bfhi(w.w); }
    return a;
}
__device__ __forceinline__ float dot_f32row(const float* kp, const LAS float* sq) {
    float a = 0.f;
#pragma unroll 1
    for (int i = 0; i < 16; ++i) { const f32x4 w = *(const f32x4*)(kp + 4 * i); const f32x4 q0 = *(const LAS f32x4*)(sq + 4 * i);
        a += q0.x * w.x + q0.y * w.y + q0.z * w.z + q0.w * w.w; }
    return a;
}
__device__ __forceinline__ void p2_attn_v1(Frame& F) {
    const int gw = F.vcu * 8 + F.wave, NGW = F.G * 8, lane = F.lane;
    LAS float* q = (LAS float*)(F.lds + F.wave * 256);
    for (int it = gw; it < MS * 8; it += NGW) {
        const int sr = it >> 3, h = it & 7, b = sr >> 3, t = sr & 7, row = MP + sr;
        load_q64(F.PROJ + (size_t)row * NPROJ + C_Q + h * 64, q, lane);
        float sc[3][3];
#pragma unroll
        for (int g = 0; g < 3; ++g) { const int dil = (g == 0) ? 1 : (g == 1 ? 4 : 16);
#pragma unroll
            for (int i = 0; i < 3; ++i) { const int j = lane + 64 * i; const bool valid = (j <= 128);
                const int idx = valid ? (WBUF + t - dil * j) : (WBUF + t);
                float d;
                if (idx < WBUF) d = dot_f32row(F.cache_k + (((size_t)b * WBUF + idx) * 8 + h) * 64, q);
                else d = dot_bf16row(F.PROJ + (size_t)(MP + b * DTS + idx - WBUF) * NPROJ + C_K + h * 64, q);
                sc[g][i] = valid ? d : -INFINITY; asm volatile("" ::: "memory"); } }
        float mx = -INFINITY;
#pragma unroll
        for (int g = 0; g < 3; ++g)
#pragma unroll
            for (int i = 0; i < 3; ++i) mx = fmaxf(mx, sc[g][i]);
        mx = wave_max(mx);
        float sum = 0.f;
#pragma unroll
        for (int g = 0; g < 3; ++g)
#pragma unroll
            for (int i = 0; i < 3; ++i) { sc[g][i] = __expf(sc[g][i] - mx); sum += sc[g][i]; }
        sum = wave_sum(sum);
        float o = 0.f;
#pragma unroll
        for (int g = 0; g < 3; ++g) { const int dil = (g == 0) ? 1 : (g == 1 ? 4 : 16);
#pragma unroll
            for (int i = 0; i < 3; ++i) { const int cnt = (i == 2) ? 1 : 64;
#pragma unroll 1
                for (int jj = 0; jj < cnt; ++jj) { const int idx = WBUF + t - dil * (jj + 64 * i);
                    const float p = __shfl(sc[g][i], jj);
                    const float vv = (idx < WBUF) ? F.cache_v[(((size_t)b * WBUF + idx) * 8 + h) * 64 + lane]
                                                  : bf2f(F.PROJ[(size_t)(MP + b * DTS + idx - WBUF) * NPROJ + C_V + h * 64 + lane]);
                    o += p * vv; } } }
        F.MIX[(size_t)row * DM + h * 64 + lane] = (bf16)f2bf(o / sum);
    }
    for (int i = F.vcu * 512 + F.tid; i < M * 1024; i += F.G * 512) {
        const int row = i >> 10, col = i & 1023; const bool smp = row >= MP;
        const int b = smp ? ((row - MP) >> 3) : (row >> 12), t = smp ? ((row - MP) & 7) : (row & 4095);
        float a = F.b_conv[col];
#pragma unroll
        for (int w = 0; w < 4; ++w) { const int tt = t + w - 3; float xv;
            if (tt >= 0) xv = bf2f(F.PROJ[(size_t)(row + w - 3) * NPROJ + C_RAW + col]);
            else xv = smp ? F.st_conv[((size_t)b * 3 + (3 + tt)) * 1024 + col] : 0.f;
            a += xv * F.w_conv[w * 1024 + col]; }
        const float s = a * sigmoidf_(a);
        if (col < 512) F.QF[(size_t)row * 512 + col] = s; else F.KF[(size_t)row * 512 + col - 512] = s * 0.08838834764831845f;
    }
}

__device__ __forceinline__ void p3_mlstm_local_v1(Frame& F) {
    const int tid = F.tid;
    LAS float* sB = (LAS float*)F.lds;
    LAS float* sW = sB + 128;
    LAS float* sK = (LAS float*)(F.lds + 4096);
    for (int u = F.vcu; u < 512; u += F.G) {
        const int bh = u >> 5, c = u & 31, b = bh >> 2, h = bh & 3, row0 = b * SEQ + c * 128;
        __syncthreads();
        if (tid < 128) { sB[tid] = F.lf[(row0 + tid) * 4 + h]; sW[tid] = F.ig[(row0 + tid) * 4 + h]; }
        for (int i = tid; i < 128 * 32; i += 512) { const int s = i >> 5, d4 = i & 31;
            *(LAS f32x4*)(sK + s * 128 + d4 * 4) = *(const f32x4*)(F.KF + (size_t)(row0 + s) * 512 + h * 128 + d4 * 4); }
        __syncthreads();
        if (tid == 0) { float acc = 0.f, um = -INFINITY;
            for (int s = 0; s < 128; ++s) { acc += sB[s]; const float uu = sW[s] - acc; sB[s] = acc; sW[s] = uu; um = fmaxf(um, uu); }
            for (int s = 0; s < 128; ++s) sW[s] = __expf(sW[s] - um);
            F.chk[u] = acc; F.chk[512 + u] = um; }
        __syncthreads();
        const int e = opaque(tid & 127), dg = opaque(tid >> 7);
        float acc[32];
#pragma unroll
        for (int i = 0; i < 32; ++i) acc[i] = 0.f;
#pragma unroll 1
        for (int s = 0; s < 128; ++s) {
            const float vv = sW[s] * bf2f(F.PROJ[(size_t)(row0 + s) * NPROJ + C_VB + h * 128 + e]);
#pragma unroll
            for (int d4 = 0; d4 < 8; ++d4) { const f32x4 kk = *(const LAS f32x4*)(sK + s * 128 + dg * 32 + d4 * 4);
                acc[4 * d4 + 0] += kk.x * vv; acc[4 * d4 + 1] += kk.y * vv; acc[4 * d4 + 2] += kk.z * vv; acc[4 * d4 + 3] += kk.w * vv; }
        }
#pragma unroll
        for (int i = 0; i < 32; ++i) F.L[(size_t)u * 16384 + (dg * 32 + i) * 128 + e] = acc[i];
        if (tid < 128) { float n = 0.f;
#pragma unroll 4
            for (int s = 0; s < 128; ++s) n += sW[s] * sK[s * 128 + tid];
            F.NLOC[u * 128 + tid] = n; }
    }
    LAS float* sQ = (LAS float*)(F.lds + 72 * 1024);
    LAS float* sKs = sQ + 1024;
    LAS float* sV = sKs + 1024;
    LAS float* sQC = sV + 1024;
    LAS float* sH = sQC + 4096;
    LAS float* sN0 = sH + 1024;
    LAS float* sS = sN0 + 128;
    for (int u = F.vcu; u < 512; u += F.G) {
        const int b = u >> 2, h = u & 3, r0 = MP + b * DTS;
        __syncthreads();
        for (int i = tid; i < 1024; i += 512) { const int t = i >> 7, d = i & 127;
            sQ[i] = F.QF[(size_t)(r0 + t) * 512 + h * 128 + d]; sKs[i] = F.KF[(size_t)(r0 + t) * 512 + h * 128 + d];
            sV[i] = bf2f(F.PROJ[(size_t)(r0 + t) * NPROJ + C_VB + h * 128 + d]); }
        if (tid < 128) sN0[tid] = F.st_n[(size_t)u * 128 + tid];
        if (tid == 0) {
            const float m0 = F.st_m[u]; float acc = 0.f, um = -INFINITY, cm = m0;
            for (int t = 0; t < 8; ++t) { acc += F.lf[(r0 + t) * 4 + h]; const float uu = F.ig[(r0 + t) * 4 + h] - acc; um = fmaxf(um, uu); cm = fmaxf(cm, uu);
                sS[t] = acc; sS[8 + t] = uu; sS[16 + t] = cm; sS[24 + t] = __expf(m0 - cm); }
            const float Mx = fmaxf(m0, um);
            for (int t = 0; t < 8; ++t) sS[32 + t] = __expf(sS[8 + t] - Mx);
            sS[40] = __expf(m0 - Mx);
            F.out[O_SM + u] = acc + Mx;
        }
        __syncthreads();
        if (tid < 64) { const int t = tid >> 3, s = tid & 7; float d = 0.f;
#pragma unroll 4
            for (int k = 0; k < 128; ++k) d += sQ[t * 128 + k] * sKs[s * 128 + k];
            sS[64 + tid] = (s <= t) ? d * __expf(sS[8 + s] - sS[16 + t]) : 0.f; }
        {
            const int e = opaque(tid & 127), dq = opaque(tid >> 7); const float alpha = sS[40];
            float vb[8], aq[8];
#pragma unroll
            for (int s = 0; s < 8; ++s) { vb[s] = sS[32 + s] * sV[s * 128 + e]; aq[s] = 0.f; }
            for (int dd = 0; dd < 32; ++dd) { const int d = dq * 32 + dd;
                const float c0 = F.st_C[((size_t)u * 128 + d) * 128 + e];
                float cn = alpha * c0;
#pragma unroll
                for (int s = 0; s < 8; ++s) { cn += sKs[s * 128 + d] * vb[s]; aq[s] += sQ[s * 128 + d] * c0; }
                F.out[O_SC + ((size_t)u * 128 + d) * 128 + e] = cn; }
#pragma unroll
            for (int s = 0; s < 8; ++s) sQC[(dq * 8 + s) * 128 + e] = aq[s];
        }
        if (tid < 128) { float n = sS[40] * sN0[tid];
#pragma unroll
            for (int s = 0; s < 8; ++s) n += sS[32 + s] * sKs[s * 128 + tid];
            F.out[O_SN + (size_t)u * 128 + tid] = n; }
        __syncthreads();
        if (tid < 8) { const int t = tid; float qn = 0.f;
#pragma unroll 4
            for (int k = 0; k < 128; ++k) qn += sQ[t * 128 + k] * sN0[k];
            float den = sS[24 + t] * qn; for (int s = 0; s < 8; ++s) den += sS[64 + t * 8 + s];
            sS[48 + t] = fmaxf(fabsf(den), __expf(-(sS[t] + sS[16 + t]))); }
        __syncthreads();
        { const int e = tid & 127, tq = tid >> 7;
#pragma unroll
            for (int k = 0; k < 2; ++k) { const int t = tq * 2 + k;
                float qc = sQC[(0 * 8 + t) * 128 + e] + sQC[(1 * 8 + t) * 128 + e] + sQC[(2 * 8 + t) * 128 + e] + sQC[(3 * 8 + t) * 128 + e];
                float num = sS[24 + t] * qc;
#pragma unroll
                for (int s = 0; s < 8; ++s) num += sS[64 + t * 8 + s] * sV[s * 128 + e];
                sH[t * 128 + e] = num / sS[48 + t]; } }
        __syncthreads();
        { const int t = F.wave; const float h0 = sH[t * 128 + F.lane], h1 = sH[t * 128 + 64 + F.lane];
            const float ssq = wave_sum(h0 * h0 + h1 * h1); const float rs = 1.f / sqrtf(ssq * (1.f / 128.f) + EPS);
            const int row = r0 + t;
#pragma unroll
            for (int k = 0; k < 2; ++k) { const int e = F.lane + 64 * k; const float hv = k ? h1 : h0;
                const float ob = bf2f(F.PROJ[(size_t)row * NPROJ + C_OB + h * 128 + e]);
                F.MIX[(size_t)row * DM + 512 + h * 128 + e] = (bf16)f2bf(hv * rs * F.mhg[h * 128 + e] * sigmoidf_(ob)); } }
    }
}

__device__ __forceinline__ void p4_prefix_v1(Frame& F) {
    const int tid = F.tid;
    for (int u = F.vcu; u < 256; u += F.G) {
        const int chain = u >> 4, sl = u & 15, idx = sl * 1024 + tid * 2;
        float m = 0.f, c0 = 0.f, c1 = 0.f, nn = 0.f;
        for (int c = 0; c < 32; ++c) { const int unit = chain * 32 + c;
            F.CPRE[(size_t)unit * 16384 + idx] = c0; F.CPRE[(size_t)unit * 16384 + idx + 1] = c1;
            if (sl == 0 && tid < 128) F.NPRE[unit * 128 + tid] = nn;
            if (sl == 0 && tid == 0) F.chk[1024 + unit] = m;
            const float Bc = F.chk[unit], um = F.chk[512 + unit], Mx = fmaxf(m, um), a = __expf(m - Mx), bb = __expf(um - Mx);
            c0 = a * c0 + bb * F.L[(size_t)unit * 16384 + idx]; c1 = a * c1 + bb * F.L[(size_t)unit * 16384 + idx + 1];
            if (sl == 0 && tid < 128) nn = a * nn + bb * F.NLOC[unit * 128 + tid];
            m = Bc + Mx; }
        F.out[O_PC + (size_t)chain * 16384 + idx] = c0; F.out[O_PC + (size_t)chain * 16384 + idx + 1] = c1;
        if (sl == 0 && tid < 128) F.out[O_PN + chain * 128 + tid] = nn;
        if (sl == 0 && tid == 0) F.out[O_PM + chain] = m;
    }
}

__device__ __forceinline__ void p5_mlstm_out_v1(Frame& F) {
    const int tid = F.tid;
    LAS float* sQT = (LAS float*)F.lds;
    LAS float* sKT = (LAS float*)(F.lds + 65536);
    LAS float* sB = (LAS float*)(F.lds + 131072);
    LAS float* sU = sB + 128, *sG = sU + 128, *sWi = sG + 128, *sDen = sWi + 128, *sN = sDen + 128;
    for (int u = F.vcu; u < 512; u += F.G) {
        const int bh = u >> 5, c = u & 31, b = bh >> 2, h = bh & 3, row0 = b * SEQ + c * 128;
        const float mc = F.chk[1024 + u];
        __syncthreads();
#pragma unroll 1
        for (int i = tid; i < 128 * 32; i += 512) { const int t = i >> 5, d4 = i & 31;
            const f32x4 qv = *(const f32x4*)(F.QF + (size_t)(row0 + t) * 512 + h * 128 + d4 * 4), kv = *(const f32x4*)(F.KF + (size_t)(row0 + t) * 512 + h * 128 + d4 * 4);
            sQT[(d4 * 4 + 0) * 128 + t] = qv.x; sQT[(d4 * 4 + 1) * 128 + t] = qv.y; sQT[(d4 * 4 + 2) * 128 + t] = qv.z; sQT[(d4 * 4 + 3) * 128 + t] = qv.w;
            sKT[(d4 * 4 + 0) * 128 + t] = kv.x; sKT[(d4 * 4 + 1) * 128 + t] = kv.y; sKT[(d4 * 4 + 2) * 128 + t] = kv.z; sKT[(d4 * 4 + 3) * 128 + t] = kv.w; }
        if (tid < 128) { sB[tid] = F.lf[(row0 + tid) * 4 + h]; sU[tid] = F.ig[(row0 + tid) * 4 + h]; sN[tid] = F.NPRE[u * 128 + tid]; }
        __syncthreads();
        if (tid == 0) { float acc = 0.f, cm = mc;
            for (int s = 0; s < 128; ++s) { acc += sB[s]; const float uu = sU[s] - acc; cm = fmaxf(cm, uu); sB[s] = acc; sU[s] = uu; sG[s] = cm; sWi[s] = __expf(mc - cm); } }
        __syncthreads();
        float S[4][8];
        const int tb = opaque(tid >> 4), sb = opaque(tid & 15);
#pragma unroll
        for (int i = 0; i < 4; ++i)
#pragma unroll
            for (int j = 0; j < 8; ++j) S[i][j] = 0.f;
#pragma unroll 1
        for (int d = 0; d < 128; ++d) {
            const f32x4 qv = *(const LAS f32x4*)(sQT + d * 128 + 4 * tb), k0 = *(const LAS f32x4*)(sKT + d * 128 + 8 * sb), k1 = *(const LAS f32x4*)(sKT + d * 128 + 8 * sb + 4);
#pragma unroll
            for (int i = 0; i < 4; ++i) { S[i][0] += qv[i] * k0.x; S[i][1] += qv[i] * k0.y; S[i][2] += qv[i] * k0.z; S[i][3] += qv[i] * k0.w;
                S[i][4] += qv[i] * k1.x; S[i][5] += qv[i] * k1.y; S[i][6] += qv[i] * k1.z; S[i][7] += qv[i] * k1.w; }
        }
        __syncthreads();
#pragma unroll
        for (int j = 0; j < 8; ++j) { const int s = 8 * sb + j; f32x4 pv;
#pragma unroll
            for (int i = 0; i < 4; ++i) { const int t = 4 * tb + i; pv[i] = (s <= t) ? S[i][j] * __expf(sU[s] - sG[t]) : 0.f; }
            *(LAS f32x4*)(sKT + s * 128 + 4 * tb) = pv; }
        __syncthreads();
        if (tid < 128) { const int t = tid; float qn = 0.f, ps = 0.f;
#pragma unroll 4
            for (int d = 0; d < 128; ++d) qn += sQT[d * 128 + t] * sN[d];
#pragma unroll 4
            for (int s = 0; s < 128; ++s) ps += sKT[s * 128 + t];
            const float den = sWi[t] * qn + ps;
            sDen[t] = fmaxf(fabsf(den), __expf(-(sB[t] + sG[t]))); }
        const int e = opaque(tid & 127), tg = opaque(tid >> 7);
        float aP[32], aC[32];
#pragma unroll
        for (int i = 0; i < 32; ++i) { aP[i] = 0.f; aC[i] = 0.f; }
#pragma unroll 1
        for (int s = 0; s < 128; ++s) {
            const float vv = bf2f(F.PROJ[(size_t)(row0 + s) * NPROJ + C_VB + h * 128 + e]);
            const float cc = F.CPRE[(size_t)u * 16384 + s * 128 + e];
#pragma unroll
            for (int t4 = 0; t4 < 8; ++t4) { const f32x4 pp = *(const LAS f32x4*)(sKT + s * 128 + tg * 32 + t4 * 4), qq = *(const LAS f32x4*)(sQT + s * 128 + tg * 32 + t4 * 4);
                aP[4 * t4 + 0] += pp.x * vv; aP[4 * t4 + 1] += pp.y * vv; aP[4 * t4 + 2] += pp.z * vv; aP[4 * t4 + 3] += pp.w * vv;
                aC[4 * t4 + 0] += qq.x * cc; aC[4 * t4 + 1] += qq.y * cc; aC[4 * t4 + 2] += qq.z * cc; aC[4 * t4 + 3] += qq.w * cc; }
        }
        __syncthreads();
#pragma unroll
        for (int i = 0; i < 32; ++i) { const int t = tg * 32 + i; sQT[t * 128 + e] = (sWi[t] * aC[i] + aP[i]) / sDen[t]; }
        __syncthreads();
#pragma unroll 1
        for (int r = 0; r < 16; ++r) { const int t = F.wave * 16 + r; const float h0 = sQT[t * 128 + F.lane], h1 = sQT[t * 128 + 64 + F.lane];
            const float ssq = wave_sum(h0 * h0 + h1 * h1); const float rs = 1.f / sqrtf(ssq * (1.f / 128.f) + EPS);
            const int row = row0 + t;
#pragma unroll
            for (int k = 0; k < 2; ++k) { const int ee = F.lane + 64 * k; const float hv = k ? h1 : h0;
                const float ob = bf2f(F.PROJ[(size_t)row * NPROJ + C_OB + h * 128 + ee]);
                F.MIX[(size_t)row * DM + 512 + h * 128 + ee] = (bf16)f2bf(hv * rs * F.mhg[h * 128 + ee] * sigmoidf_(ob)); } }
    }
}

__device__ __forceinline__ void p9_final_norm(Frame& F) {
    const int gw = F.vcu * 8 + F.wave, NGW = F.G * 8;
    for (int m = gw; m < M; m += NGW) {
        const float rs = 1.f / sqrtf(F.ssf[m] * (1.f / DM) + EPS);
        f32x4* p = (f32x4*)(F.out + (size_t)m * DM);
#pragma unroll
        for (int j = 0; j < 4; ++j) { const f32x4 g = *(const f32x4*)(F.gf + 256 * j + 4 * F.lane); f32x4 v = p[64 * j + F.lane]; v = v * rs * g; p[64 * j + F.lane] = v; }
    }
}

struct Args { const float* in[19]; float* out; unsigned char* ws; int ph_lo, ph_hi; };
__global__ void __launch_bounds__(512, 2) fwd(Args args) {
    extern __shared__ __attribute__((aligned(16))) unsigned char lds[];
    Frame F;
    F.lds = (LAS unsigned char*)lds;
    F.tid = threadIdx.x; F.lane = F.tid & 63; F.wave = __builtin_amdgcn_readfirstlane(F.tid >> 6);
    F.G = gridDim.x; { const int bx = blockIdx.x; F.vcu = (F.G % 8 == 0) ? (bx % 8) * (F.G / 8) + bx / 8 : bx; }
    F.xp = args.in[0]; F.xs = args.in[1]; F.cache_k = args.in[2]; F.cache_v = args.in[3]; F.st_conv = args.in[4]; F.st_C = args.in[5]; F.st_n = args.in[6]; F.st_m = args.in[7];
    F.g1 = args.in[8]; F.w_in = args.in[9]; F.b_gate = args.in[10]; F.w_conv = args.in[11]; F.b_conv = args.in[12]; F.mhg = args.in[13]; F.w_out = args.in[14]; F.g2 = args.in[15];
    F.w_up = args.in[16]; F.w_down = args.in[17]; F.gf = args.in[18];
    F.out = args.out; F.ws = args.ws;
    unsigned char* ws = args.ws;
    F.Win_t = (bf16*)(ws + WS_WIN); F.Wout_t = (bf16*)(ws + WS_WOUT); F.Wup_t = (bf16*)(ws + WS_WUP); F.Wdn_t = (bf16*)(ws + WS_WDN);
    F.XB = (bf16*)(ws + WS_XB); F.PROJ = (bf16*)(ws + WS_PROJ); F.MIX = (bf16*)(ws + WS_MIX); F.HPB = (bf16*)(ws + WS_HPB); F.ACT = (bf16*)(ws + WS_ACT);
    F.rope = (float*)(ws + WS_ROPE); F.rstd1 = (float*)(ws + WS_RSTD1); F.ig = (float*)(ws + WS_IG); F.lf = (float*)(ws + WS_LF); F.chk = (float*)(ws + WS_CHK);
    F.ss2 = (float*)(ws + WS_SS2); F.ssf = (float*)(ws + WS_SSF); F.QF = (float*)(ws + WS_QF); F.KF = (float*)(ws + WS_KF); F.L = (float*)(ws + WS_L);
    F.CPRE = (float*)(ws + WS_CPRE); F.NLOC = (float*)(ws + WS_NLOC); F.NPRE = (float*)(ws + WS_NPRE);
    volatile LAS unsigned* MISC = (volatile LAS unsigned*)(F.lds + MISC_OFF);
    if (F.tid < 32) MISC[F.tid] = 0u;
    __syncthreads();
    XcdBarrier bar; bar.bar = (unsigned*)(ws + WS_CTL) + CW_BAR; bar.x = 0; bar.st = nullptr;
    if (!PER_PHASE_LAUNCH) bar = xcd_barrier_post((unsigned*)(ws + WS_CTL) + CW_BAR, MISC + 8);
#define GRID_BAR() do { if (!PER_PHASE_LAUNCH) xcd_barrier(bar); } while (0)
    const int lo = args.ph_lo, hi = args.ph_hi;
#ifndef PHASE_MASK
#define PHASE_MASK 0x3ff
#endif
#define IN(k) (((PHASE_MASK >> (k)) & 1) && lo <= (k) && (k) < hi)
    if (IN(0)) { p0_prologue(F); GRID_BAR(); }
    if (IN(1)) {
        pg8::Gemm g{F.XB, F.Win_t, M, NPROJ, DM}; pg8::StaticOrder S; S.init(M, NPROJ, F.G, (int)blockIdx.x);
        pg8::EpiIn E{F.PROJ, F.rstd1, F.rope, F.out};
        pg8::gemm_phase<pg8::EpiIn, pg8::StaticOrder, true, true>(F.lds, g, S, E);
        GRID_BAR();
    }
    if (IN(2)) { p2_attn_prompt_mfma(F); __syncthreads(); p2_attn_v1(F); GRID_BAR(); }
    if (IN(3)) { p3_mlstm_local_v1(F); GRID_BAR(); }
    if (IN(4)) { p4_prefix_v1(F); GRID_BAR(); }
    if (IN(5)) { p5_mlstm_out_v1(F); GRID_BAR(); }
    if (IN(6)) {
        pg8::Gemm g{F.MIX, F.Wout_t, M, DM, DM}; pg8::StaticOrder S; S.init(M, DM, F.G, (int)blockIdx.x);
        pg8::EpiOut E{F.xp, F.xs, F.out, F.HPB, F.ss2};
        pg8::gemm_phase<pg8::EpiOut, pg8::StaticOrder, true, true>(F.lds, g, S, E);
        GRID_BAR();
    }
    if (IN(7)) {
        pg8::Gemm g{F.HPB, F.Wup_t, M, FF, DM}; pg8::StaticOrder S; S.init(M, FF, F.G, (int)blockIdx.x);
        pg8::EpiUp E{F.ACT, F.ss2};
        pg8::gemm_phase<pg8::EpiUp, pg8::StaticOrder, true, true>(F.lds, g, S, E);
        GRID_BAR();
    }
    if (IN(8)) {
        pg8::Gemm g{F.ACT, F.Wdn_t, M, DM, FF}; pg8::StaticOrder S; S.init(M, DM, F.G, (int)blockIdx.x);
        pg8::EpiDown E{F.out, F.ssf};
        pg8::gemm_phase<pg8::EpiDown, pg8::StaticOrder, true, true>(F.lds, g, S, E);
        GRID_BAR();
    }
    if (IN(9)) { p9_final_norm(F); }
#undef IN
}

extern "C" void kernel_launch(void* const* d_in, const int* in_sizes, int n_in, void* d_out, int out_size, void* d_ws, size_t ws_size, hipStream_t stream) {
    static int grid = 0;
    if (grid == 0) {
        if (n_in != 19 || (size_t)out_size != O_END || ws_size < WS_END) { fprintf(stderr, "kernel_launch: unexpected shapes (n_in %d out %d ws %zu)\n", n_in, out_size, ws_size); grid = -1; return; }
        int dev = 0, cus = 0, per_cu = 0;
        if (hipGetDevice(&dev) != hipSuccess || hipDeviceGetAttribute(&cus, hipDeviceAttributeMultiprocessorCount, dev) != hipSuccess) { grid = -1; return; }
        if (hipFuncSetAttribute((const void*)fwd, hipFuncAttributeMaxDynamicSharedMemorySize, LDS_BYTES) != hipSuccess) { fprintf(stderr, "kernel_launch: hipFuncSetAttribute failed\n"); grid = -1; return; }
        if (hipOccupancyMaxActiveBlocksPerMultiprocessor(&per_cu, (const void*)fwd, 512, LDS_BYTES) != hipSuccess || per_cu < 1) fprintf(stderr, "kernel_launch: occupancy query says %d\n", per_cu);
        (void)hipGetLastError();
        grid = cus;
    }
    if (grid < 0) return;
    if (hipMemsetAsync((char*)d_ws + WS_CTL, 0, CTL_ZERO_BYTES, stream) != hipSuccess) return;
    Args a{};
    for (int i = 0; i < 19; ++i) a.in[i] = (const float*)d_in[i];
    a.out = (float*)d_out; a.ws = (unsigned char*)d_ws;
#if PER_PHASE_LAUNCH
    for (int ph = 0; ph < NPH; ++ph) { a.ph_lo = ph; a.ph_hi = ph + 1; hipLaunchKernelGGL(fwd, dim3(grid), dim3(512), LDS_BYTES, stream, a); }
#else
    a.ph_lo = 0; a.ph_hi = NPH; hipLaunchKernelGGL(fwd, dim3(grid), dim3(512), LDS_BYTES, stream, a);
#endif
}
```

```cpp
#include <hip/hip_runtime.h>
#include <cstdio>
#include <cstdint>
namespace pg8 {
#define PG8_LAS __attribute__((address_space(3)))
typedef unsigned short bf16_t;
typedef short bf16x8 __attribute__((ext_vector_type(8)));
typedef float f32x4 __attribute__((ext_vector_type(4)));
typedef unsigned u32x4 __attribute__((ext_vector_type(4)));
constexpr int BM = 256, BK = 64, HALF = 128, HTB = HALF * BK * 2  , STAGE_BYTES = 8 * HTB, NXCD = 8, WGM = 8;

__host__ __device__ __forceinline__ int lds_byte(int r, int c) { const int st = (r >> 4) * 2 + (c >> 5), rr = r & 15, cc = c & 31, ob = rr * 64 + cc * 2; return st * 1024 + (ob ^ (((ob >> 9) & 1) << 5)); }
__host__ __device__ __forceinline__ void stage_rc(int b, int& R, int& C) { const int st = b / 1024, sb = b % 1024, swz = sb ^ (((sb >> 9) & 1) << 5); R = (st >> 1) * 16 + swz / 64; C = (st & 1) * 32 + (swz % 64) / 2; }
__host__ __device__ __forceinline__ int perm32(int rho) { const int n = rho >> 4, i = rho & 15; return 8 * (i >> 2) + 4 * n + (i & 3); }

struct Unit { int pm, pn; };
struct Gemm { const bf16_t* A; const bf16_t* Bt; int M, N, K; };

struct StaticOrder {
    int nM, nN, nwg, G, c;
    __host__ __device__ void init(int M, int N, int G_, int c_) { nM = M / BM; nN = N / BM; nwg = nM * nN; G = G_; c = c_; }
    __host__ __device__ bool next(int i, Unit& u) const {
        const long L = (long)i * G + c; if (L >= nwg) return false;
        int wgid = (int)L; { const int q = nwg / NXCD, r = nwg % NXCD, xcd = wgid % NXCD, off = wgid / NXCD; wgid = (xcd < r ? xcd * (q + 1) : r * (q + 1) + (xcd - r) * q) + off; }
        const int nig = WGM * nN, gid = wgid / nig, fm = gid * WGM, gsz = (nM - fm) < WGM ? (nM - fm) : WGM;
        u.pm = fm + ((wgid % nig) % gsz); u.pn = (wgid % nig) / gsz; return true;
    }
    __device__ __forceinline__ void a_ready(const Unit&) const {}
    __device__ __forceinline__ void done(const Unit&) const {}
};

__device__ __forceinline__ unsigned cvt_pk_bf16(float lo, float hi) { unsigned r; asm volatile("v_cvt_pk_bf16_f32 %0, %1, %2" : "=v"(r) : "v"(lo), "v"(hi)); return r; }
typedef float f32x2 __attribute__((ext_vector_type(2)));

template <class Epi, class Sched, bool ALIGN_EPI = false, bool SP2 = false>
__device__ __forceinline__ void gemm_phase(PG8_LAS unsigned char* lds, const Gemm g, const Sched& S, const Epi& E) {
    const int tid = threadIdx.x, wid = __builtin_amdgcn_readfirstlane(tid >> 6), lane = tid & 63, wr = wid >> 2, wc = wid & 3, fr = lane & 15, fq = lane >> 4;
    const int K = g.K, nt = K / BK;
    unsigned voffA[2], voffB[2];
#pragma unroll
    for (int i = 0; i < 2; ++i) { int R, C; stage_rc(tid * 16 + i * 8192, R, C); const int Rb = Epi::PERM ? ((R & ~31) + perm32(R & 31)) : R;
        voffA[i] = (unsigned)(R * K + C) * 2u; voffB[i] = (unsigned)(Rb * K + C) * 2u; }
    const size_t kstep = (size_t)(BK * 2);
    const size_t hstep = (size_t)HALF * K * 2;
    const size_t tstep = 2 * hstep;
    const unsigned ldsw = (unsigned)wid * 1024u;
    const int aoff = lds_byte(wr * 64 + fr, fq * 8), boff = lds_byte(wc * 32 + fr, fq * 8);
#define PG8_SA(b, h) (((b) * 2 + (h)) * HTB)
#define PG8_SB(b, h) ((4 + (b) * 2 + (h)) * HTB)
#define PG8_STAGE(bufoff, gbase, voff) do { _Pragma("unroll") for (int _i = 0; _i < 2; ++_i) \
        __builtin_amdgcn_global_load_lds((const unsigned*)((const char*)(gbase) + (voff)[_i]), (PG8_LAS unsigned*)(lds + (bufoff) + ldsw + _i * 8192), 16, 0, 0); } while (0)
#define PG8_LDA(dst, b, h) do { _Pragma("unroll") for (int m = 0; m < 4; ++m) _Pragma("unroll") for (int k = 0; k < 2; ++k) dst[m][k] = *(const PG8_LAS bf16x8*)(lds + PG8_SA(b, h) + aoff + m * 2048 + k * 1024); } while (0)
#define PG8_LDB(dst, b, h) do { _Pragma("unroll") for (int n = 0; n < 2; ++n) _Pragma("unroll") for (int k = 0; k < 2; ++k) dst[n][k] = *(const PG8_LAS bf16x8*)(lds + PG8_SB(b, h) + boff + n * 2048 + k * 1024); } while (0)
#define PG8_MMA(ai, bj, At, Bt) do { __builtin_amdgcn_s_setprio(1); _Pragma("unroll") for (int m = 0; m < 4; ++m) _Pragma("unroll") for (int n = 0; n < 2; ++n) _Pragma("unroll") for (int k = 0; k < 2; ++k) \
        acc[ai][bj][m][n] = __builtin_amdgcn_mfma_f32_16x16x32_bf16(Bt[n][k], At[m][k], acc[ai][bj][m][n], 0, 0, 0); __builtin_amdgcn_s_setprio(0); } while (0)
#define PG8_WAIT_V(n) asm volatile("s_waitcnt vmcnt(" #n ")" ::: "memory")
#define PG8_WAIT_L(n) asm volatile("s_waitcnt lgkmcnt(" #n ")" ::: "memory")
#define PG8_BAR __builtin_amdgcn_s_barrier()
#define PG8_SCHED __builtin_amdgcn_sched_barrier(0)
    Unit cur, nxt; int ui = 0;
    if (!S.next(0, cur)) return;
    f32x4 acc[2][2][4][2];
#pragma unroll
    for (int a = 0; a < 2; ++a)
#pragma unroll
        for (int b = 0; b < 2; ++b)
#pragma unroll
            for (int m = 0; m < 4; ++m)
#pragma unroll
                for (int n = 0; n < 2; ++n) acc[a][b][m][n] = (f32x4){0.f, 0.f, 0.f, 0.f};
    bf16x8 At[4][2], B0[2][2], B1[2][2];
    const char* cA = (const char*)g.A + (size_t)cur.pm * tstep; const char* cB = (const char*)g.Bt + (size_t)cur.pn * tstep;
    S.a_ready(cur);
    if constexpr (SP2) {
        PG8_STAGE(PG8_SB(0, 0), cB, voffB); PG8_STAGE(PG8_SB(0, 1), cB + hstep, voffB); PG8_STAGE(PG8_SA(0, 0), cA, voffA); PG8_STAGE(PG8_SA(0, 1), cA + hstep, voffA);
        if (wr == 1) PG8_BAR;
        PG8_WAIT_V(2); PG8_BAR;
        PG8_STAGE(PG8_SB(1, 0), cB + kstep, voffB); PG8_STAGE(PG8_SA(1, 0), cA + kstep, voffA); PG8_STAGE(PG8_SB(1, 1), cB + hstep + kstep, voffB);
        PG8_WAIT_V(6); PG8_BAR;
    } else {
        PG8_STAGE(PG8_SB(0, 0), cB, voffB); PG8_STAGE(PG8_SA(0, 0), cA, voffA); PG8_STAGE(PG8_SB(0, 1), cB + hstep, voffB); PG8_STAGE(PG8_SA(0, 1), cA + hstep, voffA);
        if (wr == 1) PG8_BAR;
        PG8_WAIT_V(4); PG8_BAR;
        PG8_STAGE(PG8_SB(1, 0), cB + kstep, voffB); PG8_STAGE(PG8_SA(1, 0), cA + kstep, voffA); PG8_STAGE(PG8_SB(1, 1), cB + hstep + kstep, voffB);
        PG8_WAIT_V(6); PG8_BAR;
    }
    for (;;) {
        const bool has_next = S.next(ui + 1, nxt);
        const char* nA = has_next ? (const char*)g.A + (size_t)nxt.pm * tstep : cA; const char* nB = has_next ? (const char*)g.Bt + (size_t)nxt.pn * tstep : cB;
        for (int t = 0; t < nt; t += 2) {
            const bool last = (t == nt - 2);
            const char* a1 = cA + (size_t)(t + 1) * kstep;
            const char* a2 = last ? nA : cA + (size_t)(t + 2) * kstep; const char* b2 = last ? nB : cB + (size_t)(t + 2) * kstep;
            const char* a3 = a2 + kstep; const char* b3 = b2 + kstep;
            if (last && has_next) S.a_ready(nxt);
            if constexpr (SP2) {
            PG8_LDB(B0, 0, 0); PG8_LDB(B1, 0, 1); PG8_SCHED; PG8_LDA(At, 0, 0); PG8_STAGE(PG8_SA(1, 1), a1 + hstep, voffA);
            PG8_WAIT_V(8); PG8_WAIT_L(0); PG8_BAR; PG8_MMA(0, 0, At, B0); PG8_MMA(0, 1, At, B1); PG8_BAR; PG8_SCHED;
            PG8_LDA(At, 0, 1); PG8_STAGE(PG8_SB(0, 0), b2, voffB); PG8_STAGE(PG8_SB(0, 1), b2 + hstep, voffB); PG8_STAGE(PG8_SA(0, 0), a2, voffA);
            PG8_WAIT_V(8); PG8_WAIT_L(0); PG8_BAR; PG8_MMA(1, 0, At, B0); PG8_MMA(1, 1, At, B1); PG8_BAR; PG8_SCHED;
            PG8_LDB(B0, 1, 0); PG8_LDB(B1, 1, 1); PG8_SCHED; PG8_LDA(At, 1, 0); PG8_STAGE(PG8_SA(0, 1), a2 + hstep, voffA);
            PG8_WAIT_V(8); PG8_WAIT_L(0); PG8_BAR; PG8_MMA(0, 0, At, B0); PG8_MMA(0, 1, At, B1); PG8_BAR; PG8_SCHED;
            PG8_LDA(At, 1, 1); PG8_STAGE(PG8_SB(1, 0), b3, voffB); PG8_STAGE(PG8_SB(1, 1), b3 + hstep, voffB); PG8_STAGE(PG8_SA(1, 0), a3, voffA);
            PG8_WAIT_V(8); PG8_WAIT_L(0); PG8_BAR; PG8_MMA(1, 0, At, B0); PG8_MMA(1, 1, At, B1); PG8_BAR; PG8_SCHED;
            } else {
            PG8_LDB(B0, 0, 0); PG8_SCHED; PG8_LDA(At, 0, 0); PG8_STAGE(PG8_SA(1, 1), a1 + hstep, voffA);
            PG8_WAIT_L(8); PG8_BAR; PG8_WAIT_L(0); PG8_MMA(0, 0, At, B0); PG8_BAR; PG8_SCHED;
            PG8_LDB(B1, 0, 1); PG8_STAGE(PG8_SB(0, 0), b2, voffB);
            PG8_BAR; PG8_WAIT_L(0); PG8_MMA(0, 1, At, B1); PG8_BAR;
            PG8_LDA(At, 0, 1); PG8_STAGE(PG8_SA(0, 0), a2, voffA);
            PG8_BAR; PG8_WAIT_L(0); PG8_MMA(1, 0, At, B0); PG8_BAR; PG8_SCHED;
            PG8_STAGE(PG8_SB(0, 1), b2 + hstep, voffB);
            PG8_WAIT_V(6); PG8_BAR; PG8_MMA(1, 1, At, B1); PG8_BAR;
            PG8_LDB(B0, 1, 0); PG8_SCHED; PG8_LDA(At, 1, 0); PG8_STAGE(PG8_SA(0, 1), a2 + hstep, voffA);
            PG8_WAIT_L(8); PG8_BAR; PG8_WAIT_L(0); PG8_MMA(0, 0, At, B0); PG8_BAR; PG8_SCHED;
            PG8_LDB(B1, 1, 1); PG8_STAGE(PG8_SB(1, 0), b3, voffB);
            PG8_BAR; PG8_WAIT_L(0); PG8_MMA(0, 1, At, B1); PG8_BAR;
            PG8_LDA(At, 1, 1); PG8_STAGE(PG8_SA(1, 0), a3, voffA);
            PG8_BAR; PG8_WAIT_L(0); PG8_MMA(1, 0, At, B0); PG8_BAR; PG8_SCHED;
            PG8_STAGE(PG8_SB(1, 1), b3 + hstep, voffB);
            PG8_WAIT_V(6); PG8_BAR; PG8_MMA(1, 1, At, B1); PG8_BAR;
            }
        }
        if constexpr (ALIGN_EPI) { if (wr == 0) PG8_BAR; }
        if constexpr (!Epi::AFTER_DRAIN) { E(acc, cur, wr, wc, fr, fq); S.done(cur); }
        if (!has_next) break;
#pragma unroll
        for (int a = 0; a < 2; ++a)
#pragma unroll
            for (int b = 0; b < 2; ++b)
#pragma unroll
                for (int m = 0; m < 4; ++m)
#pragma unroll
                    for (int n = 0; n < 2; ++n) acc[a][b][m][n] = (f32x4){0.f, 0.f, 0.f, 0.f};
        cur = nxt; cA = nA; cB = nB; ++ui;
        if constexpr (ALIGN_EPI) { if (wr == 1) PG8_BAR; }
    }
    PG8_WAIT_V(0);
    if constexpr (!ALIGN_EPI) { if (wr == 0) PG8_BAR; }
    PG8_BAR;
    if constexpr (Epi::AFTER_DRAIN) { E.fused(acc, cur, wr, wc, fr, fq, lds, wid, lane); S.done(cur); }
#undef PG8_SA
#undef PG8_SB
#undef PG8_STAGE
#undef PG8_LDA
#undef PG8_LDB
#undef PG8_MMA
#undef PG8_WAIT_V
#undef PG8_WAIT_L
#undef PG8_BAR
#undef PG8_SCHED
}
}

#ifndef PER_PHASE_LAUNCH
#define PER_PHASE_LAUNCH 0
#endif

constexpr int DM = 1024, NBP = 4, SEQ = 4096, DBS = 128, DTS = 8;
constexpr int MP = NBP * SEQ, MS = DBS * DTS, M = MP + MS;
constexpr int NPROJ = 3584, INCOLS = 3592, FF = 4096, WBUF = 2048;
constexpr int C_Q = 0, C_K = 512, C_V = 1024, C_RAW = 1536, C_VB = 2560, C_OB = 3072;
constexpr float EPS = 1e-6f;
constexpr int NPH = 10;
constexpr size_t O_YP = 0, O_YS = O_YP + (size_t)MP * DM, O_PK = O_YS + (size_t)MS * DM, O_PV = O_PK + (size_t)NBP * WBUF * 512,
    O_PCONV = O_PV + (size_t)NBP * WBUF * 512, O_PC = O_PCONV + (size_t)NBP * 3 * 1024, O_PN = O_PC + (size_t)NBP * 4 * 128 * 128, O_PM = O_PN + (size_t)NBP * 4 * 128,
    O_SK = O_PM + (size_t)NBP * 4, O_SV = O_SK + (size_t)DBS * WBUF * 512, O_SCONV = O_SV + (size_t)DBS * WBUF * 512, O_SC = O_SCONV + (size_t)DBS * 3 * 1024,
    O_SN = O_SC + (size_t)DBS * 4 * 128 * 128, O_SM = O_SN + (size_t)DBS * 4 * 128, O_END = O_SM + (size_t)DBS * 4;
static_assert(O_END == 303774224ull, "output size");
constexpr size_t MiB = 1u << 20;
constexpr size_t WS_CTL = 0, CTL_ZERO_BYTES = 1 * MiB;
constexpr int CW_BAR = 4096;
constexpr size_t WS_SS2 = 256 * 1024, WS_SSF = 512 * 1024;
constexpr size_t WS_WIN = 2 * MiB, WS_WOUT = 10 * MiB, WS_WUP = 12 * MiB, WS_WDN = 20 * MiB;
constexpr size_t WS_ROPE = 28 * MiB, WS_RSTD1 = 29 * MiB, WS_IG = 29 * MiB + 512 * 1024, WS_LF = 30 * MiB, WS_CHK = 31 * MiB;
constexpr size_t WS_XB = 32 * MiB, WS_PROJ = 68 * MiB, WS_MIX = 188 * MiB, WS_HPB = 222 * MiB, WS_ACT = 256 * MiB;
constexpr size_t WS_QF = 392 * MiB, WS_KF = 426 * MiB, WS_L = 460 * MiB, WS_CPRE = 492 * MiB, WS_NLOC = 524 * MiB, WS_NPRE = 525 * MiB, WS_DUMMY = 526 * MiB, WS_END = 544 * MiB;
static_assert(WS_PROJ + (size_t)M * NPROJ * 2 <= WS_MIX && WS_ACT + (size_t)M * FF * 2 <= WS_QF && WS_XB + (size_t)M * DM * 2 <= WS_PROJ, "ws map");

constexpr int LDS_BYTES = 147456;
constexpr int MISC_OFF = 131072 + 8192;

#define GAS __attribute__((address_space(1)))
#define LAS __attribute__((address_space(3)))
typedef unsigned short bf16;
typedef unsigned v4u __attribute__((ext_vector_type(4)));
typedef unsigned v2u __attribute__((ext_vector_type(2)));
typedef float f32x4 __attribute__((ext_vector_type(4)));
typedef GAS unsigned gu32;
#define LDS_WAIT() asm volatile("s_waitcnt lgkmcnt(0)" ::: "memory")
__device__ __forceinline__ unsigned f2bf(float f) { unsigned u = __builtin_bit_cast(unsigned, f); return (u + 0x7fffu + ((u >> 16) & 1u)) >> 16; }
__device__ __forceinline__ unsigned pk2(float lo, float hi) { return f2bf(lo) | (f2bf(hi) << 16); }
__device__ __forceinline__ float bf2f(unsigned short u) { return __builtin_bit_cast(float, (unsigned)u << 16); }
__device__ __forceinline__ float bflo(unsigned u) { return __builtin_bit_cast(float, u << 16); }
__device__ __forceinline__ float bfhi(unsigned u) { return __builtin_bit_cast(float, u & 0xffff0000u); }
__device__ __forceinline__ float wave_sum(float v) {
#pragma unroll
    for (int o = 1; o < 64; o <<= 1) v += __shfl_xor(v, o);
    return v;
}
__device__ __forceinline__ float wave_max(float v) {
#pragma unroll
    for (int o = 1; o < 64; o <<= 1) v = fmaxf(v, __shfl_xor(v, o));
    return v;
}
__device__ __forceinline__ int opaque(int v) { asm volatile("" : "+v"(v)); return v; }
__device__ __forceinline__ float sigmoidf_(float x) { return 1.f / (1.f + __expf(-x)); }

#define XB_TMO      128
#define XB_XCNT(j)  (256  + 64 * (j))
#define XB_XSUB(j)  (1280 + 64 * (j))
#define XB_XGEN(j)  (2304 + 64 * (j))
#define XB_TOP      3328
#define XB_TOPGEN   3392
#define XCD_BAR_WORDS 3456
#define XB_SPIN_CAP (1u << 18)
__device__ __forceinline__ unsigned xb_ld(unsigned* p)              { return __hip_atomic_load(p, __ATOMIC_RELAXED, __HIP_MEMORY_SCOPE_AGENT); }
__device__ __forceinline__ unsigned xb_add(unsigned* p, unsigned v) { return __hip_atomic_fetch_add(p, v, __ATOMIC_RELAXED, __HIP_MEMORY_SCOPE_AGENT); }
__device__ __forceinline__ unsigned xb_xcc_id() { return (unsigned)__builtin_amdgcn_s_getreg((3 << 11) | 20) & 0xFu; }
#define XB_SPIN(cond, bar) do { unsigned _sp = 0; while (cond) { __builtin_amdgcn_s_sleep(1); \
    if ((++_sp & 255u) == 0u) { if (xb_ld(&(bar)[XB_TMO])) break; if (_sp > XB_SPIN_CAP) { atomicAdd(&(bar)[XB_TMO], 1u); break; } } } } while (0)
struct XcdBarrier { unsigned* bar; unsigned x; volatile LAS unsigned* st; };
__device__ __forceinline__ XcdBarrier xcd_barrier_post(unsigned* bar, volatile LAS unsigned* st) {
    XcdBarrier b; b.bar = bar; b.x = xb_xcc_id(); b.st = st;
    if (threadIdx.x == 0) (void)xb_add(&bar[XB_XCNT(b.x)], 1u);
    return b;
}
__device__ __forceinline__ void xcd_barrier_complete(unsigned* bar, unsigned x, unsigned& nloc, unsigned& nx) {
    const unsigned G = gridDim.x * gridDim.y * gridDim.z;
    unsigned sum, cnt, mine, sp = 0u;
    for (;;) {
        sum = 0u; cnt = 0u; mine = 0u;
#pragma unroll
        for (unsigned j = 0; j < 16; ++j) { const unsigned c = xb_ld(&bar[XB_XCNT(j)]); sum += c; cnt += (c > 0u) ? 1u : 0u; mine = (j == x) ? c : mine; }
        if (sum == G) break;
        __builtin_amdgcn_s_sleep(1);
        if ((++sp & 255u) == 0u) { if (xb_ld(&bar[XB_TMO])) break; if (sp > XB_SPIN_CAP) { atomicAdd(&bar[XB_TMO], 1u); break; } }
    }
    nloc = mine > 0u ? mine : 1u; nx = cnt > 0u ? cnt : 1u;
}
__device__ __forceinline__ void xcd_barrier(const XcdBarrier& b) {
    asm volatile("s_waitcnt vmcnt(0)" ::: "memory");
    __syncthreads();
    if (threadIdx.x == 0) {
        unsigned* bar = b.bar;
        __builtin_amdgcn_s_waitcnt(0);
        unsigned nloc = b.st[0], nx = b.st[1];
        if (nloc == 0u) { xcd_barrier_complete(bar, b.x, nloc, nx); b.st[0] = nloc; b.st[1] = nx; }
        const unsigned old = xb_add(&bar[XB_XSUB(b.x)], 1u);
        const unsigned gen = old / nloc;
        if (old + 1u == (gen + 1u) * nloc) {
            __builtin_amdgcn_fence(__ATOMIC_RELEASE, "agent");
            asm volatile("s_waitcnt vmcnt(0)" ::: "memory");
            const unsigned og = xb_add(&bar[XB_TOP], 1u);
            const unsigned tg = og / nx;
            if (og + 1u == (tg + 1u) * nx) xb_add(&bar[XB_TOPGEN], 1u);
            else XB_SPIN(xb_ld(&bar[XB_TOPGEN]) == tg, bar);
            __builtin_amdgcn_fence(__ATOMIC_ACQUIRE, "agent");
            xb_add(&bar[XB_XGEN(b.x)], 1u);
            asm volatile("s_waitcnt vmcnt(0)" ::: "memory");
        } else {
            XB_SPIN(xb_ld(&bar[XB_XGEN(b.x)]) == gen, bar);
            __builtin_amdgcn_fence(__ATOMIC_ACQUIRE, "agent");
            asm volatile("s_waitcnt vmcnt(0)" ::: "memory");
        }
    }
    __syncthreads();
}

struct Frame {
    LAS unsigned char* lds;
    int tid, lane, wave, vcu, G;
    const float *xp, *xs, *cache_k, *cache_v, *st_conv, *st_C, *st_n, *st_m, *g1, *w_in, *b_gate, *w_conv, *b_conv, *mhg, *w_out, *g2, *w_up, *w_down, *gf;
    float* out; unsigned char* ws;
    bf16 *Win_t, *Wout_t, *Wup_t, *Wdn_t, *XB, *PROJ, *MIX, *HPB, *ACT;
    float *rope, *rstd1, *ig, *lf, *chk, *ss2, *ssf, *QF, *KF, *L, *CPRE, *NLOC, *NPRE;
};

namespace pg8 {
struct EpiIn {
    static constexpr bool PERM = true, AFTER_DRAIN = false;
    bf16_t* proj; const float* rstd; const float* rope; float* out;
    __device__ __forceinline__ void operator()(const f32x4 (&acc)[2][2][4][2], const Unit& u, int wr, int wc, int fr, int fq) const {
        const int pn = u.pn;
        const bool rot = (pn < 4) && ((wc & 1) == 0);
#pragma unroll
        for (int ai = 0; ai < 2; ++ai)
#pragma unroll
            for (int m = 0; m < 4; ++m) {
                const int row = u.pm * BM + ai * HALF + wr * 64 + m * 16 + fr;
                const float rs = rstd[row];
                const bool smp = row >= MP;
                const int b = smp ? ((row - MP) >> 3) : (row >> 12), t = smp ? ((row - MP) & 7) : (row & 4095);
                const int pidx = smp ? (SEQ + t) : t;
#pragma unroll
                for (int bj = 0; bj < 2; ++bj) {
                    const int col0 = pn * BM + bj * HALF + wc * 32 + 8 * fq;
                    f32x4 v0 = acc[ai][bj][m][0] * rs, v1 = acc[ai][bj][m][1] * rs;
                    if (rot) {
                        f32x4 p0, p1;
                        p0.x = __shfl_xor(v0.x, 16); p0.y = __shfl_xor(v0.y, 16); p0.z = __shfl_xor(v0.z, 16); p0.w = __shfl_xor(v0.w, 16);
                        p1.x = __shfl_xor(v1.x, 16); p1.y = __shfl_xor(v1.y, 16); p1.z = __shfl_xor(v1.z, 16); p1.w = __shfl_xor(v1.w, 16);
                        if (fq < 2) {
                            const f32x4 c0 = *(const f32x4*)(rope + pidx * 16), c1 = *(const f32x4*)(rope + pidx * 16 + 4);
                            const f32x4 s0 = *(const f32x4*)(rope + pidx * 16 + 8), s1 = *(const f32x4*)(rope + pidx * 16 + 12);
                            if (fq == 0) { v0 = v0 * c0 - p0 * s0; v1 = v1 * c1 - p1 * s1; }
                            else         { v0 = v0 * c0 + p0 * s0; v1 = v1 * c1 + p1 * s1; }
                        }
                    }
                    if (pn < 2) { v0 = v0 * 0.125f; v1 = v1 * 0.125f; }
                    u32x4 w; w.x = cvt_pk_bf16(v0[0], v0[1]); w.y = cvt_pk_bf16(v0[2], v0[3]); w.z = cvt_pk_bf16(v1[0], v1[1]); w.w = cvt_pk_bf16(v1[2], v1[3]);
                    *(u32x4*)(proj + (size_t)row * NPROJ + col0) = w;
                    if (pn >= 2 && pn < 6) {
                        const bool isk = pn < 4; const int cc = col0 - (isk ? C_K : C_V);
                        float* dst = nullptr;
                        if (smp) dst = out + (isk ? O_SK : O_SV) + ((size_t)b * WBUF + (WBUF - DTS) + t) * 512 + cc;
                        else if (t >= SEQ - WBUF) dst = out + (isk ? O_PK : O_PV) + ((size_t)b * WBUF + (t - (SEQ - WBUF))) * 512 + cc;
                        if (dst) { *(f32x4*)dst = v0; *(f32x4*)(dst + 4) = v1; }
                    } else if (pn >= 6 && pn < 10) {
                        const int cc = col0 - C_RAW;
                        float* dst = nullptr;
                        if (smp) { if (t >= DTS - 3) dst = out + O_SCONV + ((size_t)b * 3 + (t - (DTS - 3))) * 1024 + cc; }
                        else if (t >= SEQ - 3) dst = out + O_PCONV + ((size_t)b * 3 + (t - (SEQ - 3))) * 1024 + cc;
                        if (dst) { *(f32x4*)dst = v0; *(f32x4*)(dst + 4) = v1; }
                    }
                }
            }
    }
};
struct EpiOut {
    static constexpr bool PERM = true, AFTER_DRAIN = false;
    const float* xp; const float* xs; float* hp; bf16_t* hpb; float* ss;
    __device__ __forceinline__ void operator()(const f32x4 (&acc)[2][2][4][2], const Unit& u, int wr, int wc, int fr, int fq) const {
#pragma unroll
        for (int ai = 0; ai < 2; ++ai)
#pragma unroll
            for (int m = 0; m < 4; ++m) {
                const int row = u.pm * BM + ai * HALF + wr * 64 + m * 16 + fr;
                const float* xr = (row < MP) ? xp + (size_t)row * DM : xs + (size_t)(row - MP) * DM;
                float s = 0.f;
#pragma unroll
                for (int bj = 0; bj < 2; ++bj) {
                    const int col0 = u.pn * BM + bj * HALF + wc * 32 + 8 * fq;
                    const f32x4 v0 = acc[ai][bj][m][0] + *(const f32x4*)(xr + col0), v1 = acc[ai][bj][m][1] + *(const f32x4*)(xr + col0 + 4);
                    *(f32x4*)(hp + (size_t)row * DM + col0) = v0; *(f32x4*)(hp + (size_t)row * DM + col0 + 4) = v1;
                    u32x4 w; w.x = cvt_pk_bf16(v0[0], v0[1]); w.y = cvt_pk_bf16(v0[2], v0[3]); w.z = cvt_pk_bf16(v1[0], v1[1]); w.w = cvt_pk_bf16(v1[2], v1[3]);
                    *(u32x4*)(hpb + (size_t)row * DM + col0) = w;
                    s += (v0[0] * v0[0] + v0[1] * v0[1]) + (v0[2] * v0[2] + v0[3] * v0[3]) + (v1[0] * v1[0] + v1[1] * v1[1]) + (v1[2] * v1[2] + v1[3] * v1[3]);
                }
                s += __shfl_xor(s, 16); s += __shfl_xor(s, 32);
                if (fq == 0) atomicAdd(ss + row, s);
            }
    }
};
struct EpiUp {
    static constexpr bool PERM = true, AFTER_DRAIN = false;
    bf16_t* act; const float* ss;
    __device__ __forceinline__ void operator()(const f32x4 (&acc)[2][2][4][2], const Unit& u, int wr, int wc, int fr, int fq) const {
#pragma unroll
        for (int ai = 0; ai < 2; ++ai)
#pragma unroll
            for (int m = 0; m < 4; ++m) {
                const int row = u.pm * BM + ai * HALF + wr * 64 + m * 16 + fr;
                const float rs = 1.f / sqrtf(ss[row] * (1.f / DM) + EPS);
#pragma unroll
                for (int bj = 0; bj < 2; ++bj) {
                    const int col0 = u.pn * BM + bj * HALF + wc * 32 + 8 * fq;
                    f32x4 v0 = acc[ai][bj][m][0] * rs, v1 = acc[ai][bj][m][1] * rs;
#pragma unroll
                    for (int e = 0; e < 4; ++e) { const float a = fmaxf(v0[e], 0.f), c = fmaxf(v1[e], 0.f); v0[e] = a * a; v1[e] = c * c; }
                    u32x4 w; w.x = cvt_pk_bf16(v0[0], v0[1]); w.y = cvt_pk_bf16(v0[2], v0[3]); w.z = cvt_pk_bf16(v1[0], v1[1]); w.w = cvt_pk_bf16(v1[2], v1[3]);
                    *(u32x4*)(act + (size_t)row * FF + col0) = w;
                }
            }
    }
};
struct EpiDown {
    static constexpr bool PERM = true, AFTER_DRAIN = false;
    float* hp; float* ss;
    __device__ __forceinline__ void operator()(const f32x4 (&acc)[2][2][4][2], const Unit& u, int wr, int wc, int fr, int fq) const {
#pragma unroll
        for (int ai = 0; ai < 2; ++ai)
#pragma unroll
            for (int m = 0; m < 4; ++m) {
                const int row = u.pm * BM + ai * HALF + wr * 64 + m * 16 + fr;
                float s = 0.f;
#pragma unroll
                for (int bj = 0; bj < 2; ++bj) {
                    const int col0 = u.pn * BM + bj * HALF + wc * 32 + 8 * fq;
                    float* p = hp + (size_t)row * DM + col0;
                    const f32x4 v0 = acc[ai][bj][m][0] + *(const f32x4*)p, v1 = acc[ai][bj][m][1] + *(const f32x4*)(p + 4);
                    *(f32x4*)p = v0; *(f32x4*)(p + 4) = v1;
                    s += (v0[0] * v0[0] + v0[1] * v0[1]) + (v0[2] * v0[2] + v0[3] * v0[3]) + (v1[0] * v1[0] + v1[1] * v1[1]) + (v1[2] * v1[2] + v1[3] * v1[3]);
                }
                s += __shfl_xor(s, 16); s += __shfl_xor(s, 32);
                if (fq == 0) atomicAdd(ss + row, s);
            }
    }
};
}

__device__ __forceinline__ void p0_transpose_item(const float* W, int K, int ldw, int nblk, const float* gain, bf16* WT, LAS float* scr, int item, int lane) {
    const int kb = item / nblk, nb = item % nblk, k0 = 64 * kb, n0 = 32 * nb;
#pragma unroll 8
    for (int i = 0; i < 32; ++i) { const int kk = 2 * i + (lane >> 5); const float gg = gain ? gain[k0 + kk] : 1.f; scr[kk * 33 + (lane & 31)] = gg * W[(size_t)(k0 + kk) * ldw + n0 + (lane & 31)]; }
    LDS_WAIT(); asm volatile("" ::: "memory");
    const int c = lane & 7;
#pragma unroll
    for (int j = 0; j < 4; ++j) { const int n = (lane >> 3) + 8 * j; const LAS float* s = scr + (8 * c) * 33 + n;
        v4u o; o.x = pk2(s[0 * 33], s[1 * 33]); o.y = pk2(s[2 * 33], s[3 * 33]); o.z = pk2(s[4 * 33], s[5 * 33]); o.w = pk2(s[6 * 33], s[7 * 33]);
        *(GAS v4u*)(WT + (size_t)(n0 + n) * K + k0 + 8 * c) = o; }
    LDS_WAIT(); asm volatile("" ::: "memory");
}
__device__ __forceinline__ void sincos_d(double a, double& s, double& c) {
    const double TWO_PI = 6.283185307179586476925286766559;
    const double k = __builtin_rint(a * (1.0 / TWO_PI));
    const double r = a - k * TWO_PI, r2 = r * r;
    double sc = 1.0, ss = r, tc = 1.0, ts = r;
#pragma unroll
    for (int n = 1; n <= 17; ++n) { tc *= -r2 / (double)((2 * n - 1) * (2 * n)); sc += tc; ts *= -r2 / (double)((2 * n) * (2 * n + 1)); ss += ts; }
    s = ss; c = sc;
}
__device__ __forceinline__ float log_sigmoidf_(float x) { return x < 0.f ? x - log1pf(expf(x)) : -log1pf(expf(-x)); }

__device__ __forceinline__ void p0_prologue(Frame& F) {
    const int gw = F.vcu * 8 + F.wave, NGW = F.G * 8;
    {
        LAS float* scr = (LAS float*)(F.lds + F.wave * 16384);
        constexpr int I_IN = 16 * 112, I_OUT = 16 * 32, I_UP = 16 * 128, I_DN = 64 * 32;
        for (int it = gw; it < I_IN + I_OUT + I_UP + I_DN; it += NGW) {
            int r = it;
            if (r < I_IN) { p0_transpose_item(F.w_in, DM, INCOLS, 112, F.g1, F.Win_t, scr, r, F.lane); continue; } r -= I_IN;
            if (r < I_OUT) { p0_transpose_item(F.w_out, DM, DM, 32, nullptr, F.Wout_t, scr, r, F.lane); continue; } r -= I_OUT;
            if (r < I_UP) { p0_transpose_item(F.w_up, DM, FF, 128, F.g2, F.Wup_t, scr, r, F.lane); continue; } r -= I_UP;
            p0_transpose_item(F.w_down, FF, DM, 32, nullptr, F.Wdn_t, scr, r, F.lane);
        }
    }
    __syncthreads();
    {
        LAS float* Wg = (LAS float*)F.lds;
        for (int i = F.tid; i < 8192; i += 512) { const int k = i >> 3, j = i & 7; Wg[j * 1024 + k] = F.g1[k] * F.w_in[(size_t)k * INCOLS + NPROJ + j]; }
        __syncthreads();
        for (int m = gw; m < M; m += NGW) {
            const float* xr = (m < MP) ? F.xp + (size_t)m * DM : F.xs + (size_t)(m - MP) * DM;
            f32x4 v[4]; float ss = 0.f;
#pragma unroll
            for (int j = 0; j < 4; ++j) { v[j] = *(const f32x4*)(xr + 256 * j + 4 * F.lane); ss += (v[j].x * v[j].x + v[j].y * v[j].y) + (v[j].z * v[j].z + v[j].w * v[j].w); }
            float ga[8];
#pragma unroll
            for (int g = 0; g < 8; ++g) { float a = 0.f;
#pragma unroll
                for (int j = 0; j < 4; ++j) { const f32x4 w = *(const LAS f32x4*)(Wg + g * 1024 + 256 * j + 4 * F.lane); a += (v[j].x * w.x + v[j].y * w.y) + (v[j].z * w.z + v[j].w * w.w); }
                ga[g] = wave_sum(a); }
            ss = wave_sum(ss);
            const float rstd = 1.f / sqrtf(ss * (1.f / DM) + EPS);
            float gv = 0.f;
#pragma unroll
            for (int g = 0; g < 8; ++g) gv = (F.lane == g) ? ga[g] : gv;
            if (F.lane == 0) F.rstd1[m] = rstd;
            if (F.lane < 8) { const float gg = gv * rstd + F.b_gate[F.lane];
                if (F.lane < 4) F.ig[m * 4 + F.lane] = gg; else F.lf[m * 4 + F.lane - 4] = log_sigmoidf_(gg); }
            v2u* o8 = (v2u*)(F.XB + (size_t)m * DM);
#pragma unroll
            for (int j = 0; j < 4; ++j) { v2u o; o.x = pk2(v[j].x, v[j].y); o.y = pk2(v[j].z, v[j].w); o8[64 * j + F.lane] = o; }
        }
    }
    {
        const double invf[8] = {1.0, 0.19392274474868576, 0.03760603093086393, 0.007292664737217109, 0.001414213562373095, 0.0002742481756762073, 5.318295896944988e-05, 1.031338537721246e-05};
        for (int i = F.vcu * 512 + F.tid; i < (SEQ + DTS) * 8; i += F.G * 512) {
            const int p = i >> 3, k = i & 7; const double pos = (p < SEQ) ? (double)p : (double)(8192 + p - SEQ);
            double fr = invf[0];
#pragma unroll
            for (int q = 1; q < 8; ++q) fr = (k == q) ? invf[q] : fr;
            double s, c; sincos_d(pos * fr, s, c);
            F.rope[p * 16 + k] = (float)c; F.rope[p * 16 + 8 + k] = (float)s;
        }
    }
}

typedef short bf16x8m __attribute__((ext_vector_type(8)));
typedef short v4i16m __attribute__((ext_vector_type(4)));
struct AttnTileP { int dil, rg, Q0, sp, ks, Lg; };
__device__ __forceinline__ AttnTileP attn_tile_params(int ti, int r16, int L0) {
    AttnTileP t;
    if (ti < 5)       { t.dil = 16; t.rg = r16;     t.Q0 = L0;                  t.sp = 1;  t.ks = t.Q0 - 128 + 32 * ti;        t.Lg = 256; }
    else if (ti < 11) { t.dil = 4;  t.rg = r16 & 3; t.Q0 = 4 * L0 + (r16 >> 2); t.sp = 4;  t.ks = t.Q0 - 128 + 32 * (ti - 5);  t.Lg = 1024; }
    else              { t.dil = 1;  t.rg = 0;       t.Q0 = 16 * L0 + r16;       t.sp = 16; t.ks = t.Q0 - 128 + 32 * (ti - 11); t.Lg = 4096; }
    return t;
}
__device__ __forceinline__ void attn_tile_load(const bf16* P, int b, int h, const AttnTileP& t, int lane, bf16x8m (&kf)[2][2], v4u (&vv)[4]) {
    const int fr = lane & 15, g4 = lane >> 4;
#pragma unroll
    for (int sub = 0; sub < 2; ++sub) { int kp = t.ks + 16 * sub + fr; kp = kp < 0 ? 0 : (kp >= t.Lg ? t.Lg - 1 : kp);
        const bf16* kr = P + (size_t)(b * SEQ + t.dil * kp + t.rg) * NPROJ + C_K + h * 64 + 8 * g4;
        kf[sub][0] = *(const bf16x8m*)kr; kf[sub][1] = *(const bf16x8m*)(kr + 32); }
#pragma unroll
    for (int k = 0; k < 4; ++k) { int kp = t.ks + (lane >> 3) + 8 * k; kp = kp < 0 ? 0 : (kp >= t.Lg ? t.Lg - 1 : kp);
        vv[k] = *(const v4u*)(P + (size_t)(b * SEQ + t.dil * kp + t.rg) * NPROJ + C_V + h * 64 + 8 * (lane & 7)); }
}
__device__ __forceinline__ void p2_attn_prompt_mfma(Frame& F) {
    const int lane = F.lane, fr = lane & 15, g4 = lane >> 4;
    LAS unsigned char* vbuf = F.lds + F.wave * 10240;
    const int gw = F.vcu * 8 + F.wave, NGW = F.G * 8;
    const int vwoff = (lane >> 3) * 160 + (lane & 7) * 16;
    const int troff = (4 * g4 + (fr >> 2)) * 160 + (fr & 3) * 8;
    for (int wt = gw; wt < 8192; wt += NGW) {
        const int r16 = wt & 15, L0 = ((wt >> 4) & 15) * 16, h = (wt >> 8) & 7, b = wt >> 11;
        const int rowq = b * SEQ + 16 * (L0 + fr) + r16;
        bf16x8m qf[2];
        { const bf16* qr = F.PROJ + (size_t)rowq * NPROJ + C_Q + h * 64 + 8 * g4; qf[0] = *(const bf16x8m*)qr; qf[1] = *(const bf16x8m*)(qr + 32); }
        f32x4 acc[4];
#pragma unroll
        for (int i = 0; i < 4; ++i) acc[i] = (f32x4){0.f, 0.f, 0.f, 0.f};
        float m = -1e30f, lsum = 0.f;
        bf16x8m kc[2][2]; v4u vr[4];
        { const AttnTileP t0 = attn_tile_params(0, r16, L0); attn_tile_load(F.PROJ, b, h, t0, lane, kc, vr); }
#pragma unroll
        for (int k = 0; k < 4; ++k) *(LAS v4u*)(vbuf + vwoff + k * 1280) = vr[k];
#pragma unroll 1
        for (int ti = 0; ti < 23; ++ti) {
            const AttnTileP t = attn_tile_params(ti, r16, L0);
            bf16x8m kn[2][2];
            if (ti + 1 < 23) { const AttnTileP tn = attn_tile_params(ti + 1, r16, L0); attn_tile_load(F.PROJ, b, h, tn, lane, kn, vr); }
            else {
#pragma unroll
                for (int a = 0; a < 2; ++a) { kn[a][0] = kc[a][0]; kn[a][1] = kc[a][1]; } }
            LAS unsigned char* vb = vbuf + (ti & 1) * 5120;
            f32x4 s0 = (f32x4){0.f, 0.f, 0.f, 0.f}, s1 = (f32x4){0.f, 0.f, 0.f, 0.f};
            s0 = __builtin_amdgcn_mfma_f32_16x16x32_bf16(kc[0][0], qf[0], s0, 0, 0, 0); s0 = __builtin_amdgcn_mfma_f32_16x16x32_bf16(kc[0][1], qf[1], s0, 0, 0, 0);
            s1 = __builtin_amdgcn_mfma_f32_16x16x32_bf16(kc[1][0], qf[0], s1, 0, 0, 0); s1 = __builtin_amdgcn_mfma_f32_16x16x32_bf16(kc[1][1], qf[1], s1, 0, 0, 0);
            const int qp = t.Q0 + t.sp * fr;
            float mx = -INFINITY;
#pragma unroll
            for (int i = 0; i < 4; ++i) { const int k0 = t.ks + 4 * g4 + i, k1 = k0 + 16;
                const bool v0 = (k0 >= 0) && (k0 <= qp) && (qp - k0 <= 128), v1 = (k1 >= 0) && (k1 <= qp) && (qp - k1 <= 128);
                s0[i] = v0 ? s0[i] : -INFINITY; s1[i] = v1 ? s1[i] : -INFINITY; mx = fmaxf(mx, fmaxf(s0[i], s1[i])); }
            mx = fmaxf(mx, __shfl_xor(mx, 16)); mx = fmaxf(mx, __shfl_xor(mx, 32));
            const float mn = fmaxf(m, mx), alpha = __expf(m - mn); m = mn;
            float ps = 0.f;
#pragma unroll
            for (int i = 0; i < 4; ++i) { s0[i] = __expf(s0[i] - mn); s1[i] = __expf(s1[i] - mn); ps += s0[i] + s1[i]; }
            lsum = lsum * alpha + ps;
#pragma unroll
            for (int i = 0; i < 4; ++i) acc[i] = acc[i] * alpha;
            bf16x8m pb;
            { v4u w; w.x = pk2(s0[0], s0[1]); w.y = pk2(s0[2], s0[3]); w.z = pk2(s1[0], s1[1]); w.w = pk2(s1[2], s1[3]); pb = __builtin_bit_cast(bf16x8m, w); }
#pragma unroll
            for (int db = 0; db < 4; ++db) {
                const v4i16m a0 = __builtin_amdgcn_ds_read_tr16_b64_v4i16((LAS v4i16m*)(vb + troff + db * 32));
                const v4i16m a1 = __builtin_amdgcn_ds_read_tr16_b64_v4i16((LAS v4i16m*)(vb + troff + db * 32 + 16 * 160));
                const bf16x8m vt = __builtin_shufflevector(a0, a1, 0, 1, 2, 3, 4, 5, 6, 7);
                acc[db] = __builtin_amdgcn_mfma_f32_16x16x32_bf16(vt, pb, acc[db], 0, 0, 0);
            }
            if (ti + 1 < 23) { LAS unsigned char* vn = vbuf + ((ti + 1) & 1) * 5120;
#pragma unroll
                for (int k = 0; k < 4; ++k) *(LAS v4u*)(vn + vwoff + k * 1280) = vr[k]; }
#pragma unroll
            for (int a = 0; a < 2; ++a) { kc[a][0] = kn[a][0]; kc[a][1] = kn[a][1]; }
        }
        lsum += __shfl_xor(lsum, 16); lsum += __shfl_xor(lsum, 32);
        const float inv = 1.f / lsum;
        bf16* orow = F.MIX + (size_t)rowq * DM + h * 64 + 4 * g4;
#pragma unroll
        for (int db = 0; db < 4; ++db) { v2u o; o.x = pk2(acc[db][0] * inv, acc[db][1] * inv); o.y = pk2(acc[db][2] * inv, acc[db][3] * inv); *(v2u*)(orow + 16 * db) = o; }
    }
}


__device__ __forceinline__ bf16x8m cvt8(const f32x4 a, const f32x4 b) { v4u w; w.x = pk2(a.x, a.y); w.y = pk2(a.z, a.w); w.z = pk2(b.x, b.y); w.w = pk2(b.z, b.w); return __builtin_bit_cast(bf16x8m, w); }
__device__ __forceinline__ bf16x8m ld_sigma_g(const bf16* p) {
    const v2u a = *(const v2u*)p, c = *(const v2u*)(p + 16); v4u w; w.x = a.x; w.y = a.y; w.z = c.x; w.w = c.y; return __builtin_bit_cast(bf16x8m, w);
}
__device__ __forceinline__ void sstream_tile(const bf16x8m (&ka)[2][2], const bf16x8m q0, const bf16x8m q1, int R, int fr, int g4, const LAS unsigned char* vbuf, int troff,
                                             float& m, float& lsum, f32x4 (&acc)[4]) {
    f32x4 s0 = (f32x4){0.f, 0.f, 0.f, 0.f}, s1 = (f32x4){0.f, 0.f, 0.f, 0.f};
    s0 = __builtin_amdgcn_mfma_f32_16x16x32_bf16(ka[0][0], q0, s0, 0, 0, 0); s0 = __builtin_amdgcn_mfma_f32_16x16x32_bf16(ka[0][1], q1, s0, 0, 0, 0);
    s1 = __builtin_amdgcn_mfma_f32_16x16x32_bf16(ka[1][0], q0, s1, 0, 0, 0); s1 = __builtin_amdgcn_mfma_f32_16x16x32_bf16(ka[1][1], q1, s1, 0, 0, 0);
    float mu0[4], mu1[4]; float mx = -INFINITY;
#pragma unroll
    for (int i = 0; i < 4; ++i) {
        const int d0 = WBUF + fr - (R + 4 * g4 + i), d1 = d0 - 16;
        float c0 = 0.f, c1 = 0.f;
        if (fr < 8 && d0 >= 0) c0 = (d0 <= 128 ? 1.f : 0.f) + (((d0 & 3) == 0 && d0 <= 512) ? 1.f : 0.f) + (((d0 & 15) == 0) ? 1.f : 0.f);
        if (fr < 8 && d1 >= 0) c1 = (d1 <= 128 ? 1.f : 0.f) + (((d1 & 3) == 0 && d1 <= 512) ? 1.f : 0.f) + (((d1 & 15) == 0) ? 1.f : 0.f);
        mu0[i] = c0; mu1[i] = c1;
        mx = fmaxf(mx, (c0 > 0.f) ? s0[i] : -INFINITY);
        mx = fmaxf(mx, (c1 > 0.f) ? s1[i] : -INFINITY); }
    mx = fmaxf(mx, __shfl_xor(mx, 16)); mx = fmaxf(mx, __shfl_xor(mx, 32));
    const float mn = fmaxf(m, mx), alpha = __expf(m - mn); m = mn;
    float ps = 0.f;
#pragma unroll
    for (int i = 0; i < 4; ++i) { s0[i] = (mu0[i] > 0.f) ? mu0[i] * __expf(s0[i] - mn) : 0.f; s1[i] = (mu1[i] > 0.f) ? mu1[i] * __expf(s1[i] - mn) : 0.f; ps += s0[i] + s1[i]; }
    lsum = lsum * alpha + ps;
#pragma unroll
    for (int i = 0; i < 4; ++i) acc[i] = acc[i] * alpha;
    v4u pw; pw.x = pk2(s0[0], s0[1]); pw.y = pk2(s0[2], s0[3]); pw.z = pk2(s1[0], s1[1]); pw.w = pk2(s1[2], s1[3]);
    const bf16x8m pb = __builtin_bit_cast(bf16x8m, pw);
#pragma unroll
    for (int db = 0; db < 4; ++db) {
        const v4i16m a0 = __builtin_amdgcn_ds_read_tr16_b64_v4i16((LAS v4i16m*)(vbuf + troff + db * 32));
        const v4i16m a1 = __builtin_amdgcn_ds_read_tr16_b64_v4i16((LAS v4i16m*)(vbuf + troff + db * 32 + 16 * 160));
        acc[db] = __builtin_amdgcn_mfma_f32_16x16x32_bf16(__builtin_shufflevector(a0, a1, 0, 1, 2, 3, 4, 5, 6, 7), pb, acc[db], 0, 0, 0);
    }
}
__device__ __forceinline__ void p2_sample_stream(Frame& F) {
    const int lane = F.lane, fr = lane & 15, g4 = lane >> 4, w = F.wave;
    LAS unsigned char* vbuf = F.lds + w * 5120;
    LAS float* mrg = (LAS float*)(F.lds + 40960);
    const int troff = (4 * g4 + (fr >> 2)) * 160 + (fr & 3) * 8;
    for (int su = F.vcu; su < 256; su += F.G) {
        const int b = su >> 1, hh = 4 * (su & 1) + (w & 3), par = w >> 2;
        bf16x8m q0, q1;
        { const bf16* qr = F.PROJ + (size_t)(MP + b * DTS + (fr & 7)) * NPROJ + C_Q + hh * 64 + 4 * g4;
          q0 = ld_sigma_g(qr); q1 = ld_sigma_g(qr + 32);
          if (fr >= 8) { q0 = (bf16x8m){0, 0, 0, 0, 0, 0, 0, 0}; q1 = q0; } }
        f32x4 acc[4];
#pragma unroll
        for (int i = 0; i < 4; ++i) acc[i] = (f32x4){0.f, 0.f, 0.f, 0.f};
        float m = -1e30f, lsum = 0.f;
        const size_t hoff = ((size_t)b * WBUF * 8 + hh) * 64 + 4 * g4;
        const float* kbase = F.cache_k + hoff; const float* vbase = F.cache_v + hoff;
        float* kout = F.out + O_SK + hoff; float* vout = F.out + O_SV + hoff;
        float* dummy = (float*)(F.ws + WS_DUMMY) + ((size_t)(su * 8 + w) * 64 + lane) * 32;
        __syncthreads();
        f32x4 kx[2][4], vx[2][4];
#pragma unroll
        for (int sub = 0; sub < 2; ++sub) { const int row = 32 * par + 16 * sub + fr;
#pragma unroll
            for (int j = 0; j < 4; ++j) { kx[sub][j] = __builtin_nontemporal_load((const f32x4*)(kbase + (size_t)row * 512 + 16 * j)); vx[sub][j] = __builtin_nontemporal_load((const f32x4*)(vbase + (size_t)row * 512 + 16 * j)); } }
#pragma unroll 1
        for (int ti = par; ti < 64; ti += 2) {
            const int R = 32 * ti;
            f32x4 kn[2][4], vn[2][4];
            { const int tn = (ti + 2 < 64) ? ti + 2 : ti;
#pragma unroll
              for (int sub = 0; sub < 2; ++sub) { const int row = 32 * tn + 16 * sub + fr;
#pragma unroll
                for (int j = 0; j < 4; ++j) { kn[sub][j] = __builtin_nontemporal_load((const f32x4*)(kbase + (size_t)row * 512 + 16 * j)); vn[sub][j] = __builtin_nontemporal_load((const f32x4*)(vbase + (size_t)row * 512 + 16 * j)); } } }
            bf16x8m ka[2][2];
#pragma unroll
            for (int sub = 0; sub < 2; ++sub) { const int row = R + 16 * sub + fr;
                float* ko = (row >= DTS) ? kout + (size_t)(row - DTS) * 512 : dummy; float* vo = (row >= DTS) ? vout + (size_t)(row - DTS) * 512 : dummy + 16;
                const int st = (row >= DTS) ? 16 : 4;
#pragma unroll
                for (int j = 0; j < 4; ++j) { __builtin_nontemporal_store(kx[sub][j], (f32x4*)(ko + st * j)); __builtin_nontemporal_store(vx[sub][j], (f32x4*)(vo + st * j)); }
                ka[sub][0] = cvt8(kx[sub][0], kx[sub][1]); ka[sub][1] = cvt8(kx[sub][2], kx[sub][3]);
                LAS unsigned char* vd = vbuf + (16 * sub + fr) * 160 + 8 * g4;
#pragma unroll
                for (int j = 0; j < 4; ++j) { v2u o; o.x = pk2(vx[sub][j].x, vx[sub][j].y); o.y = pk2(vx[sub][j].z, vx[sub][j].w); *(LAS v2u*)(vd + 32 * j) = o; } }
            sstream_tile(ka, q0, q1, R, fr, g4, vbuf, troff, m, lsum, acc);
#pragma unroll
            for (int sub = 0; sub < 2; ++sub)
#pragma unroll
                for (int j = 0; j < 4; ++j) { kx[sub][j] = kn[sub][j]; vx[sub][j] = vn[sub][j]; }
        }
        if (par == 0) {
            bf16x8m ka[2][2];
            const bf16x8m z = (bf16x8m){0, 0, 0, 0, 0, 0, 0, 0};
            const bf16* kr = F.PROJ + (size_t)(MP + b * DTS + (fr & 7)) * NPROJ + C_K + hh * 64 + 4 * g4;
            const bf16* vr = F.PROJ + (size_t)(MP + b * DTS + (fr & 7)) * NPROJ + C_V + hh * 64 + 4 * g4;
            ka[0][0] = (fr < 8) ? ld_sigma_g(kr) : z; ka[0][1] = (fr < 8) ? ld_sigma_g(kr + 32) : z; ka[1][0] = z; ka[1][1] = z;
#pragma unroll
            for (int sub = 0; sub < 2; ++sub) { LAS unsigned char* vd = vbuf + (16 * sub + fr) * 160 + 8 * g4;
#pragma unroll
                for (int j = 0; j < 4; ++j) { v2u o = (v2u){0u, 0u}; if (sub == 0 && fr < 8) o = *(const v2u*)(vr + 16 * j); *(LAS v2u*)(vd + 32 * j) = o; } }
            sstream_tile(ka, q0, q1, WBUF, fr, g4, vbuf, troff, m, lsum, acc);
        }
        lsum += __shfl_xor(lsum, 16); lsum += __shfl_xor(lsum, 32);
        LAS float* mg = mrg + ((w & 3) * 64 + lane) * 18;
        if (par == 1) { mg[0] = m; mg[1] = lsum;
#pragma unroll
            for (int db = 0; db < 4; ++db) { mg[2 + 4 * db] = acc[db][0]; mg[3 + 4 * db] = acc[db][1]; mg[4 + 4 * db] = acc[db][2]; mg[5 + 4 * db] = acc[db][3]; } }
        __syncthreads();
        if (par == 0) {
            const float m2 = mg[0], l2 = mg[1], mn = fmaxf(m, m2), a1 = __expf(m - mn), a2 = __expf(m2 - mn), inv = 1.f / (lsum * a1 + l2 * a2);
            if (fr < 8) { bf16* orow = F.MIX + (size_t)(MP + b * DTS + fr) * DM + hh * 64 + 4 * g4;
#pragma unroll
                for (int db = 0; db < 4; ++db) { v2u o;
                    o.x = pk2((acc[db][0] * a1 + mg[2 + 4 * db] * a2) * inv, (acc[db][1] * a1 + mg[3 + 4 * db] * a2) * inv);
                    o.y = pk2((acc[db][2] * a1 + mg[4 + 4 * db] * a2) * inv, (acc[db][3] * a1 + mg[5 + 4 * db] * a2) * inv);
                    *(v2u*)(orow + 16 * db) = o; } }
        }
    }
}

__device__ __forceinline__ void load_q64(const bf16* qp, LAS float* sq, int lane) {
    sq[lane] = bf2f(qp[lane]);
    LDS_WAIT(); asm volatile("" ::: "memory");
}
__device__ __forceinline__ float dot_bf16row(const bf16* kp, const LAS float* sq) {
    float a = 0.f;
#pragma unroll 1
    for (int i = 0; i < 8; ++i) { const v4u w = *(const v4u*)(kp + 8 * i); const f32x4 q0 = *(const LAS f32x4*)(sq + 8 * i), q1 = *(const LAS f32x4*)(sq + 8 * i + 4);
        a += q0.x * bflo(w.x) + q0.y * bfhi(w.x) + q0.z * bflo(w.y) + q0.w * bfhi(w.y) + q1.x * bflo(w.z) + q1.y * bfhi(w.z) + q1.z * bflo(w.w) + q1.w * bfhi(w.w); }
    return a;
}
__device__ __forceinline__ float dot_f32row(const float* kp, const LAS float* sq) {
    float a = 0.f;
#pragma unroll 1
    for (int i = 0; i < 16; ++i) { const f32x4 w = *(const f32x4*)(kp + 4 * i); const f32x4 q0 = *(const LAS f32x4*)(sq + 4 * i);
        a += q0.x * w.x + q0.y * w.y + q0.z * w.z + q0.w * w.w; }
    return a;
}
__device__ __forceinline__ void p2_attn_v1(Frame& F) {
    const int gw = F.vcu * 8 + F.wave, NGW = F.G * 8, lane = F.lane;
    LAS float* q = (LAS float*)(F.lds + F.wave * 256);
    for (int it = gw; it < MS * 8; it += NGW) {
        const int sr = it >> 3, h = it & 7, b = sr >> 3, t = sr & 7, row = MP + sr;
        load_q64(F.PROJ + (size_t)row * NPROJ + C_Q + h * 64, q, lane);
        float sc[3][3];
#pragma unroll
        for (int g = 0; g < 3; ++g) { const int dil = (g == 0) ? 1 : (g == 1 ? 4 : 16);
#pragma unroll
            for (int i = 0; i < 3; ++i) { const int j = lane + 64 * i; const bool valid = (j <= 128);
                const int idx = valid ? (WBUF + t - dil * j) : (WBUF + t);
                float d;
                if (idx < WBUF) d = dot_f32row(F.cache_k + (((size_t)b * WBUF + idx) * 8 + h) * 64, q);
                else d = dot_bf16row(F.PROJ + (size_t)(MP + b * DTS + idx - WBUF) * NPROJ + C_K + h * 64, q);
                sc[g][i] = valid ? d : -INFINITY; asm volatile("" ::: "memory"); } }
        float mx = -INFINITY;
#pragma unroll
        for (int g = 0; g < 3; ++g)
#pragma unroll
            for (int i = 0; i < 3; ++i) mx = fmaxf(mx, sc[g][i]);
        mx = wave_max(mx);
        float sum = 0.f;
#pragma unroll
        for (int g = 0; g < 3; ++g)
#pragma unroll
            for (int i = 0; i < 3; ++i) { sc[g][i] = __expf(sc[g][i] - mx); sum += sc[g][i]; }
        sum = wave_sum(sum);
        float o = 0.f;
#pragma unroll
        for (int g = 0; g < 3; ++g) { const int dil = (g == 0) ? 1 : (g == 1 ? 4 : 16);
#pragma unroll
            for (int i = 0; i < 3; ++i) { const int cnt = (i == 2) ? 1 : 64;
#pragma unroll 1
                for (int jj = 0; jj < cnt; ++jj) { const int idx = WBUF + t - dil * (jj + 64 * i);
                    const float p = __shfl(sc[g][i], jj);
                    const float vv = (idx < WBUF) ? F.cache_v[(((size_t)b * WBUF + idx) * 8 + h) * 64 + lane]
                                                  : bf2f(F.PROJ[(size_t)(MP + b * DTS + idx - WBUF) * NPROJ + C_V + h * 64 + lane]);
                    o += p * vv; } } }
        F.MIX[(size_t)row * DM + h * 64 + lane] = (bf16)f2bf(o / sum);
    }
}

constexpr int TP = 288;
constexpr int ML_A = 0, ML_K = 36864, ML_V = 73728, ML_S = 110592;
typedef short v4i16s __attribute__((ext_vector_type(4)));
__device__ __forceinline__ bf16x8m tr2(const LAS unsigned char* p) {
    const v4i16m a0 = __builtin_amdgcn_ds_read_tr16_b64_v4i16((LAS v4i16m*)p);
    const v4i16m a1 = __builtin_amdgcn_ds_read_tr16_b64_v4i16((LAS v4i16m*)(p + 16 * TP));
    return __builtin_shufflevector(a0, a1, 0, 1, 2, 3, 4, 5, 6, 7);
}
__device__ __forceinline__ bf16x8m rd_sigma(const LAS unsigned char* p) {
    const v4i16m a0 = *(const LAS v4i16m*)p, a1 = *(const LAS v4i16m*)(p + 32);
    return __builtin_shufflevector(a0, a1, 0, 1, 2, 3, 4, 5, 6, 7);
}
__device__ __forceinline__ void build_conv_tile(LAS unsigned char* dst, const bf16* PROJ, int row0, bool first, int col, const float* w_conv, const float* b_conv, float scale, const LAS float* rowscale, int tid) {
    const int cc = tid & 15, rg = tid >> 4;
    v4u x[7];
#pragma unroll
    for (int i = 0; i < 7; ++i) { const int r = 4 * rg + i - 3;
        if (first && r < 0) x[i] = (v4u){0u, 0u, 0u, 0u}; else x[i] = *(const v4u*)(PROJ + (size_t)(row0 + r) * NPROJ + C_RAW + col + 8 * cc); }
    const float* wc = w_conv + col + 8 * cc;
    float out[4][8];
#pragma unroll
    for (int e = 0; e < 8; ++e) { const float bb = b_conv[col + 8 * cc + e];
#pragma unroll
        for (int r = 0; r < 4; ++r) out[r][e] = bb; }
#pragma unroll
    for (int w = 0; w < 4; ++w) {
        const f32x4 w0 = *(const f32x4*)(wc + w * 1024), w1 = *(const f32x4*)(wc + w * 1024 + 4);
#pragma unroll
        for (int r = 0; r < 4; ++r) { const v4u xv = x[r + w];
            out[r][0] += bflo(xv.x) * w0.x; out[r][1] += bfhi(xv.x) * w0.y; out[r][2] += bflo(xv.y) * w0.z; out[r][3] += bfhi(xv.y) * w0.w;
            out[r][4] += bflo(xv.z) * w1.x; out[r][5] += bfhi(xv.z) * w1.y; out[r][6] += bflo(xv.w) * w1.z; out[r][7] += bfhi(xv.w) * w1.w; }
    }
#pragma unroll
    for (int r = 0; r < 4; ++r) { const float rs = scale * (rowscale ? rowscale[4 * rg + r] : 1.f); float o[8];
#pragma unroll
        for (int e = 0; e < 8; ++e) { const float a = out[r][e]; o[e] = a * sigmoidf_(a) * rs; }
        v4u w; w.x = pk2(o[0], o[1]); w.y = pk2(o[2], o[3]); w.z = pk2(o[4], o[5]); w.w = pk2(o[6], o[7]);
        *(LAS v4u*)(dst + (4 * rg + r) * TP + cc * 16) = w; }
}
__device__ __forceinline__ void copy_v_tile(LAS unsigned char* dst, const bf16* PROJ, int row0, int col, int tid) {
#pragma unroll
    for (int k = 0; k < 4; ++k) { const int i = tid + 512 * k, r = i >> 4, cc = i & 15;
        *(LAS v4u*)(dst + r * TP + cc * 16) = *(const v4u*)(PROJ + (size_t)(row0 + r) * NPROJ + col + 8 * cc); }
}
__device__ __forceinline__ void chunk_scan(const float* lf, const float* ig, int row0, int h, int lane, float& b0, float& b1, float& u0, float& u1, float& c0, float& c1) {
    const float a0 = lf[(row0 + 2 * lane) * 4 + h], a1 = lf[(row0 + 2 * lane + 1) * 4 + h];
    const float sp = a0 + a1; float incl = sp;
#pragma unroll
    for (int o = 1; o < 64; o <<= 1) { const float t = __shfl_up(incl, o); if (lane >= o) incl += t; }
    const float excl = incl - sp;
    b0 = excl + a0; b1 = incl;
    u0 = ig[(row0 + 2 * lane) * 4 + h] - b0; u1 = ig[(row0 + 2 * lane + 1) * 4 + h] - b1;
    const float pm = fmaxf(u0, u1); float im = pm;
#pragma unroll
    for (int o = 1; o < 64; o <<= 1) { const float t = __shfl_up(im, o); if (lane >= o) im = fmaxf(im, t); }
    float em = __shfl_up(im, 1); if (lane == 0) em = -INFINITY;
    c0 = fmaxf(em, u0); c1 = im;
}

__device__ __forceinline__ void p3_mlstm_local_mfma(Frame& F) {
    const int tid = F.tid, lane = F.lane, fr = lane & 15, g4 = lane >> 4, w = F.wave;
    LAS unsigned char* sK = F.lds + ML_K; LAS unsigned char* sV = F.lds + ML_V;
    LAS float* sW = (LAS float*)(F.lds + ML_S);
    for (int u = F.vcu; u < 512; u += F.G) {
        const int bh = u >> 5, c = u & 31, b = bh >> 2, h = bh & 3, row0 = b * SEQ + c * 128;
        __syncthreads();
        if (w == 0) { float b0, b1, u0, u1, c0, c1; chunk_scan(F.lf, F.ig, row0, h, lane, b0, b1, u0, u1, c0, c1);
            const float um = __shfl(c1, 63);
            sW[2 * lane] = __expf(u0 - um); sW[2 * lane + 1] = __expf(u1 - um);
            if (lane == 63) { F.chk[u] = b1; F.chk[512 + u] = um; } }
        copy_v_tile(sV, F.PROJ, row0, C_VB + h * 128, tid);
        __syncthreads();
        build_conv_tile(sK, F.PROJ, row0, c == 0, 512 + h * 128, F.w_conv, F.b_conv, 0.08838834764831845f, sW, tid);
        __syncthreads();
        f32x4 acc[8];
#pragma unroll
        for (int i = 0; i < 8; ++i) acc[i] = (f32x4){0.f, 0.f, 0.f, 0.f};
        const int tro = (4 * g4 + (fr >> 2)) * TP + (fr & 3) * 8;
#pragma unroll
        for (int ks = 0; ks < 4; ++ks) {
            const bf16x8m vt = tr2(sV + ks * 32 * TP + tro + 32 * w);
#pragma unroll
            for (int nb = 0; nb < 8; ++nb) { const bf16x8m kt = tr2(sK + ks * 32 * TP + tro + 32 * nb);
                acc[nb] = __builtin_amdgcn_mfma_f32_16x16x32_bf16(vt, kt, acc[nb], 0, 0, 0); }
        }
#pragma unroll
        for (int nb = 0; nb < 8; ++nb) *(f32x4*)(F.L + (size_t)u * 16384 + (16 * nb + fr) * 128 + 16 * w + 4 * g4) = acc[nb];
        if (tid < 128) { float n = 0.f;
#pragma unroll 8
            for (int s2 = 0; s2 < 128; ++s2) n += bf2f(*(const LAS unsigned short*)(sK + s2 * TP + tid * 2));
            F.NLOC[u * 128 + tid] = n; }
    }
}

__device__ __forceinline__ void p5_mlstm_out_mfma(Frame& F) {
    const int tid = F.tid, lane = F.lane, fr = lane & 15, g4 = lane >> 4, w = F.wave;
    LAS unsigned char* sA = F.lds + ML_A; LAS unsigned char* sK = F.lds + ML_K; LAS unsigned char* sV = F.lds + ML_V;
    LAS float* sB = (LAS float*)(F.lds + ML_S); LAS float* sU = sB + 128; LAS float* sG = sU + 128; LAS float* sN = sG + 128;
    const int tro = (4 * g4 + (fr >> 2)) * TP + (fr & 3) * 8;
    for (int u = F.vcu; u < 512; u += F.G) {
        const int bh = u >> 5, c = u & 31, b = bh >> 2, h = bh & 3, row0 = b * SEQ + c * 128;
        const float mc = F.chk[1024 + u];
        __syncthreads();
        if (w == 0) { float b0, b1, u0, u1, c0, c1; chunk_scan(F.lf, F.ig, row0, h, lane, b0, b1, u0, u1, c0, c1);
            sB[2 * lane] = b0; sB[2 * lane + 1] = b1; sU[2 * lane] = u0; sU[2 * lane + 1] = u1; sG[2 * lane] = fmaxf(mc, c0); sG[2 * lane + 1] = fmaxf(mc, c1); }
        if (w == 1) { sN[lane] = F.NPRE[u * 128 + lane]; sN[64 + lane] = F.NPRE[u * 128 + 64 + lane]; }
        build_conv_tile(sA, F.PROJ, row0, c == 0, h * 128, F.w_conv, F.b_conv, 1.f, nullptr, tid);
        build_conv_tile(sK, F.PROJ, row0, c == 0, 512 + h * 128, F.w_conv, F.b_conv, 0.08838834764831845f, nullptr, tid);
        copy_v_tile(sV, F.PROJ, row0, C_VB + h * 128, tid);
        __syncthreads();
        const int t = 16 * w + fr;
        const float gt = sG[t], bt = sB[t], wi = __expf(mc - gt);
        bf16x8m qf[4];
#pragma unroll
        for (int kd = 0; kd < 4; ++kd) qf[kd] = rd_sigma(sA + t * TP + kd * 64 + 8 * g4);
        float qn = 0.f;
#pragma unroll
        for (int i = 0; i < 4; ++i) { const v4u qq = *(const LAS v4u*)(sA + t * TP + 64 * g4 + 16 * i); const LAS float* nn = sN + 32 * g4 + 8 * i;
            qn += bflo(qq.x) * nn[0] + bfhi(qq.x) * nn[1] + bflo(qq.y) * nn[2] + bfhi(qq.y) * nn[3] + bflo(qq.z) * nn[4] + bfhi(qq.z) * nn[5] + bflo(qq.w) * nn[6] + bfhi(qq.w) * nn[7]; }
        qn += __shfl_xor(qn, 16); qn += __shfl_xor(qn, 32);
        bf16x8m pb[4]; float psum = 0.f;
#pragma unroll
        for (int j = 0; j < 4; ++j) {
            pb[j] = (bf16x8m){0, 0, 0, 0, 0, 0, 0, 0};
            if (j <= (w >> 1)) {
                f32x4 sv[2];
#pragma unroll
                for (int sub = 0; sub < 2; ++sub) { sv[sub] = (f32x4){0.f, 0.f, 0.f, 0.f};
                    const LAS unsigned char* kr = sK + (32 * j + 16 * sub + fr) * TP + 8 * g4;
#pragma unroll
                    for (int kd = 0; kd < 4; ++kd) sv[sub] = __builtin_amdgcn_mfma_f32_16x16x32_bf16(rd_sigma(kr + kd * 64), qf[kd], sv[sub], 0, 0, 0);
                    const f32x4 us = *(const LAS f32x4*)(sU + 32 * j + 16 * sub + 4 * g4);
#pragma unroll
                    for (int i = 0; i < 4; ++i) { const int s2 = 32 * j + 16 * sub + 4 * g4 + i; const float pv = (s2 <= t) ? sv[sub][i] * __expf(us[i] - gt) : 0.f; sv[sub][i] = pv; psum += pv; } }
                v4u pw; pw.x = pk2(sv[0][0], sv[0][1]); pw.y = pk2(sv[0][2], sv[0][3]); pw.z = pk2(sv[1][0], sv[1][1]); pw.w = pk2(sv[1][2], sv[1][3]);
                pb[j] = __builtin_bit_cast(bf16x8m, pw);
            }
        }
        psum += __shfl_xor(psum, 16); psum += __shfl_xor(psum, 32);
        const float den = wi * qn + psum, dinv = 1.f / fmaxf(fabsf(den), __expf(-(bt + gt)));
        __syncthreads();
#pragma unroll
        for (int k = 0; k < 8; ++k) { const int i = tid + 512 * k, d = i >> 5, e4 = i & 31;
            const f32x4 cv = *(const f32x4*)(F.CPRE + (size_t)u * 16384 + d * 128 + 4 * e4);
            v2u o; o.x = pk2(cv.x, cv.y); o.y = pk2(cv.z, cv.w); *(LAS v2u*)(sA + d * TP + e4 * 8) = o; }
        __syncthreads();
        f32x4 acc[8];
#pragma unroll
        for (int i = 0; i < 8; ++i) acc[i] = (f32x4){0.f, 0.f, 0.f, 0.f};
#pragma unroll
        for (int kd = 0; kd < 4; ++kd)
#pragma unroll
            for (int eb = 0; eb < 8; ++eb) acc[eb] = __builtin_amdgcn_mfma_f32_16x16x32_bf16(tr2(sA + kd * 32 * TP + tro + 32 * eb), qf[kd], acc[eb], 0, 0, 0);
#pragma unroll
        for (int eb = 0; eb < 8; ++eb) acc[eb] = acc[eb] * wi;
#pragma unroll
        for (int j = 0; j < 4; ++j)
            if (j <= (w >> 1)) {
#pragma unroll
                for (int eb = 0; eb < 8; ++eb) acc[eb] = __builtin_amdgcn_mfma_f32_16x16x32_bf16(tr2(sV + j * 32 * TP + tro + 32 * eb), pb[j], acc[eb], 0, 0, 0); }
        float ssq = 0.f;
#pragma unroll
        for (int eb = 0; eb < 8; ++eb) { acc[eb] = acc[eb] * dinv; ssq += (acc[eb][0] * acc[eb][0] + acc[eb][1] * acc[eb][1]) + (acc[eb][2] * acc[eb][2] + acc[eb][3] * acc[eb][3]); }
        ssq += __shfl_xor(ssq, 16); ssq += __shfl_xor(ssq, 32);
        const float rs = 1.f / sqrtf(ssq * (1.f / 128.f) + EPS);
        const int row = row0 + t;
#pragma unroll
        for (int eb = 0; eb < 8; ++eb) { const int e = 16 * eb + 4 * g4;
            const v2u ob = *(const v2u*)(F.PROJ + (size_t)row * NPROJ + C_OB + h * 128 + e); const f32x4 gg = *(const f32x4*)(F.mhg + h * 128 + e);
            v2u o; o.x = pk2(acc[eb][0] * rs * gg.x * sigmoidf_(bflo(ob.x)), acc[eb][1] * rs * gg.y * sigmoidf_(bfhi(ob.x)));
            o.y = pk2(acc[eb][2] * rs * gg.z * sigmoidf_(bflo(ob.y)), acc[eb][3] * rs * gg.w * sigmoidf_(bfhi(ob.y)));
            *(v2u*)(F.MIX + (size_t)row * DM + 512 + h * 128 + e) = o; }
    }
}

__device__ __forceinline__ void p3_mlstm_sample(Frame& F) {
    const int tid = F.tid;
    LAS float* sQ = (LAS float*)(F.lds + 72 * 1024);
    LAS float* sKs = sQ + 1024;
    LAS float* sV = sKs + 1024;
    LAS float* sQC = sV + 1024;
    LAS float* sH = sQC + 4096;
    LAS float* sN0 = sH + 1024;
    LAS float* sS = sN0 + 128;
    for (int u = F.vcu; u < 512; u += F.G) {
        const int b = u >> 2, h = u & 3, r0 = MP + b * DTS;
        __syncthreads();
        for (int i = tid; i < 2048; i += 512) { const int part = i >> 10, t = (i >> 7) & 7, d = i & 127, col = part * 512 + h * 128 + d;
            float a = F.b_conv[col];
#pragma unroll
            for (int w = 0; w < 4; ++w) { const int tt = t + w - 3;
                const float xv = (tt >= 0) ? bf2f(F.PROJ[(size_t)(r0 + tt) * NPROJ + C_RAW + col]) : F.st_conv[((size_t)b * 3 + (3 + tt)) * 1024 + col];
                a += xv * F.w_conv[w * 1024 + col]; }
            const float sv = a * sigmoidf_(a);
            if (part == 0) sQ[t * 128 + d] = sv; else sKs[t * 128 + d] = sv * 0.08838834764831845f; }
        for (int i = tid; i < 1024; i += 512) sV[i] = bf2f(F.PROJ[(size_t)(r0 + (i >> 7)) * NPROJ + C_VB + h * 128 + (i & 127)]);
        if (tid < 128) sN0[tid] = F.st_n[(size_t)u * 128 + tid];
        if (tid == 0) {
            const float m0 = F.st_m[u]; float acc = 0.f, um = -INFINITY, cm = m0;
            for (int t = 0; t < 8; ++t) { acc += F.lf[(r0 + t) * 4 + h]; const float uu = F.ig[(r0 + t) * 4 + h] - acc; um = fmaxf(um, uu); cm = fmaxf(cm, uu);
                sS[t] = acc; sS[8 + t] = uu; sS[16 + t] = cm; sS[24 + t] = __expf(m0 - cm); }
            const float Mx = fmaxf(m0, um);
            for (int t = 0; t < 8; ++t) sS[32 + t] = __expf(sS[8 + t] - Mx);
            sS[40] = __expf(m0 - Mx);
            F.out[O_SM + u] = acc + Mx;
        }
        __syncthreads();
        if (tid < 64) { const int t = tid >> 3, s = tid & 7; float d = 0.f;
#pragma unroll 4
            for (int k = 0; k < 128; ++k) d += sQ[t * 128 + k] * sKs[s * 128 + k];
            sS[64 + tid] = (s <= t) ? d * __expf(sS[8 + s] - sS[16 + t]) : 0.f; }
        {
            const int e = opaque(tid & 127), dq = opaque(tid >> 7); const float alpha = sS[40];
            float vb[8], aq[8];
#pragma unroll
            for (int s = 0; s < 8; ++s) { vb[s] = sS[32 + s] * sV[s * 128 + e]; aq[s] = 0.f; }
            for (int dd = 0; dd < 32; ++dd) { const int d = dq * 32 + dd;
                const float c0 = F.st_C[((size_t)u * 128 + d) * 128 + e];
                float cn = alpha * c0;
#pragma unroll
                for (int s = 0; s < 8; ++s) { cn += sKs[s * 128 + d] * vb[s]; aq[s] += sQ[s * 128 + d] * c0; }
                F.out[O_SC + ((size_t)u * 128 + d) * 128 + e] = cn; }
#pragma unroll
            for (int s = 0; s < 8; ++s) sQC[(dq * 8 + s) * 128 + e] = aq[s];
        }
        if (tid < 128) { float n = sS[40] * sN0[tid];
#pragma unroll
            for (int s = 0; s < 8; ++s) n += sS[32 + s] * sKs[s * 128 + tid];
            F.out[O_SN + (size_t)u * 128 + tid] = n; }
        __syncthreads();
        if (tid < 8) { const int t = tid; float qn = 0.f;
#pragma unroll 4
            for (int k = 0; k < 128; ++k) qn += sQ[t * 128 + k] * sN0[k];
            float den = sS[24 + t] * qn; for (int s = 0; s < 8; ++s) den += sS[64 + t * 8 + s];
            sS[48 + t] = fmaxf(fabsf(den), __expf(-(sS[t] + sS[16 + t]))); }
        __syncthreads();
        { const int e = tid & 127, tq = tid >> 7;
#pragma unroll
            for (int k = 0; k < 2; ++k) { const int t = tq * 2 + k;
                float qc = sQC[(0 * 8 + t) * 128 + e] + sQC[(1 * 8 + t) * 128 + e] + sQC[(2 * 8 + t) * 128 + e] + sQC[(3 * 8 + t) * 128 + e];
                float num = sS[24 + t] * qc;
#pragma unroll
                for (int s = 0; s < 8; ++s) num += sS[64 + t * 8 + s] * sV[s * 128 + e];
                sH[t * 128 + e] = num / sS[48 + t]; } }
        __syncthreads();
        { const int t = F.wave; const float h0 = sH[t * 128 + F.lane], h1 = sH[t * 128 + 64 + F.lane];
            const float ssq = wave_sum(h0 * h0 + h1 * h1); const float rs = 1.f / sqrtf(ssq * (1.f / 128.f) + EPS);
            const int row = r0 + t;
#pragma unroll
            for (int k = 0; k < 2; ++k) { const int e = F.lane + 64 * k; const float hv = k ? h1 : h0;
                const float ob = bf2f(F.PROJ[(size_t)row * NPROJ + C_OB + h * 128 + e]);
                F.MIX[(size_t)row * DM + 512 + h * 128 + e] = (bf16)f2bf(hv * rs * F.mhg[h * 128 + e] * sigmoidf_(ob)); } }
    }
}

__device__ __forceinline__ void p4_prefix_v1(Frame& F) {
    const int tid = F.tid;
    for (int u = F.vcu; u < 256; u += F.G) {
        const int chain = u >> 4, sl = u & 15, idx = sl * 1024 + tid * 2;
        float m = 0.f, c0 = 0.f, c1 = 0.f, nn = 0.f;
        for (int c = 0; c < 32; ++c) { const int unit = chain * 32 + c;
            F.CPRE[(size_t)unit * 16384 + idx] = c0; F.CPRE[(size_t)unit * 16384 + idx + 1] = c1;
            if (sl == 0 && tid < 128) F.NPRE[unit * 128 + tid] = nn;
            if (sl == 0 && tid == 0) F.chk[1024 + unit] = m;
            const float Bc = F.chk[unit], um = F.chk[512 + unit], Mx = fmaxf(m, um), a = __expf(m - Mx), bb = __expf(um - Mx);
            c0 = a * c0 + bb * F.L[(size_t)unit * 16384 + idx]; c1 = a * c1 + bb * F.L[(size_t)unit * 16384 + idx + 1];
            if (sl == 0 && tid < 128) nn = a * nn + bb * F.NLOC[unit * 128 + tid];
            m = Bc + Mx; }
        F.out[O_PC + (size_t)chain * 16384 + idx] = c0; F.out[O_PC + (size_t)chain * 16384 + idx + 1] = c1;
        if (sl == 0 && tid < 128) F.out[O_PN + chain * 128 + tid] = nn;
        if (sl == 0 && tid == 0) F.out[O_PM + chain] = m;
    }
}

__device__ __forceinline__ void p9_final_norm(Frame& F) {
    const int gw = F.vcu * 8 + F.wave, NGW = F.G * 8;
    for (int m = gw; m < M; m += NGW) {
        const float rs = 1.f / sqrtf(F.ssf[m] * (1.f / DM) + EPS);
        f32x4* p = (f32x4*)(F.out + (size_t)m * DM);
#pragma unroll
        for (int j = 0; j < 4; ++j) { const f32x4 g = *(const f32x4*)(F.gf + 256 * j + 4 * F.lane); f32x4 v = p[64 * j + F.lane]; v = v * rs * g; p[64 * j + F.lane] = v; }
    }
}

struct Args { const float* in[19]; float* out; unsigned char* ws; int ph_lo, ph_hi; };
__global__ void __launch_bounds__(512, 2) fwd(Args args) {
    extern __shared__ __attribute__((aligned(16))) unsigned char lds[];
    Frame F;
    F.lds = (LAS unsigned char*)lds;
    F.tid = threadIdx.x; F.lane = F.tid & 63; F.wave = __builtin_amdgcn_readfirstlane(F.tid >> 6);
    F.G = gridDim.x; { const int bx = blockIdx.x; F.vcu = (F.G % 8 == 0) ? (bx % 8) * (F.G / 8) + bx / 8 : bx; }
    F.xp = args.in[0]; F.xs = args.in[1]; F.cache_k = args.in[2]; F.cache_v = args.in[3]; F.st_conv = args.in[4]; F.st_C = args.in[5]; F.st_n = args.in[6]; F.st_m = args.in[7];
    F.g1 = args.in[8]; F.w_in = args.in[9]; F.b_gate = args.in[10]; F.w_conv = args.in[11]; F.b_conv = args.in[12]; F.mhg = args.in[13]; F.w_out = args.in[14]; F.g2 = args.in[15];
    F.w_up = args.in[16]; F.w_down = args.in[17]; F.gf = args.in[18];
    F.out = args.out; F.ws = args.ws;
    unsigned char* ws = args.ws;
    F.Win_t = (bf16*)(ws + WS_WIN); F.Wout_t = (bf16*)(ws + WS_WOUT); F.Wup_t = (bf16*)(ws + WS_WUP); F.Wdn_t = (bf16*)(ws + WS_WDN);
    F.XB = (bf16*)(ws + WS_XB); F.PROJ = (bf16*)(ws + WS_PROJ); F.MIX = (bf16*)(ws + WS_MIX); F.HPB = (bf16*)(ws + WS_HPB); F.ACT = (bf16*)(ws + WS_ACT);
    F.rope = (float*)(ws + WS_ROPE); F.rstd1 = (float*)(ws + WS_RSTD1); F.ig = (float*)(ws + WS_IG); F.lf = (float*)(ws + WS_LF); F.chk = (float*)(ws + WS_CHK);
    F.ss2 = (float*)(ws + WS_SS2); F.ssf = (float*)(ws + WS_SSF); F.QF = (float*)(ws + WS_QF); F.KF = (float*)(ws + WS_KF); F.L = (float*)(ws + WS_L);
    F.CPRE = (float*)(ws + WS_CPRE); F.NLOC = (float*)(ws + WS_NLOC); F.NPRE = (float*)(ws + WS_NPRE);
    volatile LAS unsigned* MISC = (volatile LAS unsigned*)(F.lds + MISC_OFF);
    if (F.tid < 32) MISC[F.tid] = 0u;
    __syncthreads();
    XcdBarrier bar; bar.bar = (unsigned*)(ws + WS_CTL) + CW_BAR; bar.x = 0; bar.st = nullptr;
    if (!PER_PHASE_LAUNCH) bar = xcd_barrier_post((unsigned*)(ws + WS_CTL) + CW_BAR, MISC + 8);
#define GRID_BAR() do { if (!PER_PHASE_LAUNCH) xcd_barrier(bar); } while (0)
    const int lo = args.ph_lo, hi = args.ph_hi;
#ifndef PHASE_MASK
#define PHASE_MASK 0x3ff
#endif
#define IN(k) (((PHASE_MASK >> (k)) & 1) && lo <= (k) && (k) < hi)
    if (IN(0)) { p0_prologue(F); GRID_BAR(); }
    if (IN(1)) {
        pg8::Gemm g{F.XB, F.Win_t, M, NPROJ, DM}; pg8::StaticOrder S; S.init(M, NPROJ, F.G, (int)blockIdx.x);
        pg8::EpiIn E{F.PROJ, F.rstd1, F.rope, F.out};
        pg8::gemm_phase<pg8::EpiIn, pg8::StaticOrder, true, true>(F.lds, g, S, E);
        GRID_BAR();
    }
    if (IN(2)) { p2_attn_prompt_mfma(F); __syncthreads(); p2_sample_stream(F); GRID_BAR(); }
    if (IN(3)) { p3_mlstm_local_mfma(F); p3_mlstm_sample(F); GRID_BAR(); }
    if (IN(4)) { p4_prefix_v1(F); GRID_BAR(); }
    if (IN(5)) { p5_mlstm_out_mfma(F); GRID_BAR(); }
    if (IN(6)) {
        pg8::Gemm g{F.MIX, F.Wout_t, M, DM, DM}; pg8::StaticOrder S; S.init(M, DM, F.G, (int)blockIdx.x);
        pg8::EpiOut E{F.xp, F.xs, F.out, F.HPB, F.ss2};
        pg8::gemm_phase<pg8::EpiOut, pg8::StaticOrder, true, true>(F.lds, g, S, E);
        GRID_BAR();
    }
    if (IN(7)) {
        pg8::Gemm g{F.HPB, F.Wup_t, M, FF, DM}; pg8::StaticOrder S; S.init(M, FF, F.G, (int)blockIdx.x);
        pg8::EpiUp E{F.ACT, F.ss2};
        pg8::gemm_phase<pg8::EpiUp, pg8::StaticOrder, true, true>(F.lds, g, S, E);
        GRID_BAR();
    }
    if (IN(8)) {
        pg8::Gemm g{F.ACT, F.Wdn_t, M, DM, FF}; pg8::StaticOrder S; S.init(M, DM, F.G, (int)blockIdx.x);
        pg8::EpiDown E{F.out, F.ssf};
        pg8::gemm_phase<pg8::EpiDown, pg8::StaticOrder, true, true>(F.lds, g, S, E);
        GRID_BAR();
    }
    if (IN(9)) { p9_final_norm(F); }
#undef IN
}

extern "C" void kernel_launch(void* const* d_in, const int* in_sizes, int n_in, void* d_out, int out_size, void* d_ws, size_t ws_size, hipStream_t stream) {
    static int grid = 0;
    if (grid == 0) {
        if (n_in != 19 || (size_t)out_size != O_END || ws_size < WS_END) { fprintf(stderr, "kernel_launch: unexpected shapes (n_in %d out %d ws %zu)\n", n_in, out_size, ws_size); grid = -1; return; }
        int dev = 0, cus = 0, per_cu = 0;
        if (hipGetDevice(&dev) != hipSuccess || hipDeviceGetAttribute(&cus, hipDeviceAttributeMultiprocessorCount, dev) != hipSuccess) { grid = -1; return; }
        if (hipFuncSetAttribute((const void*)fwd, hipFuncAttributeMaxDynamicSharedMemorySize, LDS_BYTES) != hipSuccess) { fprintf(stderr, "kernel_launch: hipFuncSetAttribute failed\n"); grid = -1; return; }
        if (hipOccupancyMaxActiveBlocksPerMultiprocessor(&per_cu, (const void*)fwd, 512, LDS_BYTES) != hipSuccess || per_cu < 1) fprintf(stderr, "kernel_launch: occupancy query says %d\n", per_cu);
        (void)hipGetLastError();
        grid = cus;
    }
    if (grid < 0) return;
    if (hipMemsetAsync((char*)d_ws + WS_CTL, 0, CTL_ZERO_BYTES, stream) != hipSuccess) return;
    Args a{};
    for (int i = 0; i < 19; ++i) a.in[i] = (const float*)d_in[i];
    a.out = (float*)d_out; a.ws = (unsigned char*)d_ws;
#if PER_PHASE_LAUNCH
    for (int ph = 0; ph < NPH; ++ph) { a.ph_lo = ph; a.ph_hi = ph + 1; hipLaunchKernelGGL(fwd, dim3(grid), dim3(512), LDS_BYTES, stream, a); }
#else
    a.ph_lo = 0; a.ph_hi = NPH; hipLaunchKernelGGL(fwd, dim3(grid), dim3(512), LDS_BYTES, stream, a);
#endif
}
```

```cpp
#include <hip/hip_runtime.h>
#include <cstdio>
#include <cstdint>
namespace pg8 {
#define PG8_LAS __attribute__((address_space(3)))
typedef unsigned short bf16_t;
typedef short bf16x8 __attribute__((ext_vector_type(8)));
typedef float f32x4 __attribute__((ext_vector_type(4)));
typedef unsigned u32x4 __attribute__((ext_vector_type(4)));
constexpr int BM = 256, BK = 64, HALF = 128, HTB = HALF * BK * 2  , STAGE_BYTES = 8 * HTB, NXCD = 8, WGM = 8;

__host__ __device__ __forceinline__ int lds_byte(int r, int c) { const int st = (r >> 4) * 2 + (c >> 5), rr = r & 15, cc = c & 31, ob = rr * 64 + cc * 2; return st * 1024 + (ob ^ (((ob >> 9) & 1) << 5)); }
__host__ __device__ __forceinline__ void stage_rc(int b, int& R, int& C) { const int st = b / 1024, sb = b % 1024, swz = sb ^ (((sb >> 9) & 1) << 5); R = (st >> 1) * 16 + swz / 64; C = (st & 1) * 32 + (swz % 64) / 2; }
__host__ __device__ __forceinline__ int perm32(int rho) { const int n = rho >> 4, i = rho & 15; return 8 * (i >> 2) + 4 * n + (i & 3); }

struct Unit { int pm, pn, k0; };
struct Gemm { const bf16_t* A; const bf16_t* Bt; int M, N, K, ld; };

struct StaticOrder {
    int nM, nN, nwg, G, c;
    __host__ __device__ void init(int M, int N, int G_, int c_) { nM = M / BM; nN = N / BM; nwg = nM * nN; G = G_; c = c_; }
    __host__ __device__ bool next(int i, Unit& u) const {
        const long L = (long)i * G + c; if (L >= nwg) return false;
        int wgid = (int)L; { const int q = nwg / NXCD, r = nwg % NXCD, xcd = wgid % NXCD, off = wgid / NXCD; wgid = (xcd < r ? xcd * (q + 1) : r * (q + 1) + (xcd - r) * q) + off; }
        const int nig = WGM * nN, gid = wgid / nig, fm = gid * WGM, gsz = (nM - fm) < WGM ? (nM - fm) : WGM;
        u.pm = fm + ((wgid % nig) % gsz); u.pn = (wgid % nig) / gsz; u.k0 = 0; return true;
    }
    __device__ __forceinline__ void a_ready(const Unit&) const {}
    __device__ __forceinline__ void done(const Unit&) const {}
};

__device__ __forceinline__ unsigned cvt_pk_bf16(float lo, float hi) { unsigned r; asm volatile("v_cvt_pk_bf16_f32 %0, %1, %2" : "=v"(r) : "v"(lo), "v"(hi)); return r; }
typedef float f32x2 __attribute__((ext_vector_type(2)));

template <class Epi, class Sched, bool ALIGN_EPI = false, bool SP2 = false>
__device__ __forceinline__ void gemm_phase(PG8_LAS unsigned char* lds, const Gemm g, const Sched& S, const Epi& E) {
    const int tid = threadIdx.x, wid = __builtin_amdgcn_readfirstlane(tid >> 6), lane = tid & 63, wr = wid >> 2, wc = wid & 3, fr = lane & 15, fq = lane >> 4;
    const int K = g.K, nt = K / BK, LD = g.ld;
    unsigned voffA[2], voffB[2];
#pragma unroll
    for (int i = 0; i < 2; ++i) { int R, C; stage_rc(tid * 16 + i * 8192, R, C); const int Rb = Epi::PERM ? ((R & ~31) + perm32(R & 31)) : R;
        voffA[i] = (unsigned)(R * LD + C) * 2u; voffB[i] = (unsigned)(Rb * LD + C) * 2u; }
    const size_t kstep = (size_t)(BK * 2);
    const size_t hstep = (size_t)HALF * LD * 2;
    const size_t tstep = 2 * hstep;
    const unsigned ldsw = (unsigned)wid * 1024u;
    const int aoff = lds_byte(wr * 64 + fr, fq * 8), boff = lds_byte(wc * 32 + fr, fq * 8);
#define PG8_SA(b, h) (((b) * 2 + (h)) * HTB)
#define PG8_SB(b, h) ((4 + (b) * 2 + (h)) * HTB)
#define PG8_STAGE(bufoff, gbase, voff) do { _Pragma("unroll") for (int _i = 0; _i < 2; ++_i) \
        __builtin_amdgcn_global_load_lds((const unsigned*)((const char*)(gbase) + (voff)[_i]), (PG8_LAS unsigned*)(lds + (bufoff) + ldsw + _i * 8192), 16, 0, 0); } while (0)
#define PG8_LDA(dst, b, h) do { _Pragma("unroll") for (int m = 0; m < 4; ++m) _Pragma("unroll") for (int k = 0; k < 2; ++k) dst[m][k] = *(const PG8_LAS bf16x8*)(lds + PG8_SA(b, h) + aoff + m * 2048 + k * 1024); } while (0)
#define PG8_LDB(dst, b, h) do { _Pragma("unroll") for (int n = 0; n < 2; ++n) _Pragma("unroll") for (int k = 0; k < 2; ++k) dst[n][k] = *(const PG8_LAS bf16x8*)(lds + PG8_SB(b, h) + boff + n * 2048 + k * 1024); } while (0)
#define PG8_MMA(ai, bj, At, Bt) do { __builtin_amdgcn_s_setprio(1); _Pragma("unroll") for (int m = 0; m < 4; ++m) _Pragma("unroll") for (int n = 0; n < 2; ++n) _Pragma("unroll") for (int k = 0; k < 2; ++k) \
        acc[ai][bj][m][n] = __builtin_amdgcn_mfma_f32_16x16x32_bf16(Bt[n][k], At[m][k], acc[ai][bj][m][n], 0, 0, 0); __builtin_amdgcn_s_setprio(0); } while (0)
#define PG8_WAIT_V(n) asm volatile("s_waitcnt vmcnt(" #n ")" ::: "memory")
#define PG8_WAIT_L(n) asm volatile("s_waitcnt lgkmcnt(" #n ")" ::: "memory")
#define PG8_BAR __builtin_amdgcn_s_barrier()
#define PG8_SCHED __builtin_amdgcn_sched_barrier(0)
    Unit cur, nxt; int ui = 0;
    if (!S.next(0, cur)) return;
    f32x4 acc[2][2][4][2];
#pragma unroll
    for (int a = 0; a < 2; ++a)
#pragma unroll
        for (int b = 0; b < 2; ++b)
#pragma unroll
            for (int m = 0; m < 4; ++m)
#pragma unroll
                for (int n = 0; n < 2; ++n) acc[a][b][m][n] = (f32x4){0.f, 0.f, 0.f, 0.f};
    bf16x8 At[4][2], B0[2][2], B1[2][2];
    const char* cA = (const char*)g.A + (size_t)cur.pm * tstep + (size_t)cur.k0 * 2; const char* cB = (const char*)g.Bt + (size_t)cur.pn * tstep + (size_t)cur.k0 * 2;
    S.a_ready(cur);
    if constexpr (SP2) {
        PG8_STAGE(PG8_SB(0, 0), cB, voffB); PG8_STAGE(PG8_SB(0, 1), cB + hstep, voffB); PG8_STAGE(PG8_SA(0, 0), cA, voffA); PG8_STAGE(PG8_SA(0, 1), cA + hstep, voffA);
        if (wr == 1) PG8_BAR;
        PG8_WAIT_V(2); PG8_BAR;
        PG8_STAGE(PG8_SB(1, 0), cB + kstep, voffB); PG8_STAGE(PG8_SA(1, 0), cA + kstep, voffA); PG8_STAGE(PG8_SB(1, 1), cB + hstep + kstep, voffB);
        PG8_WAIT_V(6); PG8_BAR;
    } else {
        PG8_STAGE(PG8_SB(0, 0), cB, voffB); PG8_STAGE(PG8_SA(0, 0), cA, voffA); PG8_STAGE(PG8_SB(0, 1), cB + hstep, voffB); PG8_STAGE(PG8_SA(0, 1), cA + hstep, voffA);
        if (wr == 1) PG8_BAR;
        PG8_WAIT_V(4); PG8_BAR;
        PG8_STAGE(PG8_SB(1, 0), cB + kstep, voffB); PG8_STAGE(PG8_SA(1, 0), cA + kstep, voffA); PG8_STAGE(PG8_SB(1, 1), cB + hstep + kstep, voffB);
        PG8_WAIT_V(6); PG8_BAR;
    }
    for (;;) {
        const bool has_next = S.next(ui + 1, nxt);
        const char* nA = has_next ? (const char*)g.A + (size_t)nxt.pm * tstep + (size_t)nxt.k0 * 2 : cA; const char* nB = has_next ? (const char*)g.Bt + (size_t)nxt.pn * tstep + (size_t)nxt.k0 * 2 : cB;
        for (int t = 0; t < nt; t += 2) {
            const bool last = (t == nt - 2);
            const char* a1 = cA + (size_t)(t + 1) * kstep;
            const char* a2 = last ? nA : cA + (size_t)(t + 2) * kstep; const char* b2 = last ? nB : cB + (size_t)(t + 2) * kstep;
            const char* a3 = a2 + kstep; const char* b3 = b2 + kstep;
            if (last && has_next) S.a_ready(nxt);
            if constexpr (SP2) {
            PG8_LDB(B0, 0, 0); PG8_LDB(B1, 0, 1); PG8_SCHED; PG8_LDA(At, 0, 0); PG8_STAGE(PG8_SA(1, 1), a1 + hstep, voffA);
            PG8_WAIT_V(8); PG8_WAIT_L(0); PG8_BAR; PG8_MMA(0, 0, At, B0); PG8_MMA(0, 1, At, B1); PG8_BAR; PG8_SCHED;
            PG8_LDA(At, 0, 1); PG8_STAGE(PG8_SB(0, 0), b2, voffB); PG8_STAGE(PG8_SB(0, 1), b2 + hstep, voffB); PG8_STAGE(PG8_SA(0, 0), a2, voffA);
            PG8_WAIT_V(8); PG8_WAIT_L(0); PG8_BAR; PG8_MMA(1, 0, At, B0); PG8_MMA(1, 1, At, B1); PG8_BAR; PG8_SCHED;
            PG8_LDB(B0, 1, 0); PG8_LDB(B1, 1, 1); PG8_SCHED; PG8_LDA(At, 1, 0); PG8_STAGE(PG8_SA(0, 1), a2 + hstep, voffA);
            PG8_WAIT_V(8); PG8_WAIT_L(0); PG8_BAR; PG8_MMA(0, 0, At, B0); PG8_MMA(0, 1, At, B1); PG8_BAR; PG8_SCHED;
            PG8_LDA(At, 1, 1); PG8_STAGE(PG8_SB(1, 0), b3, voffB); PG8_STAGE(PG8_SB(1, 1), b3 + hstep, voffB); PG8_STAGE(PG8_SA(1, 0), a3, voffA);
            PG8_WAIT_V(8); PG8_WAIT_L(0); PG8_BAR; PG8_MMA(1, 0, At, B0); PG8_MMA(1, 1, At, B1); PG8_BAR; PG8_SCHED;
            } else {
            PG8_LDB(B0, 0, 0); PG8_SCHED; PG8_LDA(At, 0, 0); PG8_STAGE(PG8_SA(1, 1), a1 + hstep, voffA);
            PG8_WAIT_L(8); PG8_BAR; PG8_WAIT_L(0); PG8_MMA(0, 0, At, B0); PG8_BAR; PG8_SCHED;
            PG8_LDB(B1, 0, 1); PG8_STAGE(PG8_SB(0, 0), b2, voffB);
            PG8_BAR; PG8_WAIT_L(0); PG8_MMA(0, 1, At, B1); PG8_BAR;
            PG8_LDA(At, 0, 1); PG8_STAGE(PG8_SA(0, 0), a2, voffA);
            PG8_BAR; PG8_WAIT_L(0); PG8_MMA(1, 0, At, B0); PG8_BAR; PG8_SCHED;
            PG8_STAGE(PG8_SB(0, 1), b2 + hstep, voffB);
            PG8_WAIT_V(6); PG8_BAR; PG8_MMA(1, 1, At, B1); PG8_BAR;
            PG8_LDB(B0, 1, 0); PG8_SCHED; PG8_LDA(At, 1, 0); PG8_STAGE(PG8_SA(0, 1), a2 + hstep, voffA);
            PG8_WAIT_L(8); PG8_BAR; PG8_WAIT_L(0); PG8_MMA(0, 0, At, B0); PG8_BAR; PG8_SCHED;
            PG8_LDB(B1, 1, 1); PG8_STAGE(PG8_SB(1, 0), b3, voffB);
            PG8_BAR; PG8_WAIT_L(0); PG8_MMA(0, 1, At, B1); PG8_BAR;
            PG8_LDA(At, 1, 1); PG8_STAGE(PG8_SA(1, 0), a3, voffA);
            PG8_BAR; PG8_WAIT_L(0); PG8_MMA(1, 0, At, B0); PG8_BAR; PG8_SCHED;
            PG8_STAGE(PG8_SB(1, 1), b3 + hstep, voffB);
            PG8_WAIT_V(6); PG8_BAR; PG8_MMA(1, 1, At, B1); PG8_BAR;
            }
        }
        if constexpr (ALIGN_EPI) { if (wr == 0) PG8_BAR; }
        if constexpr (!Epi::AFTER_DRAIN) { E(acc, cur, wr, wc, fr, fq); S.done(cur); }
        if (!has_next) break;
#pragma unroll
        for (int a = 0; a < 2; ++a)
#pragma unroll
            for (int b = 0; b < 2; ++b)
#pragma unroll
                for (int m = 0; m < 4; ++m)
#pragma unroll
                    for (int n = 0; n < 2; ++n) acc[a][b][m][n] = (f32x4){0.f, 0.f, 0.f, 0.f};
        cur = nxt; cA = nA; cB = nB; ++ui;
        if constexpr (ALIGN_EPI) { if (wr == 1) PG8_BAR; }
    }
    PG8_WAIT_V(0);
    if constexpr (!ALIGN_EPI) { if (wr == 0) PG8_BAR; }
    PG8_BAR;
    if constexpr (Epi::AFTER_DRAIN) { E.fused(acc, cur, wr, wc, fr, fq, lds, wid, lane); S.done(cur); }
#undef PG8_SA
#undef PG8_SB
#undef PG8_STAGE
#undef PG8_LDA
#undef PG8_LDB
#undef PG8_MMA
#undef PG8_WAIT_V
#undef PG8_WAIT_L
#undef PG8_BAR
#undef PG8_SCHED
}
}

#ifndef PER_PHASE_LAUNCH
#define PER_PHASE_LAUNCH 0
#endif

constexpr int DM = 1024, NBP = 4, SEQ = 4096, DBS = 128, DTS = 8;
constexpr int MP = NBP * SEQ, MS = DBS * DTS, M = MP + MS;
constexpr int NPROJ = 3584, INCOLS = 3592, FF = 4096, WBUF = 2048;
constexpr int C_Q = 0, C_K = 512, C_V = 1024, C_RAW = 1536, C_VB = 2560, C_OB = 3072;
constexpr float EPS = 1e-6f;
constexpr int NPH = 10;
constexpr size_t O_YP = 0, O_YS = O_YP + (size_t)MP * DM, O_PK = O_YS + (size_t)MS * DM, O_PV = O_PK + (size_t)NBP * WBUF * 512,
    O_PCONV = O_PV + (size_t)NBP * WBUF * 512, O_PC = O_PCONV + (size_t)NBP * 3 * 1024, O_PN = O_PC + (size_t)NBP * 4 * 128 * 128, O_PM = O_PN + (size_t)NBP * 4 * 128,
    O_SK = O_PM + (size_t)NBP * 4, O_SV = O_SK + (size_t)DBS * WBUF * 512, O_SCONV = O_SV + (size_t)DBS * WBUF * 512, O_SC = O_SCONV + (size_t)DBS * 3 * 1024,
    O_SN = O_SC + (size_t)DBS * 4 * 128 * 128, O_SM = O_SN + (size_t)DBS * 4 * 128, O_END = O_SM + (size_t)DBS * 4;
static_assert(O_END == 303774224ull, "output size");
constexpr size_t MiB = 1u << 20;
constexpr size_t WS_CTL = 0, CTL_ZERO_BYTES = 1 * MiB;
constexpr int CW_BAR = 4096;
constexpr size_t WS_PCNT = 128 * 1024, WS_SS2 = 256 * 1024, WS_SSF = 512 * 1024;
constexpr size_t WS_WIN = 2 * MiB, WS_WOUT = 10 * MiB, WS_WUP = 12 * MiB, WS_WDN = 20 * MiB;
constexpr size_t WS_ROPE = 28 * MiB, WS_RSTD1 = 29 * MiB, WS_IG = 29 * MiB + 512 * 1024, WS_LF = 30 * MiB, WS_CHK = 31 * MiB;
constexpr size_t WS_XB = 32 * MiB, WS_PROJ = 68 * MiB, WS_MIX = 188 * MiB, WS_HPB = 222 * MiB, WS_ACT = 256 * MiB;
constexpr size_t WS_QF = 392 * MiB, WS_KF = 426 * MiB, WS_L = 460 * MiB, WS_CPRE = 492 * MiB, WS_NLOC = 524 * MiB, WS_NPRE = 525 * MiB, WS_DUMMY = 526 * MiB, WS_SCR = 544 * MiB, WS_END = 616 * MiB;
static_assert(WS_PROJ + (size_t)M * NPROJ * 2 <= WS_MIX && WS_ACT + (size_t)M * FF * 2 <= WS_QF && WS_XB + (size_t)M * DM * 2 <= WS_PROJ, "ws map");

constexpr int LDS_BYTES = 147456;
constexpr int MISC_OFF = 131072 + 8192;

#define GAS __attribute__((address_space(1)))
#define LAS __attribute__((address_space(3)))
typedef unsigned short bf16;
typedef unsigned v4u __attribute__((ext_vector_type(4)));
typedef unsigned v2u __attribute__((ext_vector_type(2)));
typedef float f32x4 __attribute__((ext_vector_type(4)));
typedef GAS unsigned gu32;
#define LDS_WAIT() asm volatile("s_waitcnt lgkmcnt(0)" ::: "memory")
__device__ __forceinline__ unsigned f2bf(float f) { unsigned u = __builtin_bit_cast(unsigned, f); return (u + 0x7fffu + ((u >> 16) & 1u)) >> 16; }
typedef float f32x2_t __attribute__((ext_vector_type(2))); typedef __bf16 bf16x2_t __attribute__((ext_vector_type(2)));
__device__ __forceinline__ unsigned pk2(float lo, float hi) { f32x2_t v = {lo, hi}; bf16x2_t b = __builtin_convertvector(v, bf16x2_t); return __builtin_bit_cast(unsigned, b); }
__device__ __forceinline__ float bf2f(unsigned short u) { return __builtin_bit_cast(float, (unsigned)u << 16); }
__device__ __forceinline__ float bflo(unsigned u) { return __builtin_bit_cast(float, u << 16); }
__device__ __forceinline__ float bfhi(unsigned u) { return __builtin_bit_cast(float, u & 0xffff0000u); }
__device__ __forceinline__ float wave_sum(float v) {
#pragma unroll
    for (int o = 1; o < 64; o <<= 1) v += __shfl_xor(v, o);
    return v;
}
__device__ __forceinline__ float wave_max(float v) {
#pragma unroll
    for (int o = 1; o < 64; o <<= 1) v = fmaxf(v, __shfl_xor(v, o));
    return v;
}
__device__ __forceinline__ int opaque(int v) { asm volatile("" : "+v"(v)); return v; }
__device__ __forceinline__ float sigmoidf_(float x) { return 1.f / (1.f + __expf(-x)); }

#define XB_TMO      128
#define XB_XCNT(j)  (256  + 64 * (j))
#define XB_XSUB(j)  (1280 + 64 * (j))
#define XB_XGEN(j)  (2304 + 64 * (j))
#define XB_TOP      3328
#define XB_TOPGEN   3392
#define XCD_BAR_WORDS 3456
#define XB_SPIN_CAP (1u << 18)
__device__ __forceinline__ unsigned xb_ld(unsigned* p)              { return __hip_atomic_load(p, __ATOMIC_RELAXED, __HIP_MEMORY_SCOPE_AGENT); }
__device__ __forceinline__ unsigned xb_add(unsigned* p, unsigned v) { return __hip_atomic_fetch_add(p, v, __ATOMIC_RELAXED, __HIP_MEMORY_SCOPE_AGENT); }
__device__ __forceinline__ unsigned xb_xcc_id() { return (unsigned)__builtin_amdgcn_s_getreg((3 << 11) | 20) & 0xFu; }
#define XB_SPIN(cond, bar) do { unsigned _sp = 0; while (cond) { __builtin_amdgcn_s_sleep(1); \
    if ((++_sp & 255u) == 0u) { if (xb_ld(&(bar)[XB_TMO])) break; if (_sp > XB_SPIN_CAP) { atomicAdd(&(bar)[XB_TMO], 1u); break; } } } } while (0)
struct XcdBarrier { unsigned* bar; unsigned x; volatile LAS unsigned* st; };
__device__ __forceinline__ XcdBarrier xcd_barrier_post(unsigned* bar, volatile LAS unsigned* st) {
    XcdBarrier b; b.bar = bar; b.x = xb_xcc_id(); b.st = st;
    if (threadIdx.x == 0) (void)xb_add(&bar[XB_XCNT(b.x)], 1u);
    return b;
}
__device__ __forceinline__ void xcd_barrier_complete(unsigned* bar, unsigned x, unsigned& nloc, unsigned& nx) {
    const unsigned G = gridDim.x * gridDim.y * gridDim.z;
    unsigned sum, cnt, mine, sp = 0u;
    for (;;) {
        sum = 0u; cnt = 0u; mine = 0u;
#pragma unroll
        for (unsigned j = 0; j < 16; ++j) { const unsigned c = xb_ld(&bar[XB_XCNT(j)]); sum += c; cnt += (c > 0u) ? 1u : 0u; mine = (j == x) ? c : mine; }
        if (sum == G) break;
        __builtin_amdgcn_s_sleep(1);
        if ((++sp & 255u) == 0u) { if (xb_ld(&bar[XB_TMO])) break; if (sp > XB_SPIN_CAP) { atomicAdd(&bar[XB_TMO], 1u); break; } }
    }
    nloc = mine > 0u ? mine : 1u; nx = cnt > 0u ? cnt : 1u;
}
__device__ __forceinline__ void xcd_barrier(const XcdBarrier& b) {
    asm volatile("s_waitcnt vmcnt(0)" ::: "memory");
    __syncthreads();
    if (threadIdx.x == 0) {
        unsigned* bar = b.bar;
        __builtin_amdgcn_s_waitcnt(0);
        unsigned nloc = b.st[0], nx = b.st[1];
        if (nloc == 0u) { xcd_barrier_complete(bar, b.x, nloc, nx); b.st[0] = nloc; b.st[1] = nx; }
        const unsigned old = xb_add(&bar[XB_XSUB(b.x)], 1u);
        const unsigned gen = old / nloc;
        if (old + 1u == (gen + 1u) * nloc) {
            __builtin_amdgcn_fence(__ATOMIC_RELEASE, "agent");
            asm volatile("s_waitcnt vmcnt(0)" ::: "memory");
            const unsigned og = xb_add(&bar[XB_TOP], 1u);
            const unsigned tg = og / nx;
            if (og + 1u == (tg + 1u) * nx) xb_add(&bar[XB_TOPGEN], 1u);
            else XB_SPIN(xb_ld(&bar[XB_TOPGEN]) == tg, bar);
            __builtin_amdgcn_fence(__ATOMIC_ACQUIRE, "agent");
            xb_add(&bar[XB_XGEN(b.x)], 1u);
            asm volatile("s_waitcnt vmcnt(0)" ::: "memory");
        } else {
            XB_SPIN(xb_ld(&bar[XB_XGEN(b.x)]) == gen, bar);
            __builtin_amdgcn_fence(__ATOMIC_ACQUIRE, "agent");
            asm volatile("s_waitcnt vmcnt(0)" ::: "memory");
        }
    }
    __syncthreads();
}

struct Frame {
    LAS unsigned char* lds;
    int tid, lane, wave, vcu, G;
    const float *xp, *xs, *cache_k, *cache_v, *st_conv, *st_C, *st_n, *st_m, *g1, *w_in, *b_gate, *w_conv, *b_conv, *mhg, *w_out, *g2, *w_up, *w_down, *gf;
    float* out; unsigned char* ws;
    bf16 *Win_t, *Wout_t, *Wup_t, *Wdn_t, *XB, *PROJ, *MIX, *HPB, *ACT;
    float *rope, *rstd1, *ig, *lf, *chk, *ss2, *ssf, *QF, *KF, *L, *CPRE, *NLOC, *NPRE;
};

namespace pg8 {
struct EpiIn {
    static constexpr bool PERM = true, AFTER_DRAIN = false;
    bf16_t* proj; const float* rstd; const float* rope; float* out;
    __device__ __forceinline__ void operator()(const f32x4 (&acc)[2][2][4][2], const Unit& u, int wr, int wc, int fr, int fq) const {
        const int pn = u.pn;
        const bool rot = (pn < 4) && ((wc & 1) == 0);
#pragma unroll
        for (int ai = 0; ai < 2; ++ai)
#pragma unroll
            for (int m = 0; m < 4; ++m) {
                const int row = u.pm * BM + ai * HALF + wr * 64 + m * 16 + fr;
                const float rs = rstd[row];
                const bool smp = row >= MP;
                const int b = smp ? ((row - MP) >> 3) : (row >> 12), t = smp ? ((row - MP) & 7) : (row & 4095);
                const int pidx = smp ? (SEQ + t) : t;
#pragma unroll
                for (int bj = 0; bj < 2; ++bj) {
                    const int col0 = pn * BM + bj * HALF + wc * 32 + 8 * fq;
                    f32x4 v0 = acc[ai][bj][m][0] * rs, v1 = acc[ai][bj][m][1] * rs;
                    if (rot) {
                        f32x4 p0, p1;
                        p0.x = __shfl_xor(v0.x, 16); p0.y = __shfl_xor(v0.y, 16); p0.z = __shfl_xor(v0.z, 16); p0.w = __shfl_xor(v0.w, 16);
                        p1.x = __shfl_xor(v1.x, 16); p1.y = __shfl_xor(v1.y, 16); p1.z = __shfl_xor(v1.z, 16); p1.w = __shfl_xor(v1.w, 16);
                        if (fq < 2) {
                            const f32x4 c0 = *(const f32x4*)(rope + pidx * 16), c1 = *(const f32x4*)(rope + pidx * 16 + 4);
                            const f32x4 s0 = *(const f32x4*)(rope + pidx * 16 + 8), s1 = *(const f32x4*)(rope + pidx * 16 + 12);
                            if (fq == 0) { v0 = v0 * c0 - p0 * s0; v1 = v1 * c1 - p1 * s1; }
                            else         { v0 = v0 * c0 + p0 * s0; v1 = v1 * c1 + p1 * s1; }
                        }
                    }
                    if (pn < 2) { v0 = v0 * 0.125f; v1 = v1 * 0.125f; }
                    u32x4 w; w.x = cvt_pk_bf16(v0[0], v0[1]); w.y = cvt_pk_bf16(v0[2], v0[3]); w.z = cvt_pk_bf16(v1[0], v1[1]); w.w = cvt_pk_bf16(v1[2], v1[3]);
                    *(u32x4*)(proj + (size_t)row * NPROJ + col0) = w;
                    if (pn >= 2 && pn < 6) {
                        const bool isk = pn < 4; const int cc = col0 - (isk ? C_K : C_V);
                        float* dst = nullptr;
                        if (smp) dst = out + (isk ? O_SK : O_SV) + ((size_t)b * WBUF + (WBUF - DTS) + t) * 512 + cc;
                        else if (t >= SEQ - WBUF) dst = out + (isk ? O_PK : O_PV) + ((size_t)b * WBUF + (t - (SEQ - WBUF))) * 512 + cc;
                        if (dst) { *(f32x4*)dst = v0; *(f32x4*)(dst + 4) = v1; }
                    } else if (pn >= 6 && pn < 10) {
                        const int cc = col0 - C_RAW;
                        float* dst = nullptr;
                        if (smp) { if (t >= DTS - 3) dst = out + O_SCONV + ((size_t)b * 3 + (t - (DTS - 3))) * 1024 + cc; }
                        else if (t >= SEQ - 3) dst = out + O_PCONV + ((size_t)b * 3 + (t - (SEQ - 3))) * 1024 + cc;
                        if (dst) { *(f32x4*)dst = v0; *(f32x4*)(dst + 4) = v1; }
                    }
                }
            }
    }
};
struct EpiOut {
    static constexpr bool PERM = true, AFTER_DRAIN = false;
    const float* xp; const float* xs; float* hp; bf16_t* hpb; float* ss;
    __device__ __forceinline__ void operator()(const f32x4 (&acc)[2][2][4][2], const Unit& u, int wr, int wc, int fr, int fq) const {
#pragma unroll
        for (int ai = 0; ai < 2; ++ai)
#pragma unroll
            for (int m = 0; m < 4; ++m) {
                const int row = u.pm * BM + ai * HALF + wr * 64 + m * 16 + fr;
                const float* xr = (row < MP) ? xp + (size_t)row * DM : xs + (size_t)(row - MP) * DM;
                float s = 0.f;
#pragma unroll
                for (int bj = 0; bj < 2; ++bj) {
                    const int col0 = u.pn * BM + bj * HALF + wc * 32 + 8 * fq;
                    const f32x4 v0 = acc[ai][bj][m][0] + *(const f32x4*)(xr + col0), v1 = acc[ai][bj][m][1] + *(const f32x4*)(xr + col0 + 4);
                    *(f32x4*)(hp + (size_t)row * DM + col0) = v0; *(f32x4*)(hp + (size_t)row * DM + col0 + 4) = v1;
                    u32x4 w; w.x = cvt_pk_bf16(v0[0], v0[1]); w.y = cvt_pk_bf16(v0[2], v0[3]); w.z = cvt_pk_bf16(v1[0], v1[1]); w.w = cvt_pk_bf16(v1[2], v1[3]);
                    *(u32x4*)(hpb + (size_t)row * DM + col0) = w;
                    s += (v0[0] * v0[0] + v0[1] * v0[1]) + (v0[2] * v0[2] + v0[3] * v0[3]) + (v1[0] * v1[0] + v1[1] * v1[1]) + (v1[2] * v1[2] + v1[3] * v1[3]);
                }
                s += __shfl_xor(s, 16); s += __shfl_xor(s, 32);
                if (fq == 0) atomicAdd(ss + row, s);
            }
    }
};
struct EpiUp {
    static constexpr bool PERM = true, AFTER_DRAIN = false;
    bf16_t* act; const float* ss;
    __device__ __forceinline__ void operator()(const f32x4 (&acc)[2][2][4][2], const Unit& u, int wr, int wc, int fr, int fq) const {
#pragma unroll
        for (int ai = 0; ai < 2; ++ai)
#pragma unroll
            for (int m = 0; m < 4; ++m) {
                const int row = u.pm * BM + ai * HALF + wr * 64 + m * 16 + fr;
                const float rs = 1.f / sqrtf(ss[row] * (1.f / DM) + EPS);
#pragma unroll
                for (int bj = 0; bj < 2; ++bj) {
                    const int col0 = u.pn * BM + bj * HALF + wc * 32 + 8 * fq;
                    f32x4 v0 = acc[ai][bj][m][0] * rs, v1 = acc[ai][bj][m][1] * rs;
#pragma unroll
                    for (int e = 0; e < 4; ++e) { const float a = fmaxf(v0[e], 0.f), c = fmaxf(v1[e], 0.f); v0[e] = a * a; v1[e] = c * c; }
                    u32x4 w; w.x = cvt_pk_bf16(v0[0], v0[1]); w.y = cvt_pk_bf16(v0[2], v0[3]); w.z = cvt_pk_bf16(v1[0], v1[1]); w.w = cvt_pk_bf16(v1[2], v1[3]);
                    *(u32x4*)(act + (size_t)row * FF + col0) = w;
                }
            }
    }
};
struct RangeOrder {
    int base_pm, nM, nN, nks, klen, G, c;
    __device__ bool next(int i, Unit& u) const {
        if (c < 0) return false;
        const int L = i * G + c; if (L >= nM * nN * nks) return false;
        u.k0 = (L % nks) * klen; u.pn = (L / nks) % nN; u.pm = base_pm + L / (nks * nN); return true;
    }
    __device__ __forceinline__ void a_ready(const Unit&) const {}
    __device__ __forceinline__ void done(const Unit&) const {}
};
template <bool ATOMIC> struct EpiDown {
    static constexpr bool PERM = true, AFTER_DRAIN = false;
    float* hp;
    __device__ __forceinline__ void operator()(const f32x4 (&acc)[2][2][4][2], const Unit& u, int wr, int wc, int fr, int fq) const {
#pragma unroll
        for (int ai = 0; ai < 2; ++ai)
#pragma unroll
            for (int m = 0; m < 4; ++m) {
                const int row = u.pm * BM + ai * HALF + wr * 64 + m * 16 + fr;
#pragma unroll
                for (int bj = 0; bj < 2; ++bj) {
                    const int col0 = u.pn * BM + bj * HALF + wc * 32 + 8 * fq;
                    float* p = hp + (size_t)row * DM + col0;
                    if (ATOMIC) {
#pragma unroll
                        for (int e = 0; e < 4; ++e) { atomicAdd(p + e, acc[ai][bj][m][0][e]); atomicAdd(p + 4 + e, acc[ai][bj][m][1][e]); }
                    } else {
                        const f32x4 v0 = acc[ai][bj][m][0] + *(const f32x4*)p, v1 = acc[ai][bj][m][1] + *(const f32x4*)(p + 4);
                        *(f32x4*)p = v0; *(f32x4*)(p + 4) = v1;
                    }
                }
            }
    }
};
struct EpiDownNorm {
    static constexpr bool PERM = true, AFTER_DRAIN = true;
    float* hp; float* ss; unsigned* cnt; const float* gf;
    __device__ __forceinline__ void operator()(const f32x4 (&)[2][2][4][2], const Unit&, int, int, int, int) const {}
    __device__ __forceinline__ void fused(const f32x4 (&acc)[2][2][4][2], const Unit& u, int wr, int wc, int fr, int fq, PG8_LAS unsigned char*, int, int) const {
#pragma unroll
        for (int ai = 0; ai < 2; ++ai)
#pragma unroll
            for (int m = 0; m < 4; ++m) {
                const int row = u.pm * BM + ai * HALF + wr * 64 + m * 16 + fr;
                float s = 0.f;
#pragma unroll
                for (int bj = 0; bj < 2; ++bj) {
                    const float* p = hp + (size_t)row * DM + u.pn * BM + bj * HALF + wc * 32 + 8 * fq;
                    const f32x4 v0 = acc[ai][bj][m][0] + *(const f32x4*)p, v1 = acc[ai][bj][m][1] + *(const f32x4*)(p + 4);
                    s += (v0[0] * v0[0] + v0[1] * v0[1]) + (v0[2] * v0[2] + v0[3] * v0[3]) + (v1[0] * v1[0] + v1[1] * v1[1]) + (v1[2] * v1[2] + v1[3] * v1[3]);
                }
                s += __shfl_xor(s, 16); s += __shfl_xor(s, 32);
                if (fq == 0) atomicAdd(ss + row, s);
            }
        asm volatile("s_waitcnt vmcnt(0)" ::: "memory");
        __syncthreads();
        if (threadIdx.x == 0) {
            unsigned* c = cnt + 64 * u.pm;
            __hip_atomic_fetch_add(c, 1u, __ATOMIC_RELAXED, __HIP_MEMORY_SCOPE_AGENT);
            unsigned sp = 0;
            while (__hip_atomic_load(c, __ATOMIC_RELAXED, __HIP_MEMORY_SCOPE_AGENT) < 4u) { __builtin_amdgcn_s_sleep(1); if (++sp > (1u << 22)) break; }
        }
        __syncthreads();
#pragma unroll
        for (int ai = 0; ai < 2; ++ai)
#pragma unroll
            for (int m = 0; m < 4; ++m) {
                const int row = u.pm * BM + ai * HALF + wr * 64 + m * 16 + fr;
                const float tot = __hip_atomic_load(ss + row, __ATOMIC_RELAXED, __HIP_MEMORY_SCOPE_AGENT);
                const float rs = 1.f / sqrtf(tot * (1.f / DM) + EPS);
#pragma unroll
                for (int bj = 0; bj < 2; ++bj) {
                    const int col0 = u.pn * BM + bj * HALF + wc * 32 + 8 * fq;
                    float* p = hp + (size_t)row * DM + col0;
                    const f32x4 g0 = *(const f32x4*)(gf + col0), g1 = *(const f32x4*)(gf + col0 + 4);
                    const f32x4 v0 = (acc[ai][bj][m][0] + *(const f32x4*)p) * rs * g0, v1 = (acc[ai][bj][m][1] + *(const f32x4*)(p + 4)) * rs * g1;
                    *(f32x4*)p = v0; *(f32x4*)(p + 4) = v1;
                }
            }
    }
};
struct EpiScratch {
    static constexpr bool PERM = true, AFTER_DRAIN = false;
    float* dst;
    __device__ __forceinline__ void operator()(const f32x4 (&acc)[2][2][4][2], const Unit& u, int wr, int wc, int fr, int fq) const {
#pragma unroll
        for (int ai = 0; ai < 2; ++ai)
#pragma unroll
            for (int m = 0; m < 4; ++m) { const int row = u.pm * BM + ai * HALF + wr * 64 + m * 16 + fr;
#pragma unroll
                for (int bj = 0; bj < 2; ++bj) { const int col0 = u.pn * BM + bj * HALF + wc * 32 + 8 * fq; float* p = dst + (size_t)row * DM + col0;
                    const f32x4 v0 = acc[ai][bj][m][0] + *(const f32x4*)p, v1 = acc[ai][bj][m][1] + *(const f32x4*)(p + 4);
                    *(f32x4*)p = v0; *(f32x4*)(p + 4) = v1; } }
    }
};
}

__device__ __forceinline__ void p0_transpose_item(const float* W, int K, int ldw, int nblk, const float* gain, bf16* WT, LAS float* scr, int item, int lane) {
    const int kb = item / nblk, nb = item % nblk, k0 = 64 * kb, n0 = 32 * nb;
#pragma unroll 8
    for (int i = 0; i < 32; ++i) { const int kk = 2 * i + (lane >> 5); const float gg = gain ? gain[k0 + kk] : 1.f; scr[kk * 33 + (lane & 31)] = gg * W[(size_t)(k0 + kk) * ldw + n0 + (lane & 31)]; }
    LDS_WAIT(); asm volatile("" ::: "memory");
    const int c = lane & 7;
#pragma unroll
    for (int j = 0; j < 4; ++j) { const int n = (lane >> 3) + 8 * j; const LAS float* s = scr + (8 * c) * 33 + n;
        v4u o; o.x = pk2(s[0 * 33], s[1 * 33]); o.y = pk2(s[2 * 33], s[3 * 33]); o.z = pk2(s[4 * 33], s[5 * 33]); o.w = pk2(s[6 * 33], s[7 * 33]);
        *(GAS v4u*)(WT + (size_t)(n0 + n) * K + k0 + 8 * c) = o; }
    LDS_WAIT(); asm volatile("" ::: "memory");
}
__device__ __forceinline__ void sincos_d(double a, double& s, double& c) {
    const double TWO_PI = 6.283185307179586476925286766559;
    const double k = __builtin_rint(a * (1.0 / TWO_PI));
    const double r = a - k * TWO_PI, r2 = r * r;
    double sc = 1.0, ss = r, tc = 1.0, ts = r;
#pragma unroll
    for (int n = 1; n <= 17; ++n) { tc *= -r2 / (double)((2 * n - 1) * (2 * n)); sc += tc; ts *= -r2 / (double)((2 * n) * (2 * n + 1)); ss += ts; }
    s = ss; c = sc;
}
__device__ __forceinline__ float log_sigmoidf_(float x) { return x < 0.f ? x - log1pf(expf(x)) : -log1pf(expf(-x)); }

__device__ __forceinline__ void p0_prologue(Frame& F) {
    const int gw = F.vcu * 8 + F.wave, NGW = F.G * 8;
    {
        LAS float* scr = (LAS float*)(F.lds + F.wave * 16384);
        constexpr int I_IN = 16 * 112, I_OUT = 16 * 32;
        for (int it = gw; it < I_IN + I_OUT; it += NGW) {
            int r = it;
            if (r < I_IN) { p0_transpose_item(F.w_in, DM, INCOLS, 112, F.g1, F.Win_t, scr, r, F.lane); continue; } r -= I_IN;
            p0_transpose_item(F.w_out, DM, DM, 32, nullptr, F.Wout_t, scr, r, F.lane);
        }
    }
    __syncthreads();
    {
        LAS float* Wg = (LAS float*)F.lds;
        for (int i = F.tid; i < 8192; i += 512) { const int k = i >> 3, j = i & 7; Wg[j * 1024 + k] = F.g1[k] * F.w_in[(size_t)k * INCOLS + NPROJ + j]; }
        __syncthreads();
        for (int m = gw; m < M; m += NGW) {
            const float* xr = (m < MP) ? F.xp + (size_t)m * DM : F.xs + (size_t)(m - MP) * DM;
            f32x4 v[4]; float ss = 0.f;
#pragma unroll
            for (int j = 0; j < 4; ++j) { v[j] = *(const f32x4*)(xr + 256 * j + 4 * F.lane); ss += (v[j].x * v[j].x + v[j].y * v[j].y) + (v[j].z * v[j].z + v[j].w * v[j].w); }
            float ga[8];
#pragma unroll
            for (int g = 0; g < 8; ++g) { float a = 0.f;
#pragma unroll
                for (int j = 0; j < 4; ++j) { const f32x4 w = *(const LAS f32x4*)(Wg + g * 1024 + 256 * j + 4 * F.lane); a += (v[j].x * w.x + v[j].y * w.y) + (v[j].z * w.z + v[j].w * w.w); }
                ga[g] = wave_sum(a); }
            ss = wave_sum(ss);
            const float rstd = 1.f / sqrtf(ss * (1.f / DM) + EPS);
            float gv = 0.f;
#pragma unroll
            for (int g = 0; g < 8; ++g) gv = (F.lane == g) ? ga[g] : gv;
            if (F.lane == 0) F.rstd1[m] = rstd;
            if (F.lane < 8) { const float gg = gv * rstd + F.b_gate[F.lane];
                if (F.lane < 4) F.ig[m * 4 + F.lane] = gg; else F.lf[m * 4 + F.lane - 4] = log_sigmoidf_(gg); }
            v2u* o8 = (v2u*)(F.XB + (size_t)m * DM);
#pragma unroll
            for (int j = 0; j < 4; ++j) { v2u o; o.x = pk2(v[j].x, v[j].y); o.y = pk2(v[j].z, v[j].w); o8[64 * j + F.lane] = o; }
        }
    }
    {
        const double invf[8] = {1.0, 0.19392274474868576, 0.03760603093086393, 0.007292664737217109, 0.001414213562373095, 0.0002742481756762073, 5.318295896944988e-05, 1.031338537721246e-05};
        for (int i = F.vcu * 512 + F.tid; i < (SEQ + DTS) * 8; i += F.G * 512) {
            const int p = i >> 3, k = i & 7; const double pos = (p < SEQ) ? (double)p : (double)(8192 + p - SEQ);
            double fr = invf[0];
#pragma unroll
            for (int q = 1; q < 8; ++q) fr = (k == q) ? invf[q] : fr;
            double s, c; sincos_d(pos * fr, s, c);
            F.rope[p * 16 + k] = (float)c; F.rope[p * 16 + 8 + k] = (float)s;
        }
    }
}

typedef short bf16x8m __attribute__((ext_vector_type(8)));
typedef short v4i16m __attribute__((ext_vector_type(4)));
struct AttnTileP { int dil, rg, Q0, sp, ks, Lg; };
__device__ __forceinline__ AttnTileP attn_tile_params(int ti, int r16, int L0) {
    AttnTileP t;
    if (ti < 5)       { t.dil = 16; t.rg = r16;     t.Q0 = L0;                  t.sp = 1;  t.ks = t.Q0 - 128 + 32 * ti;        t.Lg = 256; }
    else if (ti < 11) { t.dil = 4;  t.rg = r16 & 3; t.Q0 = 4 * L0 + (r16 >> 2); t.sp = 4;  t.ks = t.Q0 - 128 + 32 * (ti - 5);  t.Lg = 1024; }
    else              { t.dil = 1;  t.rg = 0;       t.Q0 = 16 * L0 + r16;       t.sp = 16; t.ks = t.Q0 - 128 + 32 * (ti - 11); t.Lg = 4096; }
    return t;
}
__device__ __forceinline__ void attn_tile_load(const bf16* P, int b, int h, const AttnTileP& t, int lane, bf16x8m (&kf)[2][2], v4u (&vv)[4]) {
    const int fr = lane & 15, g4 = lane >> 4;
#pragma unroll
    for (int sub = 0; sub < 2; ++sub) { int kp = t.ks + 16 * sub + fr; kp = kp < 0 ? 0 : (kp >= t.Lg ? t.Lg - 1 : kp);
        const bf16* kr = P + (size_t)(b * SEQ + t.dil * kp + t.rg) * NPROJ + C_K + h * 64 + 8 * g4;
        kf[sub][0] = *(const bf16x8m*)kr; kf[sub][1] = *(const bf16x8m*)(kr + 32); }
#pragma unroll
    for (int k = 0; k < 4; ++k) { int kp = t.ks + (lane >> 3) + 8 * k; kp = kp < 0 ? 0 : (kp >= t.Lg ? t.Lg - 1 : kp);
        vv[k] = *(const v4u*)(P + (size_t)(b * SEQ + t.dil * kp + t.rg) * NPROJ + C_V + h * 64 + 8 * (lane & 7)); }
}
__device__ __forceinline__ void p2_attn_prompt_mfma(Frame& F) {
    const int lane = F.lane, fr = lane & 15, g4 = lane >> 4;
    LAS unsigned char* vbuf = F.lds + F.wave * 10240;
    const int gw = F.vcu * 8 + F.wave, NGW = F.G * 8;
    const int vwoff = (lane >> 3) * 160 + (lane & 7) * 16;
    const int troff = (4 * g4 + (fr >> 2)) * 160 + (fr & 3) * 8;
    for (int wt = gw; wt < 8192; wt += NGW) {
        const int r16 = wt & 15, L0 = ((wt >> 4) & 15) * 16, h = (wt >> 8) & 7, b = wt >> 11;
        const int rowq = b * SEQ + 16 * (L0 + fr) + r16;
        bf16x8m qf[2];
        { const bf16* qr = F.PROJ + (size_t)rowq * NPROJ + C_Q + h * 64 + 8 * g4; qf[0] = *(const bf16x8m*)qr; qf[1] = *(const bf16x8m*)(qr + 32); }
        f32x4 acc[4];
#pragma unroll
        for (int i = 0; i < 4; ++i) acc[i] = (f32x4){0.f, 0.f, 0.f, 0.f};
        float m = -1e30f, lsum = 0.f;
        bf16x8m kc[2][2]; v4u vr[4];
        { const AttnTileP t0 = attn_tile_params(0, r16, L0); attn_tile_load(F.PROJ, b, h, t0, lane, kc, vr); }
#pragma unroll
        for (int k = 0; k < 4; ++k) *(LAS v4u*)(vbuf + vwoff + k * 1280) = vr[k];
#pragma unroll 2
        for (int ti = 0; ti < 23; ++ti) {
            const AttnTileP t = attn_tile_params(ti, r16, L0);
            bf16x8m kn[2][2];
            if (ti + 1 < 23) { const AttnTileP tn = attn_tile_params(ti + 1, r16, L0); attn_tile_load(F.PROJ, b, h, tn, lane, kn, vr); }
            else {
#pragma unroll
                for (int a = 0; a < 2; ++a) { kn[a][0] = kc[a][0]; kn[a][1] = kc[a][1]; } }
            LAS unsigned char* vb = vbuf + (ti & 1) * 5120;
            f32x4 s0 = (f32x4){0.f, 0.f, 0.f, 0.f}, s1 = (f32x4){0.f, 0.f, 0.f, 0.f};
            s0 = __builtin_amdgcn_mfma_f32_16x16x32_bf16(kc[0][0], qf[0], s0, 0, 0, 0); s0 = __builtin_amdgcn_mfma_f32_16x16x32_bf16(kc[0][1], qf[1], s0, 0, 0, 0);
            s1 = __builtin_amdgcn_mfma_f32_16x16x32_bf16(kc[1][0], qf[0], s1, 0, 0, 0); s1 = __builtin_amdgcn_mfma_f32_16x16x32_bf16(kc[1][1], qf[1], s1, 0, 0, 0);
            const int qp = t.Q0 + t.sp * fr;
            float mx = -INFINITY;
#pragma unroll
            for (int i = 0; i < 4; ++i) { const int k0 = t.ks + 4 * g4 + i, k1 = k0 + 16;
                const bool v0 = (k0 >= 0) && (k0 <= qp) && (qp - k0 <= 128), v1 = (k1 >= 0) && (k1 <= qp) && (qp - k1 <= 128);
                s0[i] = v0 ? s0[i] : -INFINITY; s1[i] = v1 ? s1[i] : -INFINITY; mx = fmaxf(mx, fmaxf(s0[i], s1[i])); }
            mx = fmaxf(mx, __shfl_xor(mx, 16)); mx = fmaxf(mx, __shfl_xor(mx, 32));
            const float mn = fmaxf(m, mx), alpha = __expf(m - mn); m = mn;
            float ps = 0.f;
#pragma unroll
            for (int i = 0; i < 4; ++i) { s0[i] = __expf(s0[i] - mn); s1[i] = __expf(s1[i] - mn); ps += s0[i] + s1[i]; }
            lsum = lsum * alpha + ps;
#pragma unroll
            for (int i = 0; i < 4; ++i) acc[i] = acc[i] * alpha;
            bf16x8m pb;
            { v4u w; w.x = pk2(s0[0], s0[1]); w.y = pk2(s0[2], s0[3]); w.z = pk2(s1[0], s1[1]); w.w = pk2(s1[2], s1[3]); pb = __builtin_bit_cast(bf16x8m, w); }
#pragma unroll
            for (int db = 0; db < 4; ++db) {
                const v4i16m a0 = __builtin_amdgcn_ds_read_tr16_b64_v4i16((LAS v4i16m*)(vb + troff + db * 32));
                const v4i16m a1 = __builtin_amdgcn_ds_read_tr16_b64_v4i16((LAS v4i16m*)(vb + troff + db * 32 + 16 * 160));
                const bf16x8m vt = __builtin_shufflevector(a0, a1, 0, 1, 2, 3, 4, 5, 6, 7);
                acc[db] = __builtin_amdgcn_mfma_f32_16x16x32_bf16(vt, pb, acc[db], 0, 0, 0);
            }
            if (ti + 1 < 23) { LAS unsigned char* vn = vbuf + ((ti + 1) & 1) * 5120;
#pragma unroll
                for (int k = 0; k < 4; ++k) *(LAS v4u*)(vn + vwoff + k * 1280) = vr[k]; }
#pragma unroll
            for (int a = 0; a < 2; ++a) { kc[a][0] = kn[a][0]; kc[a][1] = kn[a][1]; }
        }
        lsum += __shfl_xor(lsum, 16); lsum += __shfl_xor(lsum, 32);
        const float inv = 1.f / lsum;
        bf16* orow = F.MIX + (size_t)rowq * DM + h * 64 + 4 * g4;
#pragma unroll
        for (int db = 0; db < 4; ++db) { v2u o; o.x = pk2(acc[db][0] * inv, acc[db][1] * inv); o.y = pk2(acc[db][2] * inv, acc[db][3] * inv); *(v2u*)(orow + 16 * db) = o; }
    }
}


__device__ __forceinline__ bf16x8m cvt8(const f32x4 a, const f32x4 b) { v4u w; w.x = pk2(a.x, a.y); w.y = pk2(a.z, a.w); w.z = pk2(b.x, b.y); w.w = pk2(b.z, b.w); return __builtin_bit_cast(bf16x8m, w); }
__device__ __forceinline__ bf16x8m ld_sigma_g(const bf16* p) {
    const v2u a = *(const v2u*)p, c = *(const v2u*)(p + 16); v4u w; w.x = a.x; w.y = a.y; w.z = c.x; w.w = c.y; return __builtin_bit_cast(bf16x8m, w);
}
template <bool FAR>
__device__ __forceinline__ void sstream_tile(const bf16x8m (&ka)[2][2], const bf16x8m q0, const bf16x8m q1, int R, int fr, int g4, int isel, const LAS unsigned char* vbuf, int troff,
                                             float& m, float& lsum, f32x4 (&acc)[4]) {
    f32x4 s0 = (f32x4){0.f, 0.f, 0.f, 0.f}, s1 = (f32x4){0.f, 0.f, 0.f, 0.f};
    s0 = __builtin_amdgcn_mfma_f32_16x16x32_bf16(ka[0][0], q0, s0, 0, 0, 0); s0 = __builtin_amdgcn_mfma_f32_16x16x32_bf16(ka[0][1], q1, s0, 0, 0, 0);
    s1 = __builtin_amdgcn_mfma_f32_16x16x32_bf16(ka[1][0], q0, s1, 0, 0, 0); s1 = __builtin_amdgcn_mfma_f32_16x16x32_bf16(ka[1][1], q1, s1, 0, 0, 0);
    float mx;
    float mu0[4], mu1[4];
    if (FAR) {
        const float a0 = (isel == 0) ? s0[0] : (isel == 1) ? s0[1] : (isel == 2) ? s0[2] : s0[3];
        const float a1 = (isel == 0) ? s1[0] : (isel == 1) ? s1[1] : (isel == 2) ? s1[2] : s1[3];
        mx = (isel >= 0) ? fmaxf(a0, a1) : -INFINITY;
        mx = fmaxf(mx, __shfl_xor(mx, 16)); mx = fmaxf(mx, __shfl_xor(mx, 32));
        const float mn = fmaxf(m, mx), alpha = __expf(m - mn); m = mn;
        const float e0 = (isel >= 0) ? __expf(a0 - mn) : 0.f, e1 = (isel >= 0) ? __expf(a1 - mn) : 0.f;
#pragma unroll
        for (int i = 0; i < 4; ++i) { s0[i] = (i == isel) ? e0 : 0.f; s1[i] = (i == isel) ? e1 : 0.f; }
        lsum = lsum * alpha + (e0 + e1);
#pragma unroll
        for (int i = 0; i < 4; ++i) acc[i] = acc[i] * alpha;
    } else {
        mx = -INFINITY;
#pragma unroll
        for (int i = 0; i < 4; ++i) {
            const int d0 = WBUF + fr - (R + 4 * g4 + i), d1 = d0 - 16;
            float c0 = 0.f, c1 = 0.f;
            if (fr < 8 && d0 >= 0) c0 = (d0 <= 128 ? 1.f : 0.f) + (((d0 & 3) == 0 && d0 <= 512) ? 1.f : 0.f) + (((d0 & 15) == 0) ? 1.f : 0.f);
            if (fr < 8 && d1 >= 0) c1 = (d1 <= 128 ? 1.f : 0.f) + (((d1 & 3) == 0 && d1 <= 512) ? 1.f : 0.f) + (((d1 & 15) == 0) ? 1.f : 0.f);
            mu0[i] = c0; mu1[i] = c1;
            mx = fmaxf(mx, (c0 > 0.f) ? s0[i] : -INFINITY);
            mx = fmaxf(mx, (c1 > 0.f) ? s1[i] : -INFINITY); }
        mx = fmaxf(mx, __shfl_xor(mx, 16)); mx = fmaxf(mx, __shfl_xor(mx, 32));
        const float mn = fmaxf(m, mx), alpha = __expf(m - mn); m = mn;
        float ps = 0.f;
#pragma unroll
        for (int i = 0; i < 4; ++i) { s0[i] = (mu0[i] > 0.f) ? mu0[i] * __expf(s0[i] - mn) : 0.f; s1[i] = (mu1[i] > 0.f) ? mu1[i] * __expf(s1[i] - mn) : 0.f; ps += s0[i] + s1[i]; }
        lsum = lsum * alpha + ps;
#pragma unroll
        for (int i = 0; i < 4; ++i) acc[i] = acc[i] * alpha;
    }
    v4u pw; pw.x = pk2(s0[0], s0[1]); pw.y = pk2(s0[2], s0[3]); pw.z = pk2(s1[0], s1[1]); pw.w = pk2(s1[2], s1[3]);
    const bf16x8m pb = __builtin_bit_cast(bf16x8m, pw);
#pragma unroll
    for (int db = 0; db < 4; ++db) {
        const v4i16m a0 = __builtin_amdgcn_ds_read_tr16_b64_v4i16((LAS v4i16m*)(vbuf + troff + db * 32));
        const v4i16m a1 = __builtin_amdgcn_ds_read_tr16_b64_v4i16((LAS v4i16m*)(vbuf + troff + db * 32 + 16 * 160));
        acc[db] = __builtin_amdgcn_mfma_f32_16x16x32_bf16(__builtin_shufflevector(a0, a1, 0, 1, 2, 3, 4, 5, 6, 7), pb, acc[db], 0, 0, 0);
    }
}
struct STile { f32x4 k[2][4], v[2][4]; };
__device__ __forceinline__ void sstream_load(STile& T, const float* ck, const float* cv, unsigned hb, int ti, int fr) {
#pragma unroll
    for (int sub = 0; sub < 2; ++sub) { const unsigned off = hb + (unsigned)(32 * ti + 16 * sub + fr) * 2048u;
#pragma unroll
        for (int j = 0; j < 4; ++j) { T.k[sub][j] = __builtin_nontemporal_load((const f32x4*)((const char*)ck + off + 64 * j)); T.v[sub][j] = __builtin_nontemporal_load((const f32x4*)((const char*)cv + off + 64 * j)); } }
}
template <bool FAR>
__device__ __forceinline__ void sstream_process(const STile& T, float* ok, float* ov, unsigned hb, float* dummy, int ti, int fr, int g4, int isel, const bf16x8m q0, const bf16x8m q1,
                                                LAS unsigned char* vbuf, int troff, float& m, float& lsum, f32x4 (&acc)[4]) {
    const int R = 32 * ti;
    bf16x8m ka[2][2];
#pragma unroll
    for (int sub = 0; sub < 2; ++sub) { const int row = R + 16 * sub + fr;
        if (row >= DTS) { const unsigned off = hb + (unsigned)(row - DTS) * 2048u;
#pragma unroll
            for (int j = 0; j < 4; ++j) { *(f32x4*)((char*)ok + off + 64 * j) = T.k[sub][j]; *(f32x4*)((char*)ov + off + 64 * j) = T.v[sub][j]; } }
        ka[sub][0] = cvt8(T.k[sub][0], T.k[sub][1]); ka[sub][1] = cvt8(T.k[sub][2], T.k[sub][3]);
        LAS unsigned char* vd = vbuf + (16 * sub + fr) * 160 + 8 * g4;
#pragma unroll
        for (int j = 0; j < 4; ++j) { v2u o; o.x = pk2(T.v[sub][j].x, T.v[sub][j].y); o.y = pk2(T.v[sub][j].z, T.v[sub][j].w); *(LAS v2u*)(vd + 32 * j) = o; } }
    sstream_tile<FAR>(ka, q0, q1, R, fr, g4, isel, vbuf, troff, m, lsum, acc);
}
__device__ __forceinline__ void p2_sample_stream(Frame& F) {
    const int lane = F.lane, fr = lane & 15, g4 = lane >> 4, w = F.wave;
    LAS unsigned char* vbuf = F.lds + w * 5120;
    LAS float* mrg = (LAS float*)(F.lds + 40960);
    const int troff = (4 * g4 + (fr >> 2)) * 160 + (fr & 3) * 8;
    const int isel = ((fr < 8) && ((fr >> 2) == g4)) ? (fr & 3) : -1;
#ifndef STREAM_CUS
#define STREAM_CUS 256
#endif
    constexpr int SSTEP = 256 / STREAM_CUS;
    if ((F.vcu % SSTEP) == 0)
    for (int su = F.vcu / SSTEP; su < 256; su += F.G / SSTEP) {
        const int b = su >> 1, hh = 4 * (su & 1) + (w & 3), par = w >> 2;
        bf16x8m q0, q1;
        { const bf16* qr = F.PROJ + (size_t)(MP + b * DTS + (fr & 7)) * NPROJ + C_Q + hh * 64 + 4 * g4;
          q0 = ld_sigma_g(qr); q1 = ld_sigma_g(qr + 32);
          if (fr >= 8) { q0 = (bf16x8m){0, 0, 0, 0, 0, 0, 0, 0}; q1 = q0; } }
        f32x4 acc[4];
#pragma unroll
        for (int i = 0; i < 4; ++i) acc[i] = (f32x4){0.f, 0.f, 0.f, 0.f};
        float m = -1e30f, lsum = 0.f;
        const unsigned hb = (unsigned)((((size_t)b * WBUF * 8 + hh) * 64 + 4 * g4) * 4);
        const float* ck = F.cache_k; const float* cv = F.cache_v; float* ok = F.out + O_SK; float* ov = F.out + O_SV; float* dummy = nullptr;
        __syncthreads();
        STile TA, TB;
        sstream_load(TA, ck, cv, hb, par, fr);
#pragma unroll 1
        for (int ti = par; ti < 48; ti += 4) {
            sstream_load(TB, ck, cv, hb, ti + 2, fr); __builtin_amdgcn_sched_barrier(0);
            sstream_process<true>(TA, ok, ov, hb, dummy, ti, fr, g4, isel, q0, q1, vbuf, troff, m, lsum, acc); __builtin_amdgcn_sched_barrier(0);
            sstream_load(TA, ck, cv, hb, ti + 4, fr); __builtin_amdgcn_sched_barrier(0);
            sstream_process<true>(TB, ok, ov, hb, dummy, ti + 2, fr, g4, isel, q0, q1, vbuf, troff, m, lsum, acc); __builtin_amdgcn_sched_barrier(0);
        }
#pragma unroll 1
        for (int ti = 48 + par; ti < 64; ti += 4) {
            sstream_load(TB, ck, cv, hb, ti + 2, fr); __builtin_amdgcn_sched_barrier(0);
            sstream_process<false>(TA, ok, ov, hb, dummy, ti, fr, g4, isel, q0, q1, vbuf, troff, m, lsum, acc); __builtin_amdgcn_sched_barrier(0);
            sstream_load(TA, ck, cv, hb, (ti + 4 < 64) ? ti + 4 : ti + 2, fr); __builtin_amdgcn_sched_barrier(0);
            sstream_process<false>(TB, ok, ov, hb, dummy, ti + 2, fr, g4, isel, q0, q1, vbuf, troff, m, lsum, acc); __builtin_amdgcn_sched_barrier(0);
        }
        if (par == 0) {
            bf16x8m ka[2][2];
            const bf16x8m z = (bf16x8m){0, 0, 0, 0, 0, 0, 0, 0};
            const bf16* kr = F.PROJ + (size_t)(MP + b * DTS + (fr & 7)) * NPROJ + C_K + hh * 64 + 4 * g4;
            const bf16* vr = F.PROJ + (size_t)(MP + b * DTS + (fr & 7)) * NPROJ + C_V + hh * 64 + 4 * g4;
            ka[0][0] = (fr < 8) ? ld_sigma_g(kr) : z; ka[0][1] = (fr < 8) ? ld_sigma_g(kr + 32) : z; ka[1][0] = z; ka[1][1] = z;
#pragma unroll
            for (int sub = 0; sub < 2; ++sub) { LAS unsigned char* vd = vbuf + (16 * sub + fr) * 160 + 8 * g4;
#pragma unroll
                for (int j = 0; j < 4; ++j) { v2u o = (v2u){0u, 0u}; if (sub == 0 && fr < 8) o = *(const v2u*)(vr + 16 * j); *(LAS v2u*)(vd + 32 * j) = o; } }
            sstream_tile<false>(ka, q0, q1, WBUF, fr, g4, isel, vbuf, troff, m, lsum, acc);
        }
        lsum += __shfl_xor(lsum, 16); lsum += __shfl_xor(lsum, 32);
        LAS float* mg = mrg + ((w & 3) * 64 + lane) * 18;
        if (par == 1) { mg[0] = m; mg[1] = lsum;
#pragma unroll
            for (int db = 0; db < 4; ++db) { mg[2 + 4 * db] = acc[db][0]; mg[3 + 4 * db] = acc[db][1]; mg[4 + 4 * db] = acc[db][2]; mg[5 + 4 * db] = acc[db][3]; } }
        __syncthreads();
        if (par == 0) {
            const float m2 = mg[0], l2 = mg[1], mn = fmaxf(m, m2), a1 = __expf(m - mn), a2 = __expf(m2 - mn), inv = 1.f / (lsum * a1 + l2 * a2);
            if (fr < 8) { bf16* orow = F.MIX + (size_t)(MP + b * DTS + fr) * DM + hh * 64 + 4 * g4;
#pragma unroll
                for (int db = 0; db < 4; ++db) { v2u o;
                    o.x = pk2((acc[db][0] * a1 + mg[2 + 4 * db] * a2) * inv, (acc[db][1] * a1 + mg[3 + 4 * db] * a2) * inv);
                    o.y = pk2((acc[db][2] * a1 + mg[4 + 4 * db] * a2) * inv, (acc[db][3] * a1 + mg[5 + 4 * db] * a2) * inv);
                    *(v2u*)(orow + 16 * db) = o; } }
        }
    }
}

__device__ __forceinline__ void load_q64(const bf16* qp, LAS float* sq, int lane) {
    sq[lane] = bf2f(qp[lane]);
    LDS_WAIT(); asm volatile("" ::: "memory");
}
__device__ __forceinline__ float dot_bf16row(const bf16* kp, const LAS float* sq) {
    float a = 0.f;
#pragma unroll 1
    for (int i = 0; i < 8; ++i) { const v4u w = *(const v4u*)(kp + 8 * i); const f32x4 q0 = *(const LAS f32x4*)(sq + 8 * i), q1 = *(const LAS f32x4*)(sq + 8 * i + 4);
        a += q0.x * bflo(w.x) + q0.y * bfhi(w.x) + q0.z * bflo(w.y) + q0.w * bfhi(w.y) + q1.x * bflo(w.z) + q1.y * bfhi(w.z) + q1.z * bflo(w.w) + q1.w * bfhi(w.w); }
    return a;
}
__device__ __forceinline__ float dot_f32row(const float* kp, const LAS float* sq) {
    float a = 0.f;
#pragma unroll 1
    for (int i = 0; i < 16; ++i) { const f32x4 w = *(const f32x4*)(kp + 4 * i); const f32x4 q0 = *(const LAS f32x4*)(sq + 4 * i);
        a += q0.x * w.x + q0.y * w.y + q0.z * w.z + q0.w * w.w; }
    return a;
}
__device__ __forceinline__ void p2_attn_v1(Frame& F) {
    const int gw = F.vcu * 8 + F.wave, NGW = F.G * 8, lane = F.lane;
    LAS float* q = (LAS float*)(F.lds + F.wave * 256);
    for (int it = gw; it < MS * 8; it += NGW) {
        const int sr = it >> 3, h = it & 7, b = sr >> 3, t = sr & 7, row = MP + sr;
        load_q64(F.PROJ + (size_t)row * NPROJ + C_Q + h * 64, q, lane);
        float sc[3][3];
#pragma unroll
        for (int g = 0; g < 3; ++g) { const int dil = (g == 0) ? 1 : (g == 1 ? 4 : 16);
#pragma unroll
            for (int i = 0; i < 3; ++i) { const int j = lane + 64 * i; const bool valid = (j <= 128);
                const int idx = valid ? (WBUF + t - dil * j) : (WBUF + t);
                float d;
                if (idx < WBUF) d = dot_f32row(F.cache_k + (((size_t)b * WBUF + idx) * 8 + h) * 64, q);
                else d = dot_bf16row(F.PROJ + (size_t)(MP + b * DTS + idx - WBUF) * NPROJ + C_K + h * 64, q);
                sc[g][i] = valid ? d : -INFINITY; asm volatile("" ::: "memory"); } }
        float mx = -INFINITY;
#pragma unroll
        for (int g = 0; g < 3; ++g)
#pragma unroll
            for (int i = 0; i < 3; ++i) mx = fmaxf(mx, sc[g][i]);
        mx = wave_max(mx);
        float sum = 0.f;
#pragma unroll
        for (int g = 0; g < 3; ++g)
#pragma unroll
            for (int i = 0; i < 3; ++i) { sc[g][i] = __expf(sc[g][i] - mx); sum += sc[g][i]; }
        sum = wave_sum(sum);
        float o = 0.f;
#pragma unroll
        for (int g = 0; g < 3; ++g) { const int dil = (g == 0) ? 1 : (g == 1 ? 4 : 16);
#pragma unroll
            for (int i = 0; i < 3; ++i) { const int cnt = (i == 2) ? 1 : 64;
#pragma unroll 1
                for (int jj = 0; jj < cnt; ++jj) { const int idx = WBUF + t - dil * (jj + 64 * i);
                    const float p = __shfl(sc[g][i], jj);
                    const float vv = (idx < WBUF) ? F.cache_v[(((size_t)b * WBUF + idx) * 8 + h) * 64 + lane]
                                                  : bf2f(F.PROJ[(size_t)(MP + b * DTS + idx - WBUF) * NPROJ + C_V + h * 64 + lane]);
                    o += p * vv; } } }
        F.MIX[(size_t)row * DM + h * 64 + lane] = (bf16)f2bf(o / sum);
    }
}

constexpr int TP = 288;
constexpr int ML_A = 0, ML_K = 36864, ML_V = 73728, ML_S = 110592;
typedef short v4i16s __attribute__((ext_vector_type(4)));
__device__ __forceinline__ bf16x8m tr2(const LAS unsigned char* p) {
    const v4i16m a0 = __builtin_amdgcn_ds_read_tr16_b64_v4i16((LAS v4i16m*)p);
    const v4i16m a1 = __builtin_amdgcn_ds_read_tr16_b64_v4i16((LAS v4i16m*)(p + 16 * TP));
    return __builtin_shufflevector(a0, a1, 0, 1, 2, 3, 4, 5, 6, 7);
}
__device__ __forceinline__ bf16x8m rd_sigma(const LAS unsigned char* p) {
    const v4i16m a0 = *(const LAS v4i16m*)p, a1 = *(const LAS v4i16m*)(p + 32);
    return __builtin_shufflevector(a0, a1, 0, 1, 2, 3, 4, 5, 6, 7);
}
__device__ __forceinline__ void build_conv_tile(LAS unsigned char* dst, const bf16* PROJ, int row0, bool first, int col, const float* w_conv, const float* b_conv, float scale, const LAS float* rowscale, int tid) {
    const int cc = tid & 15, rg = tid >> 4;
    v4u x[7];
#pragma unroll
    for (int i = 0; i < 7; ++i) { const int r = 4 * rg + i - 3;
        if (first && r < 0) x[i] = (v4u){0u, 0u, 0u, 0u}; else x[i] = *(const v4u*)(PROJ + (size_t)(row0 + r) * NPROJ + C_RAW + col + 8 * cc); }
    const float* wc = w_conv + col + 8 * cc;
    float out[4][8];
#pragma unroll
    for (int e = 0; e < 8; ++e) { const float bb = b_conv[col + 8 * cc + e];
#pragma unroll
        for (int r = 0; r < 4; ++r) out[r][e] = bb; }
#pragma unroll
    for (int w = 0; w < 4; ++w) {
        const f32x4 w0 = *(const f32x4*)(wc + w * 1024), w1 = *(const f32x4*)(wc + w * 1024 + 4);
#pragma unroll
        for (int r = 0; r < 4; ++r) { const v4u xv = x[r + w];
            out[r][0] += bflo(xv.x) * w0.x; out[r][1] += bfhi(xv.x) * w0.y; out[r][2] += bflo(xv.y) * w0.z; out[r][3] += bfhi(xv.y) * w0.w;
            out[r][4] += bflo(xv.z) * w1.x; out[r][5] += bfhi(xv.z) * w1.y; out[r][6] += bflo(xv.w) * w1.z; out[r][7] += bfhi(xv.w) * w1.w; }
    }
#pragma unroll
    for (int r = 0; r < 4; ++r) { const float rs = scale * (rowscale ? rowscale[4 * rg + r] : 1.f); float o[8];
#pragma unroll
        for (int e = 0; e < 8; ++e) { const float a = out[r][e]; o[e] = a * sigmoidf_(a) * rs; }
        v4u w; w.x = pk2(o[0], o[1]); w.y = pk2(o[2], o[3]); w.z = pk2(o[4], o[5]); w.w = pk2(o[6], o[7]);
        *(LAS v4u*)(dst + (4 * rg + r) * TP + cc * 16) = w; }
}
__device__ __forceinline__ void copy_v_tile(LAS unsigned char* dst, const bf16* PROJ, int row0, int col, int tid) {
#pragma unroll
    for (int k = 0; k < 4; ++k) { const int i = tid + 512 * k, r = i >> 4, cc = i & 15;
        *(LAS v4u*)(dst + r * TP + cc * 16) = *(const v4u*)(PROJ + (size_t)(row0 + r) * NPROJ + col + 8 * cc); }
}
__device__ __forceinline__ void chunk_scan(const float* lf, const float* ig, int row0, int h, int lane, float& b0, float& b1, float& u0, float& u1, float& c0, float& c1) {
    const float a0 = lf[(row0 + 2 * lane) * 4 + h], a1 = lf[(row0 + 2 * lane + 1) * 4 + h];
    const float sp = a0 + a1; float incl = sp;
#pragma unroll
    for (int o = 1; o < 64; o <<= 1) { const float t = __shfl_up(incl, o); if (lane >= o) incl += t; }
    const float excl = incl - sp;
    b0 = excl + a0; b1 = incl;
    u0 = ig[(row0 + 2 * lane) * 4 + h] - b0; u1 = ig[(row0 + 2 * lane + 1) * 4 + h] - b1;
    const float pm = fmaxf(u0, u1); float im = pm;
#pragma unroll
    for (int o = 1; o < 64; o <<= 1) { const float t = __shfl_up(im, o); if (lane >= o) im = fmaxf(im, t); }
    float em = __shfl_up(im, 1); if (lane == 0) em = -INFINITY;
    c0 = fmaxf(em, u0); c1 = im;
}

__device__ __forceinline__ void p3_mlstm_local_mfma(Frame& F) {
    const int tid = F.tid, lane = F.lane, fr = lane & 15, g4 = lane >> 4, w = F.wave;
    LAS unsigned char* sK = F.lds + ML_K; LAS unsigned char* sV = F.lds + ML_V;
    LAS float* sW = (LAS float*)(F.lds + ML_S);
    for (int u = F.vcu; u < 512; u += F.G) {
        const int bh = u >> 5, c = u & 31, b = bh >> 2, h = bh & 3, row0 = b * SEQ + c * 128;
        __syncthreads();
        if (w == 0) { float b0, b1, u0, u1, c0, c1; chunk_scan(F.lf, F.ig, row0, h, lane, b0, b1, u0, u1, c0, c1);
            const float um = __shfl(c1, 63);
            sW[2 * lane] = __expf(u0 - um); sW[2 * lane + 1] = __expf(u1 - um);
            if (lane == 63) { F.chk[u] = b1; F.chk[512 + u] = um; } }
        copy_v_tile(sV, F.PROJ, row0, C_VB + h * 128, tid);
        __syncthreads();
        build_conv_tile(sK, F.PROJ, row0, c == 0, 512 + h * 128, F.w_conv, F.b_conv, 0.08838834764831845f, sW, tid);
        __syncthreads();
        f32x4 acc[8];
#pragma unroll
        for (int i = 0; i < 8; ++i) acc[i] = (f32x4){0.f, 0.f, 0.f, 0.f};
        const int tro = (4 * g4 + (fr >> 2)) * TP + (fr & 3) * 8;
#pragma unroll
        for (int ks = 0; ks < 4; ++ks) {
            const bf16x8m vt = tr2(sV + ks * 32 * TP + tro + 32 * w);
#pragma unroll
            for (int nb = 0; nb < 8; ++nb) { const bf16x8m kt = tr2(sK + ks * 32 * TP + tro + 32 * nb);
                acc[nb] = __builtin_amdgcn_mfma_f32_16x16x32_bf16(vt, kt, acc[nb], 0, 0, 0); }
        }
#pragma unroll
        for (int nb = 0; nb < 8; ++nb) *(f32x4*)(F.L + (size_t)u * 16384 + (16 * nb + fr) * 128 + 16 * w + 4 * g4) = acc[nb];
        if (tid < 128) { float n = 0.f;
#pragma unroll 8
            for (int s2 = 0; s2 < 128; ++s2) n += bf2f(*(const LAS unsigned short*)(sK + s2 * TP + tid * 2));
            F.NLOC[u * 128 + tid] = n; }
    }
}

__device__ __forceinline__ void p5_mlstm_out_mfma(Frame& F) {
    const int tid = F.tid, lane = F.lane, fr = lane & 15, g4 = lane >> 4, w = F.wave;
    LAS unsigned char* sA = F.lds + ML_A; LAS unsigned char* sK = F.lds + ML_K; LAS unsigned char* sV = F.lds + ML_V;
    LAS float* sB = (LAS float*)(F.lds + ML_S); LAS float* sU = sB + 128; LAS float* sG = sU + 128; LAS float* sN = sG + 128;
    const int tro = (4 * g4 + (fr >> 2)) * TP + (fr & 3) * 8;
    for (int u = F.vcu; u < 512; u += F.G) {
        const int bh = u >> 5, c = u & 31, b = bh >> 2, h = bh & 3, row0 = b * SEQ + c * 128;
        const float mc = F.chk[1024 + u];
        __syncthreads();
        if (w == 0) { float b0, b1, u0, u1, c0, c1; chunk_scan(F.lf, F.ig, row0, h, lane, b0, b1, u0, u1, c0, c1);
            sB[2 * lane] = b0; sB[2 * lane + 1] = b1; sU[2 * lane] = u0; sU[2 * lane + 1] = u1; sG[2 * lane] = fmaxf(mc, c0); sG[2 * lane + 1] = fmaxf(mc, c1); }
        if (w == 1) { sN[lane] = F.NPRE[u * 128 + lane]; sN[64 + lane] = F.NPRE[u * 128 + 64 + lane]; }
        build_conv_tile(sA, F.PROJ, row0, c == 0, h * 128, F.w_conv, F.b_conv, 1.f, nullptr, tid);
        build_conv_tile(sK, F.PROJ, row0, c == 0, 512 + h * 128, F.w_conv, F.b_conv, 0.08838834764831845f, nullptr, tid);
        copy_v_tile(sV, F.PROJ, row0, C_VB + h * 128, tid);
        __syncthreads();
        const int t = 16 * w + fr;
        const float gt = sG[t], bt = sB[t], wi = __expf(mc - gt);
        bf16x8m qf[4];
#pragma unroll
        for (int kd = 0; kd < 4; ++kd) qf[kd] = rd_sigma(sA + t * TP + kd * 64 + 8 * g4);
        float qn = 0.f;
#pragma unroll
        for (int i = 0; i < 4; ++i) { const v4u qq = *(const LAS v4u*)(sA + t * TP + 64 * g4 + 16 * i); const LAS float* nn = sN + 32 * g4 + 8 * i;
            qn += bflo(qq.x) * nn[0] + bfhi(qq.x) * nn[1] + bflo(qq.y) * nn[2] + bfhi(qq.y) * nn[3] + bflo(qq.z) * nn[4] + bfhi(qq.z) * nn[5] + bflo(qq.w) * nn[6] + bfhi(qq.w) * nn[7]; }
        qn += __shfl_xor(qn, 16); qn += __shfl_xor(qn, 32);
        bf16x8m pb[4]; float psum = 0.f;
#pragma unroll
        for (int j = 0; j < 4; ++j) {
            pb[j] = (bf16x8m){0, 0, 0, 0, 0, 0, 0, 0};
            if (j <= (w >> 1)) {
                f32x4 sv[2];
#pragma unroll
                for (int sub = 0; sub < 2; ++sub) { sv[sub] = (f32x4){0.f, 0.f, 0.f, 0.f};
                    const LAS unsigned char* kr = sK + (32 * j + 16 * sub + fr) * TP + 8 * g4;
#pragma unroll
                    for (int kd = 0; kd < 4; ++kd) sv[sub] = __builtin_amdgcn_mfma_f32_16x16x32_bf16(rd_sigma(kr + kd * 64), qf[kd], sv[sub], 0, 0, 0);
                    const f32x4 us = *(const LAS f32x4*)(sU + 32 * j + 16 * sub + 4 * g4);
#pragma unroll
                    for (int i = 0; i < 4; ++i) { const int s2 = 32 * j + 16 * sub + 4 * g4 + i; const float pv = (s2 <= t) ? sv[sub][i] * __expf(us[i] - gt) : 0.f; sv[sub][i] = pv; psum += pv; } }
                v4u pw; pw.x = pk2(sv[0][0], sv[0][1]); pw.y = pk2(sv[0][2], sv[0][3]); pw.z = pk2(sv[1][0], sv[1][1]); pw.w = pk2(sv[1][2], sv[1][3]);
                pb[j] = __builtin_bit_cast(bf16x8m, pw);
            }
        }
        psum += __shfl_xor(psum, 16); psum += __shfl_xor(psum, 32);
        const float den = wi * qn + psum, dinv = 1.f / fmaxf(fabsf(den), __expf(-(bt + gt)));
        __syncthreads();
#pragma unroll
        for (int k = 0; k < 8; ++k) { const int i = tid + 512 * k, d = i >> 5, e4 = i & 31;
            const f32x4 cv = *(const f32x4*)(F.CPRE + (size_t)u * 16384 + d * 128 + 4 * e4);
            v2u o; o.x = pk2(cv.x, cv.y); o.y = pk2(cv.z, cv.w); *(LAS v2u*)(sA + d * TP + e4 * 8) = o; }
        __syncthreads();
        f32x4 acc[8];
#pragma unroll
        for (int i = 0; i < 8; ++i) acc[i] = (f32x4){0.f, 0.f, 0.f, 0.f};
#pragma unroll
        for (int kd = 0; kd < 4; ++kd)
#pragma unroll
            for (int eb = 0; eb < 8; ++eb) acc[eb] = __builtin_amdgcn_mfma_f32_16x16x32_bf16(tr2(sA + kd * 32 * TP + tro + 32 * eb), qf[kd], acc[eb], 0, 0, 0);
#pragma unroll
        for (int eb = 0; eb < 8; ++eb) acc[eb] = acc[eb] * wi;
#pragma unroll
        for (int j = 0; j < 4; ++j)
            if (j <= (w >> 1)) {
#pragma unroll
                for (int eb = 0; eb < 8; ++eb) acc[eb] = __builtin_amdgcn_mfma_f32_16x16x32_bf16(tr2(sV + j * 32 * TP + tro + 32 * eb), pb[j], acc[eb], 0, 0, 0); }
        float ssq = 0.f;
#pragma unroll
        for (int eb = 0; eb < 8; ++eb) { acc[eb] = acc[eb] * dinv; ssq += (acc[eb][0] * acc[eb][0] + acc[eb][1] * acc[eb][1]) + (acc[eb][2] * acc[eb][2] + acc[eb][3] * acc[eb][3]); }
        ssq += __shfl_xor(ssq, 16); ssq += __shfl_xor(ssq, 32);
        const float rs = 1.f / sqrtf(ssq * (1.f / 128.f) + EPS);
        const int row = row0 + t;
#pragma unroll
        for (int eb = 0; eb < 8; ++eb) { const int e = 16 * eb + 4 * g4;
            const v2u ob = *(const v2u*)(F.PROJ + (size_t)row * NPROJ + C_OB + h * 128 + e); const f32x4 gg = *(const f32x4*)(F.mhg + h * 128 + e);
            v2u o; o.x = pk2(acc[eb][0] * rs * gg.x * sigmoidf_(bflo(ob.x)), acc[eb][1] * rs * gg.y * sigmoidf_(bfhi(ob.x)));
            o.y = pk2(acc[eb][2] * rs * gg.z * sigmoidf_(bflo(ob.y)), acc[eb][3] * rs * gg.w * sigmoidf_(bfhi(ob.y)));
            *(v2u*)(F.MIX + (size_t)row * DM + 512 + h * 128 + e) = o; }
    }
}

__device__ __forceinline__ void p3_mlstm_sample(Frame& F) {
    const int tid = F.tid;
    LAS float* sQ = (LAS float*)F.lds;
    LAS float* sKs = sQ + 1024;
    LAS float* sV = sKs + 1024;
    LAS float* sQC = sV + 1024;
    LAS float* sH = sQC + 16384;
    LAS float* sN0 = sH + 1024;
    LAS float* sS = sN0 + 128;
    for (int u = F.vcu; u < 512; u += F.G) {
        const int b = u >> 2, h = u & 3, r0 = MP + b * DTS;
        __syncthreads();
        for (int i = tid; i < 2048; i += 512) { const int part = i >> 10, t = (i >> 7) & 7, d = i & 127, col = part * 512 + h * 128 + d;
            float a = F.b_conv[col];
#pragma unroll
            for (int w = 0; w < 4; ++w) { const int tt = t + w - 3;
                const float xv = (tt >= 0) ? bf2f(F.PROJ[(size_t)(r0 + tt) * NPROJ + C_RAW + col]) : F.st_conv[((size_t)b * 3 + (3 + tt)) * 1024 + col];
                a += xv * F.w_conv[w * 1024 + col]; }
            const float sv = a * sigmoidf_(a);
            if (part == 0) sQ[t * 128 + d] = sv; else sKs[t * 128 + d] = sv * 0.08838834764831845f; }
        for (int i = tid; i < 1024; i += 512) sV[i] = bf2f(F.PROJ[(size_t)(r0 + (i >> 7)) * NPROJ + C_VB + h * 128 + (i & 127)]);
        if (tid < 128) sN0[tid] = F.st_n[(size_t)u * 128 + tid];
        if (tid == 0) {
            const float m0 = F.st_m[u]; float acc = 0.f, um = -INFINITY, cm = m0;
            for (int t = 0; t < 8; ++t) { acc += F.lf[(r0 + t) * 4 + h]; const float uu = F.ig[(r0 + t) * 4 + h] - acc; um = fmaxf(um, uu); cm = fmaxf(cm, uu);
                sS[t] = acc; sS[8 + t] = uu; sS[16 + t] = cm; sS[24 + t] = __expf(m0 - cm); }
            const float Mx = fmaxf(m0, um);
            for (int t = 0; t < 8; ++t) sS[32 + t] = __expf(sS[8 + t] - Mx);
            sS[40] = __expf(m0 - Mx);
            F.out[O_SM + u] = acc + Mx;
        }
        __syncthreads();
        if (tid < 64) { const int t = tid >> 3, s = tid & 7; float d = 0.f;
#pragma unroll 4
            for (int k = 0; k < 128; ++k) d += sQ[t * 128 + k] * sKs[s * 128 + k];
            sS[64 + tid] = (s <= t) ? d * __expf(sS[8 + s] - sS[16 + t]) : 0.f; }
        {
            const int e4 = opaque(tid & 31), dr = opaque(tid >> 5); const float alpha = sS[40];
            f32x4 vb[8], aq[8];
#pragma unroll
            for (int s2 = 0; s2 < 8; ++s2) { vb[s2] = *(const LAS f32x4*)(sV + s2 * 128 + 4 * e4) * sS[32 + s2]; aq[s2] = (f32x4){0.f, 0.f, 0.f, 0.f}; }
            f32x4 c0[8];
#pragma unroll
            for (int it = 0; it < 8; ++it) c0[it] = __builtin_nontemporal_load((const f32x4*)(F.st_C + ((size_t)u * 128 + it * 16 + dr) * 128 + 4 * e4));
#pragma unroll
            for (int it = 0; it < 8; ++it) { const int d = it * 16 + dr;
                f32x4 cn = c0[it] * alpha;
#pragma unroll
                for (int s2 = 0; s2 < 8; ++s2) { cn += vb[s2] * sKs[s2 * 128 + d]; aq[s2] += c0[it] * sQ[s2 * 128 + d]; }
                __builtin_nontemporal_store(cn, (f32x4*)(F.out + O_SC + ((size_t)u * 128 + d) * 128 + 4 * e4)); }
#pragma unroll
            for (int s2 = 0; s2 < 8; ++s2) *(LAS f32x4*)(sQC + (dr * 8 + s2) * 128 + 4 * e4) = aq[s2];
        }
        if (tid < 128) { float n = sS[40] * sN0[tid];
#pragma unroll
            for (int s = 0; s < 8; ++s) n += sS[32 + s] * sKs[s * 128 + tid];
            F.out[O_SN + (size_t)u * 128 + tid] = n; }
        __syncthreads();
        if (tid < 8) { const int t = tid; float qn = 0.f;
#pragma unroll 4
            for (int k = 0; k < 128; ++k) qn += sQ[t * 128 + k] * sN0[k];
            float den = sS[24 + t] * qn; for (int s = 0; s < 8; ++s) den += sS[64 + t * 8 + s];
            sS[48 + t] = fmaxf(fabsf(den), __expf(-(sS[t] + sS[16 + t]))); }
        __syncthreads();
        { const int e = tid & 127, tq = tid >> 7;
#pragma unroll
            for (int k = 0; k < 2; ++k) { const int t = tq * 2 + k;
                float qc = 0.f;
#pragma unroll
                for (int dr = 0; dr < 16; ++dr) qc += sQC[(dr * 8 + t) * 128 + e];
                float num = sS[24 + t] * qc;
#pragma unroll
                for (int s = 0; s < 8; ++s) num += sS[64 + t * 8 + s] * sV[s * 128 + e];
                sH[t * 128 + e] = num / sS[48 + t]; } }
        __syncthreads();
        { const int t = F.wave; const float h0 = sH[t * 128 + F.lane], h1 = sH[t * 128 + 64 + F.lane];
            const float ssq = wave_sum(h0 * h0 + h1 * h1); const float rs = 1.f / sqrtf(ssq * (1.f / 128.f) + EPS);
            const int row = r0 + t;
#pragma unroll
            for (int k = 0; k < 2; ++k) { const int e = F.lane + 64 * k; const float hv = k ? h1 : h0;
                const float ob = bf2f(F.PROJ[(size_t)row * NPROJ + C_OB + h * 128 + e]);
                F.MIX[(size_t)row * DM + 512 + h * 128 + e] = (bf16)f2bf(hv * rs * F.mhg[h * 128 + e] * sigmoidf_(ob)); } }
    }
}

__device__ __forceinline__ void p4_prefix_v1(Frame& F) {
    const int tid = F.tid;
    const int npw = (F.G >= 64) ? F.G - 16 : F.G;
    for (int u = F.vcu; u < 256; u += npw) {
        const int chain = u >> 4, sl = u & 15, idx = sl * 1024 + tid * 2;
        float m = 0.f, c0 = 0.f, c1 = 0.f, nn = 0.f;
        const bool nrow = (sl == 0 && tid < 128);
#pragma unroll 1
        for (int cb = 0; cb < 32; cb += 8) {
            float l0[8], l1[8], nl[8], bc[8], um8[8];
#pragma unroll
            for (int k = 0; k < 8; ++k) { const int unit = chain * 32 + cb + k;
                const float2 lv = *(const float2*)(F.L + (size_t)unit * 16384 + idx); l0[k] = lv.x; l1[k] = lv.y;
                nl[k] = nrow ? F.NLOC[unit * 128 + tid] : 0.f; bc[k] = F.chk[unit]; um8[k] = F.chk[512 + unit]; }
#pragma unroll
            for (int k = 0; k < 8; ++k) { const int unit = chain * 32 + cb + k;
                *(float2*)(F.CPRE + (size_t)unit * 16384 + idx) = make_float2(c0, c1);
                if (nrow) F.NPRE[unit * 128 + tid] = nn;
                if (sl == 0 && tid == 0) F.chk[1024 + unit] = m;
                const float Mx = fmaxf(m, um8[k]), a = __expf(m - Mx), bb = __expf(um8[k] - Mx);
                c0 = a * c0 + bb * l0[k]; c1 = a * c1 + bb * l1[k]; nn = a * nn + bb * nl[k];
                m = bc[k] + Mx; }
        }
        F.out[O_PC + (size_t)chain * 16384 + idx] = c0; F.out[O_PC + (size_t)chain * 16384 + idx + 1] = c1;
        if (sl == 0 && tid < 128) F.out[O_PN + chain * 128 + tid] = nn;
        if (sl == 0 && tid == 0) F.out[O_PM + chain] = m;
    }
}


__device__ __forceinline__ void probe_copy_simple(Frame& F) {
    constexpr int PER_B = (WBUF - DTS) * 128;
    const int total = DBS * PER_B;
    for (int i = F.vcu * 512 + F.tid; i < total; i += F.G * 512) {
        const int b = i / PER_B, r = i - b * PER_B;
        const size_t so = (size_t)b * (WBUF * 128) + DTS * 128 + r, dofs = (size_t)b * (WBUF * 128) + r;
        const f32x4 a = __builtin_nontemporal_load((const f32x4*)F.cache_k + so);
        const f32x4 c = __builtin_nontemporal_load((const f32x4*)F.cache_v + so);
        *((f32x4*)(F.out + O_SK) + dofs) = a;
        *((f32x4*)(F.out + O_SV) + dofs) = c;
    }
}

__device__ __forceinline__ void p9_final_norm(Frame& F, int m0) {
    const int gw = F.vcu * 8 + F.wave, NGW = F.G * 8;
    for (int m = m0 + gw; m < M; m += NGW) {
        f32x4* p = (f32x4*)(F.out + (size_t)m * DM);
        f32x4 v[4]; float ss = 0.f;
#pragma unroll
        for (int j = 0; j < 4; ++j) { v[j] = p[64 * j + F.lane]; ss += (v[j].x * v[j].x + v[j].y * v[j].y) + (v[j].z * v[j].z + v[j].w * v[j].w); }
        ss = wave_sum(ss);
        const float rs = 1.f / sqrtf(ss * (1.f / DM) + EPS);
#pragma unroll
        for (int j = 0; j < 4; ++j) { const f32x4 g = *(const f32x4*)(F.gf + 256 * j + 4 * F.lane); p[64 * j + F.lane] = v[j] * rs * g; }
    }
}

__device__ __forceinline__ void p4_convert_ffn(Frame& F, int iw, int nw) {
    LAS float* scr = (LAS float*)(F.lds + F.wave * 16384);
    constexpr int I_UP = 16 * 128, I_DN = 64 * 32;
    for (int it = iw * 8 + F.wave; it < I_UP + I_DN; it += nw * 8) {
        if (it < I_UP) p0_transpose_item(F.w_up, DM, FF, 128, F.g2, F.Wup_t, scr, it, F.lane);
        else p0_transpose_item(F.w_down, FF, DM, 32, nullptr, F.Wdn_t, scr, it - I_UP, F.lane);
    }
}

struct Args { const float* in[19]; float* out; unsigned char* ws; int ph_lo, ph_hi; };
__global__ void __launch_bounds__(512, 2) fwd(Args args) {
    extern __shared__ __attribute__((aligned(16))) unsigned char lds[];
    Frame F;
    F.lds = (LAS unsigned char*)lds;
    F.tid = threadIdx.x; F.lane = F.tid & 63; F.wave = __builtin_amdgcn_readfirstlane(F.tid >> 6);
    F.G = gridDim.x; { const int bx = blockIdx.x; F.vcu = (F.G % 8 == 0) ? (bx % 8) * (F.G / 8) + bx / 8 : bx; }
    F.xp = args.in[0]; F.xs = args.in[1]; F.cache_k = args.in[2]; F.cache_v = args.in[3]; F.st_conv = args.in[4]; F.st_C = args.in[5]; F.st_n = args.in[6]; F.st_m = args.in[7];
    F.g1 = args.in[8]; F.w_in = args.in[9]; F.b_gate = args.in[10]; F.w_conv = args.in[11]; F.b_conv = args.in[12]; F.mhg = args.in[13]; F.w_out = args.in[14]; F.g2 = args.in[15];
    F.w_up = args.in[16]; F.w_down = args.in[17]; F.gf = args.in[18];
    F.out = args.out; F.ws = args.ws;
    unsigned char* ws = args.ws;
    F.Win_t = (bf16*)(ws + WS_WIN); F.Wout_t = (bf16*)(ws + WS_WOUT); F.Wup_t = (bf16*)(ws + WS_WUP); F.Wdn_t = (bf16*)(ws + WS_WDN);
    F.XB = (bf16*)(ws + WS_XB); F.PROJ = (bf16*)(ws + WS_PROJ); F.MIX = (bf16*)(ws + WS_MIX); F.HPB = (bf16*)(ws + WS_HPB); F.ACT = (bf16*)(ws + WS_ACT);
    F.rope = (float*)(ws + WS_ROPE); F.rstd1 = (float*)(ws + WS_RSTD1); F.ig = (float*)(ws + WS_IG); F.lf = (float*)(ws + WS_LF); F.chk = (float*)(ws + WS_CHK);
    F.ss2 = (float*)(ws + WS_SS2); F.ssf = (float*)(ws + WS_SSF); F.QF = (float*)(ws + WS_QF); F.KF = (float*)(ws + WS_KF); F.L = (float*)(ws + WS_L);
    F.CPRE = (float*)(ws + WS_CPRE); F.NLOC = (float*)(ws + WS_NLOC); F.NPRE = (float*)(ws + WS_NPRE);
    volatile LAS unsigned* MISC = (volatile LAS unsigned*)(F.lds + MISC_OFF);
    if (F.tid < 32) MISC[F.tid] = 0u;
    __syncthreads();
    XcdBarrier bar; bar.bar = (unsigned*)(ws + WS_CTL) + CW_BAR; bar.x = 0; bar.st = nullptr;
    if (!PER_PHASE_LAUNCH) bar = xcd_barrier_post((unsigned*)(ws + WS_CTL) + CW_BAR, MISC + 8);
#define GRID_BAR() do { if (!PER_PHASE_LAUNCH) xcd_barrier(bar); } while (0)
    const int lo = args.ph_lo, hi = args.ph_hi;
#ifndef PHASE_MASK
#define PHASE_MASK 0x3ff
#endif
#define IN(k) (((PHASE_MASK >> (k)) & 1) && lo <= (k) && (k) < hi)
#ifndef DUP_MASK
#define DUP_MASK 0
#endif
#define DUP(k) ((DUP_MASK >> (k)) & 1)
    if (IN(0)) { p0_prologue(F); if (DUP(0)) { __syncthreads(); p0_prologue(F); } GRID_BAR(); }
    if (IN(1)) {
        pg8::Gemm g{F.XB, F.Win_t, M, NPROJ, DM, DM}; pg8::StaticOrder S; S.init(M, NPROJ, F.G, (int)blockIdx.x);
        pg8::EpiIn E{F.PROJ, F.rstd1, F.rope, F.out};
        pg8::gemm_phase<pg8::EpiIn, pg8::StaticOrder, true, true>(F.lds, g, S, E);
        if (DUP(1)) { __syncthreads(); pg8::gemm_phase<pg8::EpiIn, pg8::StaticOrder, true, true>(F.lds, g, S, E); }
        GRID_BAR();
    }
    if (IN(2)) { p2_attn_prompt_mfma(F); __syncthreads(); if (DUP(11)) { p2_attn_prompt_mfma(F); __syncthreads(); } p2_sample_stream(F); if (DUP(10)) { __syncthreads(); p2_sample_stream(F); } if (DUP(14)) { __syncthreads(); probe_copy_simple(F); } __syncthreads(); }
    if (IN(3)) { p3_mlstm_local_mfma(F); if (DUP(3)) { __syncthreads(); p3_mlstm_local_mfma(F); } p3_mlstm_sample(F); if (DUP(13)) { __syncthreads(); p3_mlstm_sample(F); } GRID_BAR(); }
    if (IN(4)) {
        if (F.G >= 64 && F.vcu >= F.G - 16) {
            pg8::Gemm g{F.MIX, F.Wout_t, M, DM, DM, DM}; pg8::RangeOrder S{MP / 256, MS / 256, DM / 256, 1, 0, 16, F.vcu - (F.G - 16)};
            pg8::EpiOut E{F.xp, F.xs, F.out, F.HPB, F.ss2};
            pg8::gemm_phase<pg8::EpiOut, pg8::RangeOrder, true, true>(F.lds, g, S, E);
            if (DUP(4)) { __syncthreads(); pg8::EpiScratch E2{(float*)(F.ws + WS_SCR)}; pg8::gemm_phase<pg8::EpiScratch, pg8::RangeOrder, true, true>(F.lds, g, S, E2); }
        } else { p4_prefix_v1(F); if (DUP(4)) { __syncthreads(); p4_prefix_v1(F); } __syncthreads(); p4_convert_ffn(F, F.vcu, (F.G >= 64) ? F.G - 16 : F.G); }
        GRID_BAR();
    }
    if (IN(5)) { p5_mlstm_out_mfma(F); if (DUP(5)) { __syncthreads(); p5_mlstm_out_mfma(F); } GRID_BAR(); }
    if (IN(6)) {
        pg8::Gemm g{F.MIX, F.Wout_t, MP, DM, DM, DM}; pg8::StaticOrder S; S.init(MP, DM, F.G, (int)blockIdx.x);
        pg8::EpiOut E{F.xp, F.xs, F.out, F.HPB, F.ss2};
        pg8::gemm_phase<pg8::EpiOut, pg8::StaticOrder, true, true>(F.lds, g, S, E);
        if (DUP(6)) { __syncthreads(); pg8::EpiScratch E2{(float*)(F.ws + WS_SCR)}; pg8::gemm_phase<pg8::EpiScratch, pg8::StaticOrder, true, true>(F.lds, g, S, E2); }
        GRID_BAR();
    }
    if (IN(7)) {
        pg8::Gemm g{F.HPB, F.Wup_t, M, FF, DM, DM}; pg8::StaticOrder S; S.init(M, FF, F.G, (int)blockIdx.x);
        pg8::EpiUp E{F.ACT, F.ss2};
        pg8::gemm_phase<pg8::EpiUp, pg8::StaticOrder, true, true>(F.lds, g, S, E);
        if (DUP(7)) { __syncthreads(); pg8::gemm_phase<pg8::EpiUp, pg8::StaticOrder, true, true>(F.lds, g, S, E); }
        GRID_BAR();
    }
    if (IN(8)) {
        {
            pg8::Gemm g{F.ACT, F.Wdn_t, MP, DM, FF, FF}; pg8::StaticOrder S; S.init(MP, DM, F.G, (int)blockIdx.x);
            if (F.G == 256) { pg8::EpiDownNorm E{F.out, F.ssf, (unsigned*)(F.ws + WS_PCNT), F.gf};
                pg8::gemm_phase<pg8::EpiDownNorm, pg8::StaticOrder, true, true>(F.lds, g, S, E); }
            else { pg8::EpiDown<false> E{F.out};
                pg8::gemm_phase<pg8::EpiDown<false>, pg8::StaticOrder, true, true>(F.lds, g, S, E); }
        }
        if (DUP(8)) { __syncthreads(); pg8::Gemm g{F.ACT, F.Wdn_t, MP, DM, FF, FF}; pg8::StaticOrder S; S.init(MP, DM, F.G, (int)blockIdx.x);
            pg8::EpiScratch E{(float*)(F.ws + WS_SCR)}; pg8::gemm_phase<pg8::EpiScratch, pg8::StaticOrder, true, true>(F.lds, g, S, E); }
        {
            pg8::Gemm g{F.ACT, F.Wdn_t, M, DM, DM, FF}; pg8::RangeOrder S{MP / 256, MS / 256, DM / 256, 4, 1024, F.G, F.vcu};
            pg8::EpiDown<true> E{F.out};
            pg8::gemm_phase<pg8::EpiDown<true>, pg8::RangeOrder, true, true>(F.lds, g, S, E);
        }
        GRID_BAR();
    }
    if (DUP(15)) { for (int k = 0; k < 8; ++k) GRID_BAR(); }
    if (IN(9)) { p9_final_norm(F, (F.G == 256) ? MP : 0); if (DUP(9)) { const int gw = F.vcu * 8 + F.wave, NGW = F.G * 8; for (int m = gw; m < M; m += NGW) { const f32x4* p = (const f32x4*)(F.out + (size_t)m * DM); f32x4* q = (f32x4*)(F.ws + WS_SCR) + (size_t)m * 256; f32x4 v[4]; float ss = 0.f;
#pragma unroll
        for (int j = 0; j < 4; ++j) { v[j] = p[64 * j + F.lane]; ss += v[j].x * v[j].x + v[j].y * v[j].y + v[j].z * v[j].z + v[j].w * v[j].w; }
        ss = wave_sum(ss); const float rs = 1.f / sqrtf(ss * (1.f / DM) + EPS);
#pragma unroll
        for (int j = 0; j < 4; ++j) q[64 * j + F.lane] = v[j] * rs; } } }
#undef IN
}

extern "C" void kernel_launch(void* const* d_in, const int* in_sizes, int n_in, void* d_out, int out_size, void* d_ws, size_t ws_size, hipStream_t stream) {
    static int grid = 0;
    if (grid == 0) {
        if (n_in != 19 || (size_t)out_size != O_END || ws_size < WS_END) { fprintf(stderr, "kernel_launch: unexpected shapes (n_in %d out %d ws %zu)\n", n_in, out_size, ws_size); grid = -1; return; }
        int dev = 0, cus = 0, per_cu = 0;
        if (hipGetDevice(&dev) != hipSuccess || hipDeviceGetAttribute(&cus, hipDeviceAttributeMultiprocessorCount, dev) != hipSuccess) { grid = -1; return; }
        if (hipFuncSetAttribute((const void*)fwd, hipFuncAttributeMaxDynamicSharedMemorySize, LDS_BYTES) != hipSuccess) { fprintf(stderr, "kernel_launch: hipFuncSetAttribute failed\n"); grid = -1; return; }
        if (hipOccupancyMaxActiveBlocksPerMultiprocessor(&per_cu, (const void*)fwd, 512, LDS_BYTES) != hipSuccess || per_cu < 1) fprintf(stderr, "kernel_launch: occupancy query says %d\n", per_cu);
        (void)hipGetLastError();
        grid = cus;
    }
    if (grid < 0) return;
    if (hipMemsetAsync((char*)d_ws + WS_CTL, 0, CTL_ZERO_BYTES, stream) != hipSuccess) return;
    Args a{};
    for (int i = 0; i < 19; ++i) a.in[i] = (const float*)d_in[i];
    a.out = (float*)d_out; a.ws = (unsigned char*)d_ws;
#if PER_PHASE_LAUNCH
    for (int ph = 0; ph < NPH; ++ph) { a.ph_lo = ph; a.ph_hi = ph + 1; hipLaunchKernelGGL(fwd, dim3(grid), dim3(512), LDS_BYTES, stream, a); }
#else
    a.ph_lo = 0; a.ph_hi = NPH; hipLaunchKernelGGL(fwd, dim3(grid), dim3(512), LDS_BYTES, stream, a);
#endif
}
```

```cpp
#include <hip/hip_runtime.h>
#include <cstdio>
#include <cstdint>
namespace pg8 {
#define PG8_LAS __attribute__((address_space(3)))
typedef unsigned short bf16_t;
typedef short bf16x8 __attribute__((ext_vector_type(8)));
typedef float f32x4 __attribute__((ext_vector_type(4)));
typedef unsigned u32x4 __attribute__((ext_vector_type(4)));
constexpr int BM = 256, BK = 64, HALF = 128, HTB = HALF * BK * 2  , STAGE_BYTES = 8 * HTB, NXCD = 8, WGM = 8;

__host__ __device__ __forceinline__ int lds_byte(int r, int c) { const int st = (r >> 4) * 2 + (c >> 5), rr = r & 15, cc = c & 31, ob = rr * 64 + cc * 2; return st * 1024 + (ob ^ (((ob >> 9) & 1) << 5)); }
__host__ __device__ __forceinline__ void stage_rc(int b, int& R, int& C) { const int st = b / 1024, sb = b % 1024, swz = sb ^ (((sb >> 9) & 1) << 5); R = (st >> 1) * 16 + swz / 64; C = (st & 1) * 32 + (swz % 64) / 2; }
__host__ __device__ __forceinline__ int perm32(int rho) { const int n = rho >> 4, i = rho & 15; return 8 * (i >> 2) + 4 * n + (i & 3); }

struct Unit { int pm, pn, k0; };
struct Gemm { const bf16_t* A; const bf16_t* Bt; int M, N, K, ld; };

struct StaticOrder {
    int nM, nN, nwg, G, c;
    __host__ __device__ void init(int M, int N, int G_, int c_) { nM = M / BM; nN = N / BM; nwg = nM * nN; G = G_; c = c_; }
    __host__ __device__ bool next(int i, Unit& u) const {
        const long L = (long)i * G + c; if (L >= nwg) return false;
        int wgid = (int)L; { const int q = nwg / NXCD, r = nwg % NXCD, xcd = wgid % NXCD, off = wgid / NXCD; wgid = (xcd < r ? xcd * (q + 1) : r * (q + 1) + (xcd - r) * q) + off; }
        const int nig = WGM * nN, gid = wgid / nig, fm = gid * WGM, gsz = (nM - fm) < WGM ? (nM - fm) : WGM;
        u.pm = fm + ((wgid % nig) % gsz); u.pn = (wgid % nig) / gsz; u.k0 = 0; return true;
    }
    __device__ __forceinline__ void a_ready(const Unit&) const {}
    __device__ __forceinline__ void done(const Unit&) const {}
};

__device__ __forceinline__ unsigned cvt_pk_bf16(float lo, float hi) { unsigned r; asm volatile("v_cvt_pk_bf16_f32 %0, %1, %2" : "=v"(r) : "v"(lo), "v"(hi)); return r; }
typedef float f32x2 __attribute__((ext_vector_type(2)));

template <class Epi, class Sched, bool ALIGN_EPI = false, bool SP2 = false>
__device__ __forceinline__ void gemm_phase(PG8_LAS unsigned char* lds, const Gemm g, const Sched& S, const Epi& E) {
    const int tid = threadIdx.x, wid = __builtin_amdgcn_readfirstlane(tid >> 6), lane = tid & 63, wr = wid >> 2, wc = wid & 3, fr = lane & 15, fq = lane >> 4;
    const int K = g.K, nt = K / BK, LD = g.ld;
    unsigned voffA[2], voffB[2];
#pragma unroll
    for (int i = 0; i < 2; ++i) { int R, C; stage_rc(tid * 16 + i * 8192, R, C); const int Rb = Epi::PERM ? ((R & ~31) + perm32(R & 31)) : R;
        voffA[i] = (unsigned)(R * LD + C) * 2u; voffB[i] = (unsigned)(Rb * LD + C) * 2u; }
    const size_t kstep = (size_t)(BK * 2);
    const size_t hstep = (size_t)HALF * LD * 2;
    const size_t tstep = 2 * hstep;
    const unsigned ldsw = (unsigned)wid * 1024u;
    const int aoff = lds_byte(wr * 64 + fr, fq * 8), boff = lds_byte(wc * 32 + fr, fq * 8);
#define PG8_SA(b, h) (((b) * 2 + (h)) * HTB)
#define PG8_SB(b, h) ((4 + (b) * 2 + (h)) * HTB)
#define PG8_STAGE(bufoff, gbase, voff) do { _Pragma("unroll") for (int _i = 0; _i < 2; ++_i) \
        __builtin_amdgcn_global_load_lds((const unsigned*)((const char*)(gbase) + (voff)[_i]), (PG8_LAS unsigned*)(lds + (bufoff) + ldsw + _i * 8192), 16, 0, 0); } while (0)
#define PG8_LDA(dst, b, h) do { _Pragma("unroll") for (int m = 0; m < 4; ++m) _Pragma("unroll") for (int k = 0; k < 2; ++k) dst[m][k] = *(const PG8_LAS bf16x8*)(lds + PG8_SA(b, h) + aoff + m * 2048 + k * 1024); } while (0)
#define PG8_LDB(dst, b, h) do { _Pragma("unroll") for (int n = 0; n < 2; ++n) _Pragma("unroll") for (int k = 0; k < 2; ++k) dst[n][k] = *(const PG8_LAS bf16x8*)(lds + PG8_SB(b, h) + boff + n * 2048 + k * 1024); } while (0)
#define PG8_MMA(ai, bj, At, Bt) do { __builtin_amdgcn_s_setprio(1); _Pragma("unroll") for (int m = 0; m < 4; ++m) _Pragma("unroll") for (int n = 0; n < 2; ++n) _Pragma("unroll") for (int k = 0; k < 2; ++k) \
        acc[ai][bj][m][n] = __builtin_amdgcn_mfma_f32_16x16x32_bf16(Bt[n][k], At[m][k], acc[ai][bj][m][n], 0, 0, 0); __builtin_amdgcn_s_setprio(0); } while (0)
#define PG8_WAIT_V(n) asm volatile("s_waitcnt vmcnt(" #n ")" ::: "memory")
#define PG8_WAIT_L(n) asm volatile("s_waitcnt lgkmcnt(" #n ")" ::: "memory")
#define PG8_BAR __builtin_amdgcn_s_barrier()
#define PG8_SCHED __builtin_amdgcn_sched_barrier(0)
    Unit cur, nxt; int ui = 0;
    if (!S.next(0, cur)) return;
    f32x4 acc[2][2][4][2];
#pragma unroll
    for (int a = 0; a < 2; ++a)
#pragma unroll
        for (int b = 0; b < 2; ++b)
#pragma unroll
            for (int m = 0; m < 4; ++m)
#pragma unroll
                for (int n = 0; n < 2; ++n) acc[a][b][m][n] = (f32x4){0.f, 0.f, 0.f, 0.f};
    bf16x8 At[4][2], B0[2][2], B1[2][2];
    const char* cA = (const char*)g.A + (size_t)cur.pm * tstep + (size_t)cur.k0 * 2; const char* cB = (const char*)g.Bt + (size_t)cur.pn * tstep + (size_t)cur.k0 * 2;
    S.a_ready(cur);
    if constexpr (SP2) {
        PG8_STAGE(PG8_SB(0, 0), cB, voffB); PG8_STAGE(PG8_SB(0, 1), cB + hstep, voffB); PG8_STAGE(PG8_SA(0, 0), cA, voffA); PG8_STAGE(PG8_SA(0, 1), cA + hstep, voffA);
        if (wr == 1) PG8_BAR;
        PG8_WAIT_V(2); PG8_BAR;
        PG8_STAGE(PG8_SB(1, 0), cB + kstep, voffB); PG8_STAGE(PG8_SA(1, 0), cA + kstep, voffA); PG8_STAGE(PG8_SB(1, 1), cB + hstep + kstep, voffB);
        PG8_WAIT_V(6); PG8_BAR;
    } else {
        PG8_STAGE(PG8_SB(0, 0), cB, voffB); PG8_STAGE(PG8_SA(0, 0), cA, voffA); PG8_STAGE(PG8_SB(0, 1), cB + hstep, voffB); PG8_STAGE(PG8_SA(0, 1), cA + hstep, voffA);
        if (wr == 1) PG8_BAR;
        PG8_WAIT_V(4); PG8_BAR;
        PG8_STAGE(PG8_SB(1, 0), cB + kstep, voffB); PG8_STAGE(PG8_SA(1, 0), cA + kstep, voffA); PG8_STAGE(PG8_SB(1, 1), cB + hstep + kstep, voffB);
        PG8_WAIT_V(6); PG8_BAR;
    }
    for (;;) {
        const bool has_next = S.next(ui + 1, nxt);
        const char* nA = has_next ? (const char*)g.A + (size_t)nxt.pm * tstep + (size_t)nxt.k0 * 2 : cA; const char* nB = has_next ? (const char*)g.Bt + (size_t)nxt.pn * tstep + (size_t)nxt.k0 * 2 : cB;
        for (int t = 0; t < nt; t += 2) {
            const bool last = (t == nt - 2);
            const char* a1 = cA + (size_t)(t + 1) * kstep;
            const char* a2 = last ? nA : cA + (size_t)(t + 2) * kstep; const char* b2 = last ? nB : cB + (size_t)(t + 2) * kstep;
            const char* a3 = a2 + kstep; const char* b3 = b2 + kstep;
            if (last && has_next) S.a_ready(nxt);
            if constexpr (SP2) {
            PG8_LDB(B0, 0, 0); PG8_LDB(B1, 0, 1); PG8_SCHED; PG8_LDA(At, 0, 0); PG8_STAGE(PG8_SA(1, 1), a1 + hstep, voffA);
            PG8_WAIT_V(8); PG8_WAIT_L(0); PG8_BAR; PG8_MMA(0, 0, At, B0); PG8_MMA(0, 1, At, B1); PG8_BAR; PG8_SCHED;
            PG8_LDA(At, 0, 1); PG8_STAGE(PG8_SB(0, 0), b2, voffB); PG8_STAGE(PG8_SB(0, 1), b2 + hstep, voffB); PG8_STAGE(PG8_SA(0, 0), a2, voffA);
            PG8_WAIT_V(8); PG8_WAIT_L(0); PG8_BAR; PG8_MMA(1, 0, At, B0); PG8_MMA(1, 1, At, B1); PG8_BAR; PG8_SCHED;
            PG8_LDB(B0, 1, 0); PG8_LDB(B1, 1, 1); PG8_SCHED; PG8_LDA(At, 1, 0); PG8_STAGE(PG8_SA(0, 1), a2 + hstep, voffA);
            PG8_WAIT_V(8); PG8_WAIT_L(0); PG8_BAR; PG8_MMA(0, 0, At, B0); PG8_MMA(0, 1, At, B1); PG8_BAR; PG8_SCHED;
            PG8_LDA(At, 1, 1); PG8_STAGE(PG8_SB(1, 0), b3, voffB); PG8_STAGE(PG8_SB(1, 1), b3 + hstep, voffB); PG8_STAGE(PG8_SA(1, 0), a3, voffA);
            PG8_WAIT_V(8); PG8_WAIT_L(0); PG8_BAR; PG8_MMA(1, 0, At, B0); PG8_MMA(1, 1, At, B1); PG8_BAR; PG8_SCHED;
            } else {
            PG8_LDB(B0, 0, 0); PG8_SCHED; PG8_LDA(At, 0, 0); PG8_STAGE(PG8_SA(1, 1), a1 + hstep, voffA);
            PG8_WAIT_L(8); PG8_BAR; PG8_WAIT_L(0); PG8_MMA(0, 0, At, B0); PG8_BAR; PG8_SCHED;
            PG8_LDB(B1, 0, 1); PG8_STAGE(PG8_SB(0, 0), b2, voffB);
            PG8_BAR; PG8_WAIT_L(0); PG8_MMA(0, 1, At, B1); PG8_BAR;
            PG8_LDA(At, 0, 1); PG8_STAGE(PG8_SA(0, 0), a2, voffA);
            PG8_BAR; PG8_WAIT_L(0); PG8_MMA(1, 0, At, B0); PG8_BAR; PG8_SCHED;
            PG8_STAGE(PG8_SB(0, 1), b2 + hstep, voffB);
            PG8_WAIT_V(6); PG8_BAR; PG8_MMA(1, 1, At, B1); PG8_BAR;
            PG8_LDB(B0, 1, 0); PG8_SCHED; PG8_LDA(At, 1, 0); PG8_STAGE(PG8_SA(0, 1), a2 + hstep, voffA);
            PG8_WAIT_L(8); PG8_BAR; PG8_WAIT_L(0); PG8_MMA(0, 0, At, B0); PG8_BAR; PG8_SCHED;
            PG8_LDB(B1, 1, 1); PG8_STAGE(PG8_SB(1, 0), b3, voffB);
            PG8_BAR; PG8_WAIT_L(0); PG8_MMA(0, 1, At, B1); PG8_BAR;
            PG8_LDA(At, 1, 1); PG8_STAGE(PG8_SA(1, 0), a3, voffA);
            PG8_BAR; PG8_WAIT_L(0); PG8_MMA(1, 0, At, B0); PG8_BAR; PG8_SCHED;
            PG8_STAGE(PG8_SB(1, 1), b3 + hstep, voffB);
            PG8_WAIT_V(6); PG8_BAR; PG8_MMA(1, 1, At, B1); PG8_BAR;
            }
        }
        if constexpr (ALIGN_EPI) { if (wr == 0) PG8_BAR; }
        if constexpr (!Epi::AFTER_DRAIN) { E(acc, cur, wr, wc, fr, fq); S.done(cur); }
        if (!has_next) break;
#pragma unroll
        for (int a = 0; a < 2; ++a)
#pragma unroll
            for (int b = 0; b < 2; ++b)
#pragma unroll
                for (int m = 0; m < 4; ++m)
#pragma unroll
                    for (int n = 0; n < 2; ++n) acc[a][b][m][n] = (f32x4){0.f, 0.f, 0.f, 0.f};
        cur = nxt; cA = nA; cB = nB; ++ui;
        if constexpr (ALIGN_EPI) { if (wr == 1) PG8_BAR; }
    }
    PG8_WAIT_V(0);
    if constexpr (!ALIGN_EPI) { if (wr == 0) PG8_BAR; }
    PG8_BAR;
    if constexpr (Epi::AFTER_DRAIN) { E.fused(acc, cur, wr, wc, fr, fq, lds, wid, lane); S.done(cur); }
#undef PG8_SA
#undef PG8_SB
#undef PG8_STAGE
#undef PG8_LDA
#undef PG8_LDB
#undef PG8_MMA
#undef PG8_WAIT_V
#undef PG8_WAIT_L
#undef PG8_BAR
#undef PG8_SCHED
}
}

#ifndef PER_PHASE_LAUNCH
#define PER_PHASE_LAUNCH 0
#endif

constexpr int DM = 1024, NBP = 4, SEQ = 4096, DBS = 128, DTS = 8;
constexpr int MP = NBP * SEQ, MS = DBS * DTS, M = MP + MS;
constexpr int NPROJ = 3584, INCOLS = 3592, FF = 4096, WBUF = 2048;
constexpr int C_Q = 0, C_K = 512, C_V = 1024, C_RAW = 1536, C_VB = 2560, C_OB = 3072;
constexpr float EPS = 1e-6f;
constexpr int NPH = 10;
constexpr size_t O_YP = 0, O_YS = O_YP + (size_t)MP * DM, O_PK = O_YS + (size_t)MS * DM, O_PV = O_PK + (size_t)NBP * WBUF * 512,
    O_PCONV = O_PV + (size_t)NBP * WBUF * 512, O_PC = O_PCONV + (size_t)NBP * 3 * 1024, O_PN = O_PC + (size_t)NBP * 4 * 128 * 128, O_PM = O_PN + (size_t)NBP * 4 * 128,
    O_SK = O_PM + (size_t)NBP * 4, O_SV = O_SK + (size_t)DBS * WBUF * 512, O_SCONV = O_SV + (size_t)DBS * WBUF * 512, O_SC = O_SCONV + (size_t)DBS * 3 * 1024,
    O_SN = O_SC + (size_t)DBS * 4 * 128 * 128, O_SM = O_SN + (size_t)DBS * 4 * 128, O_END = O_SM + (size_t)DBS * 4;
static_assert(O_END == 303774224ull, "output size");
constexpr size_t MiB = 1u << 20;
constexpr size_t WS_CTL = 0, CTL_ZERO_BYTES = 192 * 1024;
constexpr int CW_BAR = 4096;
constexpr size_t WS_CLAIM = 32 * 1024, WS_CPY = 64 * 1024, WS_PCNT = 128 * 1024, WS_SS2 = 256 * 1024, WS_SSF = 512 * 1024;
constexpr size_t WS_WIN = 2 * MiB, WS_WOUT = 10 * MiB, WS_WUP = 12 * MiB, WS_WDN = 20 * MiB;
constexpr size_t WS_ROPE = 28 * MiB, WS_RSTD1 = 29 * MiB, WS_IG = 29 * MiB + 512 * 1024, WS_LF = 30 * MiB, WS_CHK = 31 * MiB;
constexpr size_t WS_XB = 32 * MiB, WS_PROJ = 68 * MiB, WS_MIX = 188 * MiB, WS_HPB = 222 * MiB, WS_ACT = 256 * MiB;
constexpr size_t WS_QF = 392 * MiB, WS_KF = 426 * MiB, WS_L = 460 * MiB, WS_CPRE = 492 * MiB, WS_NLOC = 524 * MiB, WS_NPRE = 525 * MiB, WS_DUMMY = 526 * MiB, WS_SCR = 544 * MiB, WS_PART = 616 * MiB, WS_SS2P = 648 * MiB, WS_SSFP = 650 * MiB, WS_END = 651 * MiB;
static_assert(WS_PROJ + (size_t)M * NPROJ * 2 <= WS_MIX && WS_ACT + (size_t)M * FF * 2 <= WS_QF && WS_XB + (size_t)M * DM * 2 <= WS_PROJ, "ws map");

constexpr int LDS_BYTES = 147456;
constexpr int MISC_OFF = 131072 + 8192;

#define GAS __attribute__((address_space(1)))
#define LAS __attribute__((address_space(3)))
typedef unsigned short bf16;
typedef unsigned v4u __attribute__((ext_vector_type(4)));
typedef unsigned v2u __attribute__((ext_vector_type(2)));
typedef float f32x4 __attribute__((ext_vector_type(4)));
typedef GAS unsigned gu32;
#define LDS_WAIT() asm volatile("s_waitcnt lgkmcnt(0)" ::: "memory")
__device__ __forceinline__ unsigned f2bf(float f) { unsigned u = __builtin_bit_cast(unsigned, f); return (u + 0x7fffu + ((u >> 16) & 1u)) >> 16; }
typedef float f32x2_t __attribute__((ext_vector_type(2))); typedef __bf16 bf16x2_t __attribute__((ext_vector_type(2)));
__device__ __forceinline__ unsigned pk2(float lo, float hi) { f32x2_t v = {lo, hi}; bf16x2_t b = __builtin_convertvector(v, bf16x2_t); return __builtin_bit_cast(unsigned, b); }
__device__ __forceinline__ float bf2f(unsigned short u) { return __builtin_bit_cast(float, (unsigned)u << 16); }
__device__ __forceinline__ float bflo(unsigned u) { return __builtin_bit_cast(float, u << 16); }
__device__ __forceinline__ float bfhi(unsigned u) { return __builtin_bit_cast(float, u & 0xffff0000u); }
__device__ __forceinline__ float wave_sum(float v) {
#pragma unroll
    for (int o = 1; o < 64; o <<= 1) v += __shfl_xor(v, o);
    return v;
}
__device__ __forceinline__ float wave_max(float v) {
#pragma unroll
    for (int o = 1; o < 64; o <<= 1) v = fmaxf(v, __shfl_xor(v, o));
    return v;
}
__device__ __forceinline__ int opaque(int v) { asm volatile("" : "+v"(v)); return v; }
__device__ __forceinline__ float sigmoidf_(float x) { return __builtin_amdgcn_rcpf(1.f + __expf(-x)); }

#define XB_TMO      128
#define XB_XCNT(j)  (256  + 64 * (j))
#define XB_XSUB(j)  (1280 + 64 * (j))
#define XB_XGEN(j)  (2304 + 64 * (j))
#define XB_TOP      3328
#define XB_TOPGEN   3392
#define XCD_BAR_WORDS 3456
#define XB_SPIN_CAP (1u << 18)
__device__ __forceinline__ unsigned xb_ld(unsigned* p)              { return __hip_atomic_load(p, __ATOMIC_RELAXED, __HIP_MEMORY_SCOPE_AGENT); }
__device__ __forceinline__ unsigned xb_add(unsigned* p, unsigned v) { return __hip_atomic_fetch_add(p, v, __ATOMIC_RELAXED, __HIP_MEMORY_SCOPE_AGENT); }
__device__ __forceinline__ unsigned xb_xcc_id() { return (unsigned)__builtin_amdgcn_s_getreg((3 << 11) | 20) & 0xFu; }
#define XB_SPIN(cond, bar) do { unsigned _sp = 0; while (cond) { __builtin_amdgcn_s_sleep(1); \
    if ((++_sp & 255u) == 0u) { if (xb_ld(&(bar)[XB_TMO])) break; if (_sp > XB_SPIN_CAP) { atomicAdd(&(bar)[XB_TMO], 1u); break; } } } } while (0)
struct XcdBarrier { unsigned* bar; unsigned x; volatile LAS unsigned* st; };
__device__ __forceinline__ XcdBarrier xcd_barrier_post(unsigned* bar, volatile LAS unsigned* st) {
    XcdBarrier b; b.bar = bar; b.x = xb_xcc_id(); b.st = st;
    if (threadIdx.x == 0) (void)xb_add(&bar[XB_XCNT(b.x)], 1u);
    return b;
}
__device__ __forceinline__ void xcd_barrier_complete(unsigned* bar, unsigned x, unsigned& nloc, unsigned& nx) {
    const unsigned G = gridDim.x * gridDim.y * gridDim.z;
    unsigned sum, cnt, mine, sp = 0u;
    for (;;) {
        sum = 0u; cnt = 0u; mine = 0u;
#pragma unroll
        for (unsigned j = 0; j < 16; ++j) { const unsigned c = xb_ld(&bar[XB_XCNT(j)]); sum += c; cnt += (c > 0u) ? 1u : 0u; mine = (j == x) ? c : mine; }
        if (sum == G) break;
        __builtin_amdgcn_s_sleep(1);
        if ((++sp & 255u) == 0u) { if (xb_ld(&bar[XB_TMO])) break; if (sp > XB_SPIN_CAP) { atomicAdd(&bar[XB_TMO], 1u); break; } }
    }
    nloc = mine > 0u ? mine : 1u; nx = cnt > 0u ? cnt : 1u;
}
__device__ __forceinline__ void xcd_barrier(const XcdBarrier& b) {
    asm volatile("s_waitcnt vmcnt(0)" ::: "memory");
    __syncthreads();
    if (threadIdx.x == 0) {
        unsigned* bar = b.bar;
        __builtin_amdgcn_s_waitcnt(0);
        unsigned nloc = b.st[0], nx = b.st[1];
        if (nloc == 0u) { xcd_barrier_complete(bar, b.x, nloc, nx); b.st[0] = nloc; b.st[1] = nx; }
        const unsigned old = xb_add(&bar[XB_XSUB(b.x)], 1u);
        const unsigned gen = old / nloc;
        if (old + 1u == (gen + 1u) * nloc) {
            __builtin_amdgcn_fence(__ATOMIC_RELEASE, "agent");
            asm volatile("s_waitcnt vmcnt(0)" ::: "memory");
            const unsigned og = xb_add(&bar[XB_TOP], 1u);
            const unsigned tg = og / nx;
            if (og + 1u == (tg + 1u) * nx) xb_add(&bar[XB_TOPGEN], 1u);
            else XB_SPIN(xb_ld(&bar[XB_TOPGEN]) == tg, bar);
            __builtin_amdgcn_fence(__ATOMIC_ACQUIRE, "agent");
            xb_add(&bar[XB_XGEN(b.x)], 1u);
            asm volatile("s_waitcnt vmcnt(0)" ::: "memory");
        } else {
            XB_SPIN(xb_ld(&bar[XB_XGEN(b.x)]) == gen, bar);
            __builtin_amdgcn_fence(__ATOMIC_ACQUIRE, "agent");
            asm volatile("s_waitcnt vmcnt(0)" ::: "memory");
        }
    }
    __syncthreads();
}

struct Frame {
    LAS unsigned char* lds;
    int tid, lane, wave, vcu, G;
    const float *xp, *xs, *cache_k, *cache_v, *st_conv, *st_C, *st_n, *st_m, *g1, *w_in, *b_gate, *w_conv, *b_conv, *mhg, *w_out, *g2, *w_up, *w_down, *gf;
    float* out; unsigned char* ws;
    bf16 *Win_t, *Wout_t, *Wup_t, *Wdn_t, *XB, *PROJ, *MIX, *HPB, *ACT;
    float *rope, *rstd1, *ig, *lf, *chk, *ss2, *ssf, *QF, *KF, *L, *CPRE, *NLOC, *NPRE;
};

namespace pg8 {
struct EpiIn {
    static constexpr bool PERM = true, AFTER_DRAIN = false;
    bf16_t* proj; const float* rstd; const float* rope; float* out;
    __device__ __forceinline__ void operator()(const f32x4 (&acc)[2][2][4][2], const Unit& u, int wr, int wc, int fr, int fq) const {
        const int pn = u.pn;
        const bool rot = (pn < 4) && ((wc & 1) == 0);
#pragma unroll
        for (int ai = 0; ai < 2; ++ai)
#pragma unroll
            for (int m = 0; m < 4; ++m) {
                const int row = u.pm * BM + ai * HALF + wr * 64 + m * 16 + fr;
                const float rs = rstd[row];
                const bool smp = row >= MP;
                const int b = smp ? ((row - MP) >> 3) : (row >> 12), t = smp ? ((row - MP) & 7) : (row & 4095);
                const int pidx = smp ? (SEQ + t) : t;
#pragma unroll
                for (int bj = 0; bj < 2; ++bj) {
                    const int col0 = pn * BM + bj * HALF + wc * 32 + 8 * fq;
                    f32x4 v0 = acc[ai][bj][m][0] * rs, v1 = acc[ai][bj][m][1] * rs;
                    if (rot) {
                        f32x4 p0, p1;
                        p0.x = __shfl_xor(v0.x, 16); p0.y = __shfl_xor(v0.y, 16); p0.z = __shfl_xor(v0.z, 16); p0.w = __shfl_xor(v0.w, 16);
                        p1.x = __shfl_xor(v1.x, 16); p1.y = __shfl_xor(v1.y, 16); p1.z = __shfl_xor(v1.z, 16); p1.w = __shfl_xor(v1.w, 16);
                        if (fq < 2) {
                            const f32x4 c0 = *(const f32x4*)(rope + pidx * 16), c1 = *(const f32x4*)(rope + pidx * 16 + 4);
                            const f32x4 s0 = *(const f32x4*)(rope + pidx * 16 + 8), s1 = *(const f32x4*)(rope + pidx * 16 + 12);
                            if (fq == 0) { v0 = v0 * c0 - p0 * s0; v1 = v1 * c1 - p1 * s1; }
                            else         { v0 = v0 * c0 + p0 * s0; v1 = v1 * c1 + p1 * s1; }
                        }
                    }
                    if (pn < 2) { v0 = v0 * 0.125f; v1 = v1 * 0.125f; }
                    u32x4 w; w.x = cvt_pk_bf16(v0[0], v0[1]); w.y = cvt_pk_bf16(v0[2], v0[3]); w.z = cvt_pk_bf16(v1[0], v1[1]); w.w = cvt_pk_bf16(v1[2], v1[3]);
                    *(u32x4*)(proj + (size_t)row * NPROJ + col0) = w;
                    if (pn >= 2 && pn < 6) {
                        const bool isk = pn < 4; const int cc = col0 - (isk ? C_K : C_V);
                        float* dst = nullptr;
                        if (smp) dst = out + (isk ? O_SK : O_SV) + ((size_t)b * WBUF + (WBUF - DTS) + t) * 512 + cc;
                        else if (t >= SEQ - WBUF) dst = out + (isk ? O_PK : O_PV) + ((size_t)b * WBUF + (t - (SEQ - WBUF))) * 512 + cc;
                        if (dst) { __builtin_nontemporal_store(v0, (f32x4*)dst); __builtin_nontemporal_store(v1, (f32x4*)(dst + 4)); }
                    } else if (pn >= 6 && pn < 10) {
                        const int cc = col0 - C_RAW;
                        float* dst = nullptr;
                        if (smp) { if (t >= DTS - 3) dst = out + O_SCONV + ((size_t)b * 3 + (t - (DTS - 3))) * 1024 + cc; }
                        else if (t >= SEQ - 3) dst = out + O_PCONV + ((size_t)b * 3 + (t - (SEQ - 3))) * 1024 + cc;
                        if (dst) { __builtin_nontemporal_store(v0, (f32x4*)dst); __builtin_nontemporal_store(v1, (f32x4*)(dst + 4)); }
                    }
                }
            }
    }
};
template <bool F32OUT> struct EpiOut {
    static constexpr bool PERM = true, AFTER_DRAIN = false;
    const float* xp; const float* xs; float* hp; bf16_t* hpb; float* ss; const bf16_t* xb;
    __device__ __forceinline__ void operator()(const f32x4 (&acc)[2][2][4][2], const Unit& u, int wr, int wc, int fr, int fq) const {
#pragma unroll
        for (int ai = 0; ai < 2; ++ai)
#pragma unroll
            for (int m = 0; m < 4; ++m) {
                const int row = u.pm * BM + ai * HALF + wr * 64 + m * 16 + fr;
                const float* xr = (row < MP) ? xp + (size_t)row * DM : xs + (size_t)(row - MP) * DM;
                float s = 0.f;
#pragma unroll
                for (int bj = 0; bj < 2; ++bj) {
                    const int col0 = u.pn * BM + bj * HALF + wc * 32 + 8 * fq;
                    f32x4 r0, r1;
                    if (F32OUT) { r0 = *(const f32x4*)(xr + col0); r1 = *(const f32x4*)(xr + col0 + 4); }
                    else { const u32x4 xw = *(const u32x4*)(xb + (size_t)row * DM + col0);
                        r0 = (f32x4){__builtin_bit_cast(float, xw.x << 16), __builtin_bit_cast(float, xw.x & 0xffff0000u), __builtin_bit_cast(float, xw.y << 16), __builtin_bit_cast(float, xw.y & 0xffff0000u)};
                        r1 = (f32x4){__builtin_bit_cast(float, xw.z << 16), __builtin_bit_cast(float, xw.z & 0xffff0000u), __builtin_bit_cast(float, xw.w << 16), __builtin_bit_cast(float, xw.w & 0xffff0000u)}; }
                    const f32x4 v0 = acc[ai][bj][m][0] + r0, v1 = acc[ai][bj][m][1] + r1;
                    if (F32OUT) { *(f32x4*)(hp + (size_t)row * DM + col0) = v0; *(f32x4*)(hp + (size_t)row * DM + col0 + 4) = v1; }
                    u32x4 w; w.x = cvt_pk_bf16(v0[0], v0[1]); w.y = cvt_pk_bf16(v0[2], v0[3]); w.z = cvt_pk_bf16(v1[0], v1[1]); w.w = cvt_pk_bf16(v1[2], v1[3]);
                    *(u32x4*)(hpb + (size_t)row * DM + col0) = w;
                    s += (v0[0] * v0[0] + v0[1] * v0[1]) + (v0[2] * v0[2] + v0[3] * v0[3]) + (v1[0] * v1[0] + v1[1] * v1[1]) + (v1[2] * v1[2] + v1[3] * v1[3]);
                }
                s += __shfl_xor(s, 16); s += __shfl_xor(s, 32);
                if (fq == 0) ss[(size_t)row * 16 + u.pn * 4 + wc] = s;
            }
    }
};
struct EpiUp {
    static constexpr bool PERM = true, AFTER_DRAIN = false;
    bf16_t* act; const float* ss;
    __device__ __forceinline__ void operator()(const f32x4 (&acc)[2][2][4][2], const Unit& u, int wr, int wc, int fr, int fq) const {
#pragma unroll
        for (int ai = 0; ai < 2; ++ai)
#pragma unroll
            for (int m = 0; m < 4; ++m) {
                const int row = u.pm * BM + ai * HALF + wr * 64 + m * 16 + fr;
                const f32x4* sp = (const f32x4*)(ss + (size_t)row * 16); const f32x4 t4 = (sp[0] + sp[1]) + (sp[2] + sp[3]);
                const float rs = 1.f / sqrtf(((t4.x + t4.y) + (t4.z + t4.w)) * (1.f / DM) + EPS);
#pragma unroll
                for (int bj = 0; bj < 2; ++bj) {
                    const int col0 = u.pn * BM + bj * HALF + wc * 32 + 8 * fq;
                    f32x4 v0 = acc[ai][bj][m][0] * rs, v1 = acc[ai][bj][m][1] * rs;
#pragma unroll
                    for (int e = 0; e < 4; ++e) { const float a = fmaxf(v0[e], 0.f), c = fmaxf(v1[e], 0.f); v0[e] = a * a; v1[e] = c * c; }
                    u32x4 w; w.x = cvt_pk_bf16(v0[0], v0[1]); w.y = cvt_pk_bf16(v0[2], v0[3]); w.z = cvt_pk_bf16(v1[0], v1[1]); w.w = cvt_pk_bf16(v1[2], v1[3]);
                    *(u32x4*)(act + (size_t)row * FF + col0) = w;
                }
            }
    }
};
struct RangeOrder {
    int base_pm, nM, nN, nks, klen, G, c;
    __device__ bool next(int i, Unit& u) const {
        if (c < 0) return false;
        const int L = i * G + c; if (L >= nM * nN * nks) return false;
        u.k0 = (L % nks) * klen; u.pn = (L / nks) % nN; u.pm = base_pm + L / (nks * nN); return true;
    }
    __device__ __forceinline__ void a_ready(const Unit&) const {}
    __device__ __forceinline__ void done(const Unit&) const {}
};
template <bool ATOMIC> struct EpiDown {
    static constexpr bool PERM = true, AFTER_DRAIN = false;
    float* hp;
    __device__ __forceinline__ void operator()(const f32x4 (&acc)[2][2][4][2], const Unit& u, int wr, int wc, int fr, int fq) const {
#pragma unroll
        for (int ai = 0; ai < 2; ++ai)
#pragma unroll
            for (int m = 0; m < 4; ++m) {
                const int row = u.pm * BM + ai * HALF + wr * 64 + m * 16 + fr;
#pragma unroll
                for (int bj = 0; bj < 2; ++bj) {
                    const int col0 = u.pn * BM + bj * HALF + wc * 32 + 8 * fq;
                    float* p = hp + (size_t)row * DM + col0;
                    if (ATOMIC) {
#pragma unroll
                        for (int e = 0; e < 4; ++e) { atomicAdd(p + e, acc[ai][bj][m][0][e]); atomicAdd(p + 4 + e, acc[ai][bj][m][1][e]); }
                    } else {
                        const f32x4 v0 = acc[ai][bj][m][0] + *(const f32x4*)p, v1 = acc[ai][bj][m][1] + *(const f32x4*)(p + 4);
                        *(f32x4*)p = v0; *(f32x4*)(p + 4) = v1;
                    }
                }
            }
    }
};
struct EpiDownNorm {
    static constexpr bool PERM = true, AFTER_DRAIN = true;
    float* hp; const bf16_t* hpb; float* ssp; unsigned* cnt; const float* gf;
    __device__ __forceinline__ void operator()(const f32x4 (&)[2][2][4][2], const Unit&, int, int, int, int) const {}
    __device__ __forceinline__ void fused(f32x4 (&acc)[2][2][4][2], const Unit& u, int wr, int wc, int fr, int fq, PG8_LAS unsigned char* lds, int, int) const {
        PG8_LAS float* part = (PG8_LAS float*)lds;
        PG8_LAS float* rstd = part + 1024;
#pragma unroll
        for (int ai = 0; ai < 2; ++ai)
#pragma unroll
            for (int m = 0; m < 4; ++m) {
                const int rl = ai * HALF + wr * 64 + m * 16 + fr, row = u.pm * BM + rl;
                float s = 0.f;
#pragma unroll
                for (int bj = 0; bj < 2; ++bj) {
                    const u32x4 hw = *(const u32x4*)(hpb + (size_t)row * DM + u.pn * BM + bj * HALF + wc * 32 + 8 * fq);
                    const f32x4 h0 = {__builtin_bit_cast(float, hw.x << 16), __builtin_bit_cast(float, hw.x & 0xffff0000u), __builtin_bit_cast(float, hw.y << 16), __builtin_bit_cast(float, hw.y & 0xffff0000u)};
                    const f32x4 h1 = {__builtin_bit_cast(float, hw.z << 16), __builtin_bit_cast(float, hw.z & 0xffff0000u), __builtin_bit_cast(float, hw.w << 16), __builtin_bit_cast(float, hw.w & 0xffff0000u)};
                    const f32x4 v0 = acc[ai][bj][m][0] + h0, v1 = acc[ai][bj][m][1] + h1;
                    acc[ai][bj][m][0] = v0; acc[ai][bj][m][1] = v1;
                    s += (v0[0] * v0[0] + v0[1] * v0[1]) + (v0[2] * v0[2] + v0[3] * v0[3]) + (v1[0] * v1[0] + v1[1] * v1[1]) + (v1[2] * v1[2] + v1[3] * v1[3]);
                }
                s += __shfl_xor(s, 16); s += __shfl_xor(s, 32);
                if (fq == 0) part[rl * 4 + wc] = s;
            }
        __syncthreads();
        if (threadIdx.x < 256) { const PG8_LAS f32x4* pp = (const PG8_LAS f32x4*)(part + threadIdx.x * 4); const f32x4 t = *pp;
            __hip_atomic_store((unsigned*)(ssp + ((size_t)u.pm * BM + threadIdx.x) * 4 + u.pn), __builtin_bit_cast(unsigned, (t.x + t.y) + (t.z + t.w)), __ATOMIC_RELAXED, __HIP_MEMORY_SCOPE_AGENT); }
        asm volatile("s_waitcnt vmcnt(0)" ::: "memory");
        __syncthreads();
        if (threadIdx.x == 0) {
            unsigned* c = cnt + 64 * u.pm;
            __hip_atomic_fetch_add(c, 1u, __ATOMIC_RELAXED, __HIP_MEMORY_SCOPE_AGENT);
            unsigned sp = 0;
            while (__hip_atomic_load(c, __ATOMIC_RELAXED, __HIP_MEMORY_SCOPE_AGENT) < 4u) { __builtin_amdgcn_s_sleep(1); if (++sp > (1u << 22)) break; }
        }
        __syncthreads();
        if (threadIdx.x < 256) { const unsigned* q = (const unsigned*)(ssp + ((size_t)u.pm * BM + threadIdx.x) * 4); float tot = 0.f;
#pragma unroll
            for (int k = 0; k < 4; ++k) tot += __builtin_bit_cast(float, __hip_atomic_load(q + k, __ATOMIC_RELAXED, __HIP_MEMORY_SCOPE_AGENT));
            rstd[threadIdx.x] = 1.f / sqrtf(tot * (1.f / DM) + EPS); }
        __syncthreads();
#pragma unroll
        for (int ai = 0; ai < 2; ++ai)
#pragma unroll
            for (int m = 0; m < 4; ++m) {
                const int rl = ai * HALF + wr * 64 + m * 16 + fr, row = u.pm * BM + rl;
                const float rs = rstd[rl];
#pragma unroll
                for (int bj = 0; bj < 2; ++bj) {
                    const int col0 = u.pn * BM + bj * HALF + wc * 32 + 8 * fq;
                    float* p = hp + (size_t)row * DM + col0;
                    const f32x4 g0 = *(const f32x4*)(gf + col0), g1 = *(const f32x4*)(gf + col0 + 4);
                    const f32x4 v0 = acc[ai][bj][m][0] * rs * g0, v1 = acc[ai][bj][m][1] * rs * g1;
                    __builtin_nontemporal_store(v0, (f32x4*)p); __builtin_nontemporal_store(v1, (f32x4*)(p + 4));
                }
            }
    }
};
struct EpiPartial {
    static constexpr bool PERM = true, AFTER_DRAIN = false;
    float* part; int klen;
    __device__ __forceinline__ void operator()(const f32x4 (&acc)[2][2][4][2], const Unit& u, int wr, int wc, int fr, int fq) const {
        float* slab = part + (size_t)(u.k0 / klen) * MS * DM;
#pragma unroll
        for (int ai = 0; ai < 2; ++ai)
#pragma unroll
            for (int m = 0; m < 4; ++m) { const int row = u.pm * BM + ai * HALF + wr * 64 + m * 16 + fr - MP;
#pragma unroll
                for (int bj = 0; bj < 2; ++bj) { float* p = slab + (size_t)row * DM + u.pn * BM + bj * HALF + wc * 32 + 8 * fq;
                    *(f32x4*)p = acc[ai][bj][m][0]; *(f32x4*)(p + 4) = acc[ai][bj][m][1]; } }
    }
};
struct EpiScratch {
    static constexpr bool PERM = true, AFTER_DRAIN = false;
    float* dst;
    __device__ __forceinline__ void operator()(const f32x4 (&acc)[2][2][4][2], const Unit& u, int wr, int wc, int fr, int fq) const {
#pragma unroll
        for (int ai = 0; ai < 2; ++ai)
#pragma unroll
            for (int m = 0; m < 4; ++m) { const int row = u.pm * BM + ai * HALF + wr * 64 + m * 16 + fr;
#pragma unroll
                for (int bj = 0; bj < 2; ++bj) { const int col0 = u.pn * BM + bj * HALF + wc * 32 + 8 * fq; float* p = dst + (size_t)row * DM + col0;
                    const f32x4 v0 = acc[ai][bj][m][0] + *(const f32x4*)p, v1 = acc[ai][bj][m][1] + *(const f32x4*)(p + 4);
                    *(f32x4*)p = v0; *(f32x4*)(p + 4) = v1; } }
    }
};
}

__device__ __forceinline__ void p0_transpose_item(const float* W, int K, int ldw, int nblk, const float* gain, bf16* WT, LAS float* scr, int item, int lane) {
    const int kb = item / nblk, nb = item % nblk, k0 = 64 * kb, n0 = 32 * nb;
#pragma unroll 8
    for (int i = 0; i < 32; ++i) { const int kk = 2 * i + (lane >> 5); const float gg = gain ? gain[k0 + kk] : 1.f; scr[kk * 33 + (lane & 31)] = gg * W[(size_t)(k0 + kk) * ldw + n0 + (lane & 31)]; }
    LDS_WAIT(); asm volatile("" ::: "memory");
    const int c = lane & 7;
#pragma unroll
    for (int j = 0; j < 4; ++j) { const int n = (lane >> 3) + 8 * j; const LAS float* s = scr + (8 * c) * 33 + n;
        v4u o; o.x = pk2(s[0 * 33], s[1 * 33]); o.y = pk2(s[2 * 33], s[3 * 33]); o.z = pk2(s[4 * 33], s[5 * 33]); o.w = pk2(s[6 * 33], s[7 * 33]);
        *(GAS v4u*)(WT + (size_t)(n0 + n) * K + k0 + 8 * c) = o; }
    LDS_WAIT(); asm volatile("" ::: "memory");
}
__device__ __forceinline__ void sincos_d(double a, double& s, double& c) {
    const double TWO_PI = 6.283185307179586476925286766559;
    const double k = __builtin_rint(a * (1.0 / TWO_PI));
    const double r = a - k * TWO_PI, r2 = r * r;
    double sc = 1.0, ss = r, tc = 1.0, ts = r;
#pragma unroll
    for (int n = 1; n <= 17; ++n) { tc *= -r2 * (1.0 / (double)((2 * n - 1) * (2 * n))); sc += tc; ts *= -r2 * (1.0 / (double)((2 * n) * (2 * n + 1))); ss += ts; }
    s = ss; c = sc;
}
__device__ __forceinline__ float log_sigmoidf_(float x) { return x < 0.f ? x - log1pf(expf(x)) : -log1pf(expf(-x)); }

__device__ __forceinline__ void p0_prologue(Frame& F) {
    const int gw = F.vcu * 8 + F.wave, NGW = F.G * 8;
    {
        LAS float* scr = (LAS float*)(F.lds + F.wave * 16384);
        constexpr int I_IN = 16 * 112, I_OUT = 16 * 32;
        for (int it = gw; it < I_IN + I_OUT; it += NGW) {
            int r = it;
            if (r < I_IN) { p0_transpose_item(F.w_in, DM, INCOLS, 112, F.g1, F.Win_t, scr, r, F.lane); continue; } r -= I_IN;
            p0_transpose_item(F.w_out, DM, DM, 32, nullptr, F.Wout_t, scr, r, F.lane);
        }
    }
    __syncthreads();
    {
        LAS float* Wg = (LAS float*)F.lds;
        { float wv[16], gv1[16];
#pragma unroll
          for (int q = 0; q < 16; ++q) { const int i = F.tid + 512 * q, k = i >> 3, j = i & 7; wv[q] = F.w_in[(size_t)k * INCOLS + NPROJ + j]; gv1[q] = F.g1[k]; }
#pragma unroll
          for (int q = 0; q < 16; ++q) { const int i = F.tid + 512 * q, k = i >> 3, j = i & 7; Wg[j * 1024 + k] = gv1[q] * wv[q]; } }
        __syncthreads();
        f32x4 vn[4];
        if (gw < M) { const float* xr = (gw < MP) ? F.xp + (size_t)gw * DM : F.xs + (size_t)(gw - MP) * DM;
#pragma unroll
            for (int j = 0; j < 4; ++j) vn[j] = *(const f32x4*)(xr + 256 * j + 4 * F.lane); }
        for (int m = gw; m < M; m += NGW) {
            f32x4 v[4]; float ss = 0.f;
#pragma unroll
            for (int j = 0; j < 4; ++j) { v[j] = vn[j]; ss += (v[j].x * v[j].x + v[j].y * v[j].y) + (v[j].z * v[j].z + v[j].w * v[j].w); }
            { const int mn = m + NGW;
              if (mn < M) { const float* xr = (mn < MP) ? F.xp + (size_t)mn * DM : F.xs + (size_t)(mn - MP) * DM;
#pragma unroll
                for (int j = 0; j < 4; ++j) vn[j] = *(const f32x4*)(xr + 256 * j + 4 * F.lane); } }
            float ga[8];
#pragma unroll
            for (int g = 0; g < 8; ++g) { float a = 0.f;
#pragma unroll
                for (int j = 0; j < 4; ++j) { const f32x4 w = *(const LAS f32x4*)(Wg + g * 1024 + 256 * j + 4 * F.lane); a += (v[j].x * w.x + v[j].y * w.y) + (v[j].z * w.z + v[j].w * w.w); }
                ga[g] = wave_sum(a); }
            ss = wave_sum(ss);
            const float rstd = 1.f / sqrtf(ss * (1.f / DM) + EPS);
            float gv = 0.f;
#pragma unroll
            for (int g = 0; g < 8; ++g) gv = (F.lane == g) ? ga[g] : gv;
            if (F.lane == 0) F.rstd1[m] = rstd;
            if (F.lane < 8) { const float gg = gv * rstd + F.b_gate[F.lane];
                if (F.lane < 4) F.ig[m * 4 + F.lane] = gg; else F.lf[m * 4 + F.lane - 4] = log_sigmoidf_(gg); }
            v2u* o8 = (v2u*)(F.XB + (size_t)m * DM);
#pragma unroll
            for (int j = 0; j < 4; ++j) { v2u o; o.x = pk2(v[j].x, v[j].y); o.y = pk2(v[j].z, v[j].w); o8[64 * j + F.lane] = o; }
        }
    }
    {
        const double invf[8] = {1.0, 0.19392274474868576, 0.03760603093086393, 0.007292664737217109, 0.001414213562373095, 0.0002742481756762073, 5.318295896944988e-05, 1.031338537721246e-05};
        for (int i = F.tid * F.G + F.vcu; i < (SEQ + DTS) * 8; i += F.G * 512) {
            const int p = i >> 3, k = i & 7; const double pos = (p < SEQ) ? (double)p : (double)(8192 + p - SEQ);
            double fr = invf[0];
#pragma unroll
            for (int q = 1; q < 8; ++q) fr = (k == q) ? invf[q] : fr;
            double s, c; sincos_d(pos * fr, s, c);
            F.rope[p * 16 + k] = (float)c; F.rope[p * 16 + 8 + k] = (float)s;
        }
    }
}

typedef short bf16x8m __attribute__((ext_vector_type(8)));
typedef short v4i16m __attribute__((ext_vector_type(4)));
struct AttnTileP { int dil, rg, Q0, sp, ks, Lg; };
__device__ __forceinline__ AttnTileP attn_tile_params(int ti, int r16, int L0) {
    AttnTileP t;
    if (ti < 5)       { t.dil = 16; t.rg = r16;     t.Q0 = L0;                  t.sp = 1;  t.ks = t.Q0 - 128 + 32 * ti;        t.Lg = 256; }
    else if (ti < 11) { t.dil = 4;  t.rg = r16 & 3; t.Q0 = 4 * L0 + (r16 >> 2); t.sp = 4;  t.ks = t.Q0 - 128 + 32 * (ti - 5);  t.Lg = 1024; }
    else              { t.dil = 1;  t.rg = 0;       t.Q0 = 16 * L0 + r16;       t.sp = 16; t.ks = t.Q0 - 128 + 32 * (ti - 11); t.Lg = 4096; }
    return t;
}
__device__ __forceinline__ void attn_tile_load(const bf16* P, int b, int h, const AttnTileP& t, int lane, bf16x8m (&kf)[2][2], v4u (&vv)[4]) {
    const int fr = lane & 15, g4 = lane >> 4;
#pragma unroll
    for (int sub = 0; sub < 2; ++sub) { int kp = t.ks + 16 * sub + fr; kp = kp < 0 ? 0 : (kp >= t.Lg ? t.Lg - 1 : kp);
        const bf16* kr = P + (size_t)(b * SEQ + t.dil * kp + t.rg) * NPROJ + C_K + h * 64 + 8 * g4;
        kf[sub][0] = *(const bf16x8m*)kr; kf[sub][1] = *(const bf16x8m*)(kr + 32); }
#pragma unroll
    for (int k = 0; k < 4; ++k) { int kp = t.ks + (lane >> 3) + 8 * k; kp = kp < 0 ? 0 : (kp >= t.Lg ? t.Lg - 1 : kp);
        vv[k] = *(const v4u*)(P + (size_t)(b * SEQ + t.dil * kp + t.rg) * NPROJ + C_V + h * 64 + 8 * (lane & 7)); }
}
struct Claimer { int nxt; };
__device__ __forceinline__ int claim_unit(Frame& F, int which, int limit, Claimer& C) {
    unsigned* ctr = (unsigned*)(F.ws + WS_CLAIM) + 64 * which;
    volatile LAS int* sh = (volatile LAS int*)(F.lds + MISC_OFF + 72);
    __syncthreads();
    if (F.tid == 0) { if (C.nxt == -2) C.nxt = (int)__hip_atomic_fetch_add(ctr, 1u, __ATOMIC_RELAXED, __HIP_MEMORY_SCOPE_AGENT); sh[0] = C.nxt; }
    __syncthreads();
    const int u = sh[0];
    if (F.tid == 0) C.nxt = (u < limit) ? (int)__hip_atomic_fetch_add(ctr, 1u, __ATOMIC_RELAXED, __HIP_MEMORY_SCOPE_AGENT) : -2;
    return u;
}
__device__ __forceinline__ void attn_tile_math(const bf16x8m (&kc)[2][2], const bf16x8m (&qf)[2], int ks, int qp, int g4, const LAS unsigned char* vb, int troff, float& m, float& lsum, f32x4 (&acc)[4]) {
    f32x4 s0 = (f32x4){0.f, 0.f, 0.f, 0.f}, s1 = (f32x4){0.f, 0.f, 0.f, 0.f};
    s0 = __builtin_amdgcn_mfma_f32_16x16x32_bf16(kc[0][0], qf[0], s0, 0, 0, 0); s0 = __builtin_amdgcn_mfma_f32_16x16x32_bf16(kc[0][1], qf[1], s0, 0, 0, 0);
    s1 = __builtin_amdgcn_mfma_f32_16x16x32_bf16(kc[1][0], qf[0], s1, 0, 0, 0); s1 = __builtin_amdgcn_mfma_f32_16x16x32_bf16(kc[1][1], qf[1], s1, 0, 0, 0);
    float mx = -INFINITY;
    const int dbase = qp - ks - 4 * g4; const unsigned dlim = (unsigned)(qp < 128 ? qp : 128);
#pragma unroll
    for (int i = 0; i < 4; ++i) { const bool v0 = (unsigned)(dbase - i) <= dlim, v1 = (unsigned)(dbase - 16 - i) <= dlim;
        s0[i] = v0 ? s0[i] : -INFINITY; s1[i] = v1 ? s1[i] : -INFINITY; mx = fmaxf(mx, fmaxf(s0[i], s1[i])); }
    if (__builtin_amdgcn_ballot_w64(mx > m + 8.f) != 0ull) {
        mx = fmaxf(mx, __shfl_xor(mx, 16)); mx = fmaxf(mx, __shfl_xor(mx, 32));
        const float mn = fmaxf(m, mx), alpha = __expf(m - mn); m = mn;
        lsum = lsum * alpha;
#pragma unroll
        for (int i = 0; i < 4; ++i) acc[i] = acc[i] * alpha;
    }
    float ps = 0.f;
#pragma unroll
    for (int i = 0; i < 4; ++i) { s0[i] = __expf(s0[i] - m); s1[i] = __expf(s1[i] - m); ps += s0[i] + s1[i]; }
    lsum += ps;
    v4u w; w.x = pk2(s0[0], s0[1]); w.y = pk2(s0[2], s0[3]); w.z = pk2(s1[0], s1[1]); w.w = pk2(s1[2], s1[3]);
    const bf16x8m pb = __builtin_bit_cast(bf16x8m, w);
#pragma unroll
    for (int db = 0; db < 4; ++db) {
        const v4i16m a0 = __builtin_amdgcn_ds_read_tr16_b64_v4i16((LAS v4i16m*)(vb + troff + db * 32));
        const v4i16m a1 = __builtin_amdgcn_ds_read_tr16_b64_v4i16((LAS v4i16m*)(vb + troff + db * 32 + 16 * 160));
        acc[db] = __builtin_amdgcn_mfma_f32_16x16x32_bf16(__builtin_shufflevector(a0, a1, 0, 1, 2, 3, 4, 5, 6, 7), pb, acc[db], 0, 0, 0);
    }
}
__device__ __forceinline__ void p2_attn_prompt_mfma(Frame& F, int stop_at, Claimer& C) {
    const int lane = F.lane, fr = lane & 15, g4 = lane >> 4, tid = F.tid;
    LAS unsigned char* vbuf = F.lds + F.wave * 5120;
    LAS unsigned char* Ksh = F.lds + 40960; LAS unsigned char* Vsh = Ksh + 30720;
    const int vwoff = (lane >> 3) * 160 + (lane & 7) * 16;
    const int troff = (4 * g4 + (fr >> 2)) * 160 + (fr & 3) * 8;
    for (int bu = claim_unit(F, 0, 1024, C); bu < 1024; bu = claim_unit(F, 0, 1024, C)) {
        const int r16 = (bu & 1) * 8 + F.wave, L0 = ((bu >> 1) & 15) * 16, h = (bu >> 5) & 7, b = bu >> 8;
        const int rowq = b * SEQ + 16 * (L0 + fr) + r16;
        bf16x8m qf[2];
        { const bf16* qr = F.PROJ + (size_t)rowq * NPROJ + C_Q + h * 64 + 8 * g4; qf[0] = *(const bf16x8m*)qr; qf[1] = *(const bf16x8m*)(qr + 32); }
        v4u wreg[6];
#pragma unroll
        for (int k = 0; k < 6; ++k) { const int i = tid + 512 * k, which = (i >= 1536) ? 1 : 0, r = (i - which * 1536) >> 3, c = i & 7;
            int tok = 16 * L0 - 128 + r; tok = tok < 0 ? 0 : tok;
            wreg[k] = *(const v4u*)(F.PROJ + (size_t)(b * SEQ + tok) * NPROJ + (which ? C_V : C_K) + h * 64 + 8 * c); }
        f32x4 acc[4];
#pragma unroll
        for (int i = 0; i < 4; ++i) acc[i] = (f32x4){0.f, 0.f, 0.f, 0.f};
        float m = -1e30f, lsum = 0.f;
        bf16x8m kc[2][2]; v4u vr[4];
        { const AttnTileP t0 = attn_tile_params(0, r16, L0); attn_tile_load(F.PROJ, b, h, t0, lane, kc, vr); }
#pragma unroll 1
        for (int ti = 0; ti < 11; ++ti) {
            const AttnTileP t = attn_tile_params(ti, r16, L0);
#pragma unroll
            for (int k = 0; k < 4; ++k) *(LAS v4u*)(vbuf + vwoff + k * 1280) = vr[k];
            bf16x8m kn[2][2];
            { const AttnTileP tn = attn_tile_params((ti + 1 < 11) ? ti + 1 : ti, r16, L0); attn_tile_load(F.PROJ, b, h, tn, lane, kn, vr); }
            attn_tile_math(kc, qf, t.ks, t.Q0 + t.sp * fr, g4, vbuf, troff, m, lsum, acc);
#pragma unroll
            for (int a = 0; a < 2; ++a) { kc[a][0] = kn[a][0]; kc[a][1] = kn[a][1]; }
        }
        const int W0 = 16 * L0 - 128, qp1 = 16 * L0 + r16 + 16 * fr;
#pragma unroll 1
        for (int pass = 0; pass < 2; ++pass) {
            __syncthreads();
#pragma unroll
            for (int k = 0; k < 6; ++k) { const int i = tid + 512 * k, which = (i >= 1536) ? 1 : 0, r = (i - which * 1536) >> 3, c = i & 7;
                *(LAS v4u*)(Ksh + which * 30720 + r * 160 + c * 16) = wreg[k]; }
            if (pass == 0) {
#pragma unroll
                for (int k = 0; k < 6; ++k) { const int i = tid + 512 * k, which = (i >= 1536) ? 1 : 0, r = (i - which * 1536) >> 3, c = i & 7;
                    int tok = W0 + 192 + r; tok = tok < 0 ? 0 : tok;
                    wreg[k] = *(const v4u*)(F.PROJ + (size_t)(b * SEQ + tok) * NPROJ + (which ? C_V : C_K) + h * 64 + 8 * c); } }
            __syncthreads();
#pragma unroll 2
            for (int j = 0; j < 6; ++j) {
                bf16x8m kk[2][2];
#pragma unroll
                for (int sub = 0; sub < 2; ++sub) { const LAS unsigned char* kr = Ksh + (32 * j + 16 * sub + fr) * 160 + 16 * g4;
                    kk[sub][0] = *(const LAS bf16x8m*)kr; kk[sub][1] = *(const LAS bf16x8m*)(kr + 64); }
                attn_tile_math(kk, qf, W0 + 192 * pass + 32 * j, qp1, g4, Vsh + 32 * j * 160, troff, m, lsum, acc);
            }
        }
        lsum += __shfl_xor(lsum, 16); lsum += __shfl_xor(lsum, 32);
        const float inv = 1.f / lsum;
        bf16* orow = F.MIX + (size_t)rowq * DM + h * 64 + 4 * g4;
#pragma unroll
        for (int db = 0; db < 4; ++db) { v2u o; o.x = pk2(acc[db][0] * inv, acc[db][1] * inv); o.y = pk2(acc[db][2] * inv, acc[db][3] * inv); *(v2u*)(orow + 16 * db) = o; }
        if (bu >= stop_at) break;
    }
}


__device__ __forceinline__ bf16x8m cvt8(const f32x4 a, const f32x4 b) { v4u w; w.x = pk2(a.x, a.y); w.y = pk2(a.z, a.w); w.z = pk2(b.x, b.y); w.w = pk2(b.z, b.w); return __builtin_bit_cast(bf16x8m, w); }
__device__ __forceinline__ bf16x8m ld_sigma_g(const bf16* p) {
    const v2u a = *(const v2u*)p, c = *(const v2u*)(p + 16); v4u w; w.x = a.x; w.y = a.y; w.z = c.x; w.w = c.y; return __builtin_bit_cast(bf16x8m, w);
}
template <bool FAR>
__device__ __forceinline__ void sstream_tile(const bf16x8m (&ka)[2][2], const bf16x8m q0, const bf16x8m q1, int R, int fr, int g4, int isel, const LAS unsigned char* vbuf, int troff,
                                             float& m, float& lsum, f32x4 (&acc)[4]) {
    f32x4 s0 = (f32x4){0.f, 0.f, 0.f, 0.f}, s1 = (f32x4){0.f, 0.f, 0.f, 0.f};
    s0 = __builtin_amdgcn_mfma_f32_16x16x32_bf16(ka[0][0], q0, s0, 0, 0, 0); s0 = __builtin_amdgcn_mfma_f32_16x16x32_bf16(ka[0][1], q1, s0, 0, 0, 0);
    s1 = __builtin_amdgcn_mfma_f32_16x16x32_bf16(ka[1][0], q0, s1, 0, 0, 0); s1 = __builtin_amdgcn_mfma_f32_16x16x32_bf16(ka[1][1], q1, s1, 0, 0, 0);
    float mx;
    float mu0[4], mu1[4];
    if (FAR) {
        const float a0 = (isel == 0) ? s0[0] : (isel == 1) ? s0[1] : (isel == 2) ? s0[2] : s0[3];
        const float a1 = (isel == 0) ? s1[0] : (isel == 1) ? s1[1] : (isel == 2) ? s1[2] : s1[3];
        mx = (isel >= 0) ? fmaxf(a0, a1) : -INFINITY;
        if (__builtin_amdgcn_ballot_w64(mx > m + 8.f) != 0ull) {
            mx = fmaxf(mx, __shfl_xor(mx, 16)); mx = fmaxf(mx, __shfl_xor(mx, 32));
            const float mn = fmaxf(m, mx), alpha = __expf(m - mn); m = mn;
            lsum = lsum * alpha;
#pragma unroll
            for (int i = 0; i < 4; ++i) acc[i] = acc[i] * alpha;
        }
        const float e0 = (isel >= 0) ? __expf(a0 - m) : 0.f, e1 = (isel >= 0) ? __expf(a1 - m) : 0.f;
#pragma unroll
        for (int i = 0; i < 4; ++i) { s0[i] = (i == isel) ? e0 : 0.f; s1[i] = (i == isel) ? e1 : 0.f; }
        lsum += (e0 + e1);
    } else {
        mx = -INFINITY;
#pragma unroll
        for (int i = 0; i < 4; ++i) {
            const int d0 = WBUF + fr - (R + 4 * g4 + i), d1 = d0 - 16;
            float c0 = 0.f, c1 = 0.f;
            if (fr < 8 && d0 >= 0) c0 = (d0 <= 128 ? 1.f : 0.f) + (((d0 & 3) == 0 && d0 <= 512) ? 1.f : 0.f) + (((d0 & 15) == 0) ? 1.f : 0.f);
            if (fr < 8 && d1 >= 0) c1 = (d1 <= 128 ? 1.f : 0.f) + (((d1 & 3) == 0 && d1 <= 512) ? 1.f : 0.f) + (((d1 & 15) == 0) ? 1.f : 0.f);
            mu0[i] = c0; mu1[i] = c1;
            mx = fmaxf(mx, (c0 > 0.f) ? s0[i] : -INFINITY);
            mx = fmaxf(mx, (c1 > 0.f) ? s1[i] : -INFINITY); }
        if (__builtin_amdgcn_ballot_w64(mx > m + 8.f) != 0ull) {
            mx = fmaxf(mx, __shfl_xor(mx, 16)); mx = fmaxf(mx, __shfl_xor(mx, 32));
            const float mn = fmaxf(m, mx), alpha = __expf(m - mn); m = mn;
            lsum = lsum * alpha;
#pragma unroll
            for (int i = 0; i < 4; ++i) acc[i] = acc[i] * alpha;
        }
        float ps = 0.f;
#pragma unroll
        for (int i = 0; i < 4; ++i) { s0[i] = (mu0[i] > 0.f) ? mu0[i] * __expf(s0[i] - m) : 0.f; s1[i] = (mu1[i] > 0.f) ? mu1[i] * __expf(s1[i] - m) : 0.f; ps += s0[i] + s1[i]; }
        lsum += ps;
    }
    v4u pw; pw.x = pk2(s0[0], s0[1]); pw.y = pk2(s0[2], s0[3]); pw.z = pk2(s1[0], s1[1]); pw.w = pk2(s1[2], s1[3]);
    const bf16x8m pb = __builtin_bit_cast(bf16x8m, pw);
#pragma unroll
    for (int db = 0; db < 4; ++db) {
        const v4i16m a0 = __builtin_amdgcn_ds_read_tr16_b64_v4i16((LAS v4i16m*)(vbuf + troff + db * 32));
        const v4i16m a1 = __builtin_amdgcn_ds_read_tr16_b64_v4i16((LAS v4i16m*)(vbuf + troff + db * 32 + 16 * 160));
        acc[db] = __builtin_amdgcn_mfma_f32_16x16x32_bf16(__builtin_shufflevector(a0, a1, 0, 1, 2, 3, 4, 5, 6, 7), pb, acc[db], 0, 0, 0);
    }
}
struct STile { f32x4 k[2][4], v[2][4]; };
template <bool FAR> __device__ __forceinline__ int srow(int ti, int sub, int fr) { return FAR ? 64 * ti + 32 * sub + (fr & 7) + 16 * (fr >> 3) : 32 * ti + 16 * sub + fr; }
template <bool FAR>
__device__ __forceinline__ void sstream_load(STile& T, const float* ck, const float* cv, unsigned hb, int ti, int fr) {
#pragma unroll
    for (int sub = 0; sub < 2; ++sub) { const unsigned off = hb + (unsigned)srow<FAR>(ti, sub, fr) * 2048u;
#pragma unroll
        for (int j = 0; j < 4; ++j) { T.k[sub][j] = *(const f32x4*)((const char*)ck + off + 64 * j); T.v[sub][j] = *(const f32x4*)((const char*)cv + off + 64 * j); } }
}
template <bool FAR>
__device__ __forceinline__ void sstream_consume(const STile& T, float* ok, float* ov, unsigned hb, int ti, int fr, int g4, LAS unsigned char* vbuf, bf16x8m (&ka)[2][2]) {
#pragma unroll
    for (int sub = 0; sub < 2; ++sub) { const int row = srow<FAR>(ti, sub, fr);
        if (row >= DTS) { const unsigned off = hb + (unsigned)(row - DTS) * 2048u;
#pragma unroll
            for (int j = 0; j < 4; ++j) { *(f32x4*)((char*)ok + off + 64 * j) = T.k[sub][j]; *(f32x4*)((char*)ov + off + 64 * j) = T.v[sub][j]; } }
        ka[sub][0] = cvt8(T.k[sub][0], T.k[sub][1]); ka[sub][1] = cvt8(T.k[sub][2], T.k[sub][3]);
        LAS unsigned char* vd = vbuf + (16 * sub + fr) * 160 + 8 * g4;
#pragma unroll
        for (int j = 0; j < 4; ++j) { v2u o; o.x = pk2(T.v[sub][j].x, T.v[sub][j].y); o.y = pk2(T.v[sub][j].z, T.v[sub][j].w); *(LAS v2u*)(vd + 32 * j) = o; } }
}
template <bool MATH = true>
__device__ __forceinline__ void p2_sample_stream(Frame& F) {
    const int lane = F.lane, fr = lane & 15, g4 = lane >> 4, w = F.wave;
    LAS unsigned char* vbuf = F.lds + w * 5120;
    LAS float* mrg = (LAS float*)(F.lds + 40960);
    const int troff = (4 * g4 + (fr >> 2)) * 160 + (fr & 3) * 8;
    const int isel = ((fr < 8) && ((fr >> 2) == (g4 & 1))) ? (fr & 3) : -1;
#ifndef STREAM_CUS
#define STREAM_CUS 256
#endif
    constexpr int SSTEP = 256 / STREAM_CUS;
    if ((F.vcu % SSTEP) == 0)
    for (int su = F.vcu / SSTEP; su < 256; su += F.G / SSTEP) {
        const int b = su >> 1, hh = 4 * (su & 1) + (w & 3), par = w >> 2;
        bf16x8m q0, q1;
        { const bf16* qr = F.PROJ + (size_t)(MP + b * DTS + (fr & 7)) * NPROJ + C_Q + hh * 64 + 4 * g4;
          q0 = ld_sigma_g(qr); q1 = ld_sigma_g(qr + 32);
          if (fr >= 8) { q0 = (bf16x8m){0, 0, 0, 0, 0, 0, 0, 0}; q1 = q0; } }
        f32x4 acc[4];
#pragma unroll
        for (int i = 0; i < 4; ++i) acc[i] = (f32x4){0.f, 0.f, 0.f, 0.f};
        float m = -1e30f, lsum = 0.f;
        const unsigned hb = (unsigned)((((size_t)b * WBUF * 8 + hh) * 64 + 4 * g4) * 4);
        const float* ck = F.cache_k; const float* cv = F.cache_v; float* ok = F.out + O_SK; float* ov = F.out + O_SV;
        __syncthreads();
        STile TA, TB; bf16x8m ka[2][2];
        sstream_load<true>(TA, ck, cv, hb, par, fr); sstream_load<true>(TB, ck, cv, hb, par + 2, fr);
#define SS_LOAD(T, k) do { const int _k = (k); if (_k < 12) sstream_load<true>(T, ck, cv, hb, par + 2 * _k, fr); else sstream_load<false>(T, ck, cv, hb, 48 + par + 2 * ((_k < 20 ? _k : 19) - 12), fr); } while (0)
#pragma unroll 1
        for (int k = 0; k < 12; k += 2) {
            sstream_consume<true>(TA, ok, ov, hb, par + 2 * k, fr, g4, vbuf, ka); __builtin_amdgcn_sched_barrier(0);
            SS_LOAD(TA, k + 2); __builtin_amdgcn_sched_barrier(0);
            sstream_tile<true>(ka, q0, q1, 0, fr, g4, isel, vbuf, troff, m, lsum, acc); __builtin_amdgcn_sched_barrier(0);
            sstream_consume<true>(TB, ok, ov, hb, par + 2 * k + 2, fr, g4, vbuf, ka); __builtin_amdgcn_sched_barrier(0);
            SS_LOAD(TB, k + 3); __builtin_amdgcn_sched_barrier(0);
            sstream_tile<true>(ka, q0, q1, 0, fr, g4, isel, vbuf, troff, m, lsum, acc); __builtin_amdgcn_sched_barrier(0);
        }
#pragma unroll 1
        for (int k = 12; k < 20; k += 2) {
            const int ti = 48 + par + 2 * (k - 12);
            sstream_consume<false>(TA, ok, ov, hb, ti, fr, g4, vbuf, ka); __builtin_amdgcn_sched_barrier(0);
            SS_LOAD(TA, k + 2); __builtin_amdgcn_sched_barrier(0);
            sstream_tile<false>(ka, q0, q1, 32 * ti, fr, g4, isel, vbuf, troff, m, lsum, acc); __builtin_amdgcn_sched_barrier(0);
            sstream_consume<false>(TB, ok, ov, hb, ti + 2, fr, g4, vbuf, ka); __builtin_amdgcn_sched_barrier(0);
            SS_LOAD(TB, k + 3); __builtin_amdgcn_sched_barrier(0);
            sstream_tile<false>(ka, q0, q1, 32 * (ti + 2), fr, g4, isel, vbuf, troff, m, lsum, acc); __builtin_amdgcn_sched_barrier(0);
        }
#undef SS_LOAD
        if (MATH && par == 0) {
            bf16x8m ka[2][2];
            const bf16x8m z = (bf16x8m){0, 0, 0, 0, 0, 0, 0, 0};
            const bf16* kr = F.PROJ + (size_t)(MP + b * DTS + (fr & 7)) * NPROJ + C_K + hh * 64 + 4 * g4;
            const bf16* vr = F.PROJ + (size_t)(MP + b * DTS + (fr & 7)) * NPROJ + C_V + hh * 64 + 4 * g4;
            ka[0][0] = (fr < 8) ? ld_sigma_g(kr) : z; ka[0][1] = (fr < 8) ? ld_sigma_g(kr + 32) : z; ka[1][0] = z; ka[1][1] = z;
#pragma unroll
            for (int sub = 0; sub < 2; ++sub) { LAS unsigned char* vd = vbuf + (16 * sub + fr) * 160 + 8 * g4;
#pragma unroll
                for (int j = 0; j < 4; ++j) { v2u o = (v2u){0u, 0u}; if (sub == 0 && fr < 8) o = *(const v2u*)(vr + 16 * j); *(LAS v2u*)(vd + 32 * j) = o; } }
            sstream_tile<false>(ka, q0, q1, WBUF, fr, g4, isel, vbuf, troff, m, lsum, acc);
        }
        lsum += __shfl_xor(lsum, 16); lsum += __shfl_xor(lsum, 32);
        LAS float* mg = mrg + ((w & 3) * 64 + lane) * 18;
        if (MATH && par == 1) { mg[0] = m; mg[1] = lsum;
#pragma unroll
            for (int db = 0; db < 4; ++db) { mg[2 + 4 * db] = acc[db][0]; mg[3 + 4 * db] = acc[db][1]; mg[4 + 4 * db] = acc[db][2]; mg[5 + 4 * db] = acc[db][3]; } }
        __syncthreads();
        if (MATH && par == 0) {
            const float m2 = mg[0], l2 = mg[1], mn = fmaxf(m, m2), a1 = __expf(m - mn), a2 = __expf(m2 - mn), inv = 1.f / (lsum * a1 + l2 * a2);
            if (fr < 8) { bf16* orow = F.MIX + (size_t)(MP + b * DTS + fr) * DM + hh * 64 + 4 * g4;
#pragma unroll
                for (int db = 0; db < 4; ++db) { v2u o;
                    o.x = pk2((acc[db][0] * a1 + mg[2 + 4 * db] * a2) * inv, (acc[db][1] * a1 + mg[3 + 4 * db] * a2) * inv);
                    o.y = pk2((acc[db][2] * a1 + mg[4 + 4 * db] * a2) * inv, (acc[db][3] * a1 + mg[5 + 4 * db] * a2) * inv);
                    *(v2u*)(orow + 16 * db) = o; } }
        }
    }
}

constexpr int NCHUNK = 2 * DBS * 96, CLAIM = 4;
__device__ __forceinline__ void copy_load(Frame& F, int c0, f32x4 (&v)[8]) {
#pragma unroll
    for (int k = 0; k < 8; ++k) { const int i = F.tid + 512 * k, c = c0 + (i >> 10), r = i & 1023;
        const float* src = ((c & 1) ? F.cache_v : F.cache_k) + ((size_t)((c >> 1) & 127) * WBUF + 16 * (c >> 8) + 8) * 512;
        v[k] = __builtin_nontemporal_load((const f32x4*)src + r); }
}
__device__ __forceinline__ void copy_store(Frame& F, int c0, const f32x4 (&v)[8]) {
#pragma unroll
    for (int k = 0; k < 8; ++k) { const int i = F.tid + 512 * k, c = c0 + (i >> 10), r = i & 1023;
        float* dst = F.out + ((c & 1) ? O_SV : O_SK) + ((size_t)((c >> 1) & 127) * WBUF + 16 * (c >> 8)) * 512;
        __builtin_nontemporal_store(v[k], (f32x4*)dst + r); }
}
__device__ __forceinline__ void copy_claim(Frame& F, int c0) { f32x4 v[8]; copy_load(F, c0, v); copy_store(F, c0, v); }
__device__ __forceinline__ void copy_quota(Frame& F, int n) {
    unsigned* ctl = (unsigned*)(F.ws + WS_CPY);
    volatile LAS int* sh = (volatile LAS int*)(F.lds + MISC_OFF + 64);
    for (int k = 0; k < n; ++k) {
        __syncthreads();
        if (F.tid == 0) { const unsigned c = __hip_atomic_fetch_add(ctl, (unsigned)CLAIM, __ATOMIC_RELAXED, __HIP_MEMORY_SCOPE_AGENT); sh[0] = (c < (unsigned)NCHUNK) ? (int)c : -1; }
        __syncthreads();
        const int c0 = sh[0];
        if (c0 < 0) break;
        copy_claim(F, c0);
    }
    __syncthreads();
}
__device__ __forceinline__ void help_copy(Frame& F, int phase, bool announce = true, bool announce_only = false) {
    unsigned* ctl = (unsigned*)(F.ws + WS_CPY);
    volatile LAS int* sh = (volatile LAS int*)(F.lds + MISC_OFF + 64);
    __syncthreads();
    if (announce && phase >= 0 && F.tid == 0) __hip_atomic_fetch_add(ctl + 64 * (1 + phase), 1u, __ATOMIC_RELAXED, __HIP_MEMORY_SCOPE_AGENT);
    if (announce_only) return;
    int nxt = -1;
    if (F.tid == 0) { const bool busy = (phase < 0) || (__hip_atomic_load(ctl + 64 * (1 + phase), __ATOMIC_RELAXED, __HIP_MEMORY_SCOPE_AGENT) < (unsigned)F.G);
        if (busy) { const unsigned c = __hip_atomic_fetch_add(ctl, (unsigned)CLAIM, __ATOMIC_RELAXED, __HIP_MEMORY_SCOPE_AGENT); if (c < (unsigned)NCHUNK) nxt = (int)c; } }
    int cur = -1; f32x4 va[8], vb[8];
    for (;;) {
        if (F.tid == 0) sh[0] = nxt;
        __syncthreads();
        const int c1 = sh[0];
        __syncthreads();
        if (c1 >= 0) {
            if (F.tid == 0) { nxt = -1;
                const bool busy = (phase < 0) || (__hip_atomic_load(ctl + 64 * (1 + phase), __ATOMIC_RELAXED, __HIP_MEMORY_SCOPE_AGENT) < (unsigned)F.G);
                if (busy) { const unsigned c = __hip_atomic_fetch_add(ctl, (unsigned)CLAIM, __ATOMIC_RELAXED, __HIP_MEMORY_SCOPE_AGENT); if (c < (unsigned)NCHUNK) nxt = (int)c; } }
            copy_load(F, c1, vb);
        }
        if (cur >= 0) copy_store(F, cur, va);
        if (c1 < 0) break;
#pragma unroll
        for (int k = 0; k < 8; ++k) va[k] = vb[k];
        cur = c1;
    }
}

__device__ __forceinline__ void load_q64(const bf16* qp, LAS float* sq, int lane) {
    sq[lane] = bf2f(qp[lane]);
    LDS_WAIT(); asm volatile("" ::: "memory");
}
__device__ __forceinline__ float dot_bf16row(const bf16* kp, const LAS float* sq) {
    float a = 0.f;
#pragma unroll 1
    for (int i = 0; i < 8; ++i) { const v4u w = *(const v4u*)(kp + 8 * i); const f32x4 q0 = *(const LAS f32x4*)(sq + 8 * i), q1 = *(const LAS f32x4*)(sq + 8 * i + 4);
        a += q0.x * bflo(w.x) + q0.y * bfhi(w.x) + q0.z * bflo(w.y) + q0.w * bfhi(w.y) + q1.x * bflo(w.z) + q1.y * bfhi(w.z) + q1.z * bflo(w.w) + q1.w * bfhi(w.w); }
    return a;
}
__device__ __forceinline__ float dot_f32row(const float* kp, const LAS float* sq) {
    float a = 0.f;
#pragma unroll 1
    for (int i = 0; i < 16; ++i) { const f32x4 w = *(const f32x4*)(kp + 4 * i); const f32x4 q0 = *(const LAS f32x4*)(sq + 4 * i);
        a += q0.x * w.x + q0.y * w.y + q0.z * w.z + q0.w * w.w; }
    return a;
}
__device__ __forceinline__ void p2_attn_v1(Frame& F) {
    const int gw = F.vcu * 8 + F.wave, NGW = F.G * 8, lane = F.lane;
    LAS float* q = (LAS float*)(F.lds + F.wave * 256);
    for (int it = gw; it < MS * 8; it += NGW) {
        const int sr = it >> 3, h = it & 7, b = sr >> 3, t = sr & 7, row = MP + sr;
        load_q64(F.PROJ + (size_t)row * NPROJ + C_Q + h * 64, q, lane);
        float sc[3][3];
#pragma unroll
        for (int g = 0; g < 3; ++g) { const int dil = (g == 0) ? 1 : (g == 1 ? 4 : 16);
#pragma unroll
            for (int i = 0; i < 3; ++i) { const int j = lane + 64 * i; const bool valid = (j <= 128);
                const int idx = valid ? (WBUF + t - dil * j) : (WBUF + t);
                float d;
                if (idx < WBUF) d = dot_f32row(F.cache_k + (((size_t)b * WBUF + idx) * 8 + h) * 64, q);
                else d = dot_bf16row(F.PROJ + (size_t)(MP + b * DTS + idx - WBUF) * NPROJ + C_K + h * 64, q);
                sc[g][i] = valid ? d : -INFINITY; asm volatile("" ::: "memory"); } }
        float mx = -INFINITY;
#pragma unroll
        for (int g = 0; g < 3; ++g)
#pragma unroll
            for (int i = 0; i < 3; ++i) mx = fmaxf(mx, sc[g][i]);
        mx = wave_max(mx);
        float sum = 0.f;
#pragma unroll
        for (int g = 0; g < 3; ++g)
#pragma unroll
            for (int i = 0; i < 3; ++i) { sc[g][i] = __expf(sc[g][i] - mx); sum += sc[g][i]; }
        sum = wave_sum(sum);
        float o = 0.f;
#pragma unroll
        for (int g = 0; g < 3; ++g) { const int dil = (g == 0) ? 1 : (g == 1 ? 4 : 16);
#pragma unroll
            for (int i = 0; i < 3; ++i) { const int cnt = (i == 2) ? 1 : 64;
#pragma unroll 1
                for (int jj = 0; jj < cnt; ++jj) { const int idx = WBUF + t - dil * (jj + 64 * i);
                    const float p = __shfl(sc[g][i], jj);
                    const float vv = (idx < WBUF) ? F.cache_v[(((size_t)b * WBUF + idx) * 8 + h) * 64 + lane]
                                                  : bf2f(F.PROJ[(size_t)(MP + b * DTS + idx - WBUF) * NPROJ + C_V + h * 64 + lane]);
                    o += p * vv; } } }
        F.MIX[(size_t)row * DM + h * 64 + lane] = (bf16)f2bf(o / sum);
    }
}

constexpr int TP = 288;
constexpr int ML_A = 0, ML_K = 36864, ML_V = 73728, ML_S = 110592;
typedef short v4i16s __attribute__((ext_vector_type(4)));
__device__ __forceinline__ bf16x8m tr2(const LAS unsigned char* p) {
    const v4i16m a0 = __builtin_amdgcn_ds_read_tr16_b64_v4i16((LAS v4i16m*)p);
    const v4i16m a1 = __builtin_amdgcn_ds_read_tr16_b64_v4i16((LAS v4i16m*)(p + 16 * TP));
    return __builtin_shufflevector(a0, a1, 0, 1, 2, 3, 4, 5, 6, 7);
}
__device__ __forceinline__ bf16x8m rd_sigma(const LAS unsigned char* p) {
    const v4i16m a0 = *(const LAS v4i16m*)p, a1 = *(const LAS v4i16m*)(p + 32);
    return __builtin_shufflevector(a0, a1, 0, 1, 2, 3, 4, 5, 6, 7);
}
__device__ __forceinline__ void build_conv_tile(LAS unsigned char* dst, const bf16* PROJ, int row0, bool first, int col, const float* w_conv, const float* b_conv, float scale, const LAS float* rowscale, int tid) {
    const int cc = tid & 15, rg = tid >> 4;
    v4u x[7];
#pragma unroll
    for (int i = 0; i < 7; ++i) { const int r = 4 * rg + i - 3;
        if (first && r < 0) x[i] = (v4u){0u, 0u, 0u, 0u}; else x[i] = *(const v4u*)(PROJ + (size_t)(row0 + r) * NPROJ + C_RAW + col + 8 * cc); }
    const float* wc = w_conv + col + 8 * cc;
    float out[4][8];
#pragma unroll
    for (int e = 0; e < 8; ++e) { const float bb = b_conv[col + 8 * cc + e];
#pragma unroll
        for (int r = 0; r < 4; ++r) out[r][e] = bb; }
#pragma unroll
    for (int w = 0; w < 4; ++w) {
        const f32x4 w0 = *(const f32x4*)(wc + w * 1024), w1 = *(const f32x4*)(wc + w * 1024 + 4);
#pragma unroll
        for (int r = 0; r < 4; ++r) { const v4u xv = x[r + w];
            out[r][0] += bflo(xv.x) * w0.x; out[r][1] += bfhi(xv.x) * w0.y; out[r][2] += bflo(xv.y) * w0.z; out[r][3] += bfhi(xv.y) * w0.w;
            out[r][4] += bflo(xv.z) * w1.x; out[r][5] += bfhi(xv.z) * w1.y; out[r][6] += bflo(xv.w) * w1.z; out[r][7] += bfhi(xv.w) * w1.w; }
    }
#pragma unroll
    for (int r = 0; r < 4; ++r) { const float rs = scale * (rowscale ? rowscale[4 * rg + r] : 1.f); float o[8];
#pragma unroll
        for (int e = 0; e < 8; ++e) { const float a = out[r][e]; o[e] = a * sigmoidf_(a) * rs; }
        v4u w; w.x = pk2(o[0], o[1]); w.y = pk2(o[2], o[3]); w.z = pk2(o[4], o[5]); w.w = pk2(o[6], o[7]);
        *(LAS v4u*)(dst + (4 * rg + r) * TP + cc * 16) = w; }
}
__device__ __forceinline__ void copy_v_tile(LAS unsigned char* dst, const bf16* PROJ, int row0, int col, int tid) {
#pragma unroll
    for (int k = 0; k < 4; ++k) { const int i = tid + 512 * k, r = i >> 4, cc = i & 15;
        *(LAS v4u*)(dst + r * TP + cc * 16) = *(const v4u*)(PROJ + (size_t)(row0 + r) * NPROJ + col + 8 * cc); }
}
__device__ __forceinline__ void chunk_scan(const float* lf, const float* ig, int row0, int h, int lane, float& b0, float& b1, float& u0, float& u1, float& c0, float& c1) {
    const float a0 = lf[(row0 + 2 * lane) * 4 + h], a1 = lf[(row0 + 2 * lane + 1) * 4 + h];
    const float sp = a0 + a1; float incl = sp;
#pragma unroll
    for (int o = 1; o < 64; o <<= 1) { const float t = __shfl_up(incl, o); if (lane >= o) incl += t; }
    const float excl = incl - sp;
    b0 = excl + a0; b1 = incl;
    u0 = ig[(row0 + 2 * lane) * 4 + h] - b0; u1 = ig[(row0 + 2 * lane + 1) * 4 + h] - b1;
    const float pm = fmaxf(u0, u1); float im = pm;
#pragma unroll
    for (int o = 1; o < 64; o <<= 1) { const float t = __shfl_up(im, o); if (lane >= o) im = fmaxf(im, t); }
    float em = __shfl_up(im, 1); if (lane == 0) em = -INFINITY;
    c0 = fmaxf(em, u0); c1 = im;
}

__device__ __forceinline__ void p3_mlstm_local_mfma(Frame& F) {
    const int tid = F.tid, lane = F.lane, fr = lane & 15, g4 = lane >> 4, w = F.wave;
    LAS unsigned char* sK = F.lds + ML_K; LAS unsigned char* sV = F.lds + ML_V;
    LAS float* sW = (LAS float*)(F.lds + ML_S);
    Claimer C{-2};
    for (int u = claim_unit(F, 1, 512, C); u < 512; u = claim_unit(F, 1, 512, C)) {
        const int bh = u >> 5, c = u & 31, b = bh >> 2, h = bh & 3, row0 = b * SEQ + c * 128;
        __syncthreads();
        if (w == 0) { float b0, b1, u0, u1, c0, c1; chunk_scan(F.lf, F.ig, row0, h, lane, b0, b1, u0, u1, c0, c1);
            const float um = __shfl(c1, 63);
            sW[2 * lane] = __expf(u0 - um); sW[2 * lane + 1] = __expf(u1 - um);
            if (lane == 63) { F.chk[u] = b1; F.chk[512 + u] = um; } }
        copy_v_tile(sV, F.PROJ, row0, C_VB + h * 128, tid);
        __syncthreads();
        build_conv_tile(sK, F.PROJ, row0, c == 0, 512 + h * 128, F.w_conv, F.b_conv, 0.08838834764831845f, sW, tid);
        __syncthreads();
        f32x4 acc[8];
#pragma unroll
        for (int i = 0; i < 8; ++i) acc[i] = (f32x4){0.f, 0.f, 0.f, 0.f};
        const int tro = (4 * g4 + (fr >> 2)) * TP + (fr & 3) * 8;
#pragma unroll
        for (int ks = 0; ks < 4; ++ks) {
            const bf16x8m vt = tr2(sV + ks * 32 * TP + tro + 32 * w);
#pragma unroll
            for (int nb = 0; nb < 8; ++nb) { const bf16x8m kt = tr2(sK + ks * 32 * TP + tro + 32 * nb);
                acc[nb] = __builtin_amdgcn_mfma_f32_16x16x32_bf16(vt, kt, acc[nb], 0, 0, 0); }
        }
#pragma unroll
        for (int nb = 0; nb < 8; ++nb) { v2u o; o.x = pk2(acc[nb][0], acc[nb][1]); o.y = pk2(acc[nb][2], acc[nb][3]);
            *(v2u*)((bf16*)F.L + (size_t)u * 16384 + (16 * nb + fr) * 128 + 16 * w + 4 * g4) = o; }
        { const int d = tid & 127, sq = tid >> 7; float n = 0.f;
#pragma unroll 8
            for (int s2 = 0; s2 < 32; ++s2) n += bf2f(*(const LAS unsigned short*)(sK + (32 * sq + s2) * TP + d * 2));
            sW[128 + sq * 128 + d] = n; }
        __syncthreads();
        if (tid < 128) F.NLOC[u * 128 + tid] = (sW[128 + tid] + sW[256 + tid]) + (sW[384 + tid] + sW[512 + tid]);
    }
}

__device__ __forceinline__ void p5_mlstm_out_mfma(Frame& F) {
    const int tid = F.tid, lane = F.lane, fr = lane & 15, g4 = lane >> 4, w = F.wave;
    LAS unsigned char* sA = F.lds + ML_A; LAS unsigned char* sK = F.lds + ML_K; LAS unsigned char* sV = F.lds + ML_V;
    LAS float* sB = (LAS float*)(F.lds + ML_S); LAS float* sU = sB + 128; LAS float* sG = sU + 128; LAS float* sN = sG + 128;
    const int tro = (4 * g4 + (fr >> 2)) * TP + (fr & 3) * 8;
    Claimer C{-2};
    for (int u = claim_unit(F, 4, 512, C); u < 512; u = claim_unit(F, 4, 512, C)) {
        const int bh = u >> 5, c = u & 31, b = bh >> 2, h = bh & 3, row0 = b * SEQ + c * 128;
        const float mc = F.chk[1024 + u];
        v2u cpre[8];
#pragma unroll
        for (int k = 0; k < 8; ++k) { const int i = tid + 512 * k, d = i >> 5, e4 = i & 31;
            cpre[k] = *(const v2u*)((const bf16*)F.CPRE + (size_t)u * 16384 + d * 128 + 4 * e4); }
        __syncthreads();
        if (w == 0) { float b0, b1, u0, u1, c0, c1; chunk_scan(F.lf, F.ig, row0, h, lane, b0, b1, u0, u1, c0, c1);
            sB[2 * lane] = b0; sB[2 * lane + 1] = b1; sU[2 * lane] = u0; sU[2 * lane + 1] = u1; sG[2 * lane] = fmaxf(mc, c0); sG[2 * lane + 1] = fmaxf(mc, c1); }
        if (w == 1) { sN[lane] = F.NPRE[u * 128 + lane]; sN[64 + lane] = F.NPRE[u * 128 + 64 + lane]; }
        build_conv_tile(sA, F.PROJ, row0, c == 0, h * 128, F.w_conv, F.b_conv, 1.f, nullptr, tid);
        build_conv_tile(sK, F.PROJ, row0, c == 0, 512 + h * 128, F.w_conv, F.b_conv, 0.08838834764831845f, nullptr, tid);
        copy_v_tile(sV, F.PROJ, row0, C_VB + h * 128, tid);
        __syncthreads();
        const int t = 16 * w + fr;
        const float gt = sG[t], bt = sB[t], wi = __expf(mc - gt);
        bf16x8m qf[4];
#pragma unroll
        for (int kd = 0; kd < 4; ++kd) qf[kd] = rd_sigma(sA + t * TP + kd * 64 + 8 * g4);
        float qn = 0.f;
#pragma unroll
        for (int i = 0; i < 4; ++i) { const v4u qq = *(const LAS v4u*)(sA + t * TP + 64 * g4 + 16 * i); const LAS float* nn = sN + 32 * g4 + 8 * i;
            qn += bflo(qq.x) * nn[0] + bfhi(qq.x) * nn[1] + bflo(qq.y) * nn[2] + bfhi(qq.y) * nn[3] + bflo(qq.z) * nn[4] + bfhi(qq.z) * nn[5] + bflo(qq.w) * nn[6] + bfhi(qq.w) * nn[7]; }
        qn += __shfl_xor(qn, 16); qn += __shfl_xor(qn, 32);
        bf16x8m pb[4]; float psum = 0.f;
#pragma unroll
        for (int j = 0; j < 4; ++j) {
            pb[j] = (bf16x8m){0, 0, 0, 0, 0, 0, 0, 0};
            if (j <= (w >> 1)) {
                f32x4 sv[2];
#pragma unroll
                for (int sub = 0; sub < 2; ++sub) { sv[sub] = (f32x4){0.f, 0.f, 0.f, 0.f};
                    const LAS unsigned char* kr = sK + (32 * j + 16 * sub + fr) * TP + 8 * g4;
#pragma unroll
                    for (int kd = 0; kd < 4; ++kd) sv[sub] = __builtin_amdgcn_mfma_f32_16x16x32_bf16(rd_sigma(kr + kd * 64), qf[kd], sv[sub], 0, 0, 0);
                    const f32x4 us = *(const LAS f32x4*)(sU + 32 * j + 16 * sub + 4 * g4);
#pragma unroll
                    for (int i = 0; i < 4; ++i) { const int s2 = 32 * j + 16 * sub + 4 * g4 + i; const float pv = (s2 <= t) ? sv[sub][i] * __expf(us[i] - gt) : 0.f; sv[sub][i] = pv; psum += pv; } }
                v4u pw; pw.x = pk2(sv[0][0], sv[0][1]); pw.y = pk2(sv[0][2], sv[0][3]); pw.z = pk2(sv[1][0], sv[1][1]); pw.w = pk2(sv[1][2], sv[1][3]);
                pb[j] = __builtin_bit_cast(bf16x8m, pw);
            }
        }
        psum += __shfl_xor(psum, 16); psum += __shfl_xor(psum, 32);
        const float den = wi * qn + psum, dinv = 1.f / fmaxf(fabsf(den), __expf(-(bt + gt)));
        __syncthreads();
#pragma unroll
        for (int k = 0; k < 8; ++k) { const int i = tid + 512 * k, d = i >> 5, e4 = i & 31; *(LAS v2u*)(sA + d * TP + e4 * 8) = cpre[k]; }
        __syncthreads();
        v2u obr[8];
#pragma unroll
        for (int eb = 0; eb < 8; ++eb) obr[eb] = *(const v2u*)(F.PROJ + (size_t)(row0 + t) * NPROJ + C_OB + h * 128 + 16 * eb + 4 * g4);
        f32x4 acc[8];
#pragma unroll
        for (int i = 0; i < 8; ++i) acc[i] = (f32x4){0.f, 0.f, 0.f, 0.f};
#pragma unroll
        for (int kd = 0; kd < 4; ++kd)
#pragma unroll
            for (int eb = 0; eb < 8; ++eb) acc[eb] = __builtin_amdgcn_mfma_f32_16x16x32_bf16(tr2(sA + kd * 32 * TP + tro + 32 * eb), qf[kd], acc[eb], 0, 0, 0);
#pragma unroll
        for (int eb = 0; eb < 8; ++eb) acc[eb] = acc[eb] * wi;
#pragma unroll
        for (int j = 0; j < 4; ++j)
            if (j <= (w >> 1)) {
#pragma unroll
                for (int eb = 0; eb < 8; ++eb) acc[eb] = __builtin_amdgcn_mfma_f32_16x16x32_bf16(tr2(sV + j * 32 * TP + tro + 32 * eb), pb[j], acc[eb], 0, 0, 0); }
        float ssq = 0.f;
#pragma unroll
        for (int eb = 0; eb < 8; ++eb) { acc[eb] = acc[eb] * dinv; ssq += (acc[eb][0] * acc[eb][0] + acc[eb][1] * acc[eb][1]) + (acc[eb][2] * acc[eb][2] + acc[eb][3] * acc[eb][3]); }
        ssq += __shfl_xor(ssq, 16); ssq += __shfl_xor(ssq, 32);
        const float rs = 1.f / sqrtf(ssq * (1.f / 128.f) + EPS);
        const int row = row0 + t;
#pragma unroll
        for (int eb = 0; eb < 8; ++eb) { const int e = 16 * eb + 4 * g4;
            const v2u ob = obr[eb]; const f32x4 gg = *(const f32x4*)(F.mhg + h * 128 + e);
            v2u o; o.x = pk2(acc[eb][0] * rs * gg.x * sigmoidf_(bflo(ob.x)), acc[eb][1] * rs * gg.y * sigmoidf_(bfhi(ob.x)));
            o.y = pk2(acc[eb][2] * rs * gg.z * sigmoidf_(bflo(ob.y)), acc[eb][3] * rs * gg.w * sigmoidf_(bfhi(ob.y)));
            *(v2u*)(F.MIX + (size_t)row * DM + 512 + h * 128 + e) = o; }
    }
}

__device__ __forceinline__ void p3_mlstm_sample(Frame& F) {
    const int tid = F.tid;
    LAS float* sQ = (LAS float*)F.lds;
    LAS float* sKs = sQ + 1024;
    LAS float* sV = sKs + 1024;
    LAS float* sQC = sV + 1024;
    LAS float* sH = sQC + 16384;
    LAS float* sN0 = sH + 1024;
    LAS float* sS = sN0 + 128;
    Claimer C{-2};
    for (int u = claim_unit(F, 2, 512, C); u < 512; u = claim_unit(F, 2, 512, C)) {
        const int b = u >> 2, h = u & 3, r0 = MP + b * DTS;
        __syncthreads();
        {
            float xa[4][4], wcv[4][4], bc[4];
#pragma unroll
            for (int k = 0; k < 4; ++k) { const int part = k >> 1, t = (tid >> 7) + 4 * (k & 1), d = tid & 127, col = part * 512 + h * 128 + d;
                bc[k] = F.b_conv[col];
#pragma unroll
                for (int w = 0; w < 4; ++w) { const int tt = t + w - 3, tp = tt < 0 ? 0 : tt, ts = tt < 0 ? 3 + tt : 0;
                    const float xp = bf2f(F.PROJ[(size_t)(r0 + tp) * NPROJ + C_RAW + col]), xs = F.st_conv[((size_t)b * 3 + ts) * 1024 + col];
                    xa[k][w] = (tt >= 0) ? xp : xs; wcv[k][w] = F.w_conv[w * 1024 + col]; } }
#pragma unroll
            for (int k = 0; k < 4; ++k) { const int part = k >> 1, t = (tid >> 7) + 4 * (k & 1), d = tid & 127;
                const float a = bc[k] + (xa[k][0] * wcv[k][0] + xa[k][1] * wcv[k][1]) + (xa[k][2] * wcv[k][2] + xa[k][3] * wcv[k][3]);
                const float sv = a * sigmoidf_(a);
                if (part == 0) sQ[t * 128 + d] = sv; else sKs[t * 128 + d] = sv * 0.08838834764831845f; }
        }
        for (int i = tid; i < 1024; i += 512) sV[i] = bf2f(F.PROJ[(size_t)(r0 + (i >> 7)) * NPROJ + C_VB + h * 128 + (i & 127)]);
        if (tid < 128) sN0[tid] = F.st_n[(size_t)u * 128 + tid];
        if (F.wave == 7) {
            const int t = F.lane & 7; const float m0 = F.st_m[u];
            const float lfv = F.lf[(r0 + t) * 4 + h], igv = F.ig[(r0 + t) * 4 + h];
            float acc = lfv;
#pragma unroll
            for (int o = 1; o < 8; o <<= 1) { const float x = __shfl_up(acc, o); if (t >= o) acc += x; }
            const float uu = igv - acc;
            float cm = uu;
#pragma unroll
            for (int o = 1; o < 8; o <<= 1) { const float x = __shfl_up(cm, o); if (t >= o) cm = fmaxf(cm, x); }
            const float um = __shfl(cm, 7), b7 = __shfl(acc, 7);
            cm = fmaxf(cm, m0);
            const float Mx = fmaxf(m0, um);
            if (F.lane < 8) { sS[t] = acc; sS[8 + t] = uu; sS[16 + t] = cm; sS[24 + t] = __expf(m0 - cm); sS[32 + t] = __expf(uu - Mx); }
            if (F.lane == 0) { sS[40] = __expf(m0 - Mx); F.out[O_SM + u] = b7 + Mx; }
        }
        __syncthreads();
        { const int pr = tid >> 3, part = tid & 7, t = pr >> 3, s = pr & 7; float d = 0.f;
#pragma unroll
            for (int k4 = 0; k4 < 4; ++k4) { const f32x4 qa = *(const LAS f32x4*)(sQ + t * 128 + 16 * part + 4 * k4), kb = *(const LAS f32x4*)(sKs + s * 128 + 16 * part + 4 * k4);
                d += (qa.x * kb.x + qa.y * kb.y) + (qa.z * kb.z + qa.w * kb.w); }
            d += __shfl_xor(d, 1); d += __shfl_xor(d, 2); d += __shfl_xor(d, 4);
            if (part == 0) sS[64 + pr] = (s <= t) ? d * __expf(sS[8 + s] - sS[16 + t]) : 0.f; }
        {
            const int e4 = opaque(tid & 31), dr = opaque(tid >> 5); const float alpha = sS[40];
            f32x4 vb[8], aq[8];
#pragma unroll
            for (int s2 = 0; s2 < 8; ++s2) { vb[s2] = *(const LAS f32x4*)(sV + s2 * 128 + 4 * e4) * sS[32 + s2]; aq[s2] = (f32x4){0.f, 0.f, 0.f, 0.f}; }
            f32x4 c0[8];
#pragma unroll
            for (int it = 0; it < 8; ++it) c0[it] = __builtin_nontemporal_load((const f32x4*)(F.st_C + ((size_t)u * 128 + it * 16 + dr) * 128 + 4 * e4));
#pragma unroll
            for (int it = 0; it < 8; ++it) { const int d = it * 16 + dr;
                f32x4 cn = c0[it] * alpha;
#pragma unroll
                for (int s2 = 0; s2 < 8; ++s2) { cn += vb[s2] * sKs[s2 * 128 + d]; aq[s2] += c0[it] * sQ[s2 * 128 + d]; }
                __builtin_nontemporal_store(cn, (f32x4*)(F.out + O_SC + ((size_t)u * 128 + d) * 128 + 4 * e4)); }
#pragma unroll
            for (int s2 = 0; s2 < 8; ++s2) *(LAS f32x4*)(sQC + (dr * 8 + s2) * 128 + 4 * e4) = aq[s2];
        }
        if (tid < 128) { float n = sS[40] * sN0[tid];
#pragma unroll
            for (int s = 0; s < 8; ++s) n += sS[32 + s] * sKs[s * 128 + tid];
            F.out[O_SN + (size_t)u * 128 + tid] = n; }
        __syncthreads();
        { const int t = F.wave; float qn = sQ[t * 128 + F.lane] * sN0[F.lane] + sQ[t * 128 + 64 + F.lane] * sN0[64 + F.lane];
            qn = wave_sum(qn);
            if (F.lane == 0) { float den = sS[24 + t] * qn;
#pragma unroll
                for (int s2 = 0; s2 < 8; ++s2) den += sS[64 + t * 8 + s2];
                sS[48 + t] = fmaxf(fabsf(den), __expf(-(sS[t] + sS[16 + t]))); } }
        __syncthreads();
        { const int e = tid & 127, tq = tid >> 7;
#pragma unroll
            for (int k = 0; k < 2; ++k) { const int t = tq * 2 + k;
                float qc = 0.f;
#pragma unroll
                for (int dr = 0; dr < 16; ++dr) qc += sQC[(dr * 8 + t) * 128 + e];
                float num = sS[24 + t] * qc;
#pragma unroll
                for (int s = 0; s < 8; ++s) num += sS[64 + t * 8 + s] * sV[s * 128 + e];
                sH[t * 128 + e] = num / sS[48 + t]; } }
        __syncthreads();
        { const int t = F.wave; const float h0 = sH[t * 128 + F.lane], h1 = sH[t * 128 + 64 + F.lane];
            const float ssq = wave_sum(h0 * h0 + h1 * h1); const float rs = 1.f / sqrtf(ssq * (1.f / 128.f) + EPS);
            const int row = r0 + t;
#pragma unroll
            for (int k = 0; k < 2; ++k) { const int e = F.lane + 64 * k; const float hv = k ? h1 : h0;
                const float ob = bf2f(F.PROJ[(size_t)row * NPROJ + C_OB + h * 128 + e]);
                F.MIX[(size_t)row * DM + 512 + h * 128 + e] = (bf16)f2bf(hv * rs * F.mhg[h * 128 + e] * sigmoidf_(ob)); } }
    }
}

__device__ __forceinline__ void p4_prefix_v1(Frame& F) {
    const int tid = F.tid;
    const int npw = (F.G >= 64) ? F.G - 16 : F.G;
    for (int u = F.vcu; u < 256; u += npw) {
        const int chain = u >> 4, sl = u & 15, idx = sl * 1024 + tid * 2;
        float m = 0.f, c0 = 0.f, c1 = 0.f, nn = 0.f;
        const bool nrow = (sl == 0 && tid < 128);
#pragma unroll 1
        for (int cb = 0; cb < 32; cb += 8) {
            float l0[8], l1[8], nl[8], bc[8], um8[8];
#pragma unroll
            for (int k = 0; k < 8; ++k) { const int unit = chain * 32 + cb + k;
                const unsigned lw = *(const unsigned*)((const bf16*)F.L + (size_t)unit * 16384 + idx); l0[k] = bflo(lw); l1[k] = bfhi(lw);
                nl[k] = nrow ? F.NLOC[unit * 128 + tid] : 0.f; bc[k] = F.chk[unit]; um8[k] = F.chk[512 + unit]; }
#pragma unroll
            for (int k = 0; k < 8; ++k) { const int unit = chain * 32 + cb + k;
                *(unsigned*)((bf16*)F.CPRE + (size_t)unit * 16384 + idx) = pk2(c0, c1);
                if (nrow) F.NPRE[unit * 128 + tid] = nn;
                if (sl == 0 && tid == 0) F.chk[1024 + unit] = m;
                const float Mx = fmaxf(m, um8[k]), a = __expf(m - Mx), bb = __expf(um8[k] - Mx);
                c0 = a * c0 + bb * l0[k]; c1 = a * c1 + bb * l1[k]; nn = a * nn + bb * nl[k];
                m = bc[k] + Mx; }
        }
        F.out[O_PC + (size_t)chain * 16384 + idx] = c0; F.out[O_PC + (size_t)chain * 16384 + idx + 1] = c1;
        if (sl == 0 && tid < 128) F.out[O_PN + chain * 128 + tid] = nn;
        if (sl == 0 && tid == 0) F.out[O_PM + chain] = m;
    }
}


__device__ __forceinline__ void probe_copy_simple(Frame& F) {
    constexpr int PER_B = (WBUF - DTS) * 128;
    const int total = DBS * PER_B;
    for (int i = F.vcu * 512 + F.tid; i < total; i += F.G * 512) {
        const int b = i / PER_B, r = i - b * PER_B;
        const size_t so = (size_t)b * (WBUF * 128) + DTS * 128 + r, dofs = (size_t)b * (WBUF * 128) + r;
        const f32x4 a = __builtin_nontemporal_load((const f32x4*)F.cache_k + so);
        const f32x4 c = __builtin_nontemporal_load((const f32x4*)F.cache_v + so);
        *((f32x4*)(F.out + O_SK) + dofs) = a;
        *((f32x4*)(F.out + O_SV) + dofs) = c;
    }
}


template <int NCU, int UNR>
__device__ __forceinline__ void probe_copy_subset(Frame& F) {
    constexpr int STEP = 256 / NCU;
    if (F.vcu % STEP) return;
    const int me = F.vcu / STEP;
    constexpr int PER_B = (WBUF - DTS) * 128;
    const int total = DBS * PER_B;
    for (int i0 = me * 512 * UNR + F.tid; i0 < total; i0 += NCU * 512 * UNR) {
        f32x4 a[UNR], c[UNR];
#pragma unroll
        for (int k = 0; k < UNR; ++k) { int i = i0 + 512 * k; i = i < total ? i : total - 1; const int b = i / PER_B, r = i - b * PER_B;
            const size_t so = (size_t)b * (WBUF * 128) + DTS * 128 + r;
            a[k] = __builtin_nontemporal_load((const f32x4*)F.cache_k + so); c[k] = __builtin_nontemporal_load((const f32x4*)F.cache_v + so); }
#pragma unroll
        for (int k = 0; k < UNR; ++k) { int i = i0 + 512 * k; i = i < total ? i : total - 1; const int b = i / PER_B, r = i - b * PER_B;
            const size_t dofs = (size_t)b * (WBUF * 128) + r;
            *((f32x4*)(F.out + O_SK) + dofs) = a[k]; *((f32x4*)(F.out + O_SV) + dofs) = c[k]; }
    }
}

__device__ __forceinline__ void p9_final_norm(Frame& F, int m0) {
    const int gw = F.vcu * 8 + F.wave, NGW = F.G * 8;
    for (int m = m0 + gw; m < M; m += NGW) {
        f32x4* p = (f32x4*)(F.out + (size_t)m * DM);
        f32x4 v[4]; float ss = 0.f;
#pragma unroll
        for (int j = 0; j < 4; ++j) { v[j] = p[64 * j + F.lane];
            if (m >= MP) {
#pragma unroll
                for (int ks = 0; ks < 8; ++ks) v[j] += *((const f32x4*)(F.ws + WS_PART) + ((size_t)ks * MS + (m - MP)) * 256 + 64 * j + F.lane); }
            ss += (v[j].x * v[j].x + v[j].y * v[j].y) + (v[j].z * v[j].z + v[j].w * v[j].w); }
        ss = wave_sum(ss);
        const float rs = 1.f / sqrtf(ss * (1.f / DM) + EPS);
#pragma unroll
        for (int j = 0; j < 4; ++j) { const f32x4 g = *(const f32x4*)(F.gf + 256 * j + 4 * F.lane); p[64 * j + F.lane] = v[j] * rs * g; }
    }
}

__device__ __forceinline__ void help_convert(Frame& F, int phase) {
    unsigned* ctl = (unsigned*)(F.ws + WS_CPY);
    unsigned* ctr = (unsigned*)(F.ws + WS_CLAIM) + 64 * 3;
    volatile LAS int* sh = (volatile LAS int*)(F.lds + MISC_OFF + 64);
    LAS float* scr = (LAS float*)(F.lds + F.wave * 16384);
    constexpr int I_UP = 16 * 128, I_DN = 64 * 32;
    __syncthreads();
    if (phase >= 0 && F.tid == 0) __hip_atomic_fetch_add(ctl + 64 * (1 + phase), 1u, __ATOMIC_RELAXED, __HIP_MEMORY_SCOPE_AGENT);
    for (;;) {
        if (F.tid == 0) { int c0 = -1;
            const bool busy = (phase < 0) || (__hip_atomic_load(ctl + 64 * (1 + phase), __ATOMIC_RELAXED, __HIP_MEMORY_SCOPE_AGENT) < (unsigned)F.G);
            if (busy) { const unsigned c = __hip_atomic_fetch_add(ctr, 8u, __ATOMIC_RELAXED, __HIP_MEMORY_SCOPE_AGENT); if (c < (unsigned)(I_UP + I_DN)) c0 = (int)c; }
            sh[0] = c0; }
        __syncthreads();
        const int c0 = sh[0];
        __syncthreads();
        if (c0 < 0) break;
        const int it = c0 + F.wave;
        if (it < I_UP) p0_transpose_item(F.w_up, DM, FF, 128, F.g2, F.Wup_t, scr, it, F.lane);
        else p0_transpose_item(F.w_down, FF, DM, 32, nullptr, F.Wdn_t, scr, it - I_UP, F.lane);
    }
}

struct Args { const float* in[19]; float* out; unsigned char* ws; int ph_lo, ph_hi; };
__global__ void __launch_bounds__(512, 2) fwd(Args args) {
    extern __shared__ __attribute__((aligned(16))) unsigned char lds[];
    Frame F;
    F.lds = (LAS unsigned char*)lds;
    F.tid = threadIdx.x; F.lane = F.tid & 63; F.wave = __builtin_amdgcn_readfirstlane(F.tid >> 6);
    F.G = gridDim.x; { const int bx = blockIdx.x; F.vcu = (F.G % 8 == 0) ? (bx % 8) * (F.G / 8) + bx / 8 : bx; }
    F.xp = args.in[0]; F.xs = args.in[1]; F.cache_k = args.in[2]; F.cache_v = args.in[3]; F.st_conv = args.in[4]; F.st_C = args.in[5]; F.st_n = args.in[6]; F.st_m = args.in[7];
    F.g1 = args.in[8]; F.w_in = args.in[9]; F.b_gate = args.in[10]; F.w_conv = args.in[11]; F.b_conv = args.in[12]; F.mhg = args.in[13]; F.w_out = args.in[14]; F.g2 = args.in[15];
    F.w_up = args.in[16]; F.w_down = args.in[17]; F.gf = args.in[18];
    F.out = args.out; F.ws = args.ws;
    unsigned char* ws = args.ws;
    F.Win_t = (bf16*)(ws + WS_WIN); F.Wout_t = (bf16*)(ws + WS_WOUT); F.Wup_t = (bf16*)(ws + WS_WUP); F.Wdn_t = (bf16*)(ws + WS_WDN);
    F.XB = (bf16*)(ws + WS_XB); F.PROJ = (bf16*)(ws + WS_PROJ); F.MIX = (bf16*)(ws + WS_MIX); F.HPB = (bf16*)(ws + WS_HPB); F.ACT = (bf16*)(ws + WS_ACT);
    F.rope = (float*)(ws + WS_ROPE); F.rstd1 = (float*)(ws + WS_RSTD1); F.ig = (float*)(ws + WS_IG); F.lf = (float*)(ws + WS_LF); F.chk = (float*)(ws + WS_CHK);
    F.ss2 = (float*)(ws + WS_SS2P); F.ssf = (float*)(ws + WS_SSFP); F.QF = (float*)(ws + WS_QF); F.KF = (float*)(ws + WS_KF); F.L = (float*)(ws + WS_L);
    F.CPRE = (float*)(ws + WS_CPRE); F.NLOC = (float*)(ws + WS_NLOC); F.NPRE = (float*)(ws + WS_NPRE);
    volatile LAS unsigned* MISC = (volatile LAS unsigned*)(F.lds + MISC_OFF);
    if (F.tid < 32) MISC[F.tid] = 0u;
    __syncthreads();
    XcdBarrier bar; bar.bar = (unsigned*)(ws + WS_CTL) + CW_BAR; bar.x = 0; bar.st = nullptr;
    if (!PER_PHASE_LAUNCH) bar = xcd_barrier_post((unsigned*)(ws + WS_CTL) + CW_BAR, MISC + 8);
#ifdef STAMP_SEL
    volatile LAS unsigned long long* stamps = (volatile LAS unsigned long long*)(F.lds + MISC_OFF + 256);
    int n_stamp = 0;
#define STAMP() do { if (blockIdx.x == 0 && F.tid == 0) stamps[n_stamp] = __builtin_amdgcn_s_memrealtime(); ++n_stamp; } while (0)
#else
#define STAMP() do { } while (0)
#endif
    STAMP();
#define GRID_BAR() do { if (!PER_PHASE_LAUNCH) xcd_barrier(bar); STAMP(); } while (0)
#ifdef SUBSTAMPS
#define SUBSTAMP() STAMP()
#else
#define SUBSTAMP() do { } while (0)
#endif
    const int lo = args.ph_lo, hi = args.ph_hi;
#ifndef PHASE_MASK
#define PHASE_MASK 0x3ff
#endif
#define IN(k) (((PHASE_MASK >> (k)) & 1) && lo <= (k) && (k) < hi)
#ifndef DUP_MASK
#define DUP_MASK 0
#endif
#define DUP(k) ((DUP_MASK >> (k)) & 1)
#ifndef HELP_MASK
#define HELP_MASK 0x92
#endif
#define HELP(k) ((HELP_MASK >> (k)) & 1)
    if (IN(0)) { p0_prologue(F); if (DUP(0)) { __syncthreads(); p0_prologue(F); } if (HELP(0)) help_copy(F, 0); GRID_BAR(); }
    if (IN(1)) {
        pg8::Gemm g{F.XB, F.Win_t, M, NPROJ, DM, DM}; pg8::StaticOrder S; S.init(M, NPROJ, F.G, (int)blockIdx.x);
        pg8::EpiIn E{F.PROJ, F.rstd1, F.rope, F.out};
        pg8::gemm_phase<pg8::EpiIn, pg8::StaticOrder, true, true>(F.lds, g, S, E);
        if (DUP(1)) { __syncthreads(); pg8::gemm_phase<pg8::EpiIn, pg8::StaticOrder, true, true>(F.lds, g, S, E); }
        if (HELP(1)) { help_convert(F, 1); help_copy(F, 1, false); }
        GRID_BAR();
    }
#ifndef QUOTA_ATT
#define QUOTA_ATT 0
#endif
#ifndef ANTIPHASE
#define ANTIPHASE 1
#endif
#ifndef SAMPLE_UP_IN_P5
#define SAMPLE_UP_IN_P5 0
#endif
#ifndef ATT_LIM
#define ATT_LIM 600
#endif
    if (IN(2)) {
        if (ANTIPHASE && !((F.vcu >> 1) & 1)) {   Claimer CA{-2}; p2_attn_prompt_mfma(F, ATT_LIM, CA); SUBSTAMP(); __syncthreads(); p2_sample_stream<true>(F); SUBSTAMP(); __syncthreads(); p2_attn_prompt_mfma(F, 1 << 30, CA); __syncthreads(); }
        else { Claimer CA{-2}; p2_sample_stream<true>(F); SUBSTAMP(); __syncthreads(); p2_attn_prompt_mfma(F, 1 << 30, CA); SUBSTAMP(); __syncthreads(); }
    }
    if (IN(3)) { p3_mlstm_local_mfma(F); SUBSTAMP(); p3_mlstm_sample(F); SUBSTAMP(); if (HELP(3)) help_copy(F, 3); GRID_BAR(); }
    if (IN(4)) {
        if (F.G >= 64 && F.vcu >= F.G - 16) {
            pg8::Gemm g{F.MIX, F.Wout_t, M, DM, DM, DM}; pg8::RangeOrder S{MP / 256, MS / 256, DM / 256, 1, 0, 16, F.vcu - (F.G - 16)};
            pg8::EpiOut<true> E{F.xp, F.xs, F.out, F.HPB, F.ss2, F.XB};
            pg8::gemm_phase<pg8::EpiOut<true>, pg8::RangeOrder, true, true>(F.lds, g, S, E);
            if (DUP(4)) { __syncthreads(); pg8::EpiScratch E2{(float*)(F.ws + WS_SCR)}; pg8::gemm_phase<pg8::EpiScratch, pg8::RangeOrder, true, true>(F.lds, g, S, E2); }
        } else { p4_prefix_v1(F); if (DUP(4)) { __syncthreads(); p4_prefix_v1(F); } help_convert(F, -1); }
#ifndef P4_HELPERS
#define P4_HELPERS 256
#endif
        if (HELP(4)) { if (F.vcu < P4_HELPERS) help_copy(F, 4); else help_copy(F, 4, true, true); }
        GRID_BAR();
    }
    if (IN(5)) {
        if (SAMPLE_UP_IN_P5 && F.G == 256) {
            pg8::Gemm g{F.HPB, F.Wup_t, M, FF, DM, DM}; pg8::RangeOrder S{MP / 256, MS / 256, FF / 256, 1, 0, F.G, F.vcu};
            pg8::EpiUp E{F.ACT, F.ss2};
            pg8::gemm_phase<pg8::EpiUp, pg8::RangeOrder, true, true>(F.lds, g, S, E);
            __syncthreads();
        }
        p5_mlstm_out_mfma(F); if (DUP(5)) { __syncthreads(); p5_mlstm_out_mfma(F); } if (HELP(5)) help_copy(F, 5); GRID_BAR(); }
    if (IN(6)) {
        pg8::Gemm g{F.MIX, F.Wout_t, MP, DM, DM, DM}; pg8::StaticOrder S; S.init(MP, DM, F.G, (int)blockIdx.x);
        if (F.G == 256) { pg8::EpiOut<false> E{F.xp, F.xs, F.out, F.HPB, F.ss2, F.XB}; pg8::gemm_phase<pg8::EpiOut<false>, pg8::StaticOrder, true, true>(F.lds, g, S, E); }
        else { pg8::EpiOut<true> E{F.xp, F.xs, F.out, F.HPB, F.ss2, F.XB}; pg8::gemm_phase<pg8::EpiOut<true>, pg8::StaticOrder, true, true>(F.lds, g, S, E); }
        if (DUP(6)) { __syncthreads(); pg8::EpiScratch E2{(float*)(F.ws + WS_SCR)}; pg8::gemm_phase<pg8::EpiScratch, pg8::StaticOrder, true, true>(F.lds, g, S, E2); }
        if (HELP(6)) help_copy(F, 6);
        GRID_BAR();
    }
    if (IN(7)) {
        const int mrows = (SAMPLE_UP_IN_P5 && F.G == 256) ? MP : M;
        pg8::Gemm g{F.HPB, F.Wup_t, mrows, FF, DM, DM}; pg8::StaticOrder S; S.init(mrows, FF, F.G, (int)blockIdx.x);
        pg8::EpiUp E{F.ACT, F.ss2};
        pg8::gemm_phase<pg8::EpiUp, pg8::StaticOrder, true, true>(F.lds, g, S, E);
        if (DUP(7)) { __syncthreads(); pg8::gemm_phase<pg8::EpiUp, pg8::StaticOrder, true, true>(F.lds, g, S, E); }
        if (HELP(7)) help_copy(F, 7);
        GRID_BAR();
    }
    if (IN(8)) {
        {
            pg8::Gemm g{F.ACT, F.Wdn_t, MP, DM, FF, FF}; pg8::StaticOrder S; S.init(MP, DM, F.G, (int)blockIdx.x);
            if (F.G == 256) { pg8::EpiDownNorm E{F.out, F.HPB, F.ssf, (unsigned*)(F.ws + WS_PCNT), F.gf};
                pg8::gemm_phase<pg8::EpiDownNorm, pg8::StaticOrder, true, true>(F.lds, g, S, E); }
            else { pg8::EpiDown<false> E{F.out};
                pg8::gemm_phase<pg8::EpiDown<false>, pg8::StaticOrder, true, true>(F.lds, g, S, E); }
        }
        if (DUP(8)) { __syncthreads(); pg8::Gemm g{F.ACT, F.Wdn_t, MP, DM, FF, FF}; pg8::StaticOrder S; S.init(MP, DM, F.G, (int)blockIdx.x);
            pg8::EpiScratch E{(float*)(F.ws + WS_SCR)}; pg8::gemm_phase<pg8::EpiScratch, pg8::StaticOrder, true, true>(F.lds, g, S, E); }
        if (HELP(8)) help_copy(F, 8);
        GRID_BAR();
    }
    if (DUP(15)) { for (int k = 0; k < 8; ++k) GRID_BAR(); }
    if (IN(9)) {
        {
            pg8::Gemm g{F.ACT, F.Wdn_t, M, DM, 512, FF}; pg8::RangeOrder S{MP / 256, MS / 256, DM / 256, 8, 512, F.G, F.vcu};
            pg8::EpiPartial E{(float*)(F.ws + WS_PART), 512};
            pg8::gemm_phase<pg8::EpiPartial, pg8::RangeOrder, true, true>(F.lds, g, S, E);
        }
        help_copy(F, -1);
        GRID_BAR();
        p9_final_norm(F, (F.G == 256) ? MP : 0); if (DUP(9)) { const int gw = F.vcu * 8 + F.wave, NGW = F.G * 8; for (int m = gw; m < M; m += NGW) { const f32x4* p = (const f32x4*)(F.out + (size_t)m * DM); f32x4* q = (f32x4*)(F.ws + WS_SCR) + (size_t)m * 256; f32x4 v[4]; float ss = 0.f;
#pragma unroll
        for (int j = 0; j < 4; ++j) { v[j] = p[64 * j + F.lane]; ss += v[j].x * v[j].x + v[j].y * v[j].y + v[j].z * v[j].z + v[j].w * v[j].w; }
        ss = wave_sum(ss); const float rs = 1.f / sqrtf(ss * (1.f / DM) + EPS);
#pragma unroll
        for (int j = 0; j < 4; ++j) q[64 * j + F.lane] = v[j] * rs; } } }
    STAMP();
#ifdef STAMP_SEL
    if (blockIdx.x == 0 && F.tid == 0) F.out[O_PM] += (float)(stamps[STAMP_SEL + 1] - stamps[STAMP_SEL]) * 0.01f;
#endif
#undef IN
}

extern "C" void kernel_launch(void* const* d_in, const int* in_sizes, int n_in, void* d_out, int out_size, void* d_ws, size_t ws_size, hipStream_t stream) {
    static int grid = 0;
    if (grid == 0) {
        if (n_in != 19 || (size_t)out_size != O_END || ws_size < WS_END) { fprintf(stderr, "kernel_launch: unexpected shapes (n_in %d out %d ws %zu)\n", n_in, out_size, ws_size); grid = -1; return; }
        int dev = 0, cus = 0, per_cu = 0;
        if (hipGetDevice(&dev) != hipSuccess || hipDeviceGetAttribute(&cus, hipDeviceAttributeMultiprocessorCount, dev) != hipSuccess) { grid = -1; return; }
        if (hipFuncSetAttribute((const void*)fwd, hipFuncAttributeMaxDynamicSharedMemorySize, LDS_BYTES) != hipSuccess) { fprintf(stderr, "kernel_launch: hipFuncSetAttribute failed\n"); grid = -1; return; }
        if (hipOccupancyMaxActiveBlocksPerMultiprocessor(&per_cu, (const void*)fwd, 512, LDS_BYTES) != hipSuccess || per_cu < 1) fprintf(stderr, "kernel_launch: occupancy query says %d\n", per_cu);
        (void)hipGetLastError();
        grid = cus;
    }
    if (grid < 0) return;
    if (hipMemsetAsync((char*)d_ws + WS_CTL, 0, CTL_ZERO_BYTES, stream) != hipSuccess) return;
    Args a{};
    for (int i = 0; i < 19; ++i) a.in[i] = (const float*)d_in[i];
    a.out = (float*)d_out; a.ws = (unsigned char*)d_ws;
#if PER_PHASE_LAUNCH
    for (int ph = 0; ph < NPH; ++ph) { a.ph_lo = ph; a.ph_hi = ph + 1; hipLaunchKernelGGL(fwd, dim3(grid), dim3(512), LDS_BYTES, stream, a); }
#else
    a.ph_lo = 0; a.ph_hi = NPH; hipLaunchKernelGGL(fwd, dim3(grid), dim3(512), LDS_BYTES, stream, a);
#endif
}
```

```cpp
#include <hip/hip_runtime.h>
#include <cstdio>
#include <cstdint>
namespace pg8 {
#define PG8_LAS __attribute__((address_space(3)))
typedef unsigned short bf16_t;
typedef short bf16x8 __attribute__((ext_vector_type(8)));
typedef float f32x4 __attribute__((ext_vector_type(4)));
typedef unsigned u32x4 __attribute__((ext_vector_type(4)));
constexpr int BM = 256, BK = 64, HALF = 128, HTB = HALF * BK * 2  , STAGE_BYTES = 8 * HTB, NXCD = 8, WGM = 8;

__host__ __device__ __forceinline__ int lds_byte(int r, int c) { const int st = (r >> 4) * 2 + (c >> 5), rr = r & 15, cc = c & 31, ob = rr * 64 + cc * 2; return st * 1024 + (ob ^ (((ob >> 9) & 1) << 5)); }
__host__ __device__ __forceinline__ void stage_rc(int b, int& R, int& C) { const int st = b / 1024, sb = b % 1024, swz = sb ^ (((sb >> 9) & 1) << 5); R = (st >> 1) * 16 + swz / 64; C = (st & 1) * 32 + (swz % 64) / 2; }
__host__ __device__ __forceinline__ int perm32(int rho) { const int n = rho >> 4, i = rho & 15; return 8 * (i >> 2) + 4 * n + (i & 3); }

struct Unit { int pm, pn, k0; };
struct Gemm { const bf16_t* A; const bf16_t* Bt; int M, N, K, ld; };

struct StaticOrder {
    int nM, nN, nwg, G, c;
    __host__ __device__ void init(int M, int N, int G_, int c_) { nM = M / BM; nN = N / BM; nwg = nM * nN; G = G_; c = c_; }
    __host__ __device__ bool next(int i, Unit& u) const {
        const long L = (long)i * G + c; if (L >= nwg) return false;
        int wgid = (int)L; { const int q = nwg / NXCD, r = nwg % NXCD, xcd = wgid % NXCD, off = wgid / NXCD; wgid = (xcd < r ? xcd * (q + 1) : r * (q + 1) + (xcd - r) * q) + off; }
        const int nig = WGM * nN, gid = wgid / nig, fm = gid * WGM, gsz = (nM - fm) < WGM ? (nM - fm) : WGM;
        u.pm = fm + ((wgid % nig) % gsz); u.pn = (wgid % nig) / gsz; u.k0 = 0; return true;
    }
    __device__ __forceinline__ void a_ready(const Unit&) const {}
    __device__ __forceinline__ void done(const Unit&) const {}
};

__device__ __forceinline__ unsigned cvt_pk_bf16(float lo, float hi) { unsigned r; asm volatile("v_cvt_pk_bf16_f32 %0, %1, %2" : "=v"(r) : "v"(lo), "v"(hi)); return r; }
typedef float f32x2 __attribute__((ext_vector_type(2)));

template <class Epi, class Sched, bool ALIGN_EPI = false, bool SP2 = false>
__device__ __forceinline__ void gemm_phase(PG8_LAS unsigned char* lds, const Gemm g, const Sched& S, const Epi& E) {
    const int tid = threadIdx.x, wid = __builtin_amdgcn_readfirstlane(tid >> 6), lane = tid & 63, wr = wid >> 2, wc = wid & 3, fr = lane & 15, fq = lane >> 4;
    const int K = g.K, nt = K / BK, LD = g.ld;
    unsigned voffA[2], voffB[2];
#pragma unroll
    for (int i = 0; i < 2; ++i) { int R, C; stage_rc(tid * 16 + i * 8192, R, C); const int Rb = Epi::PERM ? ((R & ~31) + perm32(R & 31)) : R;
        voffA[i] = (unsigned)(R * LD + C) * 2u; voffB[i] = (unsigned)(Rb * LD + C) * 2u; }
    const size_t kstep = (size_t)(BK * 2);
    const size_t hstep = (size_t)HALF * LD * 2;
    const size_t tstep = 2 * hstep;
    const unsigned ldsw = (unsigned)wid * 1024u;
    const int aoff = lds_byte(wr * 64 + fr, fq * 8), boff = lds_byte(wc * 32 + fr, fq * 8);
#define PG8_SA(b, h) (((b) * 2 + (h)) * HTB)
#define PG8_SB(b, h) ((4 + (b) * 2 + (h)) * HTB)
#define PG8_STAGE(bufoff, gbase, voff) do { _Pragma("unroll") for (int _i = 0; _i < 2; ++_i) \
        __builtin_amdgcn_global_load_lds((const unsigned*)((const char*)(gbase) + (voff)[_i]), (PG8_LAS unsigned*)(lds + (bufoff) + ldsw + _i * 8192), 16, 0, 0); } while (0)
#define PG8_LDA(dst, b, h) do { _Pragma("unroll") for (int m = 0; m < 4; ++m) _Pragma("unroll") for (int k = 0; k < 2; ++k) dst[m][k] = *(const PG8_LAS bf16x8*)(lds + PG8_SA(b, h) + aoff + m * 2048 + k * 1024); } while (0)
#define PG8_LDB(dst, b, h) do { _Pragma("unroll") for (int n = 0; n < 2; ++n) _Pragma("unroll") for (int k = 0; k < 2; ++k) dst[n][k] = *(const PG8_LAS bf16x8*)(lds + PG8_SB(b, h) + boff + n * 2048 + k * 1024); } while (0)
#define PG8_MMA(ai, bj, At, Bt) do { __builtin_amdgcn_s_setprio(1); _Pragma("unroll") for (int m = 0; m < 4; ++m) _Pragma("unroll") for (int n = 0; n < 2; ++n) _Pragma("unroll") for (int k = 0; k < 2; ++k) \
        acc[ai][bj][m][n] = __builtin_amdgcn_mfma_f32_16x16x32_bf16(Bt[n][k], At[m][k], acc[ai][bj][m][n], 0, 0, 0); __builtin_amdgcn_s_setprio(0); } while (0)
#define PG8_WAIT_V(n) asm volatile("s_waitcnt vmcnt(" #n ")" ::: "memory")
#define PG8_WAIT_L(n) asm volatile("s_waitcnt lgkmcnt(" #n ")" ::: "memory")
#define PG8_BAR __builtin_amdgcn_s_barrier()
#define PG8_SCHED __builtin_amdgcn_sched_barrier(0)
    Unit cur, nxt; int ui = 0;
    if (!S.next(0, cur)) return;
    f32x4 acc[2][2][4][2];
#pragma unroll
    for (int a = 0; a < 2; ++a)
#pragma unroll
        for (int b = 0; b < 2; ++b)
#pragma unroll
            for (int m = 0; m < 4; ++m)
#pragma unroll
                for (int n = 0; n < 2; ++n) acc[a][b][m][n] = (f32x4){0.f, 0.f, 0.f, 0.f};
    bf16x8 At[4][2], B0[2][2], B1[2][2];
    const char* cA = (const char*)g.A + (size_t)cur.pm * tstep + (size_t)cur.k0 * 2; const char* cB = (const char*)g.Bt + (size_t)cur.pn * tstep + (size_t)cur.k0 * 2;
    S.a_ready(cur);
    if constexpr (SP2) {
        PG8_STAGE(PG8_SB(0, 0), cB, voffB); PG8_STAGE(PG8_SB(0, 1), cB + hstep, voffB); PG8_STAGE(PG8_SA(0, 0), cA, voffA); PG8_STAGE(PG8_SA(0, 1), cA + hstep, voffA);
        if (wr == 1) PG8_BAR;
        PG8_WAIT_V(2); PG8_BAR;
        PG8_STAGE(PG8_SB(1, 0), cB + kstep, voffB); PG8_STAGE(PG8_SA(1, 0), cA + kstep, voffA); PG8_STAGE(PG8_SB(1, 1), cB + hstep + kstep, voffB);
        PG8_WAIT_V(6); PG8_BAR;
    } else {
        PG8_STAGE(PG8_SB(0, 0), cB, voffB); PG8_STAGE(PG8_SA(0, 0), cA, voffA); PG8_STAGE(PG8_SB(0, 1), cB + hstep, voffB); PG8_STAGE(PG8_SA(0, 1), cA + hstep, voffA);
        if (wr == 1) PG8_BAR;
        PG8_WAIT_V(4); PG8_BAR;
        PG8_STAGE(PG8_SB(1, 0), cB + kstep, voffB); PG8_STAGE(PG8_SA(1, 0), cA + kstep, voffA); PG8_STAGE(PG8_SB(1, 1), cB + hstep + kstep, voffB);
        PG8_WAIT_V(6); PG8_BAR;
    }
    for (;;) {
        const bool has_next = S.next(ui + 1, nxt);
        const char* nA = has_next ? (const char*)g.A + (size_t)nxt.pm * tstep + (size_t)nxt.k0 * 2 : cA; const char* nB = has_next ? (const char*)g.Bt + (size_t)nxt.pn * tstep + (size_t)nxt.k0 * 2 : cB;
        for (int t = 0; t < nt; t += 2) {
            const bool last = (t == nt - 2);
            const char* a1 = cA + (size_t)(t + 1) * kstep;
            const char* a2 = last ? nA : cA + (size_t)(t + 2) * kstep; const char* b2 = last ? nB : cB + (size_t)(t + 2) * kstep;
            const char* a3 = a2 + kstep; const char* b3 = b2 + kstep;
            if (last && has_next) S.a_ready(nxt);
            if constexpr (SP2) {
            PG8_LDB(B0, 0, 0); PG8_LDB(B1, 0, 1); PG8_SCHED; PG8_LDA(At, 0, 0); PG8_STAGE(PG8_SA(1, 1), a1 + hstep, voffA);
            PG8_WAIT_V(8); PG8_WAIT_L(0); PG8_BAR; PG8_MMA(0, 0, At, B0); PG8_MMA(0, 1, At, B1); PG8_BAR; PG8_SCHED;
            PG8_LDA(At, 0, 1); PG8_STAGE(PG8_SB(0, 0), b2, voffB); PG8_STAGE(PG8_SB(0, 1), b2 + hstep, voffB); PG8_STAGE(PG8_SA(0, 0), a2, voffA);
            PG8_WAIT_V(8); PG8_WAIT_L(0); PG8_BAR; PG8_MMA(1, 0, At, B0); PG8_MMA(1, 1, At, B1); PG8_BAR; PG8_SCHED;
            PG8_LDB(B0, 1, 0); PG8_LDB(B1, 1, 1); PG8_SCHED; PG8_LDA(At, 1, 0); PG8_STAGE(PG8_SA(0, 1), a2 + hstep, voffA);
            PG8_WAIT_V(8); PG8_WAIT_L(0); PG8_BAR; PG8_MMA(0, 0, At, B0); PG8_MMA(0, 1, At, B1); PG8_BAR; PG8_SCHED;
            PG8_LDA(At, 1, 1); PG8_STAGE(PG8_SB(1, 0), b3, voffB); PG8_STAGE(PG8_SB(1, 1), b3 + hstep, voffB); PG8_STAGE(PG8_SA(1, 0), a3, voffA);
            PG8_WAIT_V(8); PG8_WAIT_L(0); PG8_BAR; PG8_MMA(1, 0, At, B0); PG8_MMA(1, 1, At, B1); PG8_BAR; PG8_SCHED;
            } else {
            PG8_LDB(B0, 0, 0); PG8_SCHED; PG8_LDA(At, 0, 0); PG8_STAGE(PG8_SA(1, 1), a1 + hstep, voffA);
            PG8_WAIT_L(8); PG8_BAR; PG8_WAIT_L(0); PG8_MMA(0, 0, At, B0); PG8_BAR; PG8_SCHED;
            PG8_LDB(B1, 0, 1); PG8_STAGE(PG8_SB(0, 0), b2, voffB);
            PG8_BAR; PG8_WAIT_L(0); PG8_MMA(0, 1, At, B1); PG8_BAR;
            PG8_LDA(At, 0, 1); PG8_STAGE(PG8_SA(0, 0), a2, voffA);
            PG8_BAR; PG8_WAIT_L(0); PG8_MMA(1, 0, At, B0); PG8_BAR; PG8_SCHED;
            PG8_STAGE(PG8_SB(0, 1), b2 + hstep, voffB);
            PG8_WAIT_V(6); PG8_BAR; PG8_MMA(1, 1, At, B1); PG8_BAR;
            PG8_LDB(B0, 1, 0); PG8_SCHED; PG8_LDA(At, 1, 0); PG8_STAGE(PG8_SA(0, 1), a2 + hstep, voffA);
            PG8_WAIT_L(8); PG8_BAR; PG8_WAIT_L(0); PG8_MMA(0, 0, At, B0); PG8_BAR; PG8_SCHED;
            PG8_LDB(B1, 1, 1); PG8_STAGE(PG8_SB(1, 0), b3, voffB);
            PG8_BAR; PG8_WAIT_L(0); PG8_MMA(0, 1, At, B1); PG8_BAR;
            PG8_LDA(At, 1, 1); PG8_STAGE(PG8_SA(1, 0), a3, voffA);
            PG8_BAR; PG8_WAIT_L(0); PG8_MMA(1, 0, At, B0); PG8_BAR; PG8_SCHED;
            PG8_STAGE(PG8_SB(1, 1), b3 + hstep, voffB);
            PG8_WAIT_V(6); PG8_BAR; PG8_MMA(1, 1, At, B1); PG8_BAR;
            }
        }
        if constexpr (ALIGN_EPI) { if (wr == 0) PG8_BAR; }
        if constexpr (!Epi::AFTER_DRAIN) { E(acc, cur, wr, wc, fr, fq); S.done(cur); }
        if (!has_next) break;
#pragma unroll
        for (int a = 0; a < 2; ++a)
#pragma unroll
            for (int b = 0; b < 2; ++b)
#pragma unroll
                for (int m = 0; m < 4; ++m)
#pragma unroll
                    for (int n = 0; n < 2; ++n) acc[a][b][m][n] = (f32x4){0.f, 0.f, 0.f, 0.f};
        cur = nxt; cA = nA; cB = nB; ++ui;
        if constexpr (ALIGN_EPI) { if (wr == 1) PG8_BAR; }
    }
    PG8_WAIT_V(0);
    if constexpr (!ALIGN_EPI) { if (wr == 0) PG8_BAR; }
    PG8_BAR;
    if constexpr (Epi::AFTER_DRAIN) { E.fused(acc, cur, wr, wc, fr, fq, lds, wid, lane); S.done(cur); }
#undef PG8_SA
#undef PG8_SB
#undef PG8_STAGE
#undef PG8_LDA
#undef PG8_LDB
#undef PG8_MMA
#undef PG8_WAIT_V
#undef PG8_WAIT_L
#undef PG8_BAR
#undef PG8_SCHED
}
}

#ifndef PER_PHASE_LAUNCH
#define PER_PHASE_LAUNCH 0
#endif

constexpr int DM = 1024, NBP = 4, SEQ = 4096, DBS = 128, DTS = 8;
constexpr int MP = NBP * SEQ, MS = DBS * DTS, M = MP + MS;
constexpr int NPROJ = 3584, INCOLS = 3592, FF = 4096, WBUF = 2048;
constexpr int C_Q = 0, C_K = 512, C_V = 1024, C_RAW = 1536, C_VB = 2560, C_OB = 3072;
constexpr float EPS = 1e-6f;
constexpr int NPH = 10;
constexpr size_t O_YP = 0, O_YS = O_YP + (size_t)MP * DM, O_PK = O_YS + (size_t)MS * DM, O_PV = O_PK + (size_t)NBP * WBUF * 512,
    O_PCONV = O_PV + (size_t)NBP * WBUF * 512, O_PC = O_PCONV + (size_t)NBP * 3 * 1024, O_PN = O_PC + (size_t)NBP * 4 * 128 * 128, O_PM = O_PN + (size_t)NBP * 4 * 128,
    O_SK = O_PM + (size_t)NBP * 4, O_SV = O_SK + (size_t)DBS * WBUF * 512, O_SCONV = O_SV + (size_t)DBS * WBUF * 512, O_SC = O_SCONV + (size_t)DBS * 3 * 1024,
    O_SN = O_SC + (size_t)DBS * 4 * 128 * 128, O_SM = O_SN + (size_t)DBS * 4 * 128, O_END = O_SM + (size_t)DBS * 4;
static_assert(O_END == 303774224ull, "output size");
constexpr size_t MiB = 1u << 20;
constexpr size_t WS_CTL = 0, CTL_ZERO_BYTES = 192 * 1024;
constexpr int CW_BAR = 4096;
constexpr size_t WS_CLAIM = 32 * 1024, WS_CPY = 64 * 1024, WS_PCNT = 128 * 1024, WS_SS2 = 256 * 1024, WS_SSF = 512 * 1024;
constexpr size_t WS_WIN = 2 * MiB, WS_WOUT = 10 * MiB, WS_WUP = 12 * MiB, WS_WDN = 20 * MiB;
constexpr size_t WS_ROPE = 28 * MiB, WS_RSTD1 = 29 * MiB, WS_IG = 29 * MiB + 512 * 1024, WS_LF = 30 * MiB, WS_CHK = 31 * MiB;
constexpr size_t WS_XB = 32 * MiB, WS_PROJ = 68 * MiB, WS_MIX = 188 * MiB, WS_HPB = 222 * MiB, WS_ACT = 256 * MiB;
constexpr size_t WS_QF = 392 * MiB, WS_KF = 426 * MiB, WS_L = 460 * MiB, WS_CPRE = 492 * MiB, WS_NLOC = 524 * MiB, WS_NPRE = 525 * MiB, WS_DUMMY = 526 * MiB, WS_SCR = 544 * MiB, WS_PART = 616 * MiB, WS_SS2P = 648 * MiB, WS_SSFP = 650 * MiB, WS_END = 651 * MiB;
static_assert(WS_PROJ + (size_t)M * NPROJ * 2 <= WS_MIX && WS_ACT + (size_t)M * FF * 2 <= WS_QF && WS_XB + (size_t)M * DM * 2 <= WS_PROJ, "ws map");

constexpr int LDS_BYTES = 147456;
constexpr int MISC_OFF = 131072 + 8192;

#define GAS __attribute__((address_space(1)))
#define LAS __attribute__((address_space(3)))
typedef unsigned short bf16;
typedef unsigned v4u __attribute__((ext_vector_type(4)));
typedef unsigned v2u __attribute__((ext_vector_type(2)));
typedef float f32x4 __attribute__((ext_vector_type(4)));
typedef GAS unsigned gu32;
#define LDS_WAIT() asm volatile("s_waitcnt lgkmcnt(0)" ::: "memory")
__device__ __forceinline__ unsigned f2bf(float f) { unsigned u = __builtin_bit_cast(unsigned, f); return (u + 0x7fffu + ((u >> 16) & 1u)) >> 16; }
typedef float f32x2_t __attribute__((ext_vector_type(2))); typedef __bf16 bf16x2_t __attribute__((ext_vector_type(2)));
__device__ __forceinline__ unsigned pk2(float lo, float hi) { f32x2_t v = {lo, hi}; bf16x2_t b = __builtin_convertvector(v, bf16x2_t); return __builtin_bit_cast(unsigned, b); }
__device__ __forceinline__ float bf2f(unsigned short u) { return __builtin_bit_cast(float, (unsigned)u << 16); }
__device__ __forceinline__ float bflo(unsigned u) { return __builtin_bit_cast(float, u << 16); }
__device__ __forceinline__ float bfhi(unsigned u) { return __builtin_bit_cast(float, u & 0xffff0000u); }
__device__ __forceinline__ float wave_sum(float v) {
#pragma unroll
    for (int o = 1; o < 64; o <<= 1) v += __shfl_xor(v, o);
    return v;
}
__device__ __forceinline__ float wave_max(float v) {
#pragma unroll
    for (int o = 1; o < 64; o <<= 1) v = fmaxf(v, __shfl_xor(v, o));
    return v;
}
__device__ __forceinline__ int opaque(int v) { asm volatile("" : "+v"(v)); return v; }
__device__ __forceinline__ float sigmoidf_(float x) { return __builtin_amdgcn_rcpf(1.f + __expf(-x)); }

#define XB_TMO      128
#define XB_XCNT(j)  (256  + 64 * (j))
#define XB_XSUB(j)  (1280 + 64 * (j))
#define XB_XGEN(j)  (2304 + 64 * (j))
#define XB_TOP      3328
#define XB_TOPGEN   3392
#define XCD_BAR_WORDS 3456
#define XB_SPIN_CAP (1u << 18)
__device__ __forceinline__ unsigned xb_ld(unsigned* p)              { return __hip_atomic_load(p, __ATOMIC_RELAXED, __HIP_MEMORY_SCOPE_AGENT); }
__device__ __forceinline__ unsigned xb_add(unsigned* p, unsigned v) { return __hip_atomic_fetch_add(p, v, __ATOMIC_RELAXED, __HIP_MEMORY_SCOPE_AGENT); }
__device__ __forceinline__ unsigned xb_xcc_id() { return (unsigned)__builtin_amdgcn_s_getreg((3 << 11) | 20) & 0xFu; }
#define XB_SPIN(cond, bar) do { unsigned _sp = 0; while (cond) { __builtin_amdgcn_s_sleep(1); \
    if ((++_sp & 255u) == 0u) { if (xb_ld(&(bar)[XB_TMO])) break; if (_sp > XB_SPIN_CAP) { atomicAdd(&(bar)[XB_TMO], 1u); break; } } } } while (0)
struct XcdBarrier { unsigned* bar; unsigned x; volatile LAS unsigned* st; };
__device__ __forceinline__ XcdBarrier xcd_barrier_post(unsigned* bar, volatile LAS unsigned* st) {
    XcdBarrier b; b.bar = bar; b.x = xb_xcc_id(); b.st = st;
    if (threadIdx.x == 0) (void)xb_add(&bar[XB_XCNT(b.x)], 1u);
    return b;
}
__device__ __forceinline__ void xcd_barrier_complete(unsigned* bar, unsigned x, unsigned& nloc, unsigned& nx) {
    const unsigned G = gridDim.x * gridDim.y * gridDim.z;
    unsigned sum, cnt, mine, sp = 0u;
    for (;;) {
        sum = 0u; cnt = 0u; mine = 0u;
#pragma unroll
        for (unsigned j = 0; j < 16; ++j) { const unsigned c = xb_ld(&bar[XB_XCNT(j)]); sum += c; cnt += (c > 0u) ? 1u : 0u; mine = (j == x) ? c : mine; }
        if (sum == G) break;
        __builtin_amdgcn_s_sleep(1);
        if ((++sp & 255u) == 0u) { if (xb_ld(&bar[XB_TMO])) break; if (sp > XB_SPIN_CAP) { atomicAdd(&bar[XB_TMO], 1u); break; } }
    }
    nloc = mine > 0u ? mine : 1u; nx = cnt > 0u ? cnt : 1u;
}
__device__ __forceinline__ void xcd_barrier(const XcdBarrier& b) {
    asm volatile("s_waitcnt vmcnt(0)" ::: "memory");
    __syncthreads();
    if (threadIdx.x == 0) {
        unsigned* bar = b.bar;
        __builtin_amdgcn_s_waitcnt(0);
        unsigned nloc = b.st[0], nx = b.st[1];
        if (nloc == 0u) { xcd_barrier_complete(bar, b.x, nloc, nx); b.st[0] = nloc; b.st[1] = nx; }
        const unsigned old = xb_add(&bar[XB_XSUB(b.x)], 1u);
        const unsigned gen = old / nloc;
        if (old + 1u == (gen + 1u) * nloc) {
            __builtin_amdgcn_fence(__ATOMIC_RELEASE, "agent");
            asm volatile("s_waitcnt vmcnt(0)" ::: "memory");
            const unsigned og = xb_add(&bar[XB_TOP], 1u);
            const unsigned tg = og / nx;
            if (og + 1u == (tg + 1u) * nx) xb_add(&bar[XB_TOPGEN], 1u);
            else XB_SPIN(xb_ld(&bar[XB_TOPGEN]) == tg, bar);
            __builtin_amdgcn_fence(__ATOMIC_ACQUIRE, "agent");
            xb_add(&bar[XB_XGEN(b.x)], 1u);
            asm volatile("s_waitcnt vmcnt(0)" ::: "memory");
        } else {
            XB_SPIN(xb_ld(&bar[XB_XGEN(b.x)]) == gen, bar);
            __builtin_amdgcn_fence(__ATOMIC_ACQUIRE, "agent");
            asm volatile("s_waitcnt vmcnt(0)" ::: "memory");
        }
    }
    __syncthreads();
}

struct Frame {
    LAS unsigned char* lds;
    int tid, lane, wave, vcu, G;
    const float *xp, *xs, *cache_k, *cache_v, *st_conv, *st_C, *st_n, *st_m, *g1, *w_in, *b_gate, *w_conv, *b_conv, *mhg, *w_out, *g2, *w_up, *w_down, *gf;
    float* out; unsigned char* ws;
    bf16 *Win_t, *Wout_t, *Wup_t, *Wdn_t, *XB, *PROJ, *MIX, *HPB, *ACT;
    float *rope, *rstd1, *ig, *lf, *chk, *ss2, *ssf, *QF, *KF, *L, *CPRE, *NLOC, *NPRE;
};

namespace pg8 {
struct EpiIn {
    static constexpr bool PERM = true, AFTER_DRAIN = false;
    bf16_t* proj; const float* rstd; const float* rope; float* out;
    __device__ __forceinline__ void operator()(const f32x4 (&acc)[2][2][4][2], const Unit& u, int wr, int wc, int fr, int fq) const {
        const int pn = u.pn;
        const bool rot = (pn < 4) && ((wc & 1) == 0);
#pragma unroll
        for (int ai = 0; ai < 2; ++ai)
#pragma unroll
            for (int m = 0; m < 4; ++m) {
                const int row = u.pm * BM + ai * HALF + wr * 64 + m * 16 + fr;
                const float rs = rstd[row];
                const bool smp = row >= MP;
                const int b = smp ? ((row - MP) >> 3) : (row >> 12), t = smp ? ((row - MP) & 7) : (row & 4095);
                const int pidx = smp ? (SEQ + t) : t;
#pragma unroll
                for (int bj = 0; bj < 2; ++bj) {
                    const int col0 = pn * BM + bj * HALF + wc * 32 + 8 * fq;
                    f32x4 v0 = acc[ai][bj][m][0] * rs, v1 = acc[ai][bj][m][1] * rs;
                    if (rot) {
                        f32x4 p0, p1;
                        p0.x = __shfl_xor(v0.x, 16); p0.y = __shfl_xor(v0.y, 16); p0.z = __shfl_xor(v0.z, 16); p0.w = __shfl_xor(v0.w, 16);
                        p1.x = __shfl_xor(v1.x, 16); p1.y = __shfl_xor(v1.y, 16); p1.z = __shfl_xor(v1.z, 16); p1.w = __shfl_xor(v1.w, 16);
                        if (fq < 2) {
                            const f32x4 c0 = *(const f32x4*)(rope + pidx * 16), c1 = *(const f32x4*)(rope + pidx * 16 + 4);
                            const f32x4 s0 = *(const f32x4*)(rope + pidx * 16 + 8), s1 = *(const f32x4*)(rope + pidx * 16 + 12);
                            if (fq == 0) { v0 = v0 * c0 - p0 * s0; v1 = v1 * c1 - p1 * s1; }
                            else         { v0 = v0 * c0 + p0 * s0; v1 = v1 * c1 + p1 * s1; }
                        }
                    }
                    if (pn < 2) { v0 = v0 * 0.125f; v1 = v1 * 0.125f; }
                    u32x4 w; w.x = cvt_pk_bf16(v0[0], v0[1]); w.y = cvt_pk_bf16(v0[2], v0[3]); w.z = cvt_pk_bf16(v1[0], v1[1]); w.w = cvt_pk_bf16(v1[2], v1[3]);
                    *(u32x4*)(proj + (size_t)row * NPROJ + col0) = w;
                    if (pn >= 2 && pn < 6) {
                        const bool isk = pn < 4; const int cc = col0 - (isk ? C_K : C_V);
                        float* dst = nullptr;
                        if (smp) dst = out + (isk ? O_SK : O_SV) + ((size_t)b * WBUF + (WBUF - DTS) + t) * 512 + cc;
                        else if (t >= SEQ - WBUF) dst = out + (isk ? O_PK : O_PV) + ((size_t)b * WBUF + (t - (SEQ - WBUF))) * 512 + cc;
                        if (dst) { __builtin_nontemporal_store(v0, (f32x4*)dst); __builtin_nontemporal_store(v1, (f32x4*)(dst + 4)); }
                    } else if (pn >= 6 && pn < 10) {
                        const int cc = col0 - C_RAW;
                        float* dst = nullptr;
                        if (smp) { if (t >= DTS - 3) dst = out + O_SCONV + ((size_t)b * 3 + (t - (DTS - 3))) * 1024 + cc; }
                        else if (t >= SEQ - 3) dst = out + O_PCONV + ((size_t)b * 3 + (t - (SEQ - 3))) * 1024 + cc;
                        if (dst) { __builtin_nontemporal_store(v0, (f32x4*)dst); __builtin_nontemporal_store(v1, (f32x4*)(dst + 4)); }
                    }
                }
            }
    }
};
template <bool F32OUT> struct EpiOut {
    static constexpr bool PERM = true, AFTER_DRAIN = false;
    const float* xp; const float* xs; float* hp; bf16_t* hpb; float* ss; const bf16_t* xb;
    __device__ __forceinline__ void operator()(const f32x4 (&acc)[2][2][4][2], const Unit& u, int wr, int wc, int fr, int fq) const {
#pragma unroll
        for (int ai = 0; ai < 2; ++ai)
#pragma unroll
            for (int m = 0; m < 4; ++m) {
                const int row = u.pm * BM + ai * HALF + wr * 64 + m * 16 + fr;
                const float* xr = (row < MP) ? xp + (size_t)row * DM : xs + (size_t)(row - MP) * DM;
                float s = 0.f;
#pragma unroll
                for (int bj = 0; bj < 2; ++bj) {
                    const int col0 = u.pn * BM + bj * HALF + wc * 32 + 8 * fq;
                    f32x4 r0, r1;
                    if (F32OUT) { r0 = *(const f32x4*)(xr + col0); r1 = *(const f32x4*)(xr + col0 + 4); }
                    else { const u32x4 xw = *(const u32x4*)(xb + (size_t)row * DM + col0);
                        r0 = (f32x4){__builtin_bit_cast(float, xw.x << 16), __builtin_bit_cast(float, xw.x & 0xffff0000u), __builtin_bit_cast(float, xw.y << 16), __builtin_bit_cast(float, xw.y & 0xffff0000u)};
                        r1 = (f32x4){__builtin_bit_cast(float, xw.z << 16), __builtin_bit_cast(float, xw.z & 0xffff0000u), __builtin_bit_cast(float, xw.w << 16), __builtin_bit_cast(float, xw.w & 0xffff0000u)}; }
                    const f32x4 v0 = acc[ai][bj][m][0] + r0, v1 = acc[ai][bj][m][1] + r1;
                    if (F32OUT) { *(f32x4*)(hp + (size_t)row * DM + col0) = v0; *(f32x4*)(hp + (size_t)row * DM + col0 + 4) = v1; }
                    u32x4 w; w.x = cvt_pk_bf16(v0[0], v0[1]); w.y = cvt_pk_bf16(v0[2], v0[3]); w.z = cvt_pk_bf16(v1[0], v1[1]); w.w = cvt_pk_bf16(v1[2], v1[3]);
                    *(u32x4*)(hpb + (size_t)row * DM + col0) = w;
                    s += (v0[0] * v0[0] + v0[1] * v0[1]) + (v0[2] * v0[2] + v0[3] * v0[3]) + (v1[0] * v1[0] + v1[1] * v1[1]) + (v1[2] * v1[2] + v1[3] * v1[3]);
                }
                s += __shfl_xor(s, 16); s += __shfl_xor(s, 32);
                if (fq == 0) ss[(size_t)row * 16 + u.pn * 4 + wc] = s;
            }
    }
};
struct EpiUp {
    static constexpr bool PERM = true, AFTER_DRAIN = false;
    bf16_t* act; const float* ss;
    __device__ __forceinline__ void operator()(const f32x4 (&acc)[2][2][4][2], const Unit& u, int wr, int wc, int fr, int fq) const {
#pragma unroll
        for (int ai = 0; ai < 2; ++ai)
#pragma unroll
            for (int m = 0; m < 4; ++m) {
                const int row = u.pm * BM + ai * HALF + wr * 64 + m * 16 + fr;
                const f32x4* sp = (const f32x4*)(ss + (size_t)row * 16); const f32x4 t4 = (sp[0] + sp[1]) + (sp[2] + sp[3]);
                const float rs = 1.f / sqrtf(((t4.x + t4.y) + (t4.z + t4.w)) * (1.f / DM) + EPS);
#pragma unroll
                for (int bj = 0; bj < 2; ++bj) {
                    const int col0 = u.pn * BM + bj * HALF + wc * 32 + 8 * fq;
                    f32x4 v0 = acc[ai][bj][m][0] * rs, v1 = acc[ai][bj][m][1] * rs;
#pragma unroll
                    for (int e = 0; e < 4; ++e) { const float a = fmaxf(v0[e], 0.f), c = fmaxf(v1[e], 0.f); v0[e] = a * a; v1[e] = c * c; }
                    u32x4 w; w.x = cvt_pk_bf16(v0[0], v0[1]); w.y = cvt_pk_bf16(v0[2], v0[3]); w.z = cvt_pk_bf16(v1[0], v1[1]); w.w = cvt_pk_bf16(v1[2], v1[3]);
                    *(u32x4*)(act + (size_t)row * FF + col0) = w;
                }
            }
    }
};
struct RangeOrder {
    int base_pm, nM, nN, nks, klen, G, c;
    __device__ bool next(int i, Unit& u) const {
        if (c < 0) return false;
        const int L = i * G + c; if (L >= nM * nN * nks) return false;
        u.k0 = (L % nks) * klen; u.pn = (L / nks) % nN; u.pm = base_pm + L / (nks * nN); return true;
    }
    __device__ __forceinline__ void a_ready(const Unit&) const {}
    __device__ __forceinline__ void done(const Unit&) const {}
};
template <bool ATOMIC> struct EpiDown {
    static constexpr bool PERM = true, AFTER_DRAIN = false;
    float* hp;
    __device__ __forceinline__ void operator()(const f32x4 (&acc)[2][2][4][2], const Unit& u, int wr, int wc, int fr, int fq) const {
#pragma unroll
        for (int ai = 0; ai < 2; ++ai)
#pragma unroll
            for (int m = 0; m < 4; ++m) {
                const int row = u.pm * BM + ai * HALF + wr * 64 + m * 16 + fr;
#pragma unroll
                for (int bj = 0; bj < 2; ++bj) {
                    const int col0 = u.pn * BM + bj * HALF + wc * 32 + 8 * fq;
                    float* p = hp + (size_t)row * DM + col0;
                    if (ATOMIC) {
#pragma unroll
                        for (int e = 0; e < 4; ++e) { atomicAdd(p + e, acc[ai][bj][m][0][e]); atomicAdd(p + 4 + e, acc[ai][bj][m][1][e]); }
                    } else {
                        const f32x4 v0 = acc[ai][bj][m][0] + *(const f32x4*)p, v1 = acc[ai][bj][m][1] + *(const f32x4*)(p + 4);
                        *(f32x4*)p = v0; *(f32x4*)(p + 4) = v1;
                    }
                }
            }
    }
};
struct EpiDownNorm {
    static constexpr bool PERM = true, AFTER_DRAIN = true;
    float* hp; const bf16_t* hpb; float* ssp; unsigned* cnt; const float* gf;
    __device__ __forceinline__ void operator()(const f32x4 (&)[2][2][4][2], const Unit&, int, int, int, int) const {}
    __device__ __forceinline__ void fused(f32x4 (&acc)[2][2][4][2], const Unit& u, int wr, int wc, int fr, int fq, PG8_LAS unsigned char* lds, int, int) const {
        PG8_LAS float* part = (PG8_LAS float*)lds;
        PG8_LAS float* rstd = part + 1024;
#pragma unroll
        for (int ai = 0; ai < 2; ++ai)
#pragma unroll
            for (int m = 0; m < 4; ++m) {
                const int rl = ai * HALF + wr * 64 + m * 16 + fr, row = u.pm * BM + rl;
                float s = 0.f;
#pragma unroll
                for (int bj = 0; bj < 2; ++bj) {
                    const u32x4 hw = *(const u32x4*)(hpb + (size_t)row * DM + u.pn * BM + bj * HALF + wc * 32 + 8 * fq);
                    const f32x4 h0 = {__builtin_bit_cast(float, hw.x << 16), __builtin_bit_cast(float, hw.x & 0xffff0000u), __builtin_bit_cast(float, hw.y << 16), __builtin_bit_cast(float, hw.y & 0xffff0000u)};
                    const f32x4 h1 = {__builtin_bit_cast(float, hw.z << 16), __builtin_bit_cast(float, hw.z & 0xffff0000u), __builtin_bit_cast(float, hw.w << 16), __builtin_bit_cast(float, hw.w & 0xffff0000u)};
                    const f32x4 v0 = acc[ai][bj][m][0] + h0, v1 = acc[ai][bj][m][1] + h1;
                    acc[ai][bj][m][0] = v0; acc[ai][bj][m][1] = v1;
                    s += (v0[0] * v0[0] + v0[1] * v0[1]) + (v0[2] * v0[2] + v0[3] * v0[3]) + (v1[0] * v1[0] + v1[1] * v1[1]) + (v1[2] * v1[2] + v1[3] * v1[3]);
                }
                s += __shfl_xor(s, 16); s += __shfl_xor(s, 32);
                if (fq == 0) part[rl * 4 + wc] = s;
            }
        __syncthreads();
        if (threadIdx.x < 256) { const PG8_LAS f32x4* pp = (const PG8_LAS f32x4*)(part + threadIdx.x * 4); const f32x4 t = *pp;
            __hip_atomic_store((unsigned*)(ssp + ((size_t)u.pm * BM + threadIdx.x) * 4 + u.pn), __builtin_bit_cast(unsigned, (t.x + t.y) + (t.z + t.w)), __ATOMIC_RELAXED, __HIP_MEMORY_SCOPE_AGENT); }
        asm volatile("s_waitcnt vmcnt(0)" ::: "memory");
        __syncthreads();
        if (threadIdx.x == 0) {
            unsigned* c = cnt + 64 * u.pm;
            __hip_atomic_fetch_add(c, 1u, __ATOMIC_RELAXED, __HIP_MEMORY_SCOPE_AGENT);
            unsigned sp = 0;
            while (__hip_atomic_load(c, __ATOMIC_RELAXED, __HIP_MEMORY_SCOPE_AGENT) < 4u) { __builtin_amdgcn_s_sleep(1); if (++sp > (1u << 22)) break; }
        }
        __syncthreads();
        if (threadIdx.x < 256) { const unsigned* q = (const unsigned*)(ssp + ((size_t)u.pm * BM + threadIdx.x) * 4); float tot = 0.f;
#pragma unroll
            for (int k = 0; k < 4; ++k) tot += __builtin_bit_cast(float, __hip_atomic_load(q + k, __ATOMIC_RELAXED, __HIP_MEMORY_SCOPE_AGENT));
            rstd[threadIdx.x] = 1.f / sqrtf(tot * (1.f / DM) + EPS); }
        __syncthreads();
#pragma unroll
        for (int ai = 0; ai < 2; ++ai)
#pragma unroll
            for (int m = 0; m < 4; ++m) {
                const int rl = ai * HALF + wr * 64 + m * 16 + fr, row = u.pm * BM + rl;
                const float rs = rstd[rl];
#pragma unroll
                for (int bj = 0; bj < 2; ++bj) {
                    const int col0 = u.pn * BM + bj * HALF + wc * 32 + 8 * fq;
                    float* p = hp + (size_t)row * DM + col0;
                    const f32x4 g0 = *(const f32x4*)(gf + col0), g1 = *(const f32x4*)(gf + col0 + 4);
                    const f32x4 v0 = acc[ai][bj][m][0] * rs * g0, v1 = acc[ai][bj][m][1] * rs * g1;
                    __builtin_nontemporal_store(v0, (f32x4*)p); __builtin_nontemporal_store(v1, (f32x4*)(p + 4));
                }
            }
    }
};
struct EpiPartial {
    static constexpr bool PERM = true, AFTER_DRAIN = false;
    float* part; int klen;
    __device__ __forceinline__ void operator()(const f32x4 (&acc)[2][2][4][2], const Unit& u, int wr, int wc, int fr, int fq) const {
        float* slab = part + (size_t)(u.k0 / klen) * MS * DM;
#pragma unroll
        for (int ai = 0; ai < 2; ++ai)
#pragma unroll
            for (int m = 0; m < 4; ++m) { const int row = u.pm * BM + ai * HALF + wr * 64 + m * 16 + fr - MP;
#pragma unroll
                for (int bj = 0; bj < 2; ++bj) { float* p = slab + (size_t)row * DM + u.pn * BM + bj * HALF + wc * 32 + 8 * fq;
                    *(f32x4*)p = acc[ai][bj][m][0]; *(f32x4*)(p + 4) = acc[ai][bj][m][1]; } }
    }
};
struct EpiScratch {
    static constexpr bool PERM = true, AFTER_DRAIN = false;
    float* dst;
    __device__ __forceinline__ void operator()(const f32x4 (&acc)[2][2][4][2], const Unit& u, int wr, int wc, int fr, int fq) const {
#pragma unroll
        for (int ai = 0; ai < 2; ++ai)
#pragma unroll
            for (int m = 0; m < 4; ++m) { const int row = u.pm * BM + ai * HALF + wr * 64 + m * 16 + fr;
#pragma unroll
                for (int bj = 0; bj < 2; ++bj) { const int col0 = u.pn * BM + bj * HALF + wc * 32 + 8 * fq; float* p = dst + (size_t)row * DM + col0;
                    const f32x4 v0 = acc[ai][bj][m][0] + *(const f32x4*)p, v1 = acc[ai][bj][m][1] + *(const f32x4*)(p + 4);
                    *(f32x4*)p = v0; *(f32x4*)(p + 4) = v1; } }
    }
};
}

__device__ __forceinline__ void p0_transpose_item(const float* W, int K, int ldw, int nblk, const float* gain, bf16* WT, LAS float* scr, int item, int lane) {
    const int kb = item / nblk, nb = item % nblk, k0 = 64 * kb, n0 = 32 * nb;
#pragma unroll 8
    for (int i = 0; i < 32; ++i) { const int kk = 2 * i + (lane >> 5); const float gg = gain ? gain[k0 + kk] : 1.f; scr[kk * 33 + (lane & 31)] = gg * W[(size_t)(k0 + kk) * ldw + n0 + (lane & 31)]; }
    LDS_WAIT(); asm volatile("" ::: "memory");
    const int c = lane & 7;
#pragma unroll
    for (int j = 0; j < 4; ++j) { const int n = (lane >> 3) + 8 * j; const LAS float* s = scr + (8 * c) * 33 + n;
        v4u o; o.x = pk2(s[0 * 33], s[1 * 33]); o.y = pk2(s[2 * 33], s[3 * 33]); o.z = pk2(s[4 * 33], s[5 * 33]); o.w = pk2(s[6 * 33], s[7 * 33]);
        *(GAS v4u*)(WT + (size_t)(n0 + n) * K + k0 + 8 * c) = o; }
    LDS_WAIT(); asm volatile("" ::: "memory");
}
__device__ __forceinline__ void sincos_d(double a, double& s, double& c) {
    const double TWO_PI = 6.283185307179586476925286766559;
    const double k = __builtin_rint(a * (1.0 / TWO_PI));
    const double r = a - k * TWO_PI, r2 = r * r;
    double sc = 1.0, ss = r, tc = 1.0, ts = r;
#pragma unroll
    for (int n = 1; n <= 17; ++n) { tc *= -r2 * (1.0 / (double)((2 * n - 1) * (2 * n))); sc += tc; ts *= -r2 * (1.0 / (double)((2 * n) * (2 * n + 1))); ss += ts; }
    s = ss; c = sc;
}
__device__ __forceinline__ float log_sigmoidf_(float x) { return x < 0.f ? x - log1pf(expf(x)) : -log1pf(expf(-x)); }

__device__ __forceinline__ void p0_prologue(Frame& F) {
    const int gw = F.vcu * 8 + F.wave, NGW = F.G * 8;
    {
        LAS float* scr = (LAS float*)(F.lds + F.wave * 16384);
        constexpr int I_IN = 16 * 112, I_OUT = 16 * 32;
        for (int it = gw; it < I_IN + I_OUT; it += NGW) {
            int r = it;
            if (r < I_IN) { p0_transpose_item(F.w_in, DM, INCOLS, 112, F.g1, F.Win_t, scr, r, F.lane); continue; } r -= I_IN;
            p0_transpose_item(F.w_out, DM, DM, 32, nullptr, F.Wout_t, scr, r, F.lane);
        }
    }
    __syncthreads();
    {
        LAS float* Wg = (LAS float*)F.lds;
        { float wv[16], gv1[16];
#pragma unroll
          for (int q = 0; q < 16; ++q) { const int i = F.tid + 512 * q, k = i >> 3, j = i & 7; wv[q] = F.w_in[(size_t)k * INCOLS + NPROJ + j]; gv1[q] = F.g1[k]; }
#pragma unroll
          for (int q = 0; q < 16; ++q) { const int i = F.tid + 512 * q, k = i >> 3, j = i & 7; Wg[j * 1024 + k] = gv1[q] * wv[q]; } }
        __syncthreads();
        f32x4 vn[4];
        if (gw < M) { const float* xr = (gw < MP) ? F.xp + (size_t)gw * DM : F.xs + (size_t)(gw - MP) * DM;
#pragma unroll
            for (int j = 0; j < 4; ++j) vn[j] = *(const f32x4*)(xr + 256 * j + 4 * F.lane); }
        for (int m = gw; m < M; m += NGW) {
            f32x4 v[4]; float ss = 0.f;
#pragma unroll
            for (int j = 0; j < 4; ++j) { v[j] = vn[j]; ss += (v[j].x * v[j].x + v[j].y * v[j].y) + (v[j].z * v[j].z + v[j].w * v[j].w); }
            { const int mn = m + NGW;
              if (mn < M) { const float* xr = (mn < MP) ? F.xp + (size_t)mn * DM : F.xs + (size_t)(mn - MP) * DM;
#pragma unroll
                for (int j = 0; j < 4; ++j) vn[j] = *(const f32x4*)(xr + 256 * j + 4 * F.lane); } }
            float ga[8];
#pragma unroll
            for (int g = 0; g < 8; ++g) { float a = 0.f;
#pragma unroll
                for (int j = 0; j < 4; ++j) { const f32x4 w = *(const LAS f32x4*)(Wg + g * 1024 + 256 * j + 4 * F.lane); a += (v[j].x * w.x + v[j].y * w.y) + (v[j].z * w.z + v[j].w * w.w); }
                ga[g] = wave_sum(a); }
            ss = wave_sum(ss);
            const float rstd = 1.f / sqrtf(ss * (1.f / DM) + EPS);
            float gv = 0.f;
#pragma unroll
            for (int g = 0; g < 8; ++g) gv = (F.lane == g) ? ga[g] : gv;
            if (F.lane == 0) F.rstd1[m] = rstd;
            if (F.lane < 8) { const float gg = gv * rstd + F.b_gate[F.lane];
                if (F.lane < 4) F.ig[m * 4 + F.lane] = gg; else F.lf[m * 4 + F.lane - 4] = log_sigmoidf_(gg); }
            v2u* o8 = (v2u*)(F.XB + (size_t)m * DM);
#pragma unroll
            for (int j = 0; j < 4; ++j) { v2u o; o.x = pk2(v[j].x, v[j].y); o.y = pk2(v[j].z, v[j].w); o8[64 * j + F.lane] = o; }
        }
    }
    {
        const double invf[8] = {1.0, 0.19392274474868576, 0.03760603093086393, 0.007292664737217109, 0.001414213562373095, 0.0002742481756762073, 5.318295896944988e-05, 1.031338537721246e-05};
        for (int i = F.tid * F.G + F.vcu; i < (SEQ + DTS) * 8; i += F.G * 512) {
            const int p = i >> 3, k = i & 7; const double pos = (p < SEQ) ? (double)p : (double)(8192 + p - SEQ);
            double fr = invf[0];
#pragma unroll
            for (int q = 1; q < 8; ++q) fr = (k == q) ? invf[q] : fr;
            double s, c; sincos_d(pos * fr, s, c);
            F.rope[p * 16 + k] = (float)c; F.rope[p * 16 + 8 + k] = (float)s;
        }
    }
}

typedef short bf16x8m __attribute__((ext_vector_type(8)));
typedef short v4i16m __attribute__((ext_vector_type(4)));
struct AttnTileP { int dil, rg, Q0, sp, ks, Lg; };
__device__ __forceinline__ AttnTileP attn_tile_params(int ti, int r16, int L0) {
    AttnTileP t;
    if (ti < 5)       { t.dil = 16; t.rg = r16;     t.Q0 = L0;                  t.sp = 1;  t.ks = t.Q0 - 128 + 32 * ti;        t.Lg = 256; }
    else if (ti < 11) { t.dil = 4;  t.rg = r16 & 3; t.Q0 = 4 * L0 + (r16 >> 2); t.sp = 4;  t.ks = t.Q0 - 128 + 32 * (ti - 5);  t.Lg = 1024; }
    else              { t.dil = 1;  t.rg = 0;       t.Q0 = 16 * L0 + r16;       t.sp = 16; t.ks = t.Q0 - 128 + 32 * (ti - 11); t.Lg = 4096; }
    return t;
}
__device__ __forceinline__ void attn_tile_load(const bf16* P, int b, int h, const AttnTileP& t, int lane, bf16x8m (&kf)[2][2], v4u (&vv)[4]) {
    const int fr = lane & 15, g4 = lane >> 4;
#pragma unroll
    for (int sub = 0; sub < 2; ++sub) { int kp = t.ks + 16 * sub + fr; kp = kp < 0 ? 0 : (kp >= t.Lg ? t.Lg - 1 : kp);
        const bf16* kr = P + (size_t)(b * SEQ + t.dil * kp + t.rg) * NPROJ + C_K + h * 64 + 8 * g4;
        kf[sub][0] = *(const bf16x8m*)kr; kf[sub][1] = *(const bf16x8m*)(kr + 32); }
#pragma unroll
    for (int k = 0; k < 4; ++k) { int kp = t.ks + (lane >> 3) + 8 * k; kp = kp < 0 ? 0 : (kp >= t.Lg ? t.Lg - 1 : kp);
        vv[k] = *(const v4u*)(P + (size_t)(b * SEQ + t.dil * kp + t.rg) * NPROJ + C_V + h * 64 + 8 * (lane & 7)); }
}
struct Claimer { int nxt; };
__device__ __forceinline__ int claim_unit(Frame& F, int which, int limit, Claimer& C) {
    unsigned* ctr = (unsigned*)(F.ws + WS_CLAIM) + 64 * which;
    volatile LAS int* sh = (volatile LAS int*)(F.lds + MISC_OFF + 72);
    __syncthreads();
    if (F.tid == 0) { if (C.nxt == -2) C.nxt = (int)__hip_atomic_fetch_add(ctr, 1u, __ATOMIC_RELAXED, __HIP_MEMORY_SCOPE_AGENT); sh[0] = C.nxt; }
    __syncthreads();
    const int u = sh[0];
    if (F.tid == 0) C.nxt = (u < limit) ? (int)__hip_atomic_fetch_add(ctr, 1u, __ATOMIC_RELAXED, __HIP_MEMORY_SCOPE_AGENT) : -2;
    return u;
}
__device__ __forceinline__ void attn_tile_math(const bf16x8m (&kc)[2][2], const bf16x8m (&qf)[2], int ks, int qp, int g4, const LAS unsigned char* vb, int troff, float& m, float& lsum, f32x4 (&acc)[4]) {
    f32x4 s0 = (f32x4){0.f, 0.f, 0.f, 0.f}, s1 = (f32x4){0.f, 0.f, 0.f, 0.f};
    s0 = __builtin_amdgcn_mfma_f32_16x16x32_bf16(kc[0][0], qf[0], s0, 0, 0, 0); s0 = __builtin_amdgcn_mfma_f32_16x16x32_bf16(kc[0][1], qf[1], s0, 0, 0, 0);
    s1 = __builtin_amdgcn_mfma_f32_16x16x32_bf16(kc[1][0], qf[0], s1, 0, 0, 0); s1 = __builtin_amdgcn_mfma_f32_16x16x32_bf16(kc[1][1], qf[1], s1, 0, 0, 0);
    float mx = -INFINITY;
    const int dbase = qp - ks - 4 * g4; const unsigned dlim = (unsigned)(qp < 128 ? qp : 128);
#pragma unroll
    for (int i = 0; i < 4; ++i) { const bool v0 = (unsigned)(dbase - i) <= dlim, v1 = (unsigned)(dbase - 16 - i) <= dlim;
        s0[i] = v0 ? s0[i] : -INFINITY; s1[i] = v1 ? s1[i] : -INFINITY; mx = fmaxf(mx, fmaxf(s0[i], s1[i])); }
    if (__builtin_amdgcn_ballot_w64(mx > m + 8.f) != 0ull) {
        mx = fmaxf(mx, __shfl_xor(mx, 16)); mx = fmaxf(mx, __shfl_xor(mx, 32));
        const float mn = fmaxf(m, mx), alpha = __expf(m - mn); m = mn;
        lsum = lsum * alpha;
#pragma unroll
        for (int i = 0; i < 4; ++i) acc[i] = acc[i] * alpha;
    }
    float ps = 0.f;
#pragma unroll
    for (int i = 0; i < 4; ++i) { s0[i] = __expf(s0[i] - m); s1[i] = __expf(s1[i] - m); ps += s0[i] + s1[i]; }
    lsum += ps;
    v4u w; w.x = pk2(s0[0], s0[1]); w.y = pk2(s0[2], s0[3]); w.z = pk2(s1[0], s1[1]); w.w = pk2(s1[2], s1[3]);
    const bf16x8m pb = __builtin_bit_cast(bf16x8m, w);
#pragma unroll
    for (int db = 0; db < 4; ++db) {
        const v4i16m a0 = __builtin_amdgcn_ds_read_tr16_b64_v4i16((LAS v4i16m*)(vb + troff + db * 32));
        const v4i16m a1 = __builtin_amdgcn_ds_read_tr16_b64_v4i16((LAS v4i16m*)(vb + troff + db * 32 + 16 * 160));
        acc[db] = __builtin_amdgcn_mfma_f32_16x16x32_bf16(__builtin_shufflevector(a0, a1, 0, 1, 2, 3, 4, 5, 6, 7), pb, acc[db], 0, 0, 0);
    }
}
__device__ __forceinline__ void p2_attn_prompt_mfma(Frame& F, int stop_at, Claimer& C) {
    const int lane = F.lane, fr = lane & 15, g4 = lane >> 4, tid = F.tid;
    LAS unsigned char* vbuf = F.lds + F.wave * 5120;
    LAS unsigned char* Ksh = F.lds + 40960; LAS unsigned char* Vsh = Ksh + 30720;
    const int vwoff = (lane >> 3) * 160 + (lane & 7) * 16;
    const int troff = (4 * g4 + (fr >> 2)) * 160 + (fr & 3) * 8;
    for (int bu = claim_unit(F, 0, 1024, C); bu < 1024; bu = claim_unit(F, 0, 1024, C)) {
        const int r16 = (bu & 1) * 8 + F.wave, L0 = ((bu >> 1) & 15) * 16, h = (bu >> 5) & 7, b = bu >> 8;
        const int rowq = b * SEQ + 16 * (L0 + fr) + r16;
        bf16x8m qf[2];
        { const bf16* qr = F.PROJ + (size_t)rowq * NPROJ + C_Q + h * 64 + 8 * g4; qf[0] = *(const bf16x8m*)qr; qf[1] = *(const bf16x8m*)(qr + 32); }
        v4u wreg[6];
#pragma unroll
        for (int k = 0; k < 6; ++k) { const int i = tid + 512 * k, which = (i >= 1536) ? 1 : 0, r = (i - which * 1536) >> 3, c = i & 7;
            int tok = 16 * L0 - 128 + r; tok = tok < 0 ? 0 : tok;
            wreg[k] = *(const v4u*)(F.PROJ + (size_t)(b * SEQ + tok) * NPROJ + (which ? C_V : C_K) + h * 64 + 8 * c); }
        f32x4 acc[4];
#pragma unroll
        for (int i = 0; i < 4; ++i) acc[i] = (f32x4){0.f, 0.f, 0.f, 0.f};
        float m = -1e30f, lsum = 0.f;
        bf16x8m kc[2][2]; v4u vr[4];
        { const AttnTileP t0 = attn_tile_params(0, r16, L0); attn_tile_load(F.PROJ, b, h, t0, lane, kc, vr); }
#pragma unroll 1
        for (int ti = 0; ti < 11; ++ti) {
            const AttnTileP t = attn_tile_params(ti, r16, L0);
#pragma unroll
            for (int k = 0; k < 4; ++k) *(LAS v4u*)(vbuf + vwoff + k * 1280) = vr[k];
            bf16x8m kn[2][2];
            { const AttnTileP tn = attn_tile_params((ti + 1 < 11) ? ti + 1 : ti, r16, L0); attn_tile_load(F.PROJ, b, h, tn, lane, kn, vr); }
            attn_tile_math(kc, qf, t.ks, t.Q0 + t.sp * fr, g4, vbuf, troff, m, lsum, acc);
#pragma unroll
            for (int a = 0; a < 2; ++a) { kc[a][0] = kn[a][0]; kc[a][1] = kn[a][1]; }
        }
        const int W0 = 16 * L0 - 128, qp1 = 16 * L0 + r16 + 16 * fr;
#pragma unroll 1
        for (int pass = 0; pass < 2; ++pass) {
            __syncthreads();
#pragma unroll
            for (int k = 0; k < 6; ++k) { const int i = tid + 512 * k, which = (i >= 1536) ? 1 : 0, r = (i - which * 1536) >> 3, c = i & 7;
                *(LAS v4u*)(Ksh + which * 30720 + r * 160 + c * 16) = wreg[k]; }
            if (pass == 0) {
#pragma unroll
                for (int k = 0; k < 6; ++k) { const int i = tid + 512 * k, which = (i >= 1536) ? 1 : 0, r = (i - which * 1536) >> 3, c = i & 7;
                    int tok = W0 + 192 + r; tok = tok < 0 ? 0 : tok;
                    wreg[k] = *(const v4u*)(F.PROJ + (size_t)(b * SEQ + tok) * NPROJ + (which ? C_V : C_K) + h * 64 + 8 * c); } }
            __syncthreads();
#pragma unroll 2
            for (int j = 0; j < 6; ++j) {
                bf16x8m kk[2][2];
#pragma unroll
                for (int sub = 0; sub < 2; ++sub) { const LAS unsigned char* kr = Ksh + (32 * j + 16 * sub + fr) * 160 + 16 * g4;
                    kk[sub][0] = *(const LAS bf16x8m*)kr; kk[sub][1] = *(const LAS bf16x8m*)(kr + 64); }
                attn_tile_math(kk, qf, W0 + 192 * pass + 32 * j, qp1, g4, Vsh + 32 * j * 160, troff, m, lsum, acc);
            }
        }
        lsum += __shfl_xor(lsum, 16); lsum += __shfl_xor(lsum, 32);
        const float inv = 1.f / lsum;
        bf16* orow = F.MIX + (size_t)rowq * DM + h * 64 + 4 * g4;
#pragma unroll
        for (int db = 0; db < 4; ++db) { v2u o; o.x = pk2(acc[db][0] * inv, acc[db][1] * inv); o.y = pk2(acc[db][2] * inv, acc[db][3] * inv); *(v2u*)(orow + 16 * db) = o; }
        if (bu >= stop_at) break;
    }
}


__device__ __forceinline__ bf16x8m cvt8(const f32x4 a, const f32x4 b) { v4u w; w.x = pk2(a.x, a.y); w.y = pk2(a.z, a.w); w.z = pk2(b.x, b.y); w.w = pk2(b.z, b.w); return __builtin_bit_cast(bf16x8m, w); }
__device__ __forceinline__ bf16x8m ld_sigma_g(const bf16* p) {
    const v2u a = *(const v2u*)p, c = *(const v2u*)(p + 16); v4u w; w.x = a.x; w.y = a.y; w.z = c.x; w.w = c.y; return __builtin_bit_cast(bf16x8m, w);
}
template <bool FAR>
__device__ __forceinline__ void sstream_tile(const bf16x8m (&ka)[2][2], const bf16x8m q0, const bf16x8m q1, int R, int fr, int g4, int isel, const LAS unsigned char* vbuf, int troff,
                                             float& m, float& lsum, f32x4 (&acc)[4]) {
    f32x4 s0 = (f32x4){0.f, 0.f, 0.f, 0.f}, s1 = (f32x4){0.f, 0.f, 0.f, 0.f};
    s0 = __builtin_amdgcn_mfma_f32_16x16x32_bf16(ka[0][0], q0, s0, 0, 0, 0); s0 = __builtin_amdgcn_mfma_f32_16x16x32_bf16(ka[0][1], q1, s0, 0, 0, 0);
    s1 = __builtin_amdgcn_mfma_f32_16x16x32_bf16(ka[1][0], q0, s1, 0, 0, 0); s1 = __builtin_amdgcn_mfma_f32_16x16x32_bf16(ka[1][1], q1, s1, 0, 0, 0);
    float mx;
    float mu0[4], mu1[4];
    if (FAR) {
        const float a0 = (isel == 0) ? s0[0] : (isel == 1) ? s0[1] : (isel == 2) ? s0[2] : s0[3];
        const float a1 = (isel == 0) ? s1[0] : (isel == 1) ? s1[1] : (isel == 2) ? s1[2] : s1[3];
        mx = (isel >= 0) ? fmaxf(a0, a1) : -INFINITY;
        if (__builtin_amdgcn_ballot_w64(mx > m + 8.f) != 0ull) {
            mx = fmaxf(mx, __shfl_xor(mx, 16)); mx = fmaxf(mx, __shfl_xor(mx, 32));
            const float mn = fmaxf(m, mx), alpha = __expf(m - mn); m = mn;
            lsum = lsum * alpha;
#pragma unroll
            for (int i = 0; i < 4; ++i) acc[i] = acc[i] * alpha;
        }
        const float e0 = (isel >= 0) ? __expf(a0 - m) : 0.f, e1 = (isel >= 0) ? __expf(a1 - m) : 0.f;
#pragma unroll
        for (int i = 0; i < 4; ++i) { s0[i] = (i == isel) ? e0 : 0.f; s1[i] = (i == isel) ? e1 : 0.f; }
        lsum += (e0 + e1);
    } else {
        mx = -INFINITY;
#pragma unroll
        for (int i = 0; i < 4; ++i) {
            const int d0 = WBUF + fr - (R + 4 * g4 + i), d1 = d0 - 16;
            float c0 = 0.f, c1 = 0.f;
            if (fr < 8 && d0 >= 0) c0 = (d0 <= 128 ? 1.f : 0.f) + (((d0 & 3) == 0 && d0 <= 512) ? 1.f : 0.f) + (((d0 & 15) == 0) ? 1.f : 0.f);
            if (fr < 8 && d1 >= 0) c1 = (d1 <= 128 ? 1.f : 0.f) + (((d1 & 3) == 0 && d1 <= 512) ? 1.f : 0.f) + (((d1 & 15) == 0) ? 1.f : 0.f);
            mu0[i] = c0; mu1[i] = c1;
            mx = fmaxf(mx, (c0 > 0.f) ? s0[i] : -INFINITY);
            mx = fmaxf(mx, (c1 > 0.f) ? s1[i] : -INFINITY); }
        if (__builtin_amdgcn_ballot_w64(mx > m + 8.f) != 0ull) {
            mx = fmaxf(mx, __shfl_xor(mx, 16)); mx = fmaxf(mx, __shfl_xor(mx, 32));
            const float mn = fmaxf(m, mx), alpha = __expf(m - mn); m = mn;
            lsum = lsum * alpha;
#pragma unroll
            for (int i = 0; i < 4; ++i) acc[i] = acc[i] * alpha;
        }
        float ps = 0.f;
#pragma unroll
        for (int i = 0; i < 4; ++i) { s0[i] = (mu0[i] > 0.f) ? mu0[i] * __expf(s0[i] - m) : 0.f; s1[i] = (mu1[i] > 0.f) ? mu1[i] * __expf(s1[i] - m) : 0.f; ps += s0[i] + s1[i]; }
        lsum += ps;
    }
    v4u pw; pw.x = pk2(s0[0], s0[1]); pw.y = pk2(s0[2], s0[3]); pw.z = pk2(s1[0], s1[1]); pw.w = pk2(s1[2], s1[3]);
    const bf16x8m pb = __builtin_bit_cast(bf16x8m, pw);
#pragma unroll
    for (int db = 0; db < 4; ++db) {
        const v4i16m a0 = __builtin_amdgcn_ds_read_tr16_b64_v4i16((LAS v4i16m*)(vbuf + troff + db * 32));
        const v4i16m a1 = __builtin_amdgcn_ds_read_tr16_b64_v4i16((LAS v4i16m*)(vbuf + troff + db * 32 + 16 * 160));
        acc[db] = __builtin_amdgcn_mfma_f32_16x16x32_bf16(__builtin_shufflevector(a0, a1, 0, 1, 2, 3, 4, 5, 6, 7), pb, acc[db], 0, 0, 0);
    }
}
struct STile { f32x4 k[2][4], v[2][4]; };
template <bool FAR> __device__ __forceinline__ int srow(int ti, int sub, int fr) { return FAR ? 64 * ti + 32 * sub + (fr & 7) + 16 * (fr >> 3) : 32 * ti + 16 * sub + fr; }
template <bool FAR>
__device__ __forceinline__ void sstream_load(STile& T, const float* ck, const float* cv, unsigned hb, int ti, int fr) {
#pragma unroll
    for (int sub = 0; sub < 2; ++sub) { const unsigned off = hb + (unsigned)srow<FAR>(ti, sub, fr) * 2048u;
#pragma unroll
        for (int j = 0; j < 4; ++j) { T.k[sub][j] = *(const f32x4*)((const char*)ck + off + 64 * j); T.v[sub][j] = *(const f32x4*)((const char*)cv + off + 64 * j); } }
}
template <bool FAR>
__device__ __forceinline__ void sstream_consume(const STile& T, float* ok, float* ov, unsigned hb, int ti, int fr, int g4, LAS unsigned char* vbuf, bf16x8m (&ka)[2][2]) {
#pragma unroll
    for (int sub = 0; sub < 2; ++sub) { const int row = srow<FAR>(ti, sub, fr);
        if (row >= DTS) { const unsigned off = hb + (unsigned)(row - DTS) * 2048u;
#pragma unroll
            for (int j = 0; j < 4; ++j) { *(f32x4*)((char*)ok + off + 64 * j) = T.k[sub][j]; *(f32x4*)((char*)ov + off + 64 * j) = T.v[sub][j]; } }
        ka[sub][0] = cvt8(T.k[sub][0], T.k[sub][1]); ka[sub][1] = cvt8(T.k[sub][2], T.k[sub][3]);
        LAS unsigned char* vd = vbuf + (16 * sub + fr) * 160 + 8 * g4;
#pragma unroll
        for (int j = 0; j < 4; ++j) { v2u o; o.x = pk2(T.v[sub][j].x, T.v[sub][j].y); o.y = pk2(T.v[sub][j].z, T.v[sub][j].w); *(LAS v2u*)(vd + 32 * j) = o; } }
}
template <bool MATH = true>
__device__ __forceinline__ void p2_sample_stream(Frame& F) {
    const int lane = F.lane, fr = lane & 15, g4 = lane >> 4, w = F.wave;
    LAS unsigned char* vbuf = F.lds + w * 5120;
    LAS float* mrg = (LAS float*)(F.lds + 40960);
    const int troff = (4 * g4 + (fr >> 2)) * 160 + (fr & 3) * 8;
    const int isel = ((fr < 8) && ((fr >> 2) == (g4 & 1))) ? (fr & 3) : -1;
#ifndef STREAM_CUS
#define STREAM_CUS 256
#endif
    constexpr int SSTEP = 256 / STREAM_CUS;
    if ((F.vcu % SSTEP) == 0)
    for (int su = F.vcu / SSTEP; su < 256; su += F.G / SSTEP) {
        const int b = su >> 1, hh = 4 * (su & 1) + (w & 3), par = w >> 2;
        bf16x8m q0, q1;
        { const bf16* qr = F.PROJ + (size_t)(MP + b * DTS + (fr & 7)) * NPROJ + C_Q + hh * 64 + 4 * g4;
          q0 = ld_sigma_g(qr); q1 = ld_sigma_g(qr + 32);
          if (fr >= 8) { q0 = (bf16x8m){0, 0, 0, 0, 0, 0, 0, 0}; q1 = q0; } }
        f32x4 acc[4];
#pragma unroll
        for (int i = 0; i < 4; ++i) acc[i] = (f32x4){0.f, 0.f, 0.f, 0.f};
        float m = -1e30f, lsum = 0.f;
        const unsigned hb = (unsigned)((((size_t)b * WBUF * 8 + hh) * 64 + 4 * g4) * 4);
        const float* ck = F.cache_k; const float* cv = F.cache_v; float* ok = F.out + O_SK; float* ov = F.out + O_SV;
        __syncthreads();
        STile TA, TB; bf16x8m ka[2][2];
        sstream_load<true>(TA, ck, cv, hb, par, fr); sstream_load<true>(TB, ck, cv, hb, par + 2, fr);
#define SS_LOAD(T, k) do { const int _k = (k); if (_k < 12) sstream_load<true>(T, ck, cv, hb, par + 2 * _k, fr); else sstream_load<false>(T, ck, cv, hb, 48 + par + 2 * ((_k < 20 ? _k : 19) - 12), fr); } while (0)
#pragma unroll 1
        for (int k = 0; k < 12; k += 2) {
            sstream_consume<true>(TA, ok, ov, hb, par + 2 * k, fr, g4, vbuf, ka); __builtin_amdgcn_sched_barrier(0);
            SS_LOAD(TA, k + 2); __builtin_amdgcn_sched_barrier(0);
            sstream_tile<true>(ka, q0, q1, 0, fr, g4, isel, vbuf, troff, m, lsum, acc); __builtin_amdgcn_sched_barrier(0);
            sstream_consume<true>(TB, ok, ov, hb, par + 2 * k + 2, fr, g4, vbuf, ka); __builtin_amdgcn_sched_barrier(0);
            SS_LOAD(TB, k + 3); __builtin_amdgcn_sched_barrier(0);
            sstream_tile<true>(ka, q0, q1, 0, fr, g4, isel, vbuf, troff, m, lsum, acc); __builtin_amdgcn_sched_barrier(0);
        }
#pragma unroll 1
        for (int k = 12; k < 20; k += 2) {
            const int ti = 48 + par + 2 * (k - 12);
            sstream_consume<false>(TA, ok, ov, hb, ti, fr, g4, vbuf, ka); __builtin_amdgcn_sched_barrier(0);
            SS_LOAD(TA, k + 2); __builtin_amdgcn_sched_barrier(0);
            sstream_tile<false>(ka, q0, q1, 32 * ti, fr, g4, isel, vbuf, troff, m, lsum, acc); __builtin_amdgcn_sched_barrier(0);
            sstream_consume<false>(TB, ok, ov, hb, ti + 2, fr, g4, vbuf, ka); __builtin_amdgcn_sched_barrier(0);
            SS_LOAD(TB, k + 3); __builtin_amdgcn_sched_barrier(0);
            sstream_tile<false>(ka, q0, q1, 32 * (ti + 2), fr, g4, isel, vbuf, troff, m, lsum, acc); __builtin_amdgcn_sched_barrier(0);
        }
#undef SS_LOAD
        if (MATH && par == 0) {
            bf16x8m ka[2][2];
            const bf16x8m z = (bf16x8m){0, 0, 0, 0, 0, 0, 0, 0};
            const bf16* kr = F.PROJ + (size_t)(MP + b * DTS + (fr & 7)) * NPROJ + C_K + hh * 64 + 4 * g4;
            const bf16* vr = F.PROJ + (size_t)(MP + b * DTS + (fr & 7)) * NPROJ + C_V + hh * 64 + 4 * g4;
            ka[0][0] = (fr < 8) ? ld_sigma_g(kr) : z; ka[0][1] = (fr < 8) ? ld_sigma_g(kr + 32) : z; ka[1][0] = z; ka[1][1] = z;
#pragma unroll
            for (int sub = 0; sub < 2; ++sub) { LAS unsigned char* vd = vbuf + (16 * sub + fr) * 160 + 8 * g4;
#pragma unroll
                for (int j = 0; j < 4; ++j) { v2u o = (v2u){0u, 0u}; if (sub == 0 && fr < 8) o = *(const v2u*)(vr + 16 * j); *(LAS v2u*)(vd + 32 * j) = o; } }
            sstream_tile<false>(ka, q0, q1, WBUF, fr, g4, isel, vbuf, troff, m, lsum, acc);
        }
        lsum += __shfl_xor(lsum, 16); lsum += __shfl_xor(lsum, 32);
        LAS float* mg = mrg + ((w & 3) * 64 + lane) * 18;
        if (MATH && par == 1) { mg[0] = m; mg[1] = lsum;
#pragma unroll
            for (int db = 0; db < 4; ++db) { mg[2 + 4 * db] = acc[db][0]; mg[3 + 4 * db] = acc[db][1]; mg[4 + 4 * db] = acc[db][2]; mg[5 + 4 * db] = acc[db][3]; } }
        __syncthreads();
        if (MATH && par == 0) {
            const float m2 = mg[0], l2 = mg[1], mn = fmaxf(m, m2), a1 = __expf(m - mn), a2 = __expf(m2 - mn), inv = 1.f / (lsum * a1 + l2 * a2);
            if (fr < 8) { bf16* orow = F.MIX + (size_t)(MP + b * DTS + fr) * DM + hh * 64 + 4 * g4;
#pragma unroll
                for (int db = 0; db < 4; ++db) { v2u o;
                    o.x = pk2((acc[db][0] * a1 + mg[2 + 4 * db] * a2) * inv, (acc[db][1] * a1 + mg[3 + 4 * db] * a2) * inv);
                    o.y = pk2((acc[db][2] * a1 + mg[4 + 4 * db] * a2) * inv, (acc[db][3] * a1 + mg[5 + 4 * db] * a2) * inv);
                    *(v2u*)(orow + 16 * db) = o; } }
        }
    }
}

constexpr int NCHUNK = 2 * DBS * 96, CLAIM = 4;
__device__ __forceinline__ void copy_load(Frame& F, int c0, f32x4 (&v)[8]) {
#pragma unroll
    for (int k = 0; k < 8; ++k) { const int i = F.tid + 512 * k, c = c0 + (i >> 10), r = i & 1023;
        const float* src = ((c & 1) ? F.cache_v : F.cache_k) + ((size_t)((c >> 1) & 127) * WBUF + 16 * (c >> 8) + 8) * 512;
        v[k] = __builtin_nontemporal_load((const f32x4*)src + r); }
}
__device__ __forceinline__ void copy_store(Frame& F, int c0, const f32x4 (&v)[8]) {
#pragma unroll
    for (int k = 0; k < 8; ++k) { const int i = F.tid + 512 * k, c = c0 + (i >> 10), r = i & 1023;
        float* dst = F.out + ((c & 1) ? O_SV : O_SK) + ((size_t)((c >> 1) & 127) * WBUF + 16 * (c >> 8)) * 512;
        __builtin_nontemporal_store(v[k], (f32x4*)dst + r); }
}
__device__ __forceinline__ void copy_claim(Frame& F, int c0) { f32x4 v[8]; copy_load(F, c0, v); copy_store(F, c0, v); }
__device__ __forceinline__ void copy_quota(Frame& F, int n) {
    unsigned* ctl = (unsigned*)(F.ws + WS_CPY);
    volatile LAS int* sh = (volatile LAS int*)(F.lds + MISC_OFF + 64);
    for (int k = 0; k < n; ++k) {
        __syncthreads();
        if (F.tid == 0) { const unsigned c = __hip_atomic_fetch_add(ctl, (unsigned)CLAIM, __ATOMIC_RELAXED, __HIP_MEMORY_SCOPE_AGENT); sh[0] = (c < (unsigned)NCHUNK) ? (int)c : -1; }
        __syncthreads();
        const int c0 = sh[0];
        if (c0 < 0) break;
        copy_claim(F, c0);
    }
    __syncthreads();
}
__device__ __forceinline__ void help_copy(Frame& F, int phase, bool announce = true, bool announce_only = false) {
    unsigned* ctl = (unsigned*)(F.ws + WS_CPY);
    volatile LAS int* sh = (volatile LAS int*)(F.lds + MISC_OFF + 64);
    __syncthreads();
    if (announce && phase >= 0 && F.tid == 0) __hip_atomic_fetch_add(ctl + 64 * (1 + phase), 1u, __ATOMIC_RELAXED, __HIP_MEMORY_SCOPE_AGENT);
    if (announce_only) return;
    int nxt = -1;
    if (F.tid == 0) { const bool busy = (phase < 0) || (__hip_atomic_load(ctl + 64 * (1 + phase), __ATOMIC_RELAXED, __HIP_MEMORY_SCOPE_AGENT) < (unsigned)F.G);
        if (busy) { const unsigned c = __hip_atomic_fetch_add(ctl, (unsigned)CLAIM, __ATOMIC_RELAXED, __HIP_MEMORY_SCOPE_AGENT); if (c < (unsigned)NCHUNK) nxt = (int)c; } }
    int cur = -1; f32x4 va[8], vb[8];
    for (;;) {
        if (F.tid == 0) sh[0] = nxt;
        __syncthreads();
        const int c1 = sh[0];
        __syncthreads();
        if (c1 >= 0) {
            if (F.tid == 0) { nxt = -1;
                const bool busy = (phase < 0) || (__hip_atomic_load(ctl + 64 * (1 + phase), __ATOMIC_RELAXED, __HIP_MEMORY_SCOPE_AGENT) < (unsigned)F.G);
                if (busy) { const unsigned c = __hip_atomic_fetch_add(ctl, (unsigned)CLAIM, __ATOMIC_RELAXED, __HIP_MEMORY_SCOPE_AGENT); if (c < (unsigned)NCHUNK) nxt = (int)c; } }
            copy_load(F, c1, vb);
        }
        if (cur >= 0) copy_store(F, cur, va);
        if (c1 < 0) break;
#pragma unroll
        for (int k = 0; k < 8; ++k) va[k] = vb[k];
        cur = c1;
    }
}

__device__ __forceinline__ void load_q64(const bf16* qp, LAS float* sq, int lane) {
    sq[lane] = bf2f(qp[lane]);
    LDS_WAIT(); asm volatile("" ::: "memory");
}
__device__ __forceinline__ float dot_bf16row(const bf16* kp, const LAS float* sq) {
    float a = 0.f;
#pragma unroll 1
    for (int i = 0; i < 8; ++i) { const v4u w = *(const v4u*)(kp + 8 * i); const f32x4 q0 = *(const LAS f32x4*)(sq + 8 * i), q1 = *(const LAS f32x4*)(sq + 8 * i + 4);
        a += q0.x * bflo(w.x) + q0.y * bfhi(w.x) + q0.z * bflo(w.y) + q0.w * bfhi(w.y) + q1.x * bflo(w.z) + q1.y * bfhi(w.z) + q1.z * bflo(w.w) + q1.w * bfhi(w.w); }
    return a;
}
__device__ __forceinline__ float dot_f32row(const float* kp, const LAS float* sq) {
    float a = 0.f;
#pragma unroll 1
    for (int i = 0; i < 16; ++i) { const f32x4 w = *(const f32x4*)(kp + 4 * i); const f32x4 q0 = *(const LAS f32x4*)(sq + 4 * i);
        a += q0.x * w.x + q0.y * w.y + q0.z * w.z + q0.w * w.w; }
    return a;
}
__device__ __forceinline__ void p2_attn_v1(Frame& F) {
    const int gw = F.vcu * 8 + F.wave, NGW = F.G * 8, lane = F.lane;
    LAS float* q = (LAS float*)(F.lds + F.wave * 256);
    for (int it = gw; it < MS * 8; it += NGW) {
        const int sr = it >> 3, h = it & 7, b = sr >> 3, t = sr & 7, row = MP + sr;
        load_q64(F.PROJ + (size_t)row * NPROJ + C_Q + h * 64, q, lane);
        float sc[3][3];
#pragma unroll
        for (int g = 0; g < 3; ++g) { const int dil = (g == 0) ? 1 : (g == 1 ? 4 : 16);
#pragma unroll
            for (int i = 0; i < 3; ++i) { const int j = lane + 64 * i; const bool valid = (j <= 128);
                const int idx = valid ? (WBUF + t - dil * j) : (WBUF + t);
                float d;
                if (idx < WBUF) d = dot_f32row(F.cache_k + (((size_t)b * WBUF + idx) * 8 + h) * 64, q);
                else d = dot_bf16row(F.PROJ + (size_t)(MP + b * DTS + idx - WBUF) * NPROJ + C_K + h * 64, q);
                sc[g][i] = valid ? d : -INFINITY; asm volatile("" ::: "memory"); } }
        float mx = -INFINITY;
#pragma unroll
        for (int g = 0; g < 3; ++g)
#pragma unroll
            for (int i = 0; i < 3; ++i) mx = fmaxf(mx, sc[g][i]);
        mx = wave_max(mx);
        float sum = 0.f;
#pragma unroll
        for (int g = 0; g < 3; ++g)
#pragma unroll
            for (int i = 0; i < 3; ++i) { sc[g][i] = __expf(sc[g][i] - mx); sum += sc[g][i]; }
        sum = wave_sum(sum);
        float o = 0.f;
#pragma unroll
        for (int g = 0; g < 3; ++g) { const int dil = (g == 0) ? 1 : (g == 1 ? 4 : 16);
#pragma unroll
            for (int i = 0; i < 3; ++i) { const int cnt = (i == 2) ? 1 : 64;
#pragma unroll 1
                for (int jj = 0; jj < cnt; ++jj) { const int idx = WBUF + t - dil * (jj + 64 * i);
                    const float p = __shfl(sc[g][i], jj);
                    const float vv = (idx < WBUF) ? F.cache_v[(((size_t)b * WBUF + idx) * 8 + h) * 64 + lane]
                                                  : bf2f(F.PROJ[(size_t)(MP + b * DTS + idx - WBUF) * NPROJ + C_V + h * 64 + lane]);
                    o += p * vv; } } }
        F.MIX[(size_t)row * DM + h * 64 + lane] = (bf16)f2bf(o / sum);
    }
}

constexpr int TP = 288;
constexpr int ML_A = 0, ML_K = 36864, ML_V = 73728, ML_S = 110592;
typedef short v4i16s __attribute__((ext_vector_type(4)));
__device__ __forceinline__ bf16x8m tr2(const LAS unsigned char* p) {
    const v4i16m a0 = __builtin_amdgcn_ds_read_tr16_b64_v4i16((LAS v4i16m*)p);
    const v4i16m a1 = __builtin_amdgcn_ds_read_tr16_b64_v4i16((LAS v4i16m*)(p + 16 * TP));
    return __builtin_shufflevector(a0, a1, 0, 1, 2, 3, 4, 5, 6, 7);
}
__device__ __forceinline__ bf16x8m rd_sigma(const LAS unsigned char* p) {
    const v4i16m a0 = *(const LAS v4i16m*)p, a1 = *(const LAS v4i16m*)(p + 32);
    return __builtin_shufflevector(a0, a1, 0, 1, 2, 3, 4, 5, 6, 7);
}
template <bool SYNC_BEFORE_WRITE = false>
__device__ __forceinline__ void build_conv_tile(LAS unsigned char* dst, const bf16* PROJ, int row0, bool first, int col, const float* w_conv, const float* b_conv, float scale, const LAS float* rowscale, int tid) {
    const int cc = tid & 15, rg = tid >> 4;
    v4u x[7];
#pragma unroll
    for (int i = 0; i < 7; ++i) { const int r = 4 * rg + i - 3;
        if (first && r < 0) x[i] = (v4u){0u, 0u, 0u, 0u}; else x[i] = *(const v4u*)(PROJ + (size_t)(row0 + r) * NPROJ + C_RAW + col + 8 * cc); }
    const float* wc = w_conv + col + 8 * cc;
    float out[4][8];
#pragma unroll
    for (int e = 0; e < 8; ++e) { const float bb = b_conv[col + 8 * cc + e];
#pragma unroll
        for (int r = 0; r < 4; ++r) out[r][e] = bb; }
#pragma unroll
    for (int w = 0; w < 4; ++w) {
        const f32x4 w0 = *(const f32x4*)(wc + w * 1024), w1 = *(const f32x4*)(wc + w * 1024 + 4);
#pragma unroll
        for (int r = 0; r < 4; ++r) { const v4u xv = x[r + w];
            out[r][0] += bflo(xv.x) * w0.x; out[r][1] += bfhi(xv.x) * w0.y; out[r][2] += bflo(xv.y) * w0.z; out[r][3] += bfhi(xv.y) * w0.w;
            out[r][4] += bflo(xv.z) * w1.x; out[r][5] += bfhi(xv.z) * w1.y; out[r][6] += bflo(xv.w) * w1.z; out[r][7] += bfhi(xv.w) * w1.w; }
    }
    if (SYNC_BEFORE_WRITE) __syncthreads();
#pragma unroll
    for (int r = 0; r < 4; ++r) { const float rs = scale * (rowscale ? rowscale[4 * rg + r] : 1.f); float o[8];
#pragma unroll
        for (int e = 0; e < 8; ++e) { const float a = out[r][e]; o[e] = a * sigmoidf_(a) * rs; }
        v4u w; w.x = pk2(o[0], o[1]); w.y = pk2(o[2], o[3]); w.z = pk2(o[4], o[5]); w.w = pk2(o[6], o[7]);
        *(LAS v4u*)(dst + (4 * rg + r) * TP + cc * 16) = w; }
}
__device__ __forceinline__ void copy_v_tile(LAS unsigned char* dst, const bf16* PROJ, int row0, int col, int tid) {
#pragma unroll
    for (int k = 0; k < 4; ++k) { const int i = tid + 512 * k, r = i >> 4, cc = i & 15;
        *(LAS v4u*)(dst + r * TP + cc * 16) = *(const v4u*)(PROJ + (size_t)(row0 + r) * NPROJ + col + 8 * cc); }
}
__device__ __forceinline__ void chunk_scan(const float* lf, const float* ig, int row0, int h, int lane, float& b0, float& b1, float& u0, float& u1, float& c0, float& c1) {
    const float a0 = lf[(row0 + 2 * lane) * 4 + h], a1 = lf[(row0 + 2 * lane + 1) * 4 + h];
    const float sp = a0 + a1; float incl = sp;
#pragma unroll
    for (int o = 1; o < 64; o <<= 1) { const float t = __shfl_up(incl, o); if (lane >= o) incl += t; }
    const float excl = incl - sp;
    b0 = excl + a0; b1 = incl;
    u0 = ig[(row0 + 2 * lane) * 4 + h] - b0; u1 = ig[(row0 + 2 * lane + 1) * 4 + h] - b1;
    const float pm = fmaxf(u0, u1); float im = pm;
#pragma unroll
    for (int o = 1; o < 64; o <<= 1) { const float t = __shfl_up(im, o); if (lane >= o) im = fmaxf(im, t); }
    float em = __shfl_up(im, 1); if (lane == 0) em = -INFINITY;
    c0 = fmaxf(em, u0); c1 = im;
}

__device__ __forceinline__ void p3_mlstm_local_mfma(Frame& F) {
    const int tid = F.tid, lane = F.lane, fr = lane & 15, g4 = lane >> 4, w = F.wave;
    LAS unsigned char* sK = F.lds + ML_K; LAS unsigned char* sV = F.lds + ML_V;
    LAS float* sW = (LAS float*)(F.lds + ML_S);
    Claimer C{-2};
    for (int u = claim_unit(F, 1, 512, C); u < 512; u = claim_unit(F, 1, 512, C)) {
        const int bh = u >> 5, c = u & 31, b = bh >> 2, h = bh & 3, row0 = b * SEQ + c * 128;
        __syncthreads();
        if (w == 0) { float b0, b1, u0, u1, c0, c1; chunk_scan(F.lf, F.ig, row0, h, lane, b0, b1, u0, u1, c0, c1);
            const float um = __shfl(c1, 63);
            sW[2 * lane] = __expf(u0 - um); sW[2 * lane + 1] = __expf(u1 - um);
            if (lane == 63) { F.chk[u] = b1; F.chk[512 + u] = um; } }
        copy_v_tile(sV, F.PROJ, row0, C_VB + h * 128, tid);
        build_conv_tile<true>(sK, F.PROJ, row0, c == 0, 512 + h * 128, F.w_conv, F.b_conv, 0.08838834764831845f, sW, tid);
        __syncthreads();
        f32x4 acc[8];
#pragma unroll
        for (int i = 0; i < 8; ++i) acc[i] = (f32x4){0.f, 0.f, 0.f, 0.f};
        const int tro = (4 * g4 + (fr >> 2)) * TP + (fr & 3) * 8;
#pragma unroll
        for (int ks = 0; ks < 4; ++ks) {
            const bf16x8m vt = tr2(sV + ks * 32 * TP + tro + 32 * w);
#pragma unroll
            for (int nb = 0; nb < 8; ++nb) { const bf16x8m kt = tr2(sK + ks * 32 * TP + tro + 32 * nb);
                acc[nb] = __builtin_amdgcn_mfma_f32_16x16x32_bf16(vt, kt, acc[nb], 0, 0, 0); }
        }
#pragma unroll
        for (int nb = 0; nb < 8; ++nb) { v2u o; o.x = pk2(acc[nb][0], acc[nb][1]); o.y = pk2(acc[nb][2], acc[nb][3]);
            *(v2u*)((bf16*)F.L + (size_t)u * 16384 + (16 * nb + fr) * 128 + 16 * w + 4 * g4) = o; }
        { const int d = tid & 127, sq = tid >> 7; float n = 0.f;
#pragma unroll 8
            for (int s2 = 0; s2 < 32; ++s2) n += bf2f(*(const LAS unsigned short*)(sK + (32 * sq + s2) * TP + d * 2));
            sW[128 + sq * 128 + d] = n; }
        __syncthreads();
        if (tid < 128) F.NLOC[u * 128 + tid] = (sW[128 + tid] + sW[256 + tid]) + (sW[384 + tid] + sW[512 + tid]);
    }
}

__device__ __forceinline__ void p5_mlstm_out_mfma(Frame& F) {
    const int tid = F.tid, lane = F.lane, fr = lane & 15, g4 = lane >> 4, w = F.wave;
    LAS unsigned char* sA = F.lds + ML_A; LAS unsigned char* sK = F.lds + ML_K; LAS unsigned char* sV = F.lds + ML_V;
    LAS float* sB = (LAS float*)(F.lds + ML_S); LAS float* sU = sB + 128; LAS float* sG = sU + 128; LAS float* sN = sG + 128;
    const int tro = (4 * g4 + (fr >> 2)) * TP + (fr & 3) * 8;
    Claimer C{-2};
    for (int u = claim_unit(F, 4, 512, C); u < 512; u = claim_unit(F, 4, 512, C)) {
        const int bh = u >> 5, c = u & 31, b = bh >> 2, h = bh & 3, row0 = b * SEQ + c * 128;
        const float mc = F.chk[1024 + u];
        v2u cpre[8];
#pragma unroll
        for (int k = 0; k < 8; ++k) { const int i = tid + 512 * k, d = i >> 5, e4 = i & 31;
            cpre[k] = *(const v2u*)((const bf16*)F.CPRE + (size_t)u * 16384 + d * 128 + 4 * e4); }
        __syncthreads();
        if (w == 0) { float b0, b1, u0, u1, c0, c1; chunk_scan(F.lf, F.ig, row0, h, lane, b0, b1, u0, u1, c0, c1);
            sB[2 * lane] = b0; sB[2 * lane + 1] = b1; sU[2 * lane] = u0; sU[2 * lane + 1] = u1; sG[2 * lane] = fmaxf(mc, c0); sG[2 * lane + 1] = fmaxf(mc, c1); }
        if (w == 1) { sN[lane] = F.NPRE[u * 128 + lane]; sN[64 + lane] = F.NPRE[u * 128 + 64 + lane]; }
        build_conv_tile(sA, F.PROJ, row0, c == 0, h * 128, F.w_conv, F.b_conv, 1.f, nullptr, tid);
        build_conv_tile(sK, F.PROJ, row0, c == 0, 512 + h * 128, F.w_conv, F.b_conv, 0.08838834764831845f, nullptr, tid);
        copy_v_tile(sV, F.PROJ, row0, C_VB + h * 128, tid);
        __syncthreads();
        const int t = 16 * w + fr;
        const float gt = sG[t], bt = sB[t], wi = __expf(mc - gt);
        bf16x8m qf[4];
#pragma unroll
        for (int kd = 0; kd < 4; ++kd) qf[kd] = rd_sigma(sA + t * TP + kd * 64 + 8 * g4);
        float qn = 0.f;
#pragma unroll
        for (int i = 0; i < 4; ++i) { const v4u qq = *(const LAS v4u*)(sA + t * TP + 64 * g4 + 16 * i); const LAS float* nn = sN + 32 * g4 + 8 * i;
            qn += bflo(qq.x) * nn[0] + bfhi(qq.x) * nn[1] + bflo(qq.y) * nn[2] + bfhi(qq.y) * nn[3] + bflo(qq.z) * nn[4] + bfhi(qq.z) * nn[5] + bflo(qq.w) * nn[6] + bfhi(qq.w) * nn[7]; }
        qn += __shfl_xor(qn, 16); qn += __shfl_xor(qn, 32);
        bf16x8m pb[4]; float psum = 0.f;
#pragma unroll
        for (int j = 0; j < 4; ++j) {
            pb[j] = (bf16x8m){0, 0, 0, 0, 0, 0, 0, 0};
            if (j <= (w >> 1)) {
                f32x4 sv[2];
#pragma unroll
                for (int sub = 0; sub < 2; ++sub) { sv[sub] = (f32x4){0.f, 0.f, 0.f, 0.f};
                    const LAS unsigned char* kr = sK + (32 * j + 16 * sub + fr) * TP + 8 * g4;
#pragma unroll
                    for (int kd = 0; kd < 4; ++kd) sv[sub] = __builtin_amdgcn_mfma_f32_16x16x32_bf16(rd_sigma(kr + kd * 64), qf[kd], sv[sub], 0, 0, 0);
                    const f32x4 us = *(const LAS f32x4*)(sU + 32 * j + 16 * sub + 4 * g4);
#pragma unroll
                    for (int i = 0; i < 4; ++i) { const int s2 = 32 * j + 16 * sub + 4 * g4 + i; const float pv = (s2 <= t) ? sv[sub][i] * __expf(us[i] - gt) : 0.f; sv[sub][i] = pv; psum += pv; } }
                v4u pw; pw.x = pk2(sv[0][0], sv[0][1]); pw.y = pk2(sv[0][2], sv[0][3]); pw.z = pk2(sv[1][0], sv[1][1]); pw.w = pk2(sv[1][2], sv[1][3]);
                pb[j] = __builtin_bit_cast(bf16x8m, pw);
            }
        }
        psum += __shfl_xor(psum, 16); psum += __shfl_xor(psum, 32);
        const float den = wi * qn + psum, dinv = 1.f / fmaxf(fabsf(den), __expf(-(bt + gt)));
        __syncthreads();
#pragma unroll
        for (int k = 0; k < 8; ++k) { const int i = tid + 512 * k, d = i >> 5, e4 = i & 31; *(LAS v2u*)(sA + d * TP + e4 * 8) = cpre[k]; }
        __syncthreads();
        v2u obr[8];
#pragma unroll
        for (int eb = 0; eb < 8; ++eb) obr[eb] = *(const v2u*)(F.PROJ + (size_t)(row0 + t) * NPROJ + C_OB + h * 128 + 16 * eb + 4 * g4);
        f32x4 acc[8];
#pragma unroll
        for (int i = 0; i < 8; ++i) acc[i] = (f32x4){0.f, 0.f, 0.f, 0.f};
#pragma unroll
        for (int kd = 0; kd < 4; ++kd)
#pragma unroll
            for (int eb = 0; eb < 8; ++eb) acc[eb] = __builtin_amdgcn_mfma_f32_16x16x32_bf16(tr2(sA + kd * 32 * TP + tro + 32 * eb), qf[kd], acc[eb], 0, 0, 0);
#pragma unroll
        for (int eb = 0; eb < 8; ++eb) acc[eb] = acc[eb] * wi;
#pragma unroll
        for (int j = 0; j < 4; ++j)
            if (j <= (w >> 1)) {
#pragma unroll
                for (int eb = 0; eb < 8; ++eb) acc[eb] = __builtin_amdgcn_mfma_f32_16x16x32_bf16(tr2(sV + j * 32 * TP + tro + 32 * eb), pb[j], acc[eb], 0, 0, 0); }
        float ssq = 0.f;
#pragma unroll
        for (int eb = 0; eb < 8; ++eb) { acc[eb] = acc[eb] * dinv; ssq += (acc[eb][0] * acc[eb][0] + acc[eb][1] * acc[eb][1]) + (acc[eb][2] * acc[eb][2] + acc[eb][3] * acc[eb][3]); }
        ssq += __shfl_xor(ssq, 16); ssq += __shfl_xor(ssq, 32);
        const float rs = 1.f / sqrtf(ssq * (1.f / 128.f) + EPS);
        const int row = row0 + t;
#pragma unroll
        for (int eb = 0; eb < 8; ++eb) { const int e = 16 * eb + 4 * g4;
            const v2u ob = obr[eb]; const f32x4 gg = *(const f32x4*)(F.mhg + h * 128 + e);
            v2u o; o.x = pk2(acc[eb][0] * rs * gg.x * sigmoidf_(bflo(ob.x)), acc[eb][1] * rs * gg.y * sigmoidf_(bfhi(ob.x)));
            o.y = pk2(acc[eb][2] * rs * gg.z * sigmoidf_(bflo(ob.y)), acc[eb][3] * rs * gg.w * sigmoidf_(bfhi(ob.y)));
            *(v2u*)(F.MIX + (size_t)row * DM + 512 + h * 128 + e) = o; }
    }
}

__device__ __forceinline__ void p3_mlstm_sample(Frame& F) {
    const int tid = F.tid;
    LAS float* sQ = (LAS float*)F.lds;
    LAS float* sKs = sQ + 1024;
    LAS float* sV = sKs + 1024;
    LAS float* sQC = sV + 1024;
    LAS float* sH = sQC + 16384;
    LAS float* sN0 = sH + 1024;
    LAS float* sS = sN0 + 128;
    Claimer C{-2};
    for (int u = claim_unit(F, 2, 512, C); u < 512; u = claim_unit(F, 2, 512, C)) {
        const int b = u >> 2, h = u & 3, r0 = MP + b * DTS;
        __syncthreads();
        for (int i = tid; i < 2048; i += 512) { const int part = i >> 10, t = (i >> 7) & 7, d = i & 127, col = part * 512 + h * 128 + d;
            float a = F.b_conv[col];
#pragma unroll
            for (int w = 0; w < 4; ++w) { const int tt = t + w - 3;
                const float xv = (tt >= 0) ? bf2f(F.PROJ[(size_t)(r0 + tt) * NPROJ + C_RAW + col]) : F.st_conv[((size_t)b * 3 + (3 + tt)) * 1024 + col];
                a += xv * F.w_conv[w * 1024 + col]; }
            const float sv = a * sigmoidf_(a);
            if (part == 0) sQ[t * 128 + d] = sv; else sKs[t * 128 + d] = sv * 0.08838834764831845f; }
        for (int i = tid; i < 1024; i += 512) sV[i] = bf2f(F.PROJ[(size_t)(r0 + (i >> 7)) * NPROJ + C_VB + h * 128 + (i & 127)]);
        if (tid < 128) sN0[tid] = F.st_n[(size_t)u * 128 + tid];
        if (F.wave == 7) {
            const int t = F.lane & 7; const float m0 = F.st_m[u];
            const float lfv = F.lf[(r0 + t) * 4 + h], igv = F.ig[(r0 + t) * 4 + h];
            float acc = lfv;
#pragma unroll
            for (int o = 1; o < 8; o <<= 1) { const float x = __shfl_up(acc, o); if (t >= o) acc += x; }
            const float uu = igv - acc;
            float cm = uu;
#pragma unroll
            for (int o = 1; o < 8; o <<= 1) { const float x = __shfl_up(cm, o); if (t >= o) cm = fmaxf(cm, x); }
            const float um = __shfl(cm, 7), b7 = __shfl(acc, 7);
            cm = fmaxf(cm, m0);
            const float Mx = fmaxf(m0, um);
            if (F.lane < 8) { sS[t] = acc; sS[8 + t] = uu; sS[16 + t] = cm; sS[24 + t] = __expf(m0 - cm); sS[32 + t] = __expf(uu - Mx); }
            if (F.lane == 0) { sS[40] = __expf(m0 - Mx); F.out[O_SM + u] = b7 + Mx; }
        }
        __syncthreads();
        { const int pr = tid >> 3, part = tid & 7, t = pr >> 3, s = pr & 7; float d = 0.f;
#pragma unroll
            for (int k4 = 0; k4 < 4; ++k4) { const f32x4 qa = *(const LAS f32x4*)(sQ + t * 128 + 16 * part + 4 * k4), kb = *(const LAS f32x4*)(sKs + s * 128 + 16 * part + 4 * k4);
                d += (qa.x * kb.x + qa.y * kb.y) + (qa.z * kb.z + qa.w * kb.w); }
            d += __shfl_xor(d, 1); d += __shfl_xor(d, 2); d += __shfl_xor(d, 4);
            if (part == 0) sS[64 + pr] = (s <= t) ? d * __expf(sS[8 + s] - sS[16 + t]) : 0.f; }
        {
            const int e4 = opaque(tid & 31), dr = opaque(tid >> 5); const float alpha = sS[40];
            f32x4 vb[8], aq[8];
#pragma unroll
            for (int s2 = 0; s2 < 8; ++s2) { vb[s2] = *(const LAS f32x4*)(sV + s2 * 128 + 4 * e4) * sS[32 + s2]; aq[s2] = (f32x4){0.f, 0.f, 0.f, 0.f}; }
            f32x4 c0[8];
#pragma unroll
            for (int it = 0; it < 8; ++it) c0[it] = __builtin_nontemporal_load((const f32x4*)(F.st_C + ((size_t)u * 128 + it * 16 + dr) * 128 + 4 * e4));
#pragma unroll
            for (int it = 0; it < 8; ++it) { const int d = it * 16 + dr;
                f32x4 cn = c0[it] * alpha;
#pragma unroll
                for (int s2 = 0; s2 < 8; ++s2) { cn += vb[s2] * sKs[s2 * 128 + d]; aq[s2] += c0[it] * sQ[s2 * 128 + d]; }
                __builtin_nontemporal_store(cn, (f32x4*)(F.out + O_SC + ((size_t)u * 128 + d) * 128 + 4 * e4)); }
#pragma unroll
            for (int s2 = 0; s2 < 8; ++s2) *(LAS f32x4*)(sQC + (dr * 8 + s2) * 128 + 4 * e4) = aq[s2];
        }
        if (tid < 128) { float n = sS[40] * sN0[tid];
#pragma unroll
            for (int s = 0; s < 8; ++s) n += sS[32 + s] * sKs[s * 128 + tid];
            F.out[O_SN + (size_t)u * 128 + tid] = n; }
        __syncthreads();
        { const int t = F.wave; float qn = sQ[t * 128 + F.lane] * sN0[F.lane] + sQ[t * 128 + 64 + F.lane] * sN0[64 + F.lane];
            qn = wave_sum(qn);
            if (F.lane == 0) { float den = sS[24 + t] * qn;
#pragma unroll
                for (int s2 = 0; s2 < 8; ++s2) den += sS[64 + t * 8 + s2];
                sS[48 + t] = fmaxf(fabsf(den), __expf(-(sS[t] + sS[16 + t]))); } }
        __syncthreads();
        { const int e = tid & 127, tq = tid >> 7;
#pragma unroll
            for (int k = 0; k < 2; ++k) { const int t = tq * 2 + k;
                float qc = 0.f;
#pragma unroll
                for (int dr = 0; dr < 16; ++dr) qc += sQC[(dr * 8 + t) * 128 + e];
                float num = sS[24 + t] * qc;
#pragma unroll
                for (int s = 0; s < 8; ++s) num += sS[64 + t * 8 + s] * sV[s * 128 + e];
                sH[t * 128 + e] = num / sS[48 + t]; } }
        __syncthreads();
        { const int t = F.wave; const float h0 = sH[t * 128 + F.lane], h1 = sH[t * 128 + 64 + F.lane];
            const float ssq = wave_sum(h0 * h0 + h1 * h1); const float rs = 1.f / sqrtf(ssq * (1.f / 128.f) + EPS);
            const int row = r0 + t;
#pragma unroll
            for (int k = 0; k < 2; ++k) { const int e = F.lane + 64 * k; const float hv = k ? h1 : h0;
                const float ob = bf2f(F.PROJ[(size_t)row * NPROJ + C_OB + h * 128 + e]);
                F.MIX[(size_t)row * DM + 512 + h * 128 + e] = (bf16)f2bf(hv * rs * F.mhg[h * 128 + e] * sigmoidf_(ob)); } }
    }
}

__device__ __forceinline__ void p4_prefix_v1(Frame& F) {
    const int tid = F.tid;
    const int npw = (F.G >= 64) ? F.G - 16 : F.G;
    for (int u = F.vcu; u < 256; u += npw) {
        const int chain = u >> 4, sl = u & 15, idx = sl * 1024 + tid * 2;
        float m = 0.f, c0 = 0.f, c1 = 0.f, nn = 0.f;
        const bool nrow = (sl == 0 && tid < 128);
#pragma unroll 1
        for (int cb = 0; cb < 32; cb += 8) {
            float l0[8], l1[8], nl[8], bc[8], um8[8];
#pragma unroll
            for (int k = 0; k < 8; ++k) { const int unit = chain * 32 + cb + k;
                const unsigned lw = *(const unsigned*)((const bf16*)F.L + (size_t)unit * 16384 + idx); l0[k] = bflo(lw); l1[k] = bfhi(lw);
                nl[k] = nrow ? F.NLOC[unit * 128 + tid] : 0.f; bc[k] = F.chk[unit]; um8[k] = F.chk[512 + unit]; }
#pragma unroll
            for (int k = 0; k < 8; ++k) { const int unit = chain * 32 + cb + k;
                *(unsigned*)((bf16*)F.CPRE + (size_t)unit * 16384 + idx) = pk2(c0, c1);
                if (nrow) F.NPRE[unit * 128 + tid] = nn;
                if (sl == 0 && tid == 0) F.chk[1024 + unit] = m;
                const float Mx = fmaxf(m, um8[k]), a = __expf(m - Mx), bb = __expf(um8[k] - Mx);
                c0 = a * c0 + bb * l0[k]; c1 = a * c1 + bb * l1[k]; nn = a * nn + bb * nl[k];
                m = bc[k] + Mx; }
        }
        F.out[O_PC + (size_t)chain * 16384 + idx] = c0; F.out[O_PC + (size_t)chain * 16384 + idx + 1] = c1;
        if (sl == 0 && tid < 128) F.out[O_PN + chain * 128 + tid] = nn;
        if (sl == 0 && tid == 0) F.out[O_PM + chain] = m;
    }
}


__device__ __forceinline__ void probe_copy_simple(Frame& F) {
    constexpr int PER_B = (WBUF - DTS) * 128;
    const int total = DBS * PER_B;
    for (int i = F.vcu * 512 + F.tid; i < total; i += F.G * 512) {
        const int b = i / PER_B, r = i - b * PER_B;
        const size_t so = (size_t)b * (WBUF * 128) + DTS * 128 + r, dofs = (size_t)b * (WBUF * 128) + r;
        const f32x4 a = __builtin_nontemporal_load((const f32x4*)F.cache_k + so);
        const f32x4 c = __builtin_nontemporal_load((const f32x4*)F.cache_v + so);
        *((f32x4*)(F.out + O_SK) + dofs) = a;
        *((f32x4*)(F.out + O_SV) + dofs) = c;
    }
}


template <int NCU, int UNR>
__device__ __forceinline__ void probe_copy_subset(Frame& F) {
    constexpr int STEP = 256 / NCU;
    if (F.vcu % STEP) return;
    const int me = F.vcu / STEP;
    constexpr int PER_B = (WBUF - DTS) * 128;
    const int total = DBS * PER_B;
    for (int i0 = me * 512 * UNR + F.tid; i0 < total; i0 += NCU * 512 * UNR) {
        f32x4 a[UNR], c[UNR];
#pragma unroll
        for (int k = 0; k < UNR; ++k) { int i = i0 + 512 * k; i = i < total ? i : total - 1; const int b = i / PER_B, r = i - b * PER_B;
            const size_t so = (size_t)b * (WBUF * 128) + DTS * 128 + r;
            a[k] = __builtin_nontemporal_load((const f32x4*)F.cache_k + so); c[k] = __builtin_nontemporal_load((const f32x4*)F.cache_v + so); }
#pragma unroll
        for (int k = 0; k < UNR; ++k) { int i = i0 + 512 * k; i = i < total ? i : total - 1; const int b = i / PER_B, r = i - b * PER_B;
            const size_t dofs = (size_t)b * (WBUF * 128) + r;
            *((f32x4*)(F.out + O_SK) + dofs) = a[k]; *((f32x4*)(F.out + O_SV) + dofs) = c[k]; }
    }
}

__device__ __forceinline__ void p9_final_norm(Frame& F, int m0) {
    const int gw = F.vcu * 8 + F.wave, NGW = F.G * 8;
    for (int m = m0 + gw; m < M; m += NGW) {
        f32x4* p = (f32x4*)(F.out + (size_t)m * DM);
        f32x4 v[4]; float ss = 0.f;
#pragma unroll
        for (int j = 0; j < 4; ++j) { v[j] = p[64 * j + F.lane];
            if (m >= MP) {
#pragma unroll
                for (int ks = 0; ks < 8; ++ks) v[j] += *((const f32x4*)(F.ws + WS_PART) + ((size_t)ks * MS + (m - MP)) * 256 + 64 * j + F.lane); }
            ss += (v[j].x * v[j].x + v[j].y * v[j].y) + (v[j].z * v[j].z + v[j].w * v[j].w); }
        ss = wave_sum(ss);
        const float rs = 1.f / sqrtf(ss * (1.f / DM) + EPS);
#pragma unroll
        for (int j = 0; j < 4; ++j) { const f32x4 g = *(const f32x4*)(F.gf + 256 * j + 4 * F.lane); p[64 * j + F.lane] = v[j] * rs * g; }
    }
}

__device__ __forceinline__ void help_convert(Frame& F, int phase) {
    unsigned* ctl = (unsigned*)(F.ws + WS_CPY);
    unsigned* ctr = (unsigned*)(F.ws + WS_CLAIM) + 64 * 3;
    volatile LAS int* sh = (volatile LAS int*)(F.lds + MISC_OFF + 64);
    LAS float* scr = (LAS float*)(F.lds + F.wave * 16384);
    constexpr int I_UP = 16 * 128, I_DN = 64 * 32;
    __syncthreads();
    if (phase >= 0 && F.tid == 0) __hip_atomic_fetch_add(ctl + 64 * (1 + phase), 1u, __ATOMIC_RELAXED, __HIP_MEMORY_SCOPE_AGENT);
    for (;;) {
        if (F.tid == 0) { int c0 = -1;
            const bool busy = (phase < 0) || (__hip_atomic_load(ctl + 64 * (1 + phase), __ATOMIC_RELAXED, __HIP_MEMORY_SCOPE_AGENT) < (unsigned)F.G);
            if (busy) { const unsigned c = __hip_atomic_fetch_add(ctr, 8u, __ATOMIC_RELAXED, __HIP_MEMORY_SCOPE_AGENT); if (c < (unsigned)(I_UP + I_DN)) c0 = (int)c; }
            sh[0] = c0; }
        __syncthreads();
        const int c0 = sh[0];
        __syncthreads();
        if (c0 < 0) break;
        const int it = c0 + F.wave;
        if (it < I_UP) p0_transpose_item(F.w_up, DM, FF, 128, F.g2, F.Wup_t, scr, it, F.lane);
        else p0_transpose_item(F.w_down, FF, DM, 32, nullptr, F.Wdn_t, scr, it - I_UP, F.lane);
    }
}

struct Args { const float* in[19]; float* out; unsigned char* ws; int ph_lo, ph_hi; };
__global__ void __launch_bounds__(512, 2) fwd(Args args) {
    extern __shared__ __attribute__((aligned(16))) unsigned char lds[];
    Frame F;
    F.lds = (LAS unsigned char*)lds;
    F.tid = threadIdx.x; F.lane = F.tid & 63; F.wave = __builtin_amdgcn_readfirstlane(F.tid >> 6);
    F.G = gridDim.x; { const int bx = blockIdx.x; F.vcu = (F.G % 8 == 0) ? (bx % 8) * (F.G / 8) + bx / 8 : bx; }
    F.xp = args.in[0]; F.xs = args.in[1]; F.cache_k = args.in[2]; F.cache_v = args.in[3]; F.st_conv = args.in[4]; F.st_C = args.in[5]; F.st_n = args.in[6]; F.st_m = args.in[7];
    F.g1 = args.in[8]; F.w_in = args.in[9]; F.b_gate = args.in[10]; F.w_conv = args.in[11]; F.b_conv = args.in[12]; F.mhg = args.in[13]; F.w_out = args.in[14]; F.g2 = args.in[15];
    F.w_up = args.in[16]; F.w_down = args.in[17]; F.gf = args.in[18];
    F.out = args.out; F.ws = args.ws;
    unsigned char* ws = args.ws;
    F.Win_t = (bf16*)(ws + WS_WIN); F.Wout_t = (bf16*)(ws + WS_WOUT); F.Wup_t = (bf16*)(ws + WS_WUP); F.Wdn_t = (bf16*)(ws + WS_WDN);
    F.XB = (bf16*)(ws + WS_XB); F.PROJ = (bf16*)(ws + WS_PROJ); F.MIX = (bf16*)(ws + WS_MIX); F.HPB = (bf16*)(ws + WS_HPB); F.ACT = (bf16*)(ws + WS_ACT);
    F.rope = (float*)(ws + WS_ROPE); F.rstd1 = (float*)(ws + WS_RSTD1); F.ig = (float*)(ws + WS_IG); F.lf = (float*)(ws + WS_LF); F.chk = (float*)(ws + WS_CHK);
    F.ss2 = (float*)(ws + WS_SS2P); F.ssf = (float*)(ws + WS_SSFP); F.QF = (float*)(ws + WS_QF); F.KF = (float*)(ws + WS_KF); F.L = (float*)(ws + WS_L);
    F.CPRE = (float*)(ws + WS_CPRE); F.NLOC = (float*)(ws + WS_NLOC); F.NPRE = (float*)(ws + WS_NPRE);
    volatile LAS unsigned* MISC = (volatile LAS unsigned*)(F.lds + MISC_OFF);
    if (F.tid < 32) MISC[F.tid] = 0u;
    __syncthreads();
    XcdBarrier bar; bar.bar = (unsigned*)(ws + WS_CTL) + CW_BAR; bar.x = 0; bar.st = nullptr;
    if (!PER_PHASE_LAUNCH) bar = xcd_barrier_post((unsigned*)(ws + WS_CTL) + CW_BAR, MISC + 8);
#ifdef STAMP_SEL
    volatile LAS unsigned long long* stamps = (volatile LAS unsigned long long*)(F.lds + MISC_OFF + 256);
    int n_stamp = 0;
#define STAMP() do { if (blockIdx.x == 0 && F.tid == 0) stamps[n_stamp] = __builtin_amdgcn_s_memrealtime(); ++n_stamp; } while (0)
#else
#define STAMP() do { } while (0)
#endif
    STAMP();
#define GRID_BAR() do { if (!PER_PHASE_LAUNCH) xcd_barrier(bar); STAMP(); } while (0)
#ifdef SUBSTAMPS
#define SUBSTAMP() STAMP()
#else
#define SUBSTAMP() do { } while (0)
#endif
    const int lo = args.ph_lo, hi = args.ph_hi;
#ifndef PHASE_MASK
#define PHASE_MASK 0x3ff
#endif
#define IN(k) (((PHASE_MASK >> (k)) & 1) && lo <= (k) && (k) < hi)
#ifndef DUP_MASK
#define DUP_MASK 0
#endif
#define DUP(k) ((DUP_MASK >> (k)) & 1)
#ifndef HELP_MASK
#define HELP_MASK 0x92
#endif
#define HELP(k) ((HELP_MASK >> (k)) & 1)
    if (IN(0)) { p0_prologue(F); if (DUP(0)) { __syncthreads(); p0_prologue(F); } if (HELP(0)) help_copy(F, 0); GRID_BAR(); }
    if (IN(1)) {
        pg8::Gemm g{F.XB, F.Win_t, M, NPROJ, DM, DM}; pg8::StaticOrder S; S.init(M, NPROJ, F.G, (int)blockIdx.x);
        pg8::EpiIn E{F.PROJ, F.rstd1, F.rope, F.out};
        pg8::gemm_phase<pg8::EpiIn, pg8::StaticOrder, true, true>(F.lds, g, S, E);
        if (DUP(1)) { __syncthreads(); pg8::gemm_phase<pg8::EpiIn, pg8::StaticOrder, true, true>(F.lds, g, S, E); }
        if (HELP(1)) { help_convert(F, 1); help_copy(F, 1, false); }
        GRID_BAR();
    }
#ifndef QUOTA_ATT
#define QUOTA_ATT 0
#endif
#ifndef ANTIPHASE
#define ANTIPHASE 1
#endif
#ifndef SAMPLE_UP_IN_P5
#define SAMPLE_UP_IN_P5 0
#endif
#ifndef ATT_LIM
#define ATT_LIM 600
#endif
    if (IN(2)) {
        if (ANTIPHASE && !((F.vcu >> 1) & 1)) {   Claimer CA{-2}; p2_attn_prompt_mfma(F, ATT_LIM, CA); SUBSTAMP(); __syncthreads(); p2_sample_stream<true>(F); SUBSTAMP(); __syncthreads(); p2_attn_prompt_mfma(F, 1 << 30, CA); __syncthreads(); }
        else { Claimer CA{-2}; p2_sample_stream<true>(F); SUBSTAMP(); __syncthreads(); p2_attn_prompt_mfma(F, 1 << 30, CA); SUBSTAMP(); __syncthreads(); }
    }
    if (IN(3)) { p3_mlstm_local_mfma(F); SUBSTAMP(); p3_mlstm_sample(F); SUBSTAMP(); if (HELP(3)) help_copy(F, 3); GRID_BAR(); }
    if (IN(4)) {
        if (F.G >= 64 && F.vcu >= F.G - 16) {
            pg8::Gemm g{F.MIX, F.Wout_t, M, DM, DM, DM}; pg8::RangeOrder S{MP / 256, MS / 256, DM / 256, 1, 0, 16, F.vcu - (F.G - 16)};
            pg8::EpiOut<true> E{F.xp, F.xs, F.out, F.HPB, F.ss2, F.XB};
            pg8::gemm_phase<pg8::EpiOut<true>, pg8::RangeOrder, true, true>(F.lds, g, S, E);
            if (DUP(4)) { __syncthreads(); pg8::EpiScratch E2{(float*)(F.ws + WS_SCR)}; pg8::gemm_phase<pg8::EpiScratch, pg8::RangeOrder, true, true>(F.lds, g, S, E2); }
        } else { p4_prefix_v1(F); if (DUP(4)) { __syncthreads(); p4_prefix_v1(F); } help_convert(F, -1); }
#ifndef P4_HELPERS
#define P4_HELPERS 256
#endif
        if (HELP(4)) { if (F.vcu < P4_HELPERS) help_copy(F, 4); else help_copy(F, 4, true, true); }
        GRID_BAR();
    }
    if (IN(5)) {
        if (SAMPLE_UP_IN_P5 && F.G == 256) {
            pg8::Gemm g{F.HPB, F.Wup_t, M, FF, DM, DM}; pg8::RangeOrder S{MP / 256, MS / 256, FF / 256, 1, 0, F.G, F.vcu};
            pg8::EpiUp E{F.ACT, F.ss2};
            pg8::gemm_phase<pg8::EpiUp, pg8::RangeOrder, true, true>(F.lds, g, S, E);
            __syncthreads();
        }
        p5_mlstm_out_mfma(F); if (DUP(5)) { __syncthreads(); p5_mlstm_out_mfma(F); } if (HELP(5)) help_copy(F, 5); GRID_BAR(); }
    if (IN(6)) {
        pg8::Gemm g{F.MIX, F.Wout_t, MP, DM, DM, DM}; pg8::StaticOrder S; S.init(MP, DM, F.G, (int)blockIdx.x);
        if (F.G == 256) { pg8::EpiOut<false> E{F.xp, F.xs, F.out, F.HPB, F.ss2, F.XB}; pg8::gemm_phase<pg8::EpiOut<false>, pg8::StaticOrder, true, true>(F.lds, g, S, E); }
        else { pg8::EpiOut<true> E{F.xp, F.xs, F.out, F.HPB, F.ss2, F.XB}; pg8::gemm_phase<pg8::EpiOut<true>, pg8::StaticOrder, true, true>(F.lds, g, S, E); }
        if (DUP(6)) { __syncthreads(); pg8::EpiScratch E2{(float*)(F.ws + WS_SCR)}; pg8::gemm_phase<pg8::EpiScratch, pg8::StaticOrder, true, true>(F.lds, g, S, E2); }
        if (HELP(6)) help_copy(F, 6);
        GRID_BAR();
    }
    if (IN(7)) {
        const int mrows = (SAMPLE_UP_IN_P5 && F.G == 256) ? MP : M;
        pg8::Gemm g{F.HPB, F.Wup_t, mrows, FF, DM, DM}; pg8::StaticOrder S; S.init(mrows, FF, F.G, (int)blockIdx.x);
        pg8::EpiUp E{F.ACT, F.ss2};
        pg8::gemm_phase<pg8::EpiUp, pg8::StaticOrder, true, true>(F.lds, g, S, E);
        if (DUP(7)) { __syncthreads(); pg8::gemm_phase<pg8::EpiUp, pg8::StaticOrder, true, true>(F.lds, g, S, E); }
        if (HELP(7)) help_copy(F, 7);
        GRID_BAR();
    }
    if (IN(8)) {
        {
            pg8::Gemm g{F.ACT, F.Wdn_t, MP, DM, FF, FF}; pg8::StaticOrder S; S.init(MP, DM, F.G, (int)blockIdx.x);
            if (F.G == 256) { pg8::EpiDownNorm E{F.out, F.HPB, F.ssf, (unsigned*)(F.ws + WS_PCNT), F.gf};
                pg8::gemm_phase<pg8::EpiDownNorm, pg8::StaticOrder, true, true>(F.lds, g, S, E); }
            else { pg8::EpiDown<false> E{F.out};
                pg8::gemm_phase<pg8::EpiDown<false>, pg8::StaticOrder, true, true>(F.lds, g, S, E); }
        }
        if (DUP(8)) { __syncthreads(); pg8::Gemm g{F.ACT, F.Wdn_t, MP, DM, FF, FF}; pg8::StaticOrder S; S.init(MP, DM, F.G, (int)blockIdx.x);
            pg8::EpiScratch E{(float*)(F.ws + WS_SCR)}; pg8::gemm_phase<pg8::EpiScratch, pg8::StaticOrder, true, true>(F.lds, g, S, E); }
        if (HELP(8)) help_copy(F, 8);
        GRID_BAR();
    }
    if (DUP(15)) { for (int k = 0; k < 8; ++k) GRID_BAR(); }
    if (IN(9)) {
        {
            pg8::Gemm g{F.ACT, F.Wdn_t, M, DM, 512, FF}; pg8::RangeOrder S{MP / 256, MS / 256, DM / 256, 8, 512, F.G, F.vcu};
            pg8::EpiPartial E{(float*)(F.ws + WS_PART), 512};
            pg8::gemm_phase<pg8::EpiPartial, pg8::RangeOrder, true, true>(F.lds, g, S, E);
        }
        help_copy(F, -1);
        GRID_BAR();
        p9_final_norm(F, (F.G == 256) ? MP : 0); if (DUP(9)) { const int gw = F.vcu * 8 + F.wave, NGW = F.G * 8; for (int m = gw; m < M; m += NGW) { const f32x4* p = (const f32x4*)(F.out + (size_t)m * DM); f32x4* q = (f32x4*)(F.ws + WS_SCR) + (size_t)m * 256; f32x4 v[4]; float ss = 0.f;
#pragma unroll
        for (int j = 0; j < 4; ++j) { v[j] = p[64 * j + F.lane]; ss += v[j].x * v[j].x + v[j].y * v[j].y + v[j].z * v[j].z + v[j].w * v[j].w; }
        ss = wave_sum(ss); const float rs = 1.f / sqrtf(ss * (1.f / DM) + EPS);
#pragma unroll
        for (int j = 0; j < 4; ++j) q[64 * j + F.lane] = v[j] * rs; } } }
    STAMP();
#ifdef STAMP_SEL
    if (blockIdx.x == 0 && F.tid == 0) F.out[O_PM] += (float)(stamps[STAMP_SEL + 1] - stamps[STAMP_SEL]) * 0.01f;
#endif
#undef IN
}

extern "C" void kernel_launch(void* const* d_in, const int* in_sizes, int n_in, void* d_out, int out_size, void* d_ws, size_t ws_size, hipStream_t stream) {
    static int grid = 0;
    if (grid == 0) {
        if (n_in != 19 || (size_t)out_size != O_END || ws_size < WS_END) { fprintf(stderr, "kernel_launch: unexpected shapes (n_in %d out %d ws %zu)\n", n_in, out_size, ws_size); grid = -1; return; }
        int dev = 0, cus = 0, per_cu = 0;
        if (hipGetDevice(&dev) != hipSuccess || hipDeviceGetAttribute(&cus, hipDeviceAttributeMultiprocessorCount, dev) != hipSuccess) { grid = -1; return; }
        if (hipFuncSetAttribute((const void*)fwd, hipFuncAttributeMaxDynamicSharedMemorySize, LDS_BYTES) != hipSuccess) { fprintf(stderr, "kernel_launch: hipFuncSetAttribute failed\n"); grid = -1; return; }
        if (hipOccupancyMaxActiveBlocksPerMultiprocessor(&per_cu, (const void*)fwd, 512, LDS_BYTES) != hipSuccess || per_cu < 1) fprintf(stderr, "kernel_launch: occupancy query says %d\n", per_cu);
        (void)hipGetLastError();
        grid = cus;
    }
    if (grid < 0) return;
    if (hipMemsetAsync((char*)d_ws + WS_CTL, 0, CTL_ZERO_BYTES, stream) != hipSuccess) return;
    Args a{};
    for (int i = 0; i < 19; ++i) a.in[i] = (const float*)d_in[i];
    a.out = (float*)d_out; a.ws = (unsigned char*)d_ws;
#if PER_PHASE_LAUNCH
    for (int ph = 0; ph < NPH; ++ph) { a.ph_lo = ph; a.ph_hi = ph + 1; hipLaunchKernelGGL(fwd, dim3(grid), dim3(512), LDS_BYTES, stream, a); }
#else
    a.ph_lo = 0; a.ph_hi = NPH; hipLaunchKernelGGL(fwd, dim3(grid), dim3(512), LDS_BYTES, stream, a);
#endif
}
```

```cpp
#include <hip/hip_runtime.h>
#include <cstdio>
#include <cstdint>
namespace pg8 {
#define PG8_LAS __attribute__((address_space(3)))
typedef unsigned short bf16_t;
typedef short bf16x8 __attribute__((ext_vector_type(8)));
typedef float f32x4 __attribute__((ext_vector_type(4)));
typedef unsigned u32x4 __attribute__((ext_vector_type(4)));
constexpr int BM = 256, BK = 64, HALF = 128, HTB = HALF * BK * 2  , STAGE_BYTES = 8 * HTB, NXCD = 8, WGM = 8;

__host__ __device__ __forceinline__ int lds_byte(int r, int c) { const int st = (r >> 4) * 2 + (c >> 5), rr = r & 15, cc = c & 31, ob = rr * 64 + cc * 2; return st * 1024 + (ob ^ (((ob >> 9) & 1) << 5)); }
__host__ __device__ __forceinline__ void stage_rc(int b, int& R, int& C) { const int st = b / 1024, sb = b % 1024, swz = sb ^ (((sb >> 9) & 1) << 5); R = (st >> 1) * 16 + swz / 64; C = (st & 1) * 32 + (swz % 64) / 2; }
__host__ __device__ __forceinline__ int perm32(int rho) { const int n = rho >> 4, i = rho & 15; return 8 * (i >> 2) + 4 * n + (i & 3); }

struct Unit { int pm, pn, k0; };
struct Gemm { const bf16_t* A; const bf16_t* Bt; int M, N, K, ld; };

struct StaticOrder {
    int nM, nN, nwg, G, c;
    __host__ __device__ void init(int M, int N, int G_, int c_) { nM = M / BM; nN = N / BM; nwg = nM * nN; G = G_; c = c_; }
    __host__ __device__ bool next(int i, Unit& u) const {
        const long L = (long)i * G + c; if (L >= nwg) return false;
        int wgid = (int)L; { const int q = nwg / NXCD, r = nwg % NXCD, xcd = wgid % NXCD, off = wgid / NXCD; wgid = (xcd < r ? xcd * (q + 1) : r * (q + 1) + (xcd - r) * q) + off; }
        const int nig = WGM * nN, gid = wgid / nig, fm = gid * WGM, gsz = (nM - fm) < WGM ? (nM - fm) : WGM;
        u.pm = fm + ((wgid % nig) % gsz); u.pn = (wgid % nig) / gsz; u.k0 = 0; return true;
    }
    __device__ __forceinline__ void a_ready(const Unit&) const {}
    __device__ __forceinline__ void done(const Unit&) const {}
};

__device__ __forceinline__ unsigned cvt_pk_bf16(float lo, float hi) { unsigned r; asm volatile("v_cvt_pk_bf16_f32 %0, %1, %2" : "=v"(r) : "v"(lo), "v"(hi)); return r; }
typedef float f32x2 __attribute__((ext_vector_type(2)));

template <class Epi, class Sched, bool ALIGN_EPI = false, bool SP2 = false>
__device__ __forceinline__ void gemm_phase(PG8_LAS unsigned char* lds, const Gemm g, const Sched& S, const Epi& E) {
    const int tid = threadIdx.x, wid = __builtin_amdgcn_readfirstlane(tid >> 6), lane = tid & 63, wr = wid >> 2, wc = wid & 3, fr = lane & 15, fq = lane >> 4;
    const int K = g.K, nt = K / BK, LD = g.ld;
    unsigned voffA[2], voffB[2];
#pragma unroll
    for (int i = 0; i < 2; ++i) { int R, C; stage_rc(tid * 16 + i * 8192, R, C); const int Rb = Epi::PERM ? ((R & ~31) + perm32(R & 31)) : R;
        voffA[i] = (unsigned)(R * LD + C) * 2u; voffB[i] = (unsigned)(Rb * LD + C) * 2u; }
    const size_t kstep = (size_t)(BK * 2);
    const size_t hstep = (size_t)HALF * LD * 2;
    const size_t tstep = 2 * hstep;
    const unsigned ldsw = (unsigned)wid * 1024u;
    const int aoff = lds_byte(wr * 64 + fr, fq * 8), boff = lds_byte(wc * 32 + fr, fq * 8);
#define PG8_SA(b, h) (((b) * 2 + (h)) * HTB)
#define PG8_SB(b, h) ((4 + (b) * 2 + (h)) * HTB)
#define PG8_STAGE(bufoff, gbase, voff) do { _Pragma("unroll") for (int _i = 0; _i < 2; ++_i) \
        __builtin_amdgcn_global_load_lds((const unsigned*)((const char*)(gbase) + (voff)[_i]), (PG8_LAS unsigned*)(lds + (bufoff) + ldsw + _i * 8192), 16, 0, 0); } while (0)
#define PG8_LDA(dst, b, h) do { _Pragma("unroll") for (int m = 0; m < 4; ++m) _Pragma("unroll") for (int k = 0; k < 2; ++k) dst[m][k] = *(const PG8_LAS bf16x8*)(lds + PG8_SA(b, h) + aoff + m * 2048 + k * 1024); } while (0)
#define PG8_LDB(dst, b, h) do { _Pragma("unroll") for (int n = 0; n < 2; ++n) _Pragma("unroll") for (int k = 0; k < 2; ++k) dst[n][k] = *(const PG8_LAS bf16x8*)(lds + PG8_SB(b, h) + boff + n * 2048 + k * 1024); } while (0)
#define PG8_MMA(ai, bj, At, Bt) do { __builtin_amdgcn_s_setprio(1); _Pragma("unroll") for (int m = 0; m < 4; ++m) _Pragma("unroll") for (int n = 0; n < 2; ++n) _Pragma("unroll") for (int k = 0; k < 2; ++k) \
        acc[ai][bj][m][n] = __builtin_amdgcn_mfma_f32_16x16x32_bf16(Bt[n][k], At[m][k], acc[ai][bj][m][n], 0, 0, 0); __builtin_amdgcn_s_setprio(0); } while (0)
#define PG8_WAIT_V(n) asm volatile("s_waitcnt vmcnt(" #n ")" ::: "memory")
#define PG8_WAIT_L(n) asm volatile("s_waitcnt lgkmcnt(" #n ")" ::: "memory")
#define PG8_BAR __builtin_amdgcn_s_barrier()
#define PG8_SCHED __builtin_amdgcn_sched_barrier(0)
    Unit cur, nxt; int ui = 0;
    if (!S.next(0, cur)) return;
    f32x4 acc[2][2][4][2];
#pragma unroll
    for (int a = 0; a < 2; ++a)
#pragma unroll
        for (int b = 0; b < 2; ++b)
#pragma unroll
            for (int m = 0; m < 4; ++m)
#pragma unroll
                for (int n = 0; n < 2; ++n) acc[a][b][m][n] = (f32x4){0.f, 0.f, 0.f, 0.f};
    bf16x8 At[4][2], B0[2][2], B1[2][2];
    const char* cA = (const char*)g.A + (size_t)cur.pm * tstep + (size_t)cur.k0 * 2; const char* cB = (const char*)g.Bt + (size_t)cur.pn * tstep + (size_t)cur.k0 * 2;
    S.a_ready(cur);
    if constexpr (SP2) {
        PG8_STAGE(PG8_SB(0, 0), cB, voffB); PG8_STAGE(PG8_SB(0, 1), cB + hstep, voffB); PG8_STAGE(PG8_SA(0, 0), cA, voffA); PG8_STAGE(PG8_SA(0, 1), cA + hstep, voffA);
        if (wr == 1) PG8_BAR;
        PG8_WAIT_V(2); PG8_BAR;
        PG8_STAGE(PG8_SB(1, 0), cB + kstep, voffB); PG8_STAGE(PG8_SA(1, 0), cA + kstep, voffA); PG8_STAGE(PG8_SB(1, 1), cB + hstep + kstep, voffB);
        PG8_WAIT_V(6); PG8_BAR;
    } else {
        PG8_STAGE(PG8_SB(0, 0), cB, voffB); PG8_STAGE(PG8_SA(0, 0), cA, voffA); PG8_STAGE(PG8_SB(0, 1), cB + hstep, voffB); PG8_STAGE(PG8_SA(0, 1), cA + hstep, voffA);
        if (wr == 1) PG8_BAR;
        PG8_WAIT_V(4); PG8_BAR;
        PG8_STAGE(PG8_SB(1, 0), cB + kstep, voffB); PG8_STAGE(PG8_SA(1, 0), cA + kstep, voffA); PG8_STAGE(PG8_SB(1, 1), cB + hstep + kstep, voffB);
        PG8_WAIT_V(6); PG8_BAR;
    }
    for (;;) {
        const bool has_next = S.next(ui + 1, nxt);
        const char* nA = has_next ? (const char*)g.A + (size_t)nxt.pm * tstep + (size_t)nxt.k0 * 2 : cA; const char* nB = has_next ? (const char*)g.Bt + (size_t)nxt.pn * tstep + (size_t)nxt.k0 * 2 : cB;
        for (int t = 0; t < nt; t += 2) {
            const bool last = (t == nt - 2);
            const char* a1 = cA + (size_t)(t + 1) * kstep;
            const char* a2 = last ? nA : cA + (size_t)(t + 2) * kstep; const char* b2 = last ? nB : cB + (size_t)(t + 2) * kstep;
            const char* a3 = a2 + kstep; const char* b3 = b2 + kstep;
            if (last && has_next) S.a_ready(nxt);
            if constexpr (SP2) {
            PG8_LDB(B0, 0, 0); PG8_LDB(B1, 0, 1); PG8_SCHED; PG8_LDA(At, 0, 0); PG8_STAGE(PG8_SA(1, 1), a1 + hstep, voffA);
            PG8_WAIT_V(8); PG8_WAIT_L(0); PG8_BAR; PG8_MMA(0, 0, At, B0); PG8_MMA(0, 1, At, B1); PG8_BAR; PG8_SCHED;
            PG8_LDA(At, 0, 1); PG8_STAGE(PG8_SB(0, 0), b2, voffB); PG8_STAGE(PG8_SB(0, 1), b2 + hstep, voffB); PG8_STAGE(PG8_SA(0, 0), a2, voffA);
            PG8_WAIT_V(8); PG8_WAIT_L(0); PG8_BAR; PG8_MMA(1, 0, At, B0); PG8_MMA(1, 1, At, B1); PG8_BAR; PG8_SCHED;
            PG8_LDB(B0, 1, 0); PG8_LDB(B1, 1, 1); PG8_SCHED; PG8_LDA(At, 1, 0); PG8_STAGE(PG8_SA(0, 1), a2 + hstep, voffA);
            PG8_WAIT_V(8); PG8_WAIT_L(0); PG8_BAR; PG8_MMA(0, 0, At, B0); PG8_MMA(0, 1, At, B1); PG8_BAR; PG8_SCHED;
            PG8_LDA(At, 1, 1); PG8_STAGE(PG8_SB(1, 0), b3, voffB); PG8_STAGE(PG8_SB(1, 1), b3 + hstep, voffB); PG8_STAGE(PG8_SA(1, 0), a3, voffA);
            PG8_WAIT_V(8); PG8_WAIT_L(0); PG8_BAR; PG8_MMA(1, 0, At, B0); PG8_MMA(1, 1, At, B1); PG8_BAR; PG8_SCHED;
            } else {
            PG8_LDB(B0, 0, 0); PG8_SCHED; PG8_LDA(At, 0, 0); PG8_STAGE(PG8_SA(1, 1), a1 + hstep, voffA);
            PG8_WAIT_L(8); PG8_BAR; PG8_WAIT_L(0); PG8_MMA(0, 0, At, B0); PG8_BAR; PG8_SCHED;
            PG8_LDB(B1, 0, 1); PG8_STAGE(PG8_SB(0, 0), b2, voffB);
            PG8_BAR; PG8_WAIT_L(0); PG8_MMA(0, 1, At, B1); PG8_BAR;
            PG8_LDA(At, 0, 1); PG8_STAGE(PG8_SA(0, 0), a2, voffA);
            PG8_BAR; PG8_WAIT_L(0); PG8_MMA(1, 0, At, B0); PG8_BAR; PG8_SCHED;
            PG8_STAGE(PG8_SB(0, 1), b2 + hstep, voffB);
            PG8_WAIT_V(6); PG8_BAR; PG8_MMA(1, 1, At, B1); PG8_BAR;
            PG8_LDB(B0, 1, 0); PG8_SCHED; PG8_LDA(At, 1, 0); PG8_STAGE(PG8_SA(0, 1), a2 + hstep, voffA);
            PG8_WAIT_L(8); PG8_BAR; PG8_WAIT_L(0); PG8_MMA(0, 0, At, B0); PG8_BAR; PG8_SCHED;
            PG8_LDB(B1, 1, 1); PG8_STAGE(PG8_SB(1, 0), b3, voffB);
            PG8_BAR; PG8_WAIT_L(0); PG8_MMA(0, 1, At, B1); PG8_BAR;
            PG8_LDA(At, 1, 1); PG8_STAGE(PG8_SA(1, 0), a3, voffA);
            PG8_BAR; PG8_WAIT_L(0); PG8_MMA(1, 0, At, B0); PG8_BAR; PG8_SCHED;
            PG8_STAGE(PG8_SB(1, 1), b3 + hstep, voffB);
            PG8_WAIT_V(6); PG8_BAR; PG8_MMA(1, 1, At, B1); PG8_BAR;
            }
        }
        if constexpr (ALIGN_EPI) { if (wr == 0) PG8_BAR; }
        if constexpr (!Epi::AFTER_DRAIN) { E(acc, cur, wr, wc, fr, fq); S.done(cur); }
        if (!has_next) break;
#pragma unroll
        for (int a = 0; a < 2; ++a)
#pragma unroll
            for (int b = 0; b < 2; ++b)
#pragma unroll
                for (int m = 0; m < 4; ++m)
#pragma unroll
                    for (int n = 0; n < 2; ++n) acc[a][b][m][n] = (f32x4){0.f, 0.f, 0.f, 0.f};
        cur = nxt; cA = nA; cB = nB; ++ui;
        if constexpr (ALIGN_EPI) { if (wr == 1) PG8_BAR; }
    }
    PG8_WAIT_V(0);
    if constexpr (!ALIGN_EPI) { if (wr == 0) PG8_BAR; }
    PG8_BAR;
    if constexpr (Epi::AFTER_DRAIN) { E.fused(acc, cur, wr, wc, fr, fq, lds, wid, lane); S.done(cur); }
#undef PG8_SA
#undef PG8_SB
#undef PG8_STAGE
#undef PG8_LDA
#undef PG8_LDB
#undef PG8_MMA
#undef PG8_WAIT_V
#undef PG8_WAIT_L
#undef PG8_BAR
#undef PG8_SCHED
}
}

#ifndef PER_PHASE_LAUNCH
#define PER_PHASE_LAUNCH 0
#endif

constexpr int DM = 1024, NBP = 4, SEQ = 4096, DBS = 128, DTS = 8;
constexpr int MP = NBP * SEQ, MS = DBS * DTS, M = MP + MS;
constexpr int NPROJ = 3584, INCOLS = 3592, FF = 4096, WBUF = 2048;
constexpr int C_Q = 0, C_K = 512, C_V = 1024, C_RAW = 1536, C_VB = 2560, C_OB = 3072;
constexpr float EPS = 1e-6f;
constexpr int NPH = 10;
constexpr size_t O_YP = 0, O_YS = O_YP + (size_t)MP * DM, O_PK = O_YS + (size_t)MS * DM, O_PV = O_PK + (size_t)NBP * WBUF * 512,
    O_PCONV = O_PV + (size_t)NBP * WBUF * 512, O_PC = O_PCONV + (size_t)NBP * 3 * 1024, O_PN = O_PC + (size_t)NBP * 4 * 128 * 128, O_PM = O_PN + (size_t)NBP * 4 * 128,
    O_SK = O_PM + (size_t)NBP * 4, O_SV = O_SK + (size_t)DBS * WBUF * 512, O_SCONV = O_SV + (size_t)DBS * WBUF * 512, O_SC = O_SCONV + (size_t)DBS * 3 * 1024,
    O_SN = O_SC + (size_t)DBS * 4 * 128 * 128, O_SM = O_SN + (size_t)DBS * 4 * 128, O_END = O_SM + (size_t)DBS * 4;
static_assert(O_END == 303774224ull, "output size");
constexpr size_t MiB = 1u << 20;
constexpr size_t WS_CTL = 0, CTL_ZERO_BYTES = 192 * 1024;
constexpr int CW_BAR = 4096;
constexpr size_t WS_CLAIM = 32 * 1024, WS_CPY = 64 * 1024, WS_PCNT = 128 * 1024, WS_SS2 = 256 * 1024, WS_SSF = 512 * 1024;
constexpr size_t WS_WIN = 2 * MiB, WS_WOUT = 10 * MiB, WS_WUP = 12 * MiB, WS_WDN = 20 * MiB;
constexpr size_t WS_ROPE = 28 * MiB, WS_RSTD1 = 29 * MiB, WS_IG = 29 * MiB + 512 * 1024, WS_LF = 30 * MiB, WS_CHK = 31 * MiB;
constexpr size_t WS_XB = 32 * MiB, WS_PROJ = 68 * MiB, WS_MIX = 188 * MiB, WS_HPB = 222 * MiB, WS_ACT = 256 * MiB;
constexpr size_t WS_QF = 392 * MiB, WS_KF = 426 * MiB, WS_L = 460 * MiB, WS_CPRE = 492 * MiB, WS_NLOC = 524 * MiB, WS_NPRE = 525 * MiB, WS_DUMMY = 526 * MiB, WS_SCR = 544 * MiB, WS_PART = 616 * MiB, WS_SS2P = 648 * MiB, WS_SSFP = 650 * MiB, WS_END = 651 * MiB;
static_assert(WS_PROJ + (size_t)M * NPROJ * 2 <= WS_MIX && WS_ACT + (size_t)M * FF * 2 <= WS_QF && WS_XB + (size_t)M * DM * 2 <= WS_PROJ, "ws map");

constexpr int LDS_BYTES = 147456;
constexpr int MISC_OFF = 131072 + 8192;

#define GAS __attribute__((address_space(1)))
#define LAS __attribute__((address_space(3)))
typedef unsigned short bf16;
typedef unsigned v4u __attribute__((ext_vector_type(4)));
typedef unsigned v2u __attribute__((ext_vector_type(2)));
typedef float f32x4 __attribute__((ext_vector_type(4)));
typedef GAS unsigned gu32;
#define LDS_WAIT() asm volatile("s_waitcnt lgkmcnt(0)" ::: "memory")
__device__ __forceinline__ unsigned f2bf(float f) { unsigned u = __builtin_bit_cast(unsigned, f); return (u + 0x7fffu + ((u >> 16) & 1u)) >> 16; }
typedef float f32x2_t __attribute__((ext_vector_type(2))); typedef __bf16 bf16x2_t __attribute__((ext_vector_type(2)));
__device__ __forceinline__ unsigned pk2(float lo, float hi) { f32x2_t v = {lo, hi}; bf16x2_t b = __builtin_convertvector(v, bf16x2_t); return __builtin_bit_cast(unsigned, b); }
__device__ __forceinline__ float bf2f(unsigned short u) { return __builtin_bit_cast(float, (unsigned)u << 16); }
__device__ __forceinline__ float bflo(unsigned u) { return __builtin_bit_cast(float, u << 16); }
__device__ __forceinline__ float bfhi(unsigned u) { return __builtin_bit_cast(float, u & 0xffff0000u); }
__device__ __forceinline__ float wave_sum(float v) {
#pragma unroll
    for (int o = 1; o < 64; o <<= 1) v += __shfl_xor(v, o);
    return v;
}
__device__ __forceinline__ float wave_max(float v) {
#pragma unroll
    for (int o = 1; o < 64; o <<= 1) v = fmaxf(v, __shfl_xor(v, o));
    return v;
}
__device__ __forceinline__ int opaque(int v) { asm volatile("" : "+v"(v)); return v; }
__device__ __forceinline__ float sigmoidf_(float x) { return __builtin_amdgcn_rcpf(1.f + __expf(-x)); }

#define XB_TMO      128
#define XB_XCNT(j)  (256  + 64 * (j))
#define XB_XSUB(j)  (1280 + 64 * (j))
#define XB_XGEN(j)  (2304 + 64 * (j))
#define XB_TOP      3328
#define XB_TOPGEN   3392
#define XCD_BAR_WORDS 3456
#define XB_SPIN_CAP (1u << 18)
__device__ __forceinline__ unsigned xb_ld(unsigned* p)              { return __hip_atomic_load(p, __ATOMIC_RELAXED, __HIP_MEMORY_SCOPE_AGENT); }
__device__ __forceinline__ unsigned xb_add(unsigned* p, unsigned v) { return __hip_atomic_fetch_add(p, v, __ATOMIC_RELAXED, __HIP_MEMORY_SCOPE_AGENT); }
__device__ __forceinline__ unsigned xb_xcc_id() { return (unsigned)__builtin_amdgcn_s_getreg((3 << 11) | 20) & 0xFu; }
#define XB_SPIN(cond, bar) do { unsigned _sp = 0; while (cond) { __builtin_amdgcn_s_sleep(1); \
    if ((++_sp & 255u) == 0u) { if (xb_ld(&(bar)[XB_TMO])) break; if (_sp > XB_SPIN_CAP) { atomicAdd(&(bar)[XB_TMO], 1u); break; } } } } while (0)
struct XcdBarrier { unsigned* bar; unsigned x; volatile LAS unsigned* st; };
__device__ __forceinline__ XcdBarrier xcd_barrier_post(unsigned* bar, volatile LAS unsigned* st) {
    XcdBarrier b; b.bar = bar; b.x = xb_xcc_id(); b.st = st;
    if (threadIdx.x == 0) (void)xb_add(&bar[XB_XCNT(b.x)], 1u);
    return b;
}
__device__ __forceinline__ void xcd_barrier_complete(unsigned* bar, unsigned x, unsigned& nloc, unsigned& nx) {
    const unsigned G = gridDim.x * gridDim.y * gridDim.z;
    unsigned sum, cnt, mine, sp = 0u;
    for (;;) {
        sum = 0u; cnt = 0u; mine = 0u;
#pragma unroll
        for (unsigned j = 0; j < 16; ++j) { const unsigned c = xb_ld(&bar[XB_XCNT(j)]); sum += c; cnt += (c > 0u) ? 1u : 0u; mine = (j == x) ? c : mine; }
        if (sum == G) break;
        __builtin_amdgcn_s_sleep(1);
        if ((++sp & 255u) == 0u) { if (xb_ld(&bar[XB_TMO])) break; if (sp > XB_SPIN_CAP) { atomicAdd(&bar[XB_TMO], 1u); break; } }
    }
    nloc = mine > 0u ? mine : 1u; nx = cnt > 0u ? cnt : 1u;
}
__device__ __forceinline__ void xcd_barrier(const XcdBarrier& b) {
    asm volatile("s_waitcnt vmcnt(0)" ::: "memory");
    __syncthreads();
    if (threadIdx.x == 0) {
        unsigned* bar = b.bar;
        __builtin_amdgcn_s_waitcnt(0);
        unsigned nloc = b.st[0], nx = b.st[1];
        if (nloc == 0u) { xcd_barrier_complete(bar, b.x, nloc, nx); b.st[0] = nloc; b.st[1] = nx; }
        const unsigned old = xb_add(&bar[XB_XSUB(b.x)], 1u);
        const unsigned gen = old / nloc;
        if (old + 1u == (gen + 1u) * nloc) {
            __builtin_amdgcn_fence(__ATOMIC_RELEASE, "agent");
            asm volatile("s_waitcnt vmcnt(0)" ::: "memory");
            const unsigned og = xb_add(&bar[XB_TOP], 1u);
            const unsigned tg = og / nx;
            if (og + 1u == (tg + 1u) * nx) xb_add(&bar[XB_TOPGEN], 1u);
            else XB_SPIN(xb_ld(&bar[XB_TOPGEN]) == tg, bar);
            __builtin_amdgcn_fence(__ATOMIC_ACQUIRE, "agent");
            xb_add(&bar[XB_XGEN(b.x)], 1u);
            asm volatile("s_waitcnt vmcnt(0)" ::: "memory");
        } else {
            XB_SPIN(xb_ld(&bar[XB_XGEN(b.x)]) == gen, bar);
            __builtin_amdgcn_fence(__ATOMIC_ACQUIRE, "agent");
            asm volatile("s_waitcnt vmcnt(0)" ::: "memory");
        }
    }
    __syncthreads();
}

struct Frame {
    LAS unsigned char* lds;
    int tid, lane, wave, vcu, G;
    const float *xp, *xs, *cache_k, *cache_v, *st_conv, *st_C, *st_n, *st_m, *g1, *w_in, *b_gate, *w_conv, *b_conv, *mhg, *w_out, *g2, *w_up, *w_down, *gf;
    float* out; unsigned char* ws;
    bf16 *Win_t, *Wout_t, *Wup_t, *Wdn_t, *XB, *PROJ, *MIX, *HPB, *ACT;
    float *rope, *rstd1, *ig, *lf, *chk, *ss2, *ssf, *QF, *KF, *L, *CPRE, *NLOC, *NPRE;
};

namespace pg8 {
struct EpiIn {
    static constexpr bool PERM = true, AFTER_DRAIN = false;
    bf16_t* proj; const float* rstd; const float* rope; float* out;
    __device__ __forceinline__ void operator()(const f32x4 (&acc)[2][2][4][2], const Unit& u, int wr, int wc, int fr, int fq) const {
        const int pn = u.pn;
        const bool rot = (pn < 4) && ((wc & 1) == 0);
#pragma unroll
        for (int ai = 0; ai < 2; ++ai)
#pragma unroll
            for (int m = 0; m < 4; ++m) {
                const int row = u.pm * BM + ai * HALF + wr * 64 + m * 16 + fr;
                const float rs = rstd[row];
                const bool smp = row >= MP;
                const int b = smp ? ((row - MP) >> 3) : (row >> 12), t = smp ? ((row - MP) & 7) : (row & 4095);
                const int pidx = smp ? (SEQ + t) : t;
#pragma unroll
                for (int bj = 0; bj < 2; ++bj) {
                    const int col0 = pn * BM + bj * HALF + wc * 32 + 8 * fq;
                    f32x4 v0 = acc[ai][bj][m][0] * rs, v1 = acc[ai][bj][m][1] * rs;
                    if (rot) {
                        f32x4 p0, p1;
                        p0.x = __shfl_xor(v0.x, 16); p0.y = __shfl_xor(v0.y, 16); p0.z = __shfl_xor(v0.z, 16); p0.w = __shfl_xor(v0.w, 16);
                        p1.x = __shfl_xor(v1.x, 16); p1.y = __shfl_xor(v1.y, 16); p1.z = __shfl_xor(v1.z, 16); p1.w = __shfl_xor(v1.w, 16);
                        if (fq < 2) {
                            const f32x4 c0 = *(const f32x4*)(rope + pidx * 16), c1 = *(const f32x4*)(rope + pidx * 16 + 4);
                            const f32x4 s0 = *(const f32x4*)(rope + pidx * 16 + 8), s1 = *(const f32x4*)(rope + pidx * 16 + 12);
                            if (fq == 0) { v0 = v0 * c0 - p0 * s0; v1 = v1 * c1 - p1 * s1; }
                            else         { v0 = v0 * c0 + p0 * s0; v1 = v1 * c1 + p1 * s1; }
                        }
                    }
                    if (pn < 2) { v0 = v0 * 0.125f; v1 = v1 * 0.125f; }
                    u32x4 w; w.x = cvt_pk_bf16(v0[0], v0[1]); w.y = cvt_pk_bf16(v0[2], v0[3]); w.z = cvt_pk_bf16(v1[0], v1[1]); w.w = cvt_pk_bf16(v1[2], v1[3]);
                    *(u32x4*)(proj + (size_t)row * NPROJ + col0) = w;
                    if (pn >= 2 && pn < 6) {
                        const bool isk = pn < 4; const int cc = col0 - (isk ? C_K : C_V);
                        float* dst = nullptr;
                        if (smp) dst = out + (isk ? O_SK : O_SV) + ((size_t)b * WBUF + (WBUF - DTS) + t) * 512 + cc;
                        else if (t >= SEQ - WBUF) dst = out + (isk ? O_PK : O_PV) + ((size_t)b * WBUF + (t - (SEQ - WBUF))) * 512 + cc;
                        if (dst) { __builtin_nontemporal_store(v0, (f32x4*)dst); __builtin_nontemporal_store(v1, (f32x4*)(dst + 4)); }
                    } else if (pn >= 6 && pn < 10) {
                        const int cc = col0 - C_RAW;
                        float* dst = nullptr;
                        if (smp) { if (t >= DTS - 3) dst = out + O_SCONV + ((size_t)b * 3 + (t - (DTS - 3))) * 1024 + cc; }
                        else if (t >= SEQ - 3) dst = out + O_PCONV + ((size_t)b * 3 + (t - (SEQ - 3))) * 1024 + cc;
                        if (dst) { __builtin_nontemporal_store(v0, (f32x4*)dst); __builtin_nontemporal_store(v1, (f32x4*)(dst + 4)); }
                    }
                }
            }
    }
};
template <bool F32OUT> struct EpiOut {
    static constexpr bool PERM = true, AFTER_DRAIN = false;
    const float* xp; const float* xs; float* hp; bf16_t* hpb; float* ss; const bf16_t* xb;
    __device__ __forceinline__ void operator()(const f32x4 (&acc)[2][2][4][2], const Unit& u, int wr, int wc, int fr, int fq) const {
#pragma unroll
        for (int ai = 0; ai < 2; ++ai)
#pragma unroll
            for (int m = 0; m < 4; ++m) {
                const int row = u.pm * BM + ai * HALF + wr * 64 + m * 16 + fr;
                const float* xr = (row < MP) ? xp + (size_t)row * DM : xs + (size_t)(row - MP) * DM;
                float s = 0.f;
#pragma unroll
                for (int bj = 0; bj < 2; ++bj) {
                    const int col0 = u.pn * BM + bj * HALF + wc * 32 + 8 * fq;
                    f32x4 r0, r1;
                    if (F32OUT) { r0 = *(const f32x4*)(xr + col0); r1 = *(const f32x4*)(xr + col0 + 4); }
                    else { const u32x4 xw = *(const u32x4*)(xb + (size_t)row * DM + col0);
                        r0 = (f32x4){__builtin_bit_cast(float, xw.x << 16), __builtin_bit_cast(float, xw.x & 0xffff0000u), __builtin_bit_cast(float, xw.y << 16), __builtin_bit_cast(float, xw.y & 0xffff0000u)};
                        r1 = (f32x4){__builtin_bit_cast(float, xw.z << 16), __builtin_bit_cast(float, xw.z & 0xffff0000u), __builtin_bit_cast(float, xw.w << 16), __builtin_bit_cast(float, xw.w & 0xffff0000u)}; }
                    const f32x4 v0 = acc[ai][bj][m][0] + r0, v1 = acc[ai][bj][m][1] + r1;
                    if (F32OUT) { *(f32x4*)(hp + (size_t)row * DM + col0) = v0; *(f32x4*)(hp + (size_t)row * DM + col0 + 4) = v1; }
                    u32x4 w; w.x = cvt_pk_bf16(v0[0], v0[1]); w.y = cvt_pk_bf16(v0[2], v0[3]); w.z = cvt_pk_bf16(v1[0], v1[1]); w.w = cvt_pk_bf16(v1[2], v1[3]);
                    *(u32x4*)(hpb + (size_t)row * DM + col0) = w;
                    s += (v0[0] * v0[0] + v0[1] * v0[1]) + (v0[2] * v0[2] + v0[3] * v0[3]) + (v1[0] * v1[0] + v1[1] * v1[1]) + (v1[2] * v1[2] + v1[3] * v1[3]);
                }
                s += __shfl_xor(s, 16); s += __shfl_xor(s, 32);
                if (fq == 0) ss[(size_t)row * 16 + u.pn * 4 + wc] = s;
            }
    }
};
struct EpiUp {
    static constexpr bool PERM = true, AFTER_DRAIN = false;
    bf16_t* act; const float* ss;
    __device__ __forceinline__ void operator()(const f32x4 (&acc)[2][2][4][2], const Unit& u, int wr, int wc, int fr, int fq) const {
#pragma unroll
        for (int ai = 0; ai < 2; ++ai)
#pragma unroll
            for (int m = 0; m < 4; ++m) {
                const int row = u.pm * BM + ai * HALF + wr * 64 + m * 16 + fr;
                const f32x4* sp = (const f32x4*)(ss + (size_t)row * 16); const f32x4 t4 = (sp[0] + sp[1]) + (sp[2] + sp[3]);
                const float rs = 1.f / sqrtf(((t4.x + t4.y) + (t4.z + t4.w)) * (1.f / DM) + EPS);
#pragma unroll
                for (int bj = 0; bj < 2; ++bj) {
                    const int col0 = u.pn * BM + bj * HALF + wc * 32 + 8 * fq;
                    f32x4 v0 = acc[ai][bj][m][0] * rs, v1 = acc[ai][bj][m][1] * rs;
#pragma unroll
                    for (int e = 0; e < 4; ++e) { const float a = fmaxf(v0[e], 0.f), c = fmaxf(v1[e], 0.f); v0[e] = a * a; v1[e] = c * c; }
                    u32x4 w; w.x = cvt_pk_bf16(v0[0], v0[1]); w.y = cvt_pk_bf16(v0[2], v0[3]); w.z = cvt_pk_bf16(v1[0], v1[1]); w.w = cvt_pk_bf16(v1[2], v1[3]);
                    *(u32x4*)(act + (size_t)row * FF + col0) = w;
                }
            }
    }
};
struct RangeOrder {
    int base_pm, nM, nN, nks, klen, G, c;
    __device__ bool next(int i, Unit& u) const {
        if (c < 0) return false;
        const int L = i * G + c; if (L >= nM * nN * nks) return false;
        u.k0 = (L % nks) * klen; u.pn = (L / nks) % nN; u.pm = base_pm + L / (nks * nN); return true;
    }
    __device__ __forceinline__ void a_ready(const Unit&) const {}
    __device__ __forceinline__ void done(const Unit&) const {}
};
template <bool ATOMIC> struct EpiDown {
    static constexpr bool PERM = true, AFTER_DRAIN = false;
    float* hp;
    __device__ __forceinline__ void operator()(const f32x4 (&acc)[2][2][4][2], const Unit& u, int wr, int wc, int fr, int fq) const {
#pragma unroll
        for (int ai = 0; ai < 2; ++ai)
#pragma unroll
            for (int m = 0; m < 4; ++m) {
                const int row = u.pm * BM + ai * HALF + wr * 64 + m * 16 + fr;
#pragma unroll
                for (int bj = 0; bj < 2; ++bj) {
                    const int col0 = u.pn * BM + bj * HALF + wc * 32 + 8 * fq;
                    float* p = hp + (size_t)row * DM + col0;
                    if (ATOMIC) {
#pragma unroll
                        for (int e = 0; e < 4; ++e) { atomicAdd(p + e, acc[ai][bj][m][0][e]); atomicAdd(p + 4 + e, acc[ai][bj][m][1][e]); }
                    } else {
                        const f32x4 v0 = acc[ai][bj][m][0] + *(const f32x4*)p, v1 = acc[ai][bj][m][1] + *(const f32x4*)(p + 4);
                        *(f32x4*)p = v0; *(f32x4*)(p + 4) = v1;
                    }
                }
            }
    }
};
struct EpiDownNorm {
    static constexpr bool PERM = true, AFTER_DRAIN = true;
    float* hp; const bf16_t* hpb; float* ssp; unsigned* cnt; const float* gf;
    __device__ __forceinline__ void operator()(const f32x4 (&)[2][2][4][2], const Unit&, int, int, int, int) const {}
    __device__ __forceinline__ void fused(f32x4 (&acc)[2][2][4][2], const Unit& u, int wr, int wc, int fr, int fq, PG8_LAS unsigned char* lds, int, int) const {
        PG8_LAS float* part = (PG8_LAS float*)lds;
        PG8_LAS float* rstd = part + 1024;
#pragma unroll
        for (int ai = 0; ai < 2; ++ai)
#pragma unroll
            for (int m = 0; m < 4; ++m) {
                const int rl = ai * HALF + wr * 64 + m * 16 + fr, row = u.pm * BM + rl;
                float s = 0.f;
#pragma unroll
                for (int bj = 0; bj < 2; ++bj) {
                    const u32x4 hw = *(const u32x4*)(hpb + (size_t)row * DM + u.pn * BM + bj * HALF + wc * 32 + 8 * fq);
                    const f32x4 h0 = {__builtin_bit_cast(float, hw.x << 16), __builtin_bit_cast(float, hw.x & 0xffff0000u), __builtin_bit_cast(float, hw.y << 16), __builtin_bit_cast(float, hw.y & 0xffff0000u)};
                    const f32x4 h1 = {__builtin_bit_cast(float, hw.z << 16), __builtin_bit_cast(float, hw.z & 0xffff0000u), __builtin_bit_cast(float, hw.w << 16), __builtin_bit_cast(float, hw.w & 0xffff0000u)};
                    const f32x4 v0 = acc[ai][bj][m][0] + h0, v1 = acc[ai][bj][m][1] + h1;
                    acc[ai][bj][m][0] = v0; acc[ai][bj][m][1] = v1;
                    s += (v0[0] * v0[0] + v0[1] * v0[1]) + (v0[2] * v0[2] + v0[3] * v0[3]) + (v1[0] * v1[0] + v1[1] * v1[1]) + (v1[2] * v1[2] + v1[3] * v1[3]);
                }
                s += __shfl_xor(s, 16); s += __shfl_xor(s, 32);
                if (fq == 0) part[rl * 4 + wc] = s;
            }
        __syncthreads();
        if (threadIdx.x < 256) { const PG8_LAS f32x4* pp = (const PG8_LAS f32x4*)(part + threadIdx.x * 4); const f32x4 t = *pp;
            __hip_atomic_store((unsigned*)(ssp + ((size_t)u.pm * BM + threadIdx.x) * 4 + u.pn), __builtin_bit_cast(unsigned, (t.x + t.y) + (t.z + t.w)), __ATOMIC_RELAXED, __HIP_MEMORY_SCOPE_AGENT); }
        asm volatile("s_waitcnt vmcnt(0)" ::: "memory");
        __syncthreads();
        if (threadIdx.x == 0) {
            unsigned* c = cnt + 64 * u.pm;
            __hip_atomic_fetch_add(c, 1u, __ATOMIC_RELAXED, __HIP_MEMORY_SCOPE_AGENT);
            unsigned sp = 0;
            while (__hip_atomic_load(c, __ATOMIC_RELAXED, __HIP_MEMORY_SCOPE_AGENT) < 4u) { __builtin_amdgcn_s_sleep(1); if (++sp > (1u << 22)) break; }
        }
        __syncthreads();
        if (threadIdx.x < 256) { const unsigned* q = (const unsigned*)(ssp + ((size_t)u.pm * BM + threadIdx.x) * 4); float tot = 0.f;
#pragma unroll
            for (int k = 0; k < 4; ++k) tot += __builtin_bit_cast(float, __hip_atomic_load(q + k, __ATOMIC_RELAXED, __HIP_MEMORY_SCOPE_AGENT));
            rstd[threadIdx.x] = 1.f / sqrtf(tot * (1.f / DM) + EPS); }
        __syncthreads();
#pragma unroll
        for (int ai = 0; ai < 2; ++ai)
#pragma unroll
            for (int m = 0; m < 4; ++m) {
                const int rl = ai * HALF + wr * 64 + m * 16 + fr, row = u.pm * BM + rl;
                const float rs = rstd[rl];
#pragma unroll
                for (int bj = 0; bj < 2; ++bj) {
                    const int col0 = u.pn * BM + bj * HALF + wc * 32 + 8 * fq;
                    float* p = hp + (size_t)row * DM + col0;
                    const f32x4 g0 = *(const f32x4*)(gf + col0), g1 = *(const f32x4*)(gf + col0 + 4);
                    const f32x4 v0 = acc[ai][bj][m][0] * rs * g0, v1 = acc[ai][bj][m][1] * rs * g1;
                    __builtin_nontemporal_store(v0, (f32x4*)p); __builtin_nontemporal_store(v1, (f32x4*)(p + 4));
                }
            }
    }
};
struct EpiPartial {
    static constexpr bool PERM = true, AFTER_DRAIN = false;
    float* part; int klen;
    __device__ __forceinline__ void operator()(const f32x4 (&acc)[2][2][4][2], const Unit& u, int wr, int wc, int fr, int fq) const {
        float* slab = part + (size_t)(u.k0 / klen) * MS * DM;
#pragma unroll
        for (int ai = 0; ai < 2; ++ai)
#pragma unroll
            for (int m = 0; m < 4; ++m) { const int row = u.pm * BM + ai * HALF + wr * 64 + m * 16 + fr - MP;
#pragma unroll
                for (int bj = 0; bj < 2; ++bj) { float* p = slab + (size_t)row * DM + u.pn * BM + bj * HALF + wc * 32 + 8 * fq;
                    *(f32x4*)p = acc[ai][bj][m][0]; *(f32x4*)(p + 4) = acc[ai][bj][m][1]; } }
    }
};
struct EpiScratch {
    static constexpr bool PERM = true, AFTER_DRAIN = false;
    float* dst;
    __device__ __forceinline__ void operator()(const f32x4 (&acc)[2][2][4][2], const Unit& u, int wr, int wc, int fr, int fq) const {
#pragma unroll
        for (int ai = 0; ai < 2; ++ai)
#pragma unroll
            for (int m = 0; m < 4; ++m) { const int row = u.pm * BM + ai * HALF + wr * 64 + m * 16 + fr;
#pragma unroll
                for (int bj = 0; bj < 2; ++bj) { const int col0 = u.pn * BM + bj * HALF + wc * 32 + 8 * fq; float* p = dst + (size_t)row * DM + col0;
                    const f32x4 v0 = acc[ai][bj][m][0] + *(const f32x4*)p, v1 = acc[ai][bj][m][1] + *(const f32x4*)(p + 4);
                    *(f32x4*)p = v0; *(f32x4*)(p + 4) = v1; } }
    }
};
}

__device__ __forceinline__ void p0_transpose_item(const float* W, int K, int ldw, int nblk, const float* gain, bf16* WT, LAS float* scr, int item, int lane) {
    const int kb = item / nblk, nb = item % nblk, k0 = 64 * kb, n0 = 32 * nb;
    float wv[32];
#pragma unroll
    for (int i = 0; i < 32; ++i) { const int kk = 2 * i + (lane >> 5); wv[i] = W[(size_t)(k0 + kk) * ldw + n0 + (lane & 31)]; }
#pragma unroll
    for (int i = 0; i < 32; ++i) { const int kk = 2 * i + (lane >> 5); const float gg = gain ? gain[k0 + kk] : 1.f; scr[kk * 33 + (lane & 31)] = gg * wv[i]; }
    LDS_WAIT(); asm volatile("" ::: "memory");
    const int c = lane & 7;
#pragma unroll
    for (int j = 0; j < 4; ++j) { const int n = (lane >> 3) + 8 * j; const LAS float* s = scr + (8 * c) * 33 + n;
        v4u o; o.x = pk2(s[0 * 33], s[1 * 33]); o.y = pk2(s[2 * 33], s[3 * 33]); o.z = pk2(s[4 * 33], s[5 * 33]); o.w = pk2(s[6 * 33], s[7 * 33]);
        *(GAS v4u*)(WT + (size_t)(n0 + n) * K + k0 + 8 * c) = o; }
    LDS_WAIT(); asm volatile("" ::: "memory");
}
__device__ __forceinline__ void sincos_d(double a, double& s, double& c) {
    const double TWO_PI = 6.283185307179586476925286766559;
    const double k = __builtin_rint(a * (1.0 / TWO_PI));
    const double r = a - k * TWO_PI, r2 = r * r;
    double sc = 1.0, ss = r, tc = 1.0, ts = r;
#pragma unroll
    for (int n = 1; n <= 17; ++n) { tc *= -r2 * (1.0 / (double)((2 * n - 1) * (2 * n))); sc += tc; ts *= -r2 * (1.0 / (double)((2 * n) * (2 * n + 1))); ss += ts; }
    s = ss; c = sc;
}
__device__ __forceinline__ float log_sigmoidf_(float x) { return x < 0.f ? x - log1pf(expf(x)) : -log1pf(expf(-x)); }

__device__ __forceinline__ void p0_prologue(Frame& F) {
    const int gw = F.vcu * 8 + F.wave, NGW = F.G * 8;
    {
        LAS float* scr = (LAS float*)(F.lds + F.wave * 16384);
        constexpr int I_IN = 16 * 112, I_OUT = 16 * 32;
        for (int it = gw; it < I_IN + I_OUT; it += NGW) {
            int r = it;
            if (r < I_IN) { p0_transpose_item(F.w_in, DM, INCOLS, 112, F.g1, F.Win_t, scr, r, F.lane); continue; } r -= I_IN;
            p0_transpose_item(F.w_out, DM, DM, 32, nullptr, F.Wout_t, scr, r, F.lane);
        }
    }
    __syncthreads();
    {
        LAS float* Wg = (LAS float*)F.lds;
        { float wv[16], gv1[16];
#pragma unroll
          for (int q = 0; q < 16; ++q) { const int i = F.tid + 512 * q, k = i >> 3, j = i & 7; wv[q] = F.w_in[(size_t)k * INCOLS + NPROJ + j]; gv1[q] = F.g1[k]; }
#pragma unroll
          for (int q = 0; q < 16; ++q) { const int i = F.tid + 512 * q, k = i >> 3, j = i & 7; Wg[j * 1024 + k] = gv1[q] * wv[q]; } }
        __syncthreads();
        f32x4 vn[4], vn2[4];
#pragma unroll
        for (int q = 0; q < 2; ++q) { const int mq = gw + q * NGW;
            if (mq < M) { const float* xr = (mq < MP) ? F.xp + (size_t)mq * DM : F.xs + (size_t)(mq - MP) * DM;
#pragma unroll
                for (int j = 0; j < 4; ++j) { const f32x4 t4 = *(const f32x4*)(xr + 256 * j + 4 * F.lane); if (q == 0) vn[j] = t4; else vn2[j] = t4; } } }
        for (int m = gw; m < M; m += NGW) {
            f32x4 v[4]; float ss = 0.f;
#pragma unroll
            for (int j = 0; j < 4; ++j) { v[j] = vn[j]; vn[j] = vn2[j]; ss += (v[j].x * v[j].x + v[j].y * v[j].y) + (v[j].z * v[j].z + v[j].w * v[j].w); }
            { const int mn = m + 2 * NGW;
              if (mn < M) { const float* xr = (mn < MP) ? F.xp + (size_t)mn * DM : F.xs + (size_t)(mn - MP) * DM;
#pragma unroll
                for (int j = 0; j < 4; ++j) vn2[j] = *(const f32x4*)(xr + 256 * j + 4 * F.lane); } }
            float ga[8];
#pragma unroll
            for (int g = 0; g < 8; ++g) { float a = 0.f;
#pragma unroll
                for (int j = 0; j < 4; ++j) { const f32x4 w = *(const LAS f32x4*)(Wg + g * 1024 + 256 * j + 4 * F.lane); a += (v[j].x * w.x + v[j].y * w.y) + (v[j].z * w.z + v[j].w * w.w); }
                ga[g] = wave_sum(a); }
            ss = wave_sum(ss);
            const float rstd = 1.f / sqrtf(ss * (1.f / DM) + EPS);
            float gv = 0.f;
#pragma unroll
            for (int g = 0; g < 8; ++g) gv = (F.lane == g) ? ga[g] : gv;
            if (F.lane == 0) F.rstd1[m] = rstd;
            if (F.lane < 8) { const float gg = gv * rstd + F.b_gate[F.lane];
                if (F.lane < 4) F.ig[m * 4 + F.lane] = gg; else F.lf[m * 4 + F.lane - 4] = log_sigmoidf_(gg); }
            v2u* o8 = (v2u*)(F.XB + (size_t)m * DM);
#pragma unroll
            for (int j = 0; j < 4; ++j) { v2u o; o.x = pk2(v[j].x, v[j].y); o.y = pk2(v[j].z, v[j].w); o8[64 * j + F.lane] = o; }
        }
    }
    {
        const double invf[8] = {1.0, 0.19392274474868576, 0.03760603093086393, 0.007292664737217109, 0.001414213562373095, 0.0002742481756762073, 5.318295896944988e-05, 1.031338537721246e-05};
        for (int i = F.tid * F.G + F.vcu; i < (SEQ + DTS) * 8; i += F.G * 512) {
            const int p = i >> 3, k = i & 7; const double pos = (p < SEQ) ? (double)p : (double)(8192 + p - SEQ);
            double fr = invf[0];
#pragma unroll
            for (int q = 1; q < 8; ++q) fr = (k == q) ? invf[q] : fr;
            double s, c; sincos_d(pos * fr, s, c);
            F.rope[p * 16 + k] = (float)c; F.rope[p * 16 + 8 + k] = (float)s;
        }
    }
}

typedef short bf16x8m __attribute__((ext_vector_type(8)));
typedef short v4i16m __attribute__((ext_vector_type(4)));
struct AttnTileP { int dil, rg, Q0, sp, ks, Lg; };
__device__ __forceinline__ AttnTileP attn_tile_params(int ti, int r16, int L0) {
    AttnTileP t;
    if (ti < 5)       { t.dil = 16; t.rg = r16;     t.Q0 = L0;                  t.sp = 1;  t.ks = t.Q0 - 128 + 32 * ti;        t.Lg = 256; }
    else if (ti < 11) { t.dil = 4;  t.rg = r16 & 3; t.Q0 = 4 * L0 + (r16 >> 2); t.sp = 4;  t.ks = t.Q0 - 128 + 32 * (ti - 5);  t.Lg = 1024; }
    else              { t.dil = 1;  t.rg = 0;       t.Q0 = 16 * L0 + r16;       t.sp = 16; t.ks = t.Q0 - 128 + 32 * (ti - 11); t.Lg = 4096; }
    return t;
}
__device__ __forceinline__ void attn_tile_load(const bf16* P, int b, int h, const AttnTileP& t, int lane, bf16x8m (&kf)[2][2], v4u (&vv)[4]) {
    const int fr = lane & 15, g4 = lane >> 4;
#pragma unroll
    for (int sub = 0; sub < 2; ++sub) { int kp = t.ks + 16 * sub + fr; kp = kp < 0 ? 0 : (kp >= t.Lg ? t.Lg - 1 : kp);
        const bf16* kr = P + (size_t)(b * SEQ + t.dil * kp + t.rg) * NPROJ + C_K + h * 64 + 8 * g4;
        kf[sub][0] = *(const bf16x8m*)kr; kf[sub][1] = *(const bf16x8m*)(kr + 32); }
#pragma unroll
    for (int k = 0; k < 4; ++k) { int kp = t.ks + (lane >> 3) + 8 * k; kp = kp < 0 ? 0 : (kp >= t.Lg ? t.Lg - 1 : kp);
        vv[k] = *(const v4u*)(P + (size_t)(b * SEQ + t.dil * kp + t.rg) * NPROJ + C_V + h * 64 + 8 * (lane & 7)); }
}
struct Claimer { int nxt; };
__device__ __forceinline__ int claim_unit(Frame& F, int which, int limit, Claimer& C) {
    unsigned* ctr = (unsigned*)(F.ws + WS_CLAIM) + 64 * which;
    volatile LAS int* sh = (volatile LAS int*)(F.lds + MISC_OFF + 72);
    __syncthreads();
    if (F.tid == 0) { if (C.nxt == -2) C.nxt = (int)__hip_atomic_fetch_add(ctr, 1u, __ATOMIC_RELAXED, __HIP_MEMORY_SCOPE_AGENT); sh[0] = C.nxt; }
    __syncthreads();
    const int u = sh[0];
    if (F.tid == 0) C.nxt = (u < limit) ? (int)__hip_atomic_fetch_add(ctr, 1u, __ATOMIC_RELAXED, __HIP_MEMORY_SCOPE_AGENT) : -2;
    return u;
}
__device__ __forceinline__ void attn_tile_math(const bf16x8m (&kc)[2][2], const bf16x8m (&qf)[2], int ks, int qp, int g4, const LAS unsigned char* vb, int troff, float& m, float& lsum, f32x4 (&acc)[4]) {
    f32x4 s0 = (f32x4){0.f, 0.f, 0.f, 0.f}, s1 = (f32x4){0.f, 0.f, 0.f, 0.f};
    s0 = __builtin_amdgcn_mfma_f32_16x16x32_bf16(kc[0][0], qf[0], s0, 0, 0, 0); s0 = __builtin_amdgcn_mfma_f32_16x16x32_bf16(kc[0][1], qf[1], s0, 0, 0, 0);
    s1 = __builtin_amdgcn_mfma_f32_16x16x32_bf16(kc[1][0], qf[0], s1, 0, 0, 0); s1 = __builtin_amdgcn_mfma_f32_16x16x32_bf16(kc[1][1], qf[1], s1, 0, 0, 0);
    float mx = -INFINITY;
    const int dbase = qp - ks - 4 * g4; const unsigned dlim = (unsigned)(qp < 128 ? qp : 128);
#pragma unroll
    for (int i = 0; i < 4; ++i) { const bool v0 = (unsigned)(dbase - i) <= dlim, v1 = (unsigned)(dbase - 16 - i) <= dlim;
        s0[i] = v0 ? s0[i] : -INFINITY; s1[i] = v1 ? s1[i] : -INFINITY; mx = fmaxf(mx, fmaxf(s0[i], s1[i])); }
    if (__builtin_amdgcn_ballot_w64(mx > m + 8.f) != 0ull) {
        mx = fmaxf(mx, __shfl_xor(mx, 16)); mx = fmaxf(mx, __shfl_xor(mx, 32));
        const float mn = fmaxf(m, mx), alpha = __expf(m - mn); m = mn;
        lsum = lsum * alpha;
#pragma unroll
        for (int i = 0; i < 4; ++i) acc[i] = acc[i] * alpha;
    }
    float ps = 0.f;
#pragma unroll
    for (int i = 0; i < 4; ++i) { s0[i] = __expf(s0[i] - m); s1[i] = __expf(s1[i] - m); ps += s0[i] + s1[i]; }
    lsum += ps;
    v4u w; w.x = pk2(s0[0], s0[1]); w.y = pk2(s0[2], s0[3]); w.z = pk2(s1[0], s1[1]); w.w = pk2(s1[2], s1[3]);
    const bf16x8m pb = __builtin_bit_cast(bf16x8m, w);
#pragma unroll
    for (int db = 0; db < 4; ++db) {
        const v4i16m a0 = __builtin_amdgcn_ds_read_tr16_b64_v4i16((LAS v4i16m*)(vb + troff + db * 32));
        const v4i16m a1 = __builtin_amdgcn_ds_read_tr16_b64_v4i16((LAS v4i16m*)(vb + troff + db * 32 + 16 * 160));
        acc[db] = __builtin_amdgcn_mfma_f32_16x16x32_bf16(__builtin_shufflevector(a0, a1, 0, 1, 2, 3, 4, 5, 6, 7), pb, acc[db], 0, 0, 0);
    }
}
__device__ __forceinline__ void p2_attn_prompt_mfma(Frame& F, int stop_at, Claimer& C) {
    const int lane = F.lane, fr = lane & 15, g4 = lane >> 4, tid = F.tid;
    LAS unsigned char* vbuf = F.lds + F.wave * 5120;
    LAS unsigned char* Ksh = F.lds + 40960; LAS unsigned char* Vsh = Ksh + 30720;
    const int vwoff = (lane >> 3) * 160 + (lane & 7) * 16;
    const int troff = (4 * g4 + (fr >> 2)) * 160 + (fr & 3) * 8;
    for (int bu = claim_unit(F, 0, 1024, C); bu < 1024; bu = claim_unit(F, 0, 1024, C)) {
        const int r16 = (bu & 1) * 8 + F.wave, L0 = ((bu >> 1) & 15) * 16, h = (bu >> 5) & 7, b = bu >> 8;
        const int rowq = b * SEQ + 16 * (L0 + fr) + r16;
        bf16x8m qf[2];
        { const bf16* qr = F.PROJ + (size_t)rowq * NPROJ + C_Q + h * 64 + 8 * g4; qf[0] = *(const bf16x8m*)qr; qf[1] = *(const bf16x8m*)(qr + 32); }
        v4u wreg[6];
#pragma unroll
        for (int k = 0; k < 6; ++k) { const int i = tid + 512 * k, which = (i >= 1536) ? 1 : 0, r = (i - which * 1536) >> 3, c = i & 7;
            int tok = 16 * L0 - 128 + r; tok = tok < 0 ? 0 : tok;
            wreg[k] = *(const v4u*)(F.PROJ + (size_t)(b * SEQ + tok) * NPROJ + (which ? C_V : C_K) + h * 64 + 8 * c); }
        f32x4 acc[4];
#pragma unroll
        for (int i = 0; i < 4; ++i) acc[i] = (f32x4){0.f, 0.f, 0.f, 0.f};
        float m = -1e30f, lsum = 0.f;
        bf16x8m kc[2][2]; v4u vr[4];
        { const AttnTileP t0 = attn_tile_params(0, r16, L0); attn_tile_load(F.PROJ, b, h, t0, lane, kc, vr); }
#pragma unroll 1
        for (int ti = 0; ti < 11; ++ti) {
            const AttnTileP t = attn_tile_params(ti, r16, L0);
#pragma unroll
            for (int k = 0; k < 4; ++k) *(LAS v4u*)(vbuf + vwoff + k * 1280) = vr[k];
            bf16x8m kn[2][2];
            { const AttnTileP tn = attn_tile_params((ti + 1 < 11) ? ti + 1 : ti, r16, L0); attn_tile_load(F.PROJ, b, h, tn, lane, kn, vr); }
            attn_tile_math(kc, qf, t.ks, t.Q0 + t.sp * fr, g4, vbuf, troff, m, lsum, acc);
#pragma unroll
            for (int a = 0; a < 2; ++a) { kc[a][0] = kn[a][0]; kc[a][1] = kn[a][1]; }
        }
        const int W0 = 16 * L0 - 128, qp1 = 16 * L0 + r16 + 16 * fr;
#pragma unroll 1
        for (int pass = 0; pass < 2; ++pass) {
            __syncthreads();
#pragma unroll
            for (int k = 0; k < 6; ++k) { const int i = tid + 512 * k, which = (i >= 1536) ? 1 : 0, r = (i - which * 1536) >> 3, c = i & 7;
                *(LAS v4u*)(Ksh + which * 30720 + r * 160 + c * 16) = wreg[k]; }
            if (pass == 0) {
#pragma unroll
                for (int k = 0; k < 6; ++k) { const int i = tid + 512 * k, which = (i >= 1536) ? 1 : 0, r = (i - which * 1536) >> 3, c = i & 7;
                    int tok = W0 + 192 + r; tok = tok < 0 ? 0 : tok;
                    wreg[k] = *(const v4u*)(F.PROJ + (size_t)(b * SEQ + tok) * NPROJ + (which ? C_V : C_K) + h * 64 + 8 * c); } }
            __syncthreads();
#pragma unroll 2
            for (int j = 0; j < 6; ++j) {
                bf16x8m kk[2][2];
#pragma unroll
                for (int sub = 0; sub < 2; ++sub) { const LAS unsigned char* kr = Ksh + (32 * j + 16 * sub + fr) * 160 + 16 * g4;
                    kk[sub][0] = *(const LAS bf16x8m*)kr; kk[sub][1] = *(const LAS bf16x8m*)(kr + 64); }
                attn_tile_math(kk, qf, W0 + 192 * pass + 32 * j, qp1, g4, Vsh + 32 * j * 160, troff, m, lsum, acc);
            }
        }
        lsum += __shfl_xor(lsum, 16); lsum += __shfl_xor(lsum, 32);
        const float inv = 1.f / lsum;
        bf16* orow = F.MIX + (size_t)rowq * DM + h * 64 + 4 * g4;
#pragma unroll
        for (int db = 0; db < 4; ++db) { v2u o; o.x = pk2(acc[db][0] * inv, acc[db][1] * inv); o.y = pk2(acc[db][2] * inv, acc[db][3] * inv); *(v2u*)(orow + 16 * db) = o; }
        if (bu >= stop_at) break;
    }
}


__device__ __forceinline__ bf16x8m cvt8(const f32x4 a, const f32x4 b) { v4u w; w.x = pk2(a.x, a.y); w.y = pk2(a.z, a.w); w.z = pk2(b.x, b.y); w.w = pk2(b.z, b.w); return __builtin_bit_cast(bf16x8m, w); }
__device__ __forceinline__ bf16x8m ld_sigma_g(const bf16* p) {
    const v2u a = *(const v2u*)p, c = *(const v2u*)(p + 16); v4u w; w.x = a.x; w.y = a.y; w.z = c.x; w.w = c.y; return __builtin_bit_cast(bf16x8m, w);
}
template <bool FAR>
__device__ __forceinline__ void sstream_tile(const bf16x8m (&ka)[2][2], const bf16x8m q0, const bf16x8m q1, int R, int fr, int g4, int isel, const LAS unsigned char* vbuf, int troff,
                                             float& m, float& lsum, f32x4 (&acc)[4]) {
    f32x4 s0 = (f32x4){0.f, 0.f, 0.f, 0.f}, s1 = (f32x4){0.f, 0.f, 0.f, 0.f};
    s0 = __builtin_amdgcn_mfma_f32_16x16x32_bf16(ka[0][0], q0, s0, 0, 0, 0); s0 = __builtin_amdgcn_mfma_f32_16x16x32_bf16(ka[0][1], q1, s0, 0, 0, 0);
    s1 = __builtin_amdgcn_mfma_f32_16x16x32_bf16(ka[1][0], q0, s1, 0, 0, 0); s1 = __builtin_amdgcn_mfma_f32_16x16x32_bf16(ka[1][1], q1, s1, 0, 0, 0);
    float mx;
    float mu0[4], mu1[4];
    if (FAR) {
        const float a0 = (isel == 0) ? s0[0] : (isel == 1) ? s0[1] : (isel == 2) ? s0[2] : s0[3];
        const float a1 = (isel == 0) ? s1[0] : (isel == 1) ? s1[1] : (isel == 2) ? s1[2] : s1[3];
        mx = (isel >= 0) ? fmaxf(a0, a1) : -INFINITY;
        if (__builtin_amdgcn_ballot_w64(mx > m + 8.f) != 0ull) {
            mx = fmaxf(mx, __shfl_xor(mx, 16)); mx = fmaxf(mx, __shfl_xor(mx, 32));
            const float mn = fmaxf(m, mx), alpha = __expf(m - mn); m = mn;
            lsum = lsum * alpha;
#pragma unroll
            for (int i = 0; i < 4; ++i) acc[i] = acc[i] * alpha;
        }
        const float e0 = (isel >= 0) ? __expf(a0 - m) : 0.f, e1 = (isel >= 0) ? __expf(a1 - m) : 0.f;
#pragma unroll
        for (int i = 0; i < 4; ++i) { s0[i] = (i == isel) ? e0 : 0.f; s1[i] = (i == isel) ? e1 : 0.f; }
        lsum += (e0 + e1);
    } else {
        mx = -INFINITY;
#pragma unroll
        for (int i = 0; i < 4; ++i) {
            const int d0 = WBUF + fr - (R + 4 * g4 + i), d1 = d0 - 16;
            float c0 = 0.f, c1 = 0.f;
            if (fr < 8 && d0 >= 0) c0 = (d0 <= 128 ? 1.f : 0.f) + (((d0 & 3) == 0 && d0 <= 512) ? 1.f : 0.f) + (((d0 & 15) == 0) ? 1.f : 0.f);
            if (fr < 8 && d1 >= 0) c1 = (d1 <= 128 ? 1.f : 0.f) + (((d1 & 3) == 0 && d1 <= 512) ? 1.f : 0.f) + (((d1 & 15) == 0) ? 1.f : 0.f);
            mu0[i] = c0; mu1[i] = c1;
            mx = fmaxf(mx, (c0 > 0.f) ? s0[i] : -INFINITY);
            mx = fmaxf(mx, (c1 > 0.f) ? s1[i] : -INFINITY); }
        if (__builtin_amdgcn_ballot_w64(mx > m + 8.f) != 0ull) {
            mx = fmaxf(mx, __shfl_xor(mx, 16)); mx = fmaxf(mx, __shfl_xor(mx, 32));
            const float mn = fmaxf(m, mx), alpha = __expf(m - mn); m = mn;
            lsum = lsum * alpha;
#pragma unroll
            for (int i = 0; i < 4; ++i) acc[i] = acc[i] * alpha;
        }
        float ps = 0.f;
#pragma unroll
        for (int i = 0; i < 4; ++i) { s0[i] = (mu0[i] > 0.f) ? mu0[i] * __expf(s0[i] - m) : 0.f; s1[i] = (mu1[i] > 0.f) ? mu1[i] * __expf(s1[i] - m) : 0.f; ps += s0[i] + s1[i]; }
        lsum += ps;
    }
    v4u pw; pw.x = pk2(s0[0], s0[1]); pw.y = pk2(s0[2], s0[3]); pw.z = pk2(s1[0], s1[1]); pw.w = pk2(s1[2], s1[3]);
    const bf16x8m pb = __builtin_bit_cast(bf16x8m, pw);
#pragma unroll
    for (int db = 0; db < 4; ++db) {
        const v4i16m a0 = __builtin_amdgcn_ds_read_tr16_b64_v4i16((LAS v4i16m*)(vbuf + troff + db * 32));
        const v4i16m a1 = __builtin_amdgcn_ds_read_tr16_b64_v4i16((LAS v4i16m*)(vbuf + troff + db * 32 + 16 * 160));
        acc[db] = __builtin_amdgcn_mfma_f32_16x16x32_bf16(__builtin_shufflevector(a0, a1, 0, 1, 2, 3, 4, 5, 6, 7), pb, acc[db], 0, 0, 0);
    }
}
struct STile { f32x4 k[2][4], v[2][4]; };
template <bool FAR> __device__ __forceinline__ int srow(int ti, int sub, int fr) { return FAR ? 64 * ti + 32 * sub + (fr & 7) + 16 * (fr >> 3) : 32 * ti + 16 * sub + fr; }
template <bool FAR>
__device__ __forceinline__ void sstream_load(STile& T, const float* ck, const float* cv, unsigned hb, int ti, int fr) {
#pragma unroll
    for (int sub = 0; sub < 2; ++sub) { const unsigned off = hb + (unsigned)srow<FAR>(ti, sub, fr) * 2048u;
#pragma unroll
        for (int j = 0; j < 4; ++j) { T.k[sub][j] = *(const f32x4*)((const char*)ck + off + 64 * j); T.v[sub][j] = *(const f32x4*)((const char*)cv + off + 64 * j); } }
}
template <bool FAR>
__device__ __forceinline__ void sstream_consume(const STile& T, float* ok, float* ov, unsigned hb, int ti, int fr, int g4, LAS unsigned char* vbuf, bf16x8m (&ka)[2][2]) {
#pragma unroll
    for (int sub = 0; sub < 2; ++sub) { const int row = srow<FAR>(ti, sub, fr);
        if (row >= DTS) { const unsigned off = hb + (unsigned)(row - DTS) * 2048u;
#pragma unroll
            for (int j = 0; j < 4; ++j) { *(f32x4*)((char*)ok + off + 64 * j) = T.k[sub][j]; *(f32x4*)((char*)ov + off + 64 * j) = T.v[sub][j]; } }
        ka[sub][0] = cvt8(T.k[sub][0], T.k[sub][1]); ka[sub][1] = cvt8(T.k[sub][2], T.k[sub][3]);
        LAS unsigned char* vd = vbuf + (16 * sub + fr) * 160 + 8 * g4;
#pragma unroll
        for (int j = 0; j < 4; ++j) { v2u o; o.x = pk2(T.v[sub][j].x, T.v[sub][j].y); o.y = pk2(T.v[sub][j].z, T.v[sub][j].w); *(LAS v2u*)(vd + 32 * j) = o; } }
}
template <bool MATH = true>
__device__ __forceinline__ void p2_sample_stream(Frame& F) {
    const int lane = F.lane, fr = lane & 15, g4 = lane >> 4, w = F.wave;
    LAS unsigned char* vbuf = F.lds + w * 5120;
    LAS float* mrg = (LAS float*)(F.lds + 40960);
    const int troff = (4 * g4 + (fr >> 2)) * 160 + (fr & 3) * 8;
    const int isel = ((fr < 8) && ((fr >> 2) == (g4 & 1))) ? (fr & 3) : -1;
#ifndef STREAM_CUS
#define STREAM_CUS 256
#endif
    constexpr int SSTEP = 256 / STREAM_CUS;
    if ((F.vcu % SSTEP) == 0)
    for (int su = F.vcu / SSTEP; su < 256; su += F.G / SSTEP) {
        const int b = su >> 1, hh = 4 * (su & 1) + (w & 3), par = w >> 2;
        bf16x8m q0, q1;
        { const bf16* qr = F.PROJ + (size_t)(MP + b * DTS + (fr & 7)) * NPROJ + C_Q + hh * 64 + 4 * g4;
          q0 = ld_sigma_g(qr); q1 = ld_sigma_g(qr + 32);
          if (fr >= 8) { q0 = (bf16x8m){0, 0, 0, 0, 0, 0, 0, 0}; q1 = q0; } }
        f32x4 acc[4];
#pragma unroll
        for (int i = 0; i < 4; ++i) acc[i] = (f32x4){0.f, 0.f, 0.f, 0.f};
        float m = -1e30f, lsum = 0.f;
        const unsigned hb = (unsigned)((((size_t)b * WBUF * 8 + hh) * 64 + 4 * g4) * 4);
        const float* ck = F.cache_k; const float* cv = F.cache_v; float* ok = F.out + O_SK; float* ov = F.out + O_SV;
        __syncthreads();
        STile TA, TB; bf16x8m ka[2][2];
        sstream_load<true>(TA, ck, cv, hb, par, fr); sstream_load<true>(TB, ck, cv, hb, par + 2, fr);
#define SS_LOAD(T, k) do { const int _k = (k); if (_k < 12) sstream_load<true>(T, ck, cv, hb, par + 2 * _k, fr); else sstream_load<false>(T, ck, cv, hb, 48 + par + 2 * ((_k < 20 ? _k : 19) - 12), fr); } while (0)
#pragma unroll 1
        for (int k = 0; k < 12; k += 2) {
            sstream_consume<true>(TA, ok, ov, hb, par + 2 * k, fr, g4, vbuf, ka); __builtin_amdgcn_sched_barrier(0);
            SS_LOAD(TA, k + 2); __builtin_amdgcn_sched_barrier(0);
            sstream_tile<true>(ka, q0, q1, 0, fr, g4, isel, vbuf, troff, m, lsum, acc); __builtin_amdgcn_sched_barrier(0);
            sstream_consume<true>(TB, ok, ov, hb, par + 2 * k + 2, fr, g4, vbuf, ka); __builtin_amdgcn_sched_barrier(0);
            SS_LOAD(TB, k + 3); __builtin_amdgcn_sched_barrier(0);
            sstream_tile<true>(ka, q0, q1, 0, fr, g4, isel, vbuf, troff, m, lsum, acc); __builtin_amdgcn_sched_barrier(0);
        }
#pragma unroll 1
        for (int k = 12; k < 20; k += 2) {
            const int ti = 48 + par + 2 * (k - 12);
            sstream_consume<false>(TA, ok, ov, hb, ti, fr, g4, vbuf, ka); __builtin_amdgcn_sched_barrier(0);
            SS_LOAD(TA, k + 2); __builtin_amdgcn_sched_barrier(0);
            sstream_tile<false>(ka, q0, q1, 32 * ti, fr, g4, isel, vbuf, troff, m, lsum, acc); __builtin_amdgcn_sched_barrier(0);
            sstream_consume<false>(TB, ok, ov, hb, ti + 2, fr, g4, vbuf, ka); __builtin_amdgcn_sched_barrier(0);
            SS_LOAD(TB, k + 3); __builtin_amdgcn_sched_barrier(0);
            sstream_tile<false>(ka, q0, q1, 32 * (ti + 2), fr, g4, isel, vbuf, troff, m, lsum, acc); __builtin_amdgcn_sched_barrier(0);
        }
#undef SS_LOAD
        if (MATH && par == 0) {
            bf16x8m ka[2][2];
            const bf16x8m z = (bf16x8m){0, 0, 0, 0, 0, 0, 0, 0};
            const bf16* kr = F.PROJ + (size_t)(MP + b * DTS + (fr & 7)) * NPROJ + C_K + hh * 64 + 4 * g4;
            const bf16* vr = F.PROJ + (size_t)(MP + b * DTS + (fr & 7)) * NPROJ + C_V + hh * 64 + 4 * g4;
            ka[0][0] = (fr < 8) ? ld_sigma_g(kr) : z; ka[0][1] = (fr < 8) ? ld_sigma_g(kr + 32) : z; ka[1][0] = z; ka[1][1] = z;
#pragma unroll
            for (int sub = 0; sub < 2; ++sub) { LAS unsigned char* vd = vbuf + (16 * sub + fr) * 160 + 8 * g4;
#pragma unroll
                for (int j = 0; j < 4; ++j) { v2u o = (v2u){0u, 0u}; if (sub == 0 && fr < 8) o = *(const v2u*)(vr + 16 * j); *(LAS v2u*)(vd + 32 * j) = o; } }
            sstream_tile<false>(ka, q0, q1, WBUF, fr, g4, isel, vbuf, troff, m, lsum, acc);
        }
        lsum += __shfl_xor(lsum, 16); lsum += __shfl_xor(lsum, 32);
        LAS float* mg = mrg + ((w & 3) * 64 + lane) * 18;
        if (MATH && par == 1) { mg[0] = m; mg[1] = lsum;
#pragma unroll
            for (int db = 0; db < 4; ++db) { mg[2 + 4 * db] = acc[db][0]; mg[3 + 4 * db] = acc[db][1]; mg[4 + 4 * db] = acc[db][2]; mg[5 + 4 * db] = acc[db][3]; } }
        __syncthreads();
        if (MATH && par == 0) {
            const float m2 = mg[0], l2 = mg[1], mn = fmaxf(m, m2), a1 = __expf(m - mn), a2 = __expf(m2 - mn), inv = 1.f / (lsum * a1 + l2 * a2);
            if (fr < 8) { bf16* orow = F.MIX + (size_t)(MP + b * DTS + fr) * DM + hh * 64 + 4 * g4;
#pragma unroll
                for (int db = 0; db < 4; ++db) { v2u o;
                    o.x = pk2((acc[db][0] * a1 + mg[2 + 4 * db] * a2) * inv, (acc[db][1] * a1 + mg[3 + 4 * db] * a2) * inv);
                    o.y = pk2((acc[db][2] * a1 + mg[4 + 4 * db] * a2) * inv, (acc[db][3] * a1 + mg[5 + 4 * db] * a2) * inv);
                    *(v2u*)(orow + 16 * db) = o; } }
        }
    }
}

constexpr int NCHUNK = 2 * DBS * 96, CLAIM = 4;
__device__ __forceinline__ void copy_load(Frame& F, int c0, f32x4 (&v)[8]) {
#pragma unroll
    for (int k = 0; k < 8; ++k) { const int i = F.tid + 512 * k, c = c0 + (i >> 10), r = i & 1023;
        const float* src = ((c & 1) ? F.cache_v : F.cache_k) + ((size_t)((c >> 1) & 127) * WBUF + 16 * (c >> 8) + 8) * 512;
        v[k] = __builtin_nontemporal_load((const f32x4*)src + r); }
}
__device__ __forceinline__ void copy_store(Frame& F, int c0, const f32x4 (&v)[8]) {
#pragma unroll
    for (int k = 0; k < 8; ++k) { const int i = F.tid + 512 * k, c = c0 + (i >> 10), r = i & 1023;
        float* dst = F.out + ((c & 1) ? O_SV : O_SK) + ((size_t)((c >> 1) & 127) * WBUF + 16 * (c >> 8)) * 512;
        __builtin_nontemporal_store(v[k], (f32x4*)dst + r); }
}
__device__ __forceinline__ void copy_claim(Frame& F, int c0) { f32x4 v[8]; copy_load(F, c0, v); copy_store(F, c0, v); }
__device__ __forceinline__ void copy_quota(Frame& F, int n) {
    unsigned* ctl = (unsigned*)(F.ws + WS_CPY);
    volatile LAS int* sh = (volatile LAS int*)(F.lds + MISC_OFF + 64);
    for (int k = 0; k < n; ++k) {
        __syncthreads();
        if (F.tid == 0) { const unsigned c = __hip_atomic_fetch_add(ctl, (unsigned)CLAIM, __ATOMIC_RELAXED, __HIP_MEMORY_SCOPE_AGENT); sh[0] = (c < (unsigned)NCHUNK) ? (int)c : -1; }
        __syncthreads();
        const int c0 = sh[0];
        if (c0 < 0) break;
        copy_claim(F, c0);
    }
    __syncthreads();
}
__device__ __forceinline__ void help_copy(Frame& F, int phase, bool announce = true, bool announce_only = false) {
    unsigned* ctl = (unsigned*)(F.ws + WS_CPY);
    volatile LAS int* sh = (volatile LAS int*)(F.lds + MISC_OFF + 64);
    __syncthreads();
    if (announce && phase >= 0 && F.tid == 0) __hip_atomic_fetch_add(ctl + 64 * (1 + phase), 1u, __ATOMIC_RELAXED, __HIP_MEMORY_SCOPE_AGENT);
    if (announce_only) return;
    int nxt = -1;
    if (F.tid == 0) { const bool busy = (phase < 0) || (__hip_atomic_load(ctl + 64 * (1 + phase), __ATOMIC_RELAXED, __HIP_MEMORY_SCOPE_AGENT) < (unsigned)F.G);
        if (busy) { const unsigned c = __hip_atomic_fetch_add(ctl, (unsigned)CLAIM, __ATOMIC_RELAXED, __HIP_MEMORY_SCOPE_AGENT); if (c < (unsigned)NCHUNK) nxt = (int)c; } }
    int cur = -1; f32x4 va[8], vb[8];
    for (;;) {
        if (F.tid == 0) sh[0] = nxt;
        __syncthreads();
        const int c1 = sh[0];
        __syncthreads();
        if (c1 >= 0) {
            if (F.tid == 0) { nxt = -1;
                const bool busy = (phase < 0) || (__hip_atomic_load(ctl + 64 * (1 + phase), __ATOMIC_RELAXED, __HIP_MEMORY_SCOPE_AGENT) < (unsigned)F.G);
                if (busy) { const unsigned c = __hip_atomic_fetch_add(ctl, (unsigned)CLAIM, __ATOMIC_RELAXED, __HIP_MEMORY_SCOPE_AGENT); if (c < (unsigned)NCHUNK) nxt = (int)c; } }
            copy_load(F, c1, vb);
        }
        if (cur >= 0) copy_store(F, cur, va);
        if (c1 < 0) break;
#pragma unroll
        for (int k = 0; k < 8; ++k) va[k] = vb[k];
        cur = c1;
    }
}

__device__ __forceinline__ void load_q64(const bf16* qp, LAS float* sq, int lane) {
    sq[lane] = bf2f(qp[lane]);
    LDS_WAIT(); asm volatile("" ::: "memory");
}
__device__ __forceinline__ float dot_bf16row(const bf16* kp, const LAS float* sq) {
    float a = 0.f;
#pragma unroll 1
    for (int i = 0; i < 8; ++i) { const v4u w = *(const v4u*)(kp + 8 * i); const f32x4 q0 = *(const LAS f32x4*)(sq + 8 * i), q1 = *(const LAS f32x4*)(sq + 8 * i + 4);
        a += q0.x * bflo(w.x) + q0.y * bfhi(w.x) + q0.z * bflo(w.y) + q0.w * bfhi(w.y) + q1.x * bflo(w.z) + q1.y * bfhi(w.z) + q1.z * bflo(w.w) + q1.w * bfhi(w.w); }
    return a;
}
__device__ __forceinline__ float dot_f32row(const float* kp, const LAS float* sq) {
    float a = 0.f;
#pragma unroll 1
    for (int i = 0; i < 16; ++i) { const f32x4 w = *(const f32x4*)(kp + 4 * i); const f32x4 q0 = *(const LAS f32x4*)(sq + 4 * i);
        a += q0.x * w.x + q0.y * w.y + q0.z * w.z + q0.w * w.w; }
    return a;
}
__device__ __forceinline__ void p2_attn_v1(Frame& F) {
    const int gw = F.vcu * 8 + F.wave, NGW = F.G * 8, lane = F.lane;
    LAS float* q = (LAS float*)(F.lds + F.wave * 256);
    for (int it = gw; it < MS * 8; it += NGW) {
        const int sr = it >> 3, h = it & 7, b = sr >> 3, t = sr & 7, row = MP + sr;
        load_q64(F.PROJ + (size_t)row * NPROJ + C_Q + h * 64, q, lane);
        float sc[3][3];
#pragma unroll
        for (int g = 0; g < 3; ++g) { const int dil = (g == 0) ? 1 : (g == 1 ? 4 : 16);
#pragma unroll
            for (int i = 0; i < 3; ++i) { const int j = lane + 64 * i; const bool valid = (j <= 128);
                const int idx = valid ? (WBUF + t - dil * j) : (WBUF + t);
                float d;
                if (idx < WBUF) d = dot_f32row(F.cache_k + (((size_t)b * WBUF + idx) * 8 + h) * 64, q);
                else d = dot_bf16row(F.PROJ + (size_t)(MP + b * DTS + idx - WBUF) * NPROJ + C_K + h * 64, q);
                sc[g][i] = valid ? d : -INFINITY; asm volatile("" ::: "memory"); } }
        float mx = -INFINITY;
#pragma unroll
        for (int g = 0; g < 3; ++g)
#pragma unroll
            for (int i = 0; i < 3; ++i) mx = fmaxf(mx, sc[g][i]);
        mx = wave_max(mx);
        float sum = 0.f;
#pragma unroll
        for (int g = 0; g < 3; ++g)
#pragma unroll
            for (int i = 0; i < 3; ++i) { sc[g][i] = __expf(sc[g][i] - mx); sum += sc[g][i]; }
        sum = wave_sum(sum);
        float o = 0.f;
#pragma unroll
        for (int g = 0; g < 3; ++g) { const int dil = (g == 0) ? 1 : (g == 1 ? 4 : 16);
#pragma unroll
            for (int i = 0; i < 3; ++i) { const int cnt = (i == 2) ? 1 : 64;
#pragma unroll 1
                for (int jj = 0; jj < cnt; ++jj) { const int idx = WBUF + t - dil * (jj + 64 * i);
                    const float p = __shfl(sc[g][i], jj);
                    const float vv = (idx < WBUF) ? F.cache_v[(((size_t)b * WBUF + idx) * 8 + h) * 64 + lane]
                                                  : bf2f(F.PROJ[(size_t)(MP + b * DTS + idx - WBUF) * NPROJ + C_V + h * 64 + lane]);
                    o += p * vv; } } }
        F.MIX[(size_t)row * DM + h * 64 + lane] = (bf16)f2bf(o / sum);
    }
}

constexpr int TP = 288;
constexpr int ML_A = 0, ML_K = 36864, ML_V = 73728, ML_S = 110592;
typedef short v4i16s __attribute__((ext_vector_type(4)));
__device__ __forceinline__ bf16x8m tr2(const LAS unsigned char* p) {
    const v4i16m a0 = __builtin_amdgcn_ds_read_tr16_b64_v4i16((LAS v4i16m*)p);
    const v4i16m a1 = __builtin_amdgcn_ds_read_tr16_b64_v4i16((LAS v4i16m*)(p + 16 * TP));
    return __builtin_shufflevector(a0, a1, 0, 1, 2, 3, 4, 5, 6, 7);
}
__device__ __forceinline__ bf16x8m rd_sigma(const LAS unsigned char* p) {
    const v4i16m a0 = *(const LAS v4i16m*)p, a1 = *(const LAS v4i16m*)(p + 32);
    return __builtin_shufflevector(a0, a1, 0, 1, 2, 3, 4, 5, 6, 7);
}
__device__ __forceinline__ void build_conv_tile(LAS unsigned char* dst, const bf16* PROJ, int row0, bool first, int col, const float* w_conv, const float* b_conv, float scale, const LAS float* rowscale, int tid) {
    const int cc = tid & 15, rg = tid >> 4;
    v4u x[7];
#pragma unroll
    for (int i = 0; i < 7; ++i) { const int r = 4 * rg + i - 3;
        if (first && r < 0) x[i] = (v4u){0u, 0u, 0u, 0u}; else x[i] = *(const v4u*)(PROJ + (size_t)(row0 + r) * NPROJ + C_RAW + col + 8 * cc); }
    const float* wc = w_conv + col + 8 * cc;
    float out[4][8];
#pragma unroll
    for (int e = 0; e < 8; ++e) { const float bb = b_conv[col + 8 * cc + e];
#pragma unroll
        for (int r = 0; r < 4; ++r) out[r][e] = bb; }
#pragma unroll
    for (int w = 0; w < 4; ++w) {
        const f32x4 w0 = *(const f32x4*)(wc + w * 1024), w1 = *(const f32x4*)(wc + w * 1024 + 4);
#pragma unroll
        for (int r = 0; r < 4; ++r) { const v4u xv = x[r + w];
            out[r][0] += bflo(xv.x) * w0.x; out[r][1] += bfhi(xv.x) * w0.y; out[r][2] += bflo(xv.y) * w0.z; out[r][3] += bfhi(xv.y) * w0.w;
            out[r][4] += bflo(xv.z) * w1.x; out[r][5] += bfhi(xv.z) * w1.y; out[r][6] += bflo(xv.w) * w1.z; out[r][7] += bfhi(xv.w) * w1.w; }
    }
#pragma unroll
    for (int r = 0; r < 4; ++r) { const float rs = scale * (rowscale ? rowscale[4 * rg + r] : 1.f); float o[8];
#pragma unroll
        for (int e = 0; e < 8; ++e) { const float a = out[r][e]; o[e] = a * sigmoidf_(a) * rs; }
        v4u w; w.x = pk2(o[0], o[1]); w.y = pk2(o[2], o[3]); w.z = pk2(o[4], o[5]); w.w = pk2(o[6], o[7]);
        *(LAS v4u*)(dst + (4 * rg + r) * TP + cc * 16) = w; }
}
__device__ __forceinline__ void copy_v_tile(LAS unsigned char* dst, const bf16* PROJ, int row0, int col, int tid) {
#pragma unroll
    for (int k = 0; k < 4; ++k) { const int i = tid + 512 * k, r = i >> 4, cc = i & 15;
        *(LAS v4u*)(dst + r * TP + cc * 16) = *(const v4u*)(PROJ + (size_t)(row0 + r) * NPROJ + col + 8 * cc); }
}
__device__ __forceinline__ void chunk_scan(const float* lf, const float* ig, int row0, int h, int lane, float& b0, float& b1, float& u0, float& u1, float& c0, float& c1) {
    const float a0 = lf[(row0 + 2 * lane) * 4 + h], a1 = lf[(row0 + 2 * lane + 1) * 4 + h];
    const float sp = a0 + a1; float incl = sp;
#pragma unroll
    for (int o = 1; o < 64; o <<= 1) { const float t = __shfl_up(incl, o); if (lane >= o) incl += t; }
    const float excl = incl - sp;
    b0 = excl + a0; b1 = incl;
    u0 = ig[(row0 + 2 * lane) * 4 + h] - b0; u1 = ig[(row0 + 2 * lane + 1) * 4 + h] - b1;
    const float pm = fmaxf(u0, u1); float im = pm;
#pragma unroll
    for (int o = 1; o < 64; o <<= 1) { const float t = __shfl_up(im, o); if (lane >= o) im = fmaxf(im, t); }
    float em = __shfl_up(im, 1); if (lane == 0) em = -INFINITY;
    c0 = fmaxf(em, u0); c1 = im;
}

__device__ __forceinline__ void p3_mlstm_local_mfma(Frame& F) {
    const int tid = F.tid, lane = F.lane, fr = lane & 15, g4 = lane >> 4, w = F.wave;
    LAS unsigned char* sK = F.lds + ML_K; LAS unsigned char* sV = F.lds + ML_V;
    LAS float* sW = (LAS float*)(F.lds + ML_S);
    Claimer C{-2};
    for (int u = claim_unit(F, 1, 512, C); u < 512; u = claim_unit(F, 1, 512, C)) {
        const int bh = u >> 5, c = u & 31, b = bh >> 2, h = bh & 3, row0 = b * SEQ + c * 128;
        __syncthreads();
        if (w == 0) { float b0, b1, u0, u1, c0, c1; chunk_scan(F.lf, F.ig, row0, h, lane, b0, b1, u0, u1, c0, c1);
            const float um = __shfl(c1, 63);
            sW[2 * lane] = __expf(u0 - um); sW[2 * lane + 1] = __expf(u1 - um);
            if (lane == 63) { F.chk[u] = b1; F.chk[512 + u] = um; } }
        copy_v_tile(sV, F.PROJ, row0, C_VB + h * 128, tid);
        __syncthreads();
        build_conv_tile(sK, F.PROJ, row0, c == 0, 512 + h * 128, F.w_conv, F.b_conv, 0.08838834764831845f, sW, tid);
        __syncthreads();
        f32x4 acc[8];
#pragma unroll
        for (int i = 0; i < 8; ++i) acc[i] = (f32x4){0.f, 0.f, 0.f, 0.f};
        const int tro = (4 * g4 + (fr >> 2)) * TP + (fr & 3) * 8;
#pragma unroll
        for (int ks = 0; ks < 4; ++ks) {
            const bf16x8m vt = tr2(sV + ks * 32 * TP + tro + 32 * w);
#pragma unroll
            for (int nb = 0; nb < 8; ++nb) { const bf16x8m kt = tr2(sK + ks * 32 * TP + tro + 32 * nb);
                acc[nb] = __builtin_amdgcn_mfma_f32_16x16x32_bf16(vt, kt, acc[nb], 0, 0, 0); }
        }
#pragma unroll
        for (int nb = 0; nb < 8; ++nb) { v2u o; o.x = pk2(acc[nb][0], acc[nb][1]); o.y = pk2(acc[nb][2], acc[nb][3]);
            *(v2u*)((bf16*)F.L + (size_t)u * 16384 + (16 * nb + fr) * 128 + 16 * w + 4 * g4) = o; }
        { const int d = tid & 127, sq = tid >> 7; float n = 0.f;
#pragma unroll 8
            for (int s2 = 0; s2 < 32; ++s2) n += bf2f(*(const LAS unsigned short*)(sK + (32 * sq + s2) * TP + d * 2));
            sW[128 + sq * 128 + d] = n; }
        __syncthreads();
        if (tid < 128) F.NLOC[u * 128 + tid] = (sW[128 + tid] + sW[256 + tid]) + (sW[384 + tid] + sW[512 + tid]);
    }
}

__device__ __forceinline__ void p5_mlstm_out_mfma(Frame& F) {
    const int tid = F.tid, lane = F.lane, fr = lane & 15, g4 = lane >> 4, w = F.wave;
    LAS unsigned char* sA = F.lds + ML_A; LAS unsigned char* sK = F.lds + ML_K; LAS unsigned char* sV = F.lds + ML_V;
    LAS float* sB = (LAS float*)(F.lds + ML_S); LAS float* sU = sB + 128; LAS float* sG = sU + 128; LAS float* sN = sG + 128;
    const int tro = (4 * g4 + (fr >> 2)) * TP + (fr & 3) * 8;
    Claimer C{-2};
    for (int u = claim_unit(F, 4, 512, C); u < 512; u = claim_unit(F, 4, 512, C)) {
        const int bh = u >> 5, c = u & 31, b = bh >> 2, h = bh & 3, row0 = b * SEQ + c * 128;
        const float mc = F.chk[1024 + u];
        v2u cpre[8];
#pragma unroll
        for (int k = 0; k < 8; ++k) { const int i = tid + 512 * k, d = i >> 5, e4 = i & 31;
            cpre[k] = *(const v2u*)((const bf16*)F.CPRE + (size_t)u * 16384 + d * 128 + 4 * e4); }
        __syncthreads();
        if (w == 0) { float b0, b1, u0, u1, c0, c1; chunk_scan(F.lf, F.ig, row0, h, lane, b0, b1, u0, u1, c0, c1);
            sB[2 * lane] = b0; sB[2 * lane + 1] = b1; sU[2 * lane] = u0; sU[2 * lane + 1] = u1; sG[2 * lane] = fmaxf(mc, c0); sG[2 * lane + 1] = fmaxf(mc, c1); }
        if (w == 1) { sN[lane] = F.NPRE[u * 128 + lane]; sN[64 + lane] = F.NPRE[u * 128 + 64 + lane]; }
        build_conv_tile(sA, F.PROJ, row0, c == 0, h * 128, F.w_conv, F.b_conv, 1.f, nullptr, tid);
        build_conv_tile(sK, F.PROJ, row0, c == 0, 512 + h * 128, F.w_conv, F.b_conv, 0.08838834764831845f, nullptr, tid);
        copy_v_tile(sV, F.PROJ, row0, C_VB + h * 128, tid);
        __syncthreads();
        const int t = 16 * w + fr;
        const float gt = sG[t], bt = sB[t], wi = __expf(mc - gt);
        bf16x8m qf[4];
#pragma unroll
        for (int kd = 0; kd < 4; ++kd) qf[kd] = rd_sigma(sA + t * TP + kd * 64 + 8 * g4);
        float qn = 0.f;
#pragma unroll
        for (int i = 0; i < 4; ++i) { const v4u qq = *(const LAS v4u*)(sA + t * TP + 64 * g4 + 16 * i); const LAS float* nn = sN + 32 * g4 + 8 * i;
            qn += bflo(qq.x) * nn[0] + bfhi(qq.x) * nn[1] + bflo(qq.y) * nn[2] + bfhi(qq.y) * nn[3] + bflo(qq.z) * nn[4] + bfhi(qq.z) * nn[5] + bflo(qq.w) * nn[6] + bfhi(qq.w) * nn[7]; }
        qn += __shfl_xor(qn, 16); qn += __shfl_xor(qn, 32);
        bf16x8m pb[4]; float psum = 0.f;
#pragma unroll
        for (int j = 0; j < 4; ++j) {
            pb[j] = (bf16x8m){0, 0, 0, 0, 0, 0, 0, 0};
            if (j <= (w >> 1)) {
                f32x4 sv[2];
#pragma unroll
                for (int sub = 0; sub < 2; ++sub) { sv[sub] = (f32x4){0.f, 0.f, 0.f, 0.f};
                    const LAS unsigned char* kr = sK + (32 * j + 16 * sub + fr) * TP + 8 * g4;
#pragma unroll
                    for (int kd = 0; kd < 4; ++kd) sv[sub] = __builtin_amdgcn_mfma_f32_16x16x32_bf16(rd_sigma(kr + kd * 64), qf[kd], sv[sub], 0, 0, 0);
                    const f32x4 us = *(const LAS f32x4*)(sU + 32 * j + 16 * sub + 4 * g4);
#pragma unroll
                    for (int i = 0; i < 4; ++i) { const int s2 = 32 * j + 16 * sub + 4 * g4 + i; const float pv = (s2 <= t) ? sv[sub][i] * __expf(us[i] - gt) : 0.f; sv[sub][i] = pv; psum += pv; } }
                v4u pw; pw.x = pk2(sv[0][0], sv[0][1]); pw.y = pk2(sv[0][2], sv[0][3]); pw.z = pk2(sv[1][0], sv[1][1]); pw.w = pk2(sv[1][2], sv[1][3]);
                pb[j] = __builtin_bit_cast(bf16x8m, pw);
            }
        }
        psum += __shfl_xor(psum, 16); psum += __shfl_xor(psum, 32);
        const float den = wi * qn + psum, dinv = 1.f / fmaxf(fabsf(den), __expf(-(bt + gt)));
        __syncthreads();
#pragma unroll
        for (int k = 0; k < 8; ++k) { const int i = tid + 512 * k, d = i >> 5, e4 = i & 31; *(LAS v2u*)(sA + d * TP + e4 * 8) = cpre[k]; }
        __syncthreads();
        v2u obr[8];
#pragma unroll
        for (int eb = 0; eb < 8; ++eb) obr[eb] = *(const v2u*)(F.PROJ + (size_t)(row0 + t) * NPROJ + C_OB + h * 128 + 16 * eb + 4 * g4);
        f32x4 acc[8];
#pragma unroll
        for (int i = 0; i < 8; ++i) acc[i] = (f32x4){0.f, 0.f, 0.f, 0.f};
#pragma unroll
        for (int kd = 0; kd < 4; ++kd)
#pragma unroll
            for (int eb = 0; eb < 8; ++eb) acc[eb] = __builtin_amdgcn_mfma_f32_16x16x32_bf16(tr2(sA + kd * 32 * TP + tro + 32 * eb), qf[kd], acc[eb], 0, 0, 0);
#pragma unroll
        for (int eb = 0; eb < 8; ++eb) acc[eb] = acc[eb] * wi;
#pragma unroll
        for (int j = 0; j < 4; ++j)
            if (j <= (w >> 1)) {
#pragma unroll
                for (int eb = 0; eb < 8; ++eb) acc[eb] = __builtin_amdgcn_mfma_f32_16x16x32_bf16(tr2(sV + j * 32 * TP + tro + 32 * eb), pb[j], acc[eb], 0, 0, 0); }
        float ssq = 0.f;
#pragma unroll
        for (int eb = 0; eb < 8; ++eb) { acc[eb] = acc[eb] * dinv; ssq += (acc[eb][0] * acc[eb][0] + acc[eb][1] * acc[eb][1]) + (acc[eb][2] * acc[eb][2] + acc[eb][3] * acc[eb][3]); }
        ssq += __shfl_xor(ssq, 16); ssq += __shfl_xor(ssq, 32);
        const float rs = 1.f / sqrtf(ssq * (1.f / 128.f) + EPS);
        const int row = row0 + t;
#pragma unroll
        for (int eb = 0; eb < 8; ++eb) { const int e = 16 * eb + 4 * g4;
            const v2u ob = obr[eb]; const f32x4 gg = *(const f32x4*)(F.mhg + h * 128 + e);
            v2u o; o.x = pk2(acc[eb][0] * rs * gg.x * sigmoidf_(bflo(ob.x)), acc[eb][1] * rs * gg.y * sigmoidf_(bfhi(ob.x)));
            o.y = pk2(acc[eb][2] * rs * gg.z * sigmoidf_(bflo(ob.y)), acc[eb][3] * rs * gg.w * sigmoidf_(bfhi(ob.y)));
            *(v2u*)(F.MIX + (size_t)row * DM + 512 + h * 128 + e) = o; }
    }
}

__device__ __forceinline__ void p3_mlstm_sample(Frame& F) {
    const int tid = F.tid;
    LAS float* sQ = (LAS float*)F.lds;
    LAS float* sKs = sQ + 1024;
    LAS float* sV = sKs + 1024;
    LAS float* sQC = sV + 1024;
    LAS float* sH = sQC + 16384;
    LAS float* sN0 = sH + 1024;
    LAS float* sS = sN0 + 128;
    Claimer C{-2};
    for (int u = claim_unit(F, 2, 512, C); u < 512; u = claim_unit(F, 2, 512, C)) {
        const int b = u >> 2, h = u & 3, r0 = MP + b * DTS;
        __syncthreads();
        for (int i = tid; i < 2048; i += 512) { const int part = i >> 10, t = (i >> 7) & 7, d = i & 127, col = part * 512 + h * 128 + d;
            float a = F.b_conv[col];
#pragma unroll
            for (int w = 0; w < 4; ++w) { const int tt = t + w - 3;
                const float xv = (tt >= 0) ? bf2f(F.PROJ[(size_t)(r0 + tt) * NPROJ + C_RAW + col]) : F.st_conv[((size_t)b * 3 + (3 + tt)) * 1024 + col];
                a += xv * F.w_conv[w * 1024 + col]; }
            const float sv = a * sigmoidf_(a);
            if (part == 0) sQ[t * 128 + d] = sv; else sKs[t * 128 + d] = sv * 0.08838834764831845f; }
        for (int i = tid; i < 1024; i += 512) sV[i] = bf2f(F.PROJ[(size_t)(r0 + (i >> 7)) * NPROJ + C_VB + h * 128 + (i & 127)]);
        if (tid < 128) sN0[tid] = F.st_n[(size_t)u * 128 + tid];
        if (F.wave == 7) {
            const int t = F.lane & 7; const float m0 = F.st_m[u];
            const float lfv = F.lf[(r0 + t) * 4 + h], igv = F.ig[(r0 + t) * 4 + h];
            float acc = lfv;
#pragma unroll
            for (int o = 1; o < 8; o <<= 1) { const float x = __shfl_up(acc, o); if (t >= o) acc += x; }
            const float uu = igv - acc;
            float cm = uu;
#pragma unroll
            for (int o = 1; o < 8; o <<= 1) { const float x = __shfl_up(cm, o); if (t >= o) cm = fmaxf(cm, x); }
            const float um = __shfl(cm, 7), b7 = __shfl(acc, 7);
            cm = fmaxf(cm, m0);
            const float Mx = fmaxf(m0, um);
            if (F.lane < 8) { sS[t] = acc; sS[8 + t] = uu; sS[16 + t] = cm; sS[24 + t] = __expf(m0 - cm); sS[32 + t] = __expf(uu - Mx); }
            if (F.lane == 0) { sS[40] = __expf(m0 - Mx); F.out[O_SM + u] = b7 + Mx; }
        }
        __syncthreads();
        { const int pr = tid >> 3, part = tid & 7, t = pr >> 3, s = pr & 7; float d = 0.f;
#pragma unroll
            for (int k4 = 0; k4 < 4; ++k4) { const f32x4 qa = *(const LAS f32x4*)(sQ + t * 128 + 16 * part + 4 * k4), kb = *(const LAS f32x4*)(sKs + s * 128 + 16 * part + 4 * k4);
                d += (qa.x * kb.x + qa.y * kb.y) + (qa.z * kb.z + qa.w * kb.w); }
            d += __shfl_xor(d, 1); d += __shfl_xor(d, 2); d += __shfl_xor(d, 4);
            if (part == 0) sS[64 + pr] = (s <= t) ? d * __expf(sS[8 + s] - sS[16 + t]) : 0.f; }
        {
            const int e4 = opaque(tid & 31), dr = opaque(tid >> 5); const float alpha = sS[40];
            f32x4 vb[8], aq[8];
#pragma unroll
            for (int s2 = 0; s2 < 8; ++s2) { vb[s2] = *(const LAS f32x4*)(sV + s2 * 128 + 4 * e4) * sS[32 + s2]; aq[s2] = (f32x4){0.f, 0.f, 0.f, 0.f}; }
            f32x4 c0[8];
#pragma unroll
            for (int it = 0; it < 8; ++it) c0[it] = __builtin_nontemporal_load((const f32x4*)(F.st_C + ((size_t)u * 128 + it * 16 + dr) * 128 + 4 * e4));
#pragma unroll
            for (int it = 0; it < 8; ++it) { const int d = it * 16 + dr;
                f32x4 cn = c0[it] * alpha;
#pragma unroll
                for (int s2 = 0; s2 < 8; ++s2) { cn += vb[s2] * sKs[s2 * 128 + d]; aq[s2] += c0[it] * sQ[s2 * 128 + d]; }
                __builtin_nontemporal_store(cn, (f32x4*)(F.out + O_SC + ((size_t)u * 128 + d) * 128 + 4 * e4)); }
#pragma unroll
            for (int s2 = 0; s2 < 8; ++s2) *(LAS f32x4*)(sQC + (dr * 8 + s2) * 128 + 4 * e4) = aq[s2];
        }
        if (tid < 128) { float n = sS[40] * sN0[tid];
#pragma unroll
            for (int s = 0; s < 8; ++s) n += sS[32 + s] * sKs[s * 128 + tid];
            F.out[O_SN + (size_t)u * 128 + tid] = n; }
        __syncthreads();
        { const int t = F.wave; float qn = sQ[t * 128 + F.lane] * sN0[F.lane] + sQ[t * 128 + 64 + F.lane] * sN0[64 + F.lane];
            qn = wave_sum(qn);
            if (F.lane == 0) { float den = sS[24 + t] * qn;
#pragma unroll
                for (int s2 = 0; s2 < 8; ++s2) den += sS[64 + t * 8 + s2];
                sS[48 + t] = fmaxf(fabsf(den), __expf(-(sS[t] + sS[16 + t]))); } }
        __syncthreads();
        { const int e = tid & 127, tq = tid >> 7;
#pragma unroll
            for (int k = 0; k < 2; ++k) { const int t = tq * 2 + k;
                float qc = 0.f;
#pragma unroll
                for (int dr = 0; dr < 16; ++dr) qc += sQC[(dr * 8 + t) * 128 + e];
                float num = sS[24 + t] * qc;
#pragma unroll
                for (int s = 0; s < 8; ++s) num += sS[64 + t * 8 + s] * sV[s * 128 + e];
                sH[t * 128 + e] = num / sS[48 + t]; } }
        __syncthreads();
        { const int t = F.wave; const float h0 = sH[t * 128 + F.lane], h1 = sH[t * 128 + 64 + F.lane];
            const float ssq = wave_sum(h0 * h0 + h1 * h1); const float rs = 1.f / sqrtf(ssq * (1.f / 128.f) + EPS);
            const int row = r0 + t;
#pragma unroll
            for (int k = 0; k < 2; ++k) { const int e = F.lane + 64 * k; const float hv = k ? h1 : h0;
                const float ob = bf2f(F.PROJ[(size_t)row * NPROJ + C_OB + h * 128 + e]);
                F.MIX[(size_t)row * DM + 512 + h * 128 + e] = (bf16)f2bf(hv * rs * F.mhg[h * 128 + e] * sigmoidf_(ob)); } }
    }
}

__device__ __forceinline__ void p4_prefix_v1(Frame& F) {
    const int tid = F.tid;
    const int npw = (F.G >= 64) ? F.G - 16 : F.G;
    for (int u = F.vcu; u < 256; u += npw) {
        const int chain = u >> 4, sl = u & 15, idx = sl * 1024 + tid * 2;
        float m = 0.f, c0 = 0.f, c1 = 0.f, nn = 0.f;
        const bool nrow = (sl == 0 && tid < 128);
#pragma unroll 1
        for (int cb = 0; cb < 32; cb += 8) {
            float l0[8], l1[8], nl[8], bc[8], um8[8];
#pragma unroll
            for (int k = 0; k < 8; ++k) { const int unit = chain * 32 + cb + k;
                const unsigned lw = *(const unsigned*)((const bf16*)F.L + (size_t)unit * 16384 + idx); l0[k] = bflo(lw); l1[k] = bfhi(lw);
                nl[k] = nrow ? F.NLOC[unit * 128 + tid] : 0.f; bc[k] = F.chk[unit]; um8[k] = F.chk[512 + unit]; }
#pragma unroll
            for (int k = 0; k < 8; ++k) { const int unit = chain * 32 + cb + k;
                *(unsigned*)((bf16*)F.CPRE + (size_t)unit * 16384 + idx) = pk2(c0, c1);
                if (nrow) F.NPRE[unit * 128 + tid] = nn;
                if (sl == 0 && tid == 0) F.chk[1024 + unit] = m;
                const float Mx = fmaxf(m, um8[k]), a = __expf(m - Mx), bb = __expf(um8[k] - Mx);
                c0 = a * c0 + bb * l0[k]; c1 = a * c1 + bb * l1[k]; nn = a * nn + bb * nl[k];
                m = bc[k] + Mx; }
        }
        F.out[O_PC + (size_t)chain * 16384 + idx] = c0; F.out[O_PC + (size_t)chain * 16384 + idx + 1] = c1;
        if (sl == 0 && tid < 128) F.out[O_PN + chain * 128 + tid] = nn;
        if (sl == 0 && tid == 0) F.out[O_PM + chain] = m;
    }
}


__device__ __forceinline__ void probe_copy_simple(Frame& F) {
    constexpr int PER_B = (WBUF - DTS) * 128;
    const int total = DBS * PER_B;
    for (int i = F.vcu * 512 + F.tid; i < total; i += F.G * 512) {
        const int b = i / PER_B, r = i - b * PER_B;
        const size_t so = (size_t)b * (WBUF * 128) + DTS * 128 + r, dofs = (size_t)b * (WBUF * 128) + r;
        const f32x4 a = __builtin_nontemporal_load((const f32x4*)F.cache_k + so);
        const f32x4 c = __builtin_nontemporal_load((const f32x4*)F.cache_v + so);
        *((f32x4*)(F.out + O_SK) + dofs) = a;
        *((f32x4*)(F.out + O_SV) + dofs) = c;
    }
}


template <int NCU, int UNR>
__device__ __forceinline__ void probe_copy_subset(Frame& F) {
    constexpr int STEP = 256 / NCU;
    if (F.vcu % STEP) return;
    const int me = F.vcu / STEP;
    constexpr int PER_B = (WBUF - DTS) * 128;
    const int total = DBS * PER_B;
    for (int i0 = me * 512 * UNR + F.tid; i0 < total; i0 += NCU * 512 * UNR) {
        f32x4 a[UNR], c[UNR];
#pragma unroll
        for (int k = 0; k < UNR; ++k) { int i = i0 + 512 * k; i = i < total ? i : total - 1; const int b = i / PER_B, r = i - b * PER_B;
            const size_t so = (size_t)b * (WBUF * 128) + DTS * 128 + r;
            a[k] = __builtin_nontemporal_load((const f32x4*)F.cache_k + so); c[k] = __builtin_nontemporal_load((const f32x4*)F.cache_v + so); }
#pragma unroll
        for (int k = 0; k < UNR; ++k) { int i = i0 + 512 * k; i = i < total ? i : total - 1; const int b = i / PER_B, r = i - b * PER_B;
            const size_t dofs = (size_t)b * (WBUF * 128) + r;
            *((f32x4*)(F.out + O_SK) + dofs) = a[k]; *((f32x4*)(F.out + O_SV) + dofs) = c[k]; }
    }
}

__device__ __forceinline__ void p9_final_norm(Frame& F, int m0) {
    const int gw = F.vcu * 8 + F.wave, NGW = F.G * 8;
    for (int m = m0 + gw; m < M; m += NGW) {
        f32x4* p = (f32x4*)(F.out + (size_t)m * DM);
        f32x4 v[4]; float ss = 0.f;
#pragma unroll
        for (int j = 0; j < 4; ++j) { v[j] = p[64 * j + F.lane];
            if (m >= MP) {
#pragma unroll
                for (int ks = 0; ks < 8; ++ks) v[j] += *((const f32x4*)(F.ws + WS_PART) + ((size_t)ks * MS + (m - MP)) * 256 + 64 * j + F.lane); }
            ss += (v[j].x * v[j].x + v[j].y * v[j].y) + (v[j].z * v[j].z + v[j].w * v[j].w); }
        ss = wave_sum(ss);
        const float rs = 1.f / sqrtf(ss * (1.f / DM) + EPS);
#pragma unroll
        for (int j = 0; j < 4; ++j) { const f32x4 g = *(const f32x4*)(F.gf + 256 * j + 4 * F.lane); p[64 * j + F.lane] = v[j] * rs * g; }
    }
}

__device__ __forceinline__ void help_convert(Frame& F, int phase) {
    unsigned* ctl = (unsigned*)(F.ws + WS_CPY);
    unsigned* ctr = (unsigned*)(F.ws + WS_CLAIM) + 64 * 3;
    volatile LAS int* sh = (volatile LAS int*)(F.lds + MISC_OFF + 64);
    LAS float* scr = (LAS float*)(F.lds + F.wave * 16384);
    constexpr int I_UP = 16 * 128, I_DN = 64 * 32;
    __syncthreads();
    if (phase >= 0 && F.tid == 0) __hip_atomic_fetch_add(ctl + 64 * (1 + phase), 1u, __ATOMIC_RELAXED, __HIP_MEMORY_SCOPE_AGENT);
    for (;;) {
        if (F.tid == 0) { int c0 = -1;
            const bool busy = (phase < 0) || (__hip_atomic_load(ctl + 64 * (1 + phase), __ATOMIC_RELAXED, __HIP_MEMORY_SCOPE_AGENT) < (unsigned)F.G);
            if (busy) { const unsigned c = __hip_atomic_fetch_add(ctr, 8u, __ATOMIC_RELAXED, __HIP_MEMORY_SCOPE_AGENT); if (c < (unsigned)(I_UP + I_DN)) c0 = (int)c; }
            sh[0] = c0; }
        __syncthreads();
        const int c0 = sh[0];
        __syncthreads();
        if (c0 < 0) break;
        const int it = c0 + F.wave;
        if (it < I_UP) p0_transpose_item(F.w_up, DM, FF, 128, F.g2, F.Wup_t, scr, it, F.lane);
        else p0_transpose_item(F.w_down, FF, DM, 32, nullptr, F.Wdn_t, scr, it - I_UP, F.lane);
    }
}

struct Args { const float* in[19]; float* out; unsigned char* ws; int ph_lo, ph_hi; };
__global__ void __launch_bounds__(512, 2) fwd(Args args) {
    extern __shared__ __attribute__((aligned(16))) unsigned char lds[];
    Frame F;
    F.lds = (LAS unsigned char*)lds;
    F.tid = threadIdx.x; F.lane = F.tid & 63; F.wave = __builtin_amdgcn_readfirstlane(F.tid >> 6);
    F.G = gridDim.x; { const int bx = blockIdx.x; F.vcu = (F.G % 8 == 0) ? (bx % 8) * (F.G / 8) + bx / 8 : bx; }
    F.xp = args.in[0]; F.xs = args.in[1]; F.cache_k = args.in[2]; F.cache_v = args.in[3]; F.st_conv = args.in[4]; F.st_C = args.in[5]; F.st_n = args.in[6]; F.st_m = args.in[7];
    F.g1 = args.in[8]; F.w_in = args.in[9]; F.b_gate = args.in[10]; F.w_conv = args.in[11]; F.b_conv = args.in[12]; F.mhg = args.in[13]; F.w_out = args.in[14]; F.g2 = args.in[15];
    F.w_up = args.in[16]; F.w_down = args.in[17]; F.gf = args.in[18];
    F.out = args.out; F.ws = args.ws;
    unsigned char* ws = args.ws;
    F.Win_t = (bf16*)(ws + WS_WIN); F.Wout_t = (bf16*)(ws + WS_WOUT); F.Wup_t = (bf16*)(ws + WS_WUP); F.Wdn_t = (bf16*)(ws + WS_WDN);
    F.XB = (bf16*)(ws + WS_XB); F.PROJ = (bf16*)(ws + WS_PROJ); F.MIX = (bf16*)(ws + WS_MIX); F.HPB = (bf16*)(ws + WS_HPB); F.ACT = (bf16*)(ws + WS_ACT);
    F.rope = (float*)(ws + WS_ROPE); F.rstd1 = (float*)(ws + WS_RSTD1); F.ig = (float*)(ws + WS_IG); F.lf = (float*)(ws + WS_LF); F.chk = (float*)(ws + WS_CHK);
    F.ss2 = (float*)(ws + WS_SS2P); F.ssf = (float*)(ws + WS_SSFP); F.QF = (float*)(ws + WS_QF); F.KF = (float*)(ws + WS_KF); F.L = (float*)(ws + WS_L);
    F.CPRE = (float*)(ws + WS_CPRE); F.NLOC = (float*)(ws + WS_NLOC); F.NPRE = (float*)(ws + WS_NPRE);
    volatile LAS unsigned* MISC = (volatile LAS unsigned*)(F.lds + MISC_OFF);
    if (F.tid < 32) MISC[F.tid] = 0u;
    __syncthreads();
    XcdBarrier bar; bar.bar = (unsigned*)(ws + WS_CTL) + CW_BAR; bar.x = 0; bar.st = nullptr;
    if (!PER_PHASE_LAUNCH) bar = xcd_barrier_post((unsigned*)(ws + WS_CTL) + CW_BAR, MISC + 8);
#ifdef STAMP_SEL
    volatile LAS unsigned long long* stamps = (volatile LAS unsigned long long*)(F.lds + MISC_OFF + 256);
    int n_stamp = 0;
#define STAMP() do { if (blockIdx.x == 0 && F.tid == 0) stamps[n_stamp] = __builtin_amdgcn_s_memrealtime(); ++n_stamp; } while (0)
#else
#define STAMP() do { } while (0)
#endif
    STAMP();
#define GRID_BAR() do { if (!PER_PHASE_LAUNCH) xcd_barrier(bar); STAMP(); } while (0)
#ifdef SUBSTAMPS
#define SUBSTAMP() STAMP()
#else
#define SUBSTAMP() do { } while (0)
#endif
    const int lo = args.ph_lo, hi = args.ph_hi;
#ifndef PHASE_MASK
#define PHASE_MASK 0x3ff
#endif
#define IN(k) (((PHASE_MASK >> (k)) & 1) && lo <= (k) && (k) < hi)
#ifndef DUP_MASK
#define DUP_MASK 0
#endif
#define DUP(k) ((DUP_MASK >> (k)) & 1)
#ifndef HELP_MASK
#define HELP_MASK 0x92
#endif
#define HELP(k) ((HELP_MASK >> (k)) & 1)
    if (IN(0)) { p0_prologue(F); if (DUP(0)) { __syncthreads(); p0_prologue(F); } if (HELP(0)) help_copy(F, 0); GRID_BAR(); }
    if (IN(1)) {
        pg8::Gemm g{F.XB, F.Win_t, M, NPROJ, DM, DM}; pg8::StaticOrder S; S.init(M, NPROJ, F.G, (int)blockIdx.x);
        pg8::EpiIn E{F.PROJ, F.rstd1, F.rope, F.out};
        pg8::gemm_phase<pg8::EpiIn, pg8::StaticOrder, true, true>(F.lds, g, S, E);
        if (DUP(1)) { __syncthreads(); pg8::gemm_phase<pg8::EpiIn, pg8::StaticOrder, true, true>(F.lds, g, S, E); }
        if (HELP(1)) { help_convert(F, 1); help_copy(F, 1, false); }
        GRID_BAR();
    }
#ifndef QUOTA_ATT
#define QUOTA_ATT 0
#endif
#ifndef ANTIPHASE
#define ANTIPHASE 1
#endif
#ifndef SAMPLE_UP_IN_P5
#define SAMPLE_UP_IN_P5 0
#endif
#ifndef ATT_LIM
#define ATT_LIM 600
#endif
    if (IN(2)) {
        if (ANTIPHASE && !((F.vcu >> 1) & 1)) {   Claimer CA{-2}; p2_attn_prompt_mfma(F, ATT_LIM, CA); SUBSTAMP(); __syncthreads(); p2_sample_stream<true>(F); SUBSTAMP(); __syncthreads(); p2_attn_prompt_mfma(F, 1 << 30, CA); __syncthreads(); }
        else { Claimer CA{-2}; p2_sample_stream<true>(F); SUBSTAMP(); __syncthreads(); p2_attn_prompt_mfma(F, 1 << 30, CA); SUBSTAMP(); __syncthreads(); }
    }
    if (IN(3)) { p3_mlstm_local_mfma(F); SUBSTAMP(); p3_mlstm_sample(F); SUBSTAMP(); if (HELP(3)) help_copy(F, 3); GRID_BAR(); }
    if (IN(4)) {
        if (F.G >= 64 && F.vcu >= F.G - 16) {
            pg8::Gemm g{F.MIX, F.Wout_t, M, DM, DM, DM}; pg8::RangeOrder S{MP / 256, MS / 256, DM / 256, 1, 0, 16, F.vcu - (F.G - 16)};
            pg8::EpiOut<true> E{F.xp, F.xs, F.out, F.HPB, F.ss2, F.XB};
            pg8::gemm_phase<pg8::EpiOut<true>, pg8::RangeOrder, true, true>(F.lds, g, S, E);
            if (DUP(4)) { __syncthreads(); pg8::EpiScratch E2{(float*)(F.ws + WS_SCR)}; pg8::gemm_phase<pg8::EpiScratch, pg8::RangeOrder, true, true>(F.lds, g, S, E2); }
        } else { p4_prefix_v1(F); if (DUP(4)) { __syncthreads(); p4_prefix_v1(F); } help_convert(F, -1); }
#ifndef P4_HELPERS
#define P4_HELPERS 256
#endif
        if (HELP(4)) { if (F.vcu < P4_HELPERS) help_copy(F, 4); else help_copy(F, 4, true, true); }
        GRID_BAR();
    }
    if (IN(5)) {
        if (SAMPLE_UP_IN_P5 && F.G == 256) {
            pg8::Gemm g{F.HPB, F.Wup_t, M, FF, DM, DM}; pg8::RangeOrder S{MP / 256, MS / 256, FF / 256, 1, 0, F.G, F.vcu};
            pg8::EpiUp E{F.ACT, F.ss2};
            pg8::gemm_phase<pg8::EpiUp, pg8::RangeOrder, true, true>(F.lds, g, S, E);
            __syncthreads();
        }
        p5_mlstm_out_mfma(F); if (DUP(5)) { __syncthreads(); p5_mlstm_out_mfma(F); } if (HELP(5)) help_copy(F, 5); GRID_BAR(); }
    if (IN(6)) {
        pg8::Gemm g{F.MIX, F.Wout_t, MP, DM, DM, DM}; pg8::StaticOrder S; S.init(MP, DM, F.G, (int)blockIdx.x);
        if (F.G == 256) { pg8::EpiOut<false> E{F.xp, F.xs, F.out, F.HPB, F.ss2, F.XB}; pg8::gemm_phase<pg8::EpiOut<false>, pg8::StaticOrder, true, true>(F.lds, g, S, E); }
        else { pg8::EpiOut<true> E{F.xp, F.xs, F.out, F.HPB, F.ss2, F.XB}; pg8::gemm_phase<pg8::EpiOut<true>, pg8::StaticOrder, true, true>(F.lds, g, S, E); }
        if (DUP(6)) { __syncthreads(); pg8::EpiScratch E2{(float*)(F.ws + WS_SCR)}; pg8::gemm_phase<pg8::EpiScratch, pg8::StaticOrder, true, true>(F.lds, g, S, E2); }
        if (HELP(6)) help_copy(F, 6);
        GRID_BAR();
    }
    if (IN(7)) {
        const int mrows = (SAMPLE_UP_IN_P5 && F.G == 256) ? MP : M;
        pg8::Gemm g{F.HPB, F.Wup_t, mrows, FF, DM, DM}; pg8::StaticOrder S; S.init(mrows, FF, F.G, (int)blockIdx.x);
        pg8::EpiUp E{F.ACT, F.ss2};
        pg8::gemm_phase<pg8::EpiUp, pg8::StaticOrder, true, true>(F.lds, g, S, E);
        if (DUP(7)) { __syncthreads(); pg8::gemm_phase<pg8::EpiUp, pg8::StaticOrder, true, true>(F.lds, g, S, E); }
        if (HELP(7)) help_copy(F, 7);
        GRID_BAR();
    }
    if (IN(8)) {
        {
            pg8::Gemm g{F.ACT, F.Wdn_t, MP, DM, FF, FF}; pg8::StaticOrder S; S.init(MP, DM, F.G, (int)blockIdx.x);
            if (F.G == 256) { pg8::EpiDownNorm E{F.out, F.HPB, F.ssf, (unsigned*)(F.ws + WS_PCNT), F.gf};
                pg8::gemm_phase<pg8::EpiDownNorm, pg8::StaticOrder, true, true>(F.lds, g, S, E); }
            else { pg8::EpiDown<false> E{F.out};
                pg8::gemm_phase<pg8::EpiDown<false>, pg8::StaticOrder, true, true>(F.lds, g, S, E); }
        }
        if (DUP(8)) { __syncthreads(); pg8::Gemm g{F.ACT, F.Wdn_t, MP, DM, FF, FF}; pg8::StaticOrder S; S.init(MP, DM, F.G, (int)blockIdx.x);
            pg8::EpiScratch E{(float*)(F.ws + WS_SCR)}; pg8::gemm_phase<pg8::EpiScratch, pg8::StaticOrder, true, true>(F.lds, g, S, E); }
        if (HELP(8)) help_copy(F, 8);
        GRID_BAR();
    }
    if (DUP(15)) { for (int k = 0; k < 8; ++k) GRID_BAR(); }
    if (IN(9)) {
        {
            pg8::Gemm g{F.ACT, F.Wdn_t, M, DM, 512, FF}; pg8::RangeOrder S{MP / 256, MS / 256, DM / 256, 8, 512, F.G, F.vcu};
            pg8::EpiPartial E{(float*)(F.ws + WS_PART), 512};
            pg8::gemm_phase<pg8::EpiPartial, pg8::RangeOrder, true, true>(F.lds, g, S, E);
        }
        help_copy(F, -1);
        GRID_BAR();
        p9_final_norm(F, (F.G == 256) ? MP : 0); if (DUP(9)) { const int gw = F.vcu * 8 + F.wave, NGW = F.G * 8; for (int m = gw; m < M; m += NGW) { const f32x4* p = (const f32x4*)(F.out + (size_t)m * DM); f32x4* q = (f32x4*)(F.ws + WS_SCR) + (size_t)m * 256; f32x4 v[4]; float ss = 0.f;
#pragma unroll
        for (int j = 0; j < 4; ++j) { v[j] = p[64 * j + F.lane]; ss += v[j].x * v[j].x + v[j].y * v[j].y + v[j].z * v[j].z + v[j].w * v[j].w; }
        ss = wave_sum(ss); const float rs = 1.f / sqrtf(ss * (1.f / DM) + EPS);
#pragma unroll
        for (int j = 0; j < 4; ++j) q[64 * j + F.lane] = v[j] * rs; } } }
    STAMP();
#ifdef STAMP_SEL
    if (blockIdx.x == 0 && F.tid == 0) F.out[O_PM] += (float)(stamps[STAMP_SEL + 1] - stamps[STAMP_SEL]) * 0.01f;
#endif
#undef IN
}

extern "C" void kernel_launch(void* const* d_in, const int* in_sizes, int n_in, void* d_out, int out_size, void* d_ws, size_t ws_size, hipStream_t stream) {
    static int grid = 0;
    if (grid == 0) {
        if (n_in != 19 || (size_t)out_size != O_END || ws_size < WS_END) { fprintf(stderr, "kernel_launch: unexpected shapes (n_in %d out %d ws %zu)\n", n_in, out_size, ws_size); grid = -1; return; }
        int dev = 0, cus = 0, per_cu = 0;
        if (hipGetDevice(&dev) != hipSuccess || hipDeviceGetAttribute(&cus, hipDeviceAttributeMultiprocessorCount, dev) != hipSuccess) { grid = -1; return; }
        if (hipFuncSetAttribute((const void*)fwd, hipFuncAttributeMaxDynamicSharedMemorySize, LDS_BYTES) != hipSuccess) { fprintf(stderr, "kernel_launch: hipFuncSetAttribute failed\n"); grid = -1; return; }
        if (hipOccupancyMaxActiveBlocksPerMultiprocessor(&per_cu, (const void*)fwd, 512, LDS_BYTES) != hipSuccess || per_cu < 1) fprintf(stderr, "kernel_launch: occupancy query says %d\n", per_cu);
        (void)hipGetLastError();
        grid = cus;
    }
    if (grid < 0) return;
    if (hipMemsetAsync((char*)d_ws + WS_CTL, 0, CTL_ZERO_BYTES, stream) != hipSuccess) return;
    Args a{};
    for (int i = 0; i < 19; ++i) a.in[i] = (const float*)d_in[i];
    a.out = (float*)d_out; a.ws = (unsigned char*)d_ws;
#if PER_PHASE_LAUNCH
    for (int ph = 0; ph < NPH; ++ph) { a.ph_lo = ph; a.ph_hi = ph + 1; hipLaunchKernelGGL(fwd, dim3(grid), dim3(512), LDS_BYTES, stream, a); }
#else
    a.ph_lo = 0; a.ph_hi = NPH; hipLaunchKernelGGL(fwd, dim3(grid), dim3(512), LDS_BYTES, stream, a);
#endif
}
```
